# Optimizing an MI355X kernel written in HIP

```python
import math
import jax, jax.numpy as jnp
from jax import lax
import numpy as np

D_MODEL = 1024
BATCH = 4
SEQ = 8192
DEPTH = 2

GRID_W = 64
CTX_LEN = 256
EPS = 1e-6
ROPE_THETA = 10000.0
Q_BLOCK = 128

MIX_HALF = D_MODEL // 2
HEAD_DIM = 64
GQA_Q_HEADS = MIX_HALF // HEAD_DIM
GQA_KV_HEADS = GQA_Q_HEADS // 4
GQA_IN = (GQA_Q_HEADS + 2 * GQA_KV_HEADS) * HEAD_DIM

HG_DK = 128
HG_DV = 128
HG_HEADS = MIX_HALF // HG_DV
HG_W = HG_HEADS * HG_DK
HG_IN = 5 * HG_W
GLA_CHUNK = 64

MLA_HEADS = MIX_HALF // HEAD_DIM
MLA_NOPE = 64
MLA_ROPE = 32
MLA_V = 64
MLA_Q_RANK = 384
MLA_KV_RANK = 256
MLA_IN = MLA_Q_RANK + MLA_KV_RANK + MLA_ROPE

S5_WIDTH = MIX_HALF
S5_GROUP = 16
S5_GROUPS = S5_WIDTH // S5_GROUP
S5_STATE = 64

EVEN_IN = GQA_IN + HG_IN
ODD_IN = MLA_IN + S5_WIDTH
MIX_OUT = 2 * MIX_HALF

PEER_HEADS = 8
PEER_KEYS = 128
N_EXPERTS = PEER_KEYS * PEER_KEYS
PEER_TOPK = 16
PEER_QDIM = 256
PEER_HALF = PEER_QDIM // 2
PEER_BLOCK = 128

N_EVEN = (DEPTH + 1) // 2
N_ODD = DEPTH // 2

kernel_name = 'hybrid_gqa_hgrn2_mla_s5_peer_dit'


def _rms_norm(x, g):
    xf = x.astype(jnp.float32)
    y = xf * lax.rsqrt(jnp.mean(xf * xf, axis=-1, keepdims=True) + EPS)
    return (y * g.astype(jnp.float32)).astype(x.dtype)


def _modulate(h, shift, scale):
    return h * (1.0 + scale) + shift


def _axial_angles(rows, rot_dim):
    axis_dim = rot_dim // 2
    inv = ROPE_THETA ** (-jnp.arange(0, axis_dim, 2, dtype=jnp.float32) / axis_dim)
    t = jnp.arange(rows * GRID_W)
    r = (t // GRID_W).astype(jnp.float32)
    col = (t % GRID_W).astype(jnp.float32)
    return r[:, None] * inv, col[:, None] * inv


def _rope_1d(x, ang):
    cos = jnp.cos(ang)[:, None, :]
    sin = jnp.sin(ang)[:, None, :]
    x1, x2 = jnp.split(x.astype(jnp.float32), 2, axis=-1)
    return jnp.concatenate([x1 * cos - x2 * sin, x1 * sin + x2 * cos], axis=-1).astype(x.dtype)


def _rope_2d(x, angs):
    xr, xc = jnp.split(x, 2, axis=-1)
    return jnp.concatenate([_rope_1d(xr, angs[0]), _rope_1d(xc, angs[1])], axis=-1)


def _attend(q, k, v):
    b, hk, g, t, dq = q.shape
    nb = t // Q_BLOCK
    qb = jnp.moveaxis(q.reshape(b, hk, g, nb, Q_BLOCK, dq), 3, 0)
    scale = dq ** -0.5

    def block(qi):
        s = jnp.einsum('bhgqd,bhkd->bhgqk', qi, k).astype(jnp.float32) * scale
        p = jax.nn.softmax(s, axis=-1).astype(v.dtype)
        return jnp.einsum('bhgqk,bhkd->bhgqd', p, v)

    o = lax.map(block, qb)
    return jnp.moveaxis(o, 0, 3).reshape(b, hk, g, t, v.shape[-1])


def _merge_heads(o):
    return o.transpose(0, 3, 1, 2, 4).reshape(o.shape[0], o.shape[3], -1)


def _gqa(pa, pc, qn_g, kn_g, angs, need_ctx):
    nq = GQA_Q_HEADS * HEAD_DIM
    nk = GQA_KV_HEADS * HEAD_DIM
    grp = GQA_Q_HEADS // GQA_KV_HEADS

    def parts(p):
        b_, t_ = p.shape[0], p.shape[1]
        q = _rms_norm(p[..., :nq].reshape(b_, t_, GQA_Q_HEADS, HEAD_DIM), qn_g)
        k = _rms_norm(p[..., nq:nq + nk].reshape(b_, t_, GQA_KV_HEADS, HEAD_DIM), kn_g)
        v = p[..., nq + nk:].reshape(b_, t_, GQA_KV_HEADS, HEAD_DIM)
        return q, k, v

    def qh(a):
        return a.reshape(a.shape[0], a.shape[1], GQA_KV_HEADS, grp, HEAD_DIM).transpose(0, 2, 3, 1, 4)

    def kh(a):
        return a.transpose(0, 2, 1, 3)

    q, k, v = parts(pa)
    qc, kc, vc = parts(pc)
    q = _rope_2d(q, angs)
    k = _rope_2d(k, angs)
    k_all = jnp.concatenate([kh(kc), kh(k)], axis=2)
    v_all = jnp.concatenate([kh(vc), kh(v)], axis=2)
    y = _merge_heads(_attend(qh(q), k_all, v_all))
    yc = _merge_heads(_attend(qh(qc), kh(kc), kh(vc))) if need_ctx else None
    return y, yc


def _gla_scan(q, k, v, logf, s0):
    q, k, v, logf = (a.astype(jnp.float32) for a in (q, k, v, logf))
    b, h, t, dk = q.shape
    n = t // GLA_CHUNK

    def chunks(a):
        return jnp.moveaxis(a.reshape(b, h, n, GLA_CHUNK, a.shape[-1]), 2, 0)

    lower = jnp.tril(jnp.ones((GLA_CHUNK, GLA_CHUNK), dtype=bool))[:, :, None]

    def step(state, blk):
        qc, kc, vc, lc = blk
        cum = jnp.cumsum(lc, axis=2)
        rel = cum[:, :, :, None, :] - cum[:, :, None, :, :]
        dec = jnp.exp(jnp.where(lower, rel, -jnp.inf))
        att = jnp.einsum('bhtc,bhtsc,bhsc->bhts', qc, dec, kc)
        out = (jnp.einsum('bhts,bhsv->bhtv', att, vc)
               + jnp.einsum('bhtc,bhcv->bhtv', qc * jnp.exp(cum), state))
        last = cum[:, :, -1:, :]
        state = (jnp.exp(last[:, :, 0, :, None]) * state
                 + jnp.einsum('bhsc,bhsv->bhcv', kc * jnp.exp(last - cum), vc))
        return state, out

    s_final, o = lax.scan(step, s0, (chunks(q), chunks(k), chunks(v), chunks(logf)))
    return jnp.moveaxis(o, 0, 2).reshape(b, h, t, v.shape[-1]), s_final


def _hgrn2(pa, pc, lb, onorm_g, need_ctx):
    def heads(a):
        return a.reshape(a.shape[0], a.shape[1], HG_HEADS, -1).transpose(0, 2, 1, 3)

    def parts(p):
        q = heads(p[..., :HG_W])
        fs = (heads(p[..., HG_W:2 * HG_W]), heads(p[..., 2 * HG_W:3 * HG_W]))
        i = heads(p[..., 3 * HG_W:4 * HG_W])
        g = p[..., 4 * HG_W:]
        return q, fs, i, g

    def gate(fraw, lbd):
        lbd = lbd[None, :, None, :]
        f = lbd + (1.0 - lbd) * jax.nn.sigmoid(fraw.astype(jnp.float32))
        return 1.0 - f, jnp.log(f)

    q, fs, i, g = parts(pa)
    qc, fcs, ic, gc = parts(pc)
    s_zero = jnp.zeros((pa.shape[0], HG_HEADS, HG_DK, HG_DV), jnp.float32)
    o = 0.0
    oc = 0.0
    for d in range(2):
        fl = (lambda a: jnp.flip(a, axis=2)) if d == 1 else (lambda a: a)
        kc_, lc_ = gate(fcs[d], lb[d])
        k_, l_ = gate(fs[d], lb[d])
        o_ctx, s_ctx = _gla_scan(fl(qc), fl(kc_), fl(ic), fl(lc_), s_zero)
        o_lat, _ = _gla_scan(fl(q), fl(k_), fl(i), fl(l_), s_ctx)
        o = o + fl(o_lat)
        if need_ctx:
            oc = oc + fl(o_ctx)

    def readout(o_, g_):
        o_ = _rms_norm(o_, onorm_g).transpose(0, 2, 1, 3)
        return o_.reshape(o_.shape[0], o_.shape[1], -1) * jax.nn.silu(g_)

    return readout(o, g), (readout(oc, gc) if need_ctx else None)


def _mla(pa, pc, qa_g, w_qup, kva_g, w_kvup, angs, need_ctx):
    r0 = MLA_Q_RANK
    r1 = MLA_Q_RANK + MLA_KV_RANK

    def parts(p, rotate):
        b_, t_ = p.shape[0], p.shape[1]
        q = (_rms_norm(p[..., :r0], qa_g) @ w_qup).reshape(b_, t_, MLA_HEADS, MLA_NOPE + MLA_ROPE)
        kv = (_rms_norm(p[..., r0:r1], kva_g) @ w_kvup).reshape(b_, t_, MLA_HEADS, MLA_NOPE + MLA_V)
        q_nope, q_rope = q[..., :MLA_NOPE], q[..., MLA_NOPE:]
        k_rope = p[..., r1:][:, :, None, :]
        if rotate:
            q_rope = _rope_2d(q_rope, angs)
            k_rope = _rope_2d(k_rope, angs)
        q = jnp.concatenate([q_nope, q_rope], axis=-1)
        k = jnp.concatenate([kv[..., :MLA_NOPE],
                             jnp.broadcast_to(k_rope, (b_, t_, MLA_HEADS, MLA_ROPE))], axis=-1)
        v = kv[..., MLA_NOPE:]
        return q.transpose(0, 2, 1, 3)[:, :, None], k.transpose(0, 2, 1, 3), v.transpose(0, 2, 1, 3)

    q, k, v = parts(pa, True)
    qc, kc, vc = parts(pc, False)
    k_all = jnp.concatenate([kc, k], axis=2)
    v_all = jnp.concatenate([vc, v], axis=2)
    y = _merge_heads(_attend(q, k_all, v_all))
    yc = _merge_heads(_attend(qc, kc, vc)) if need_ctx else None
    return y, yc


def _diag_scan(abar, bu, h0):
    bu = jnp.moveaxis(bu, 1, 0)
    if h0 is not None:
        bu = bu.at[0].add(abar * h0)
    a = jnp.broadcast_to(abar, (bu.shape[0], 1) + abar.shape)

    def combine(l, r):
        return l[0] * r[0], r[0] * l[1] + r[1]

    _, h = lax.associative_scan(combine, (a, bu))
    return jnp.moveaxis(h, 0, 1)


def _s5(ua, uc, a_re, a_im, log_dt, b_re, b_im, c_re, c_im, d_skip, w_glu, b_glu, need_ctx):
    f32 = jnp.float32

    def grp(u):
        return u.astype(f32).reshape(u.shape[0], u.shape[1], S5_GROUPS, S5_GROUP)

    u = grp(ua)
    ucg = grp(uc)
    dsk = d_skip.astype(f32).reshape(S5_GROUPS, S5_GROUP)
    y = dsk * u
    yc = dsk * ucg if need_ctx else None
    for d in range(2):
        fl = (lambda a: jnp.flip(a, axis=1)) if d == 1 else (lambda a: a)
        lam = lax.complex(a_re[d].astype(f32), a_im[d].astype(f32))
        dt = jnp.exp(log_dt[d].astype(f32))[:, None]
        abar = jnp.exp(lam * dt)
        bbar = ((abar - 1.0) / lam)[..., None] * lax.complex(b_re[d].astype(f32), b_im[d].astype(f32))
        cmat = lax.complex(c_re[d].astype(f32), c_im[d].astype(f32))
        h_ctx = _diag_scan(abar, jnp.einsum('btgc,gpc->btgp', fl(ucg), bbar), None)
        h_lat = _diag_scan(abar, jnp.einsum('btgc,gpc->btgp', fl(u), bbar), h_ctx[:, -1])
        y = y + fl(jnp.einsum('gcp,btgp->btgc', cmat, h_lat).real)
        if need_ctx:
            yc = yc + fl(jnp.einsum('gcp,btgp->btgc', cmat, h_ctx).real)

    def glu(y_):
        z = jax.nn.gelu(y_.reshape(y_.shape[0], y_.shape[1], S5_WIDTH), approximate=False)
        return z * jax.nn.sigmoid(z @ w_glu + b_glu)

    return glu(y), (glu(yc) if need_ctx else None)


def _peer(h, wq, keys, u_tab, v_tab):
    shp = h.shape
    blocks = h.reshape(-1, PEER_BLOCK, shp[-1])

    def block(hb):
        n = hb.shape[0]
        q = (hb @ wq).reshape(n, PEER_HEADS, 2, PEER_HALF)
        s = jnp.einsum('thpk,hpnk->thpn', q, keys).astype(jnp.float32)
        s1, i1 = lax.top_k(s[:, :, 0], PEER_TOPK)
        s2, i2 = lax.top_k(s[:, :, 1], PEER_TOPK)
        cand = (s1[..., :, None] + s2[..., None, :]).reshape(n, PEER_HEADS, PEER_TOPK * PEER_TOPK)
        cidx = (i1[..., :, None] * PEER_KEYS + i2[..., None, :]).reshape(n, PEER_HEADS, PEER_TOPK * PEER_TOPK)
        sc, pos = lax.top_k(cand, PEER_TOPK)
        eidx = jnp.take_along_axis(cidx, pos, axis=-1)
        gw = jax.nn.softmax(sc, axis=-1)
        a = jnp.einsum('thkd,td->thk', u_tab[eidx], hb)
        w = (jax.nn.gelu(a.astype(jnp.float32), approximate=False) * gw).astype(hb.dtype)
        return jnp.einsum('thk,thkd->td', w, v_tab[eidx])

    return lax.map(block, blocks).reshape(shp)


def setup_inputs(seed: int = 0) -> dict:
    key = jax.random.key(seed)
    ks = iter(jax.random.split(key, 48))
    f32 = jnp.float32

    def nrm(shape, scale):
        return jax.random.normal(next(ks), shape, f32) * scale

    def gain(shape):
        return 1.0 + 0.02 * jax.random.normal(next(ks), shape, f32)

    d = D_MODEL
    a_im = (jnp.pi * jnp.arange(S5_STATE, dtype=f32)
            + 0.01 * jax.random.normal(next(ks), (N_ODD, 2, S5_GROUPS, S5_STATE), f32))
    return {
        'x': nrm((BATCH, SEQ, d), 1.0),
        'c': nrm((BATCH, d), 1.0),
        'ctx': nrm((BATCH, CTX_LEN, d), 1.0),
        'c_ctx': nrm((d,), 1.0),
        'ada_w': nrm((DEPTH, d, 6 * d), d ** -0.5),
        'ada_b': nrm((DEPTH, 6 * d), 0.02),
        'norm1_g': gain((DEPTH, d)),
        'norm2_g': gain((DEPTH, d)),
        'ev_w_in': nrm((N_EVEN, d, EVEN_IN), d ** -0.5),
        'ev_w_out': nrm((N_EVEN, MIX_OUT, d), MIX_OUT ** -0.5),
        'gqa_qn_g': gain((N_EVEN, HEAD_DIM)),
        'gqa_kn_g': gain((N_EVEN, HEAD_DIM)),
        'hg_lb_logits': nrm((2, N_EVEN + 1, HG_W), 0.5),
        'hg_onorm_g': gain((N_EVEN, HG_DV)),
        'od_w_in': nrm((N_ODD, d, ODD_IN), d ** -0.5),
        'od_w_out': nrm((N_ODD, MIX_OUT, d), MIX_OUT ** -0.5),
        'mla_qa_g': gain((N_ODD, MLA_Q_RANK)),
        'mla_w_qup': nrm((N_ODD, MLA_Q_RANK, MLA_HEADS * (MLA_NOPE + MLA_ROPE)), MLA_Q_RANK ** -0.5),
        'mla_kva_g': gain((N_ODD, MLA_KV_RANK)),
        'mla_w_kvup': nrm((N_ODD, MLA_KV_RANK, MLA_HEADS * (MLA_NOPE + MLA_V)), MLA_KV_RANK ** -0.5),
        's5_a_re': -0.5 + nrm((N_ODD, 2, S5_GROUPS, S5_STATE), 0.01),
        's5_a_im': a_im,
        's5_log_dt': jax.random.uniform(next(ks), (N_ODD, 2, S5_GROUPS), f32,
                                        minval=math.log(1e-3), maxval=math.log(1e-1)),
        's5_b_re': nrm((N_ODD, 2, S5_GROUPS, S5_STATE, S5_GROUP), (2 * S5_GROUP) ** -0.5),
        's5_b_im': nrm((N_ODD, 2, S5_GROUPS, S5_STATE, S5_GROUP), (2 * S5_GROUP) ** -0.5),
        's5_c_re': nrm((N_ODD, 2, S5_GROUPS, S5_GROUP, S5_STATE), S5_STATE ** -0.5),
        's5_c_im': nrm((N_ODD, 2, S5_GROUPS, S5_GROUP, S5_STATE), S5_STATE ** -0.5),
        's5_d': nrm((N_ODD, S5_WIDTH), 1.0),
        's5_w_glu': nrm((N_ODD, S5_WIDTH, S5_WIDTH), S5_WIDTH ** -0.5),
        's5_b_glu': nrm((N_ODD, S5_WIDTH), 0.02),
        'peer_wq': nrm((DEPTH, d, PEER_HEADS * PEER_QDIM), d ** -0.5),
        'peer_keys': nrm((DEPTH, PEER_HEADS, 2, PEER_KEYS, PEER_HALF), PEER_HALF ** -0.5),
        'peer_u': nrm((DEPTH, N_EXPERTS, d), d ** -0.5),
        'peer_v': nrm((DEPTH, N_EXPERTS, d), PEER_HEADS ** -0.5),
        'final_g': gain((d,)),
    }


def reference(x, c, ctx, c_ctx, ada_w, ada_b, norm1_g, norm2_g, ev_w_in, ev_w_out, gqa_qn_g, gqa_kn_g,
              hg_lb_logits, hg_onorm_g, od_w_in, od_w_out, mla_qa_g, mla_w_qup, mla_kva_g, mla_w_kvup,
              s5_a_re, s5_a_im, s5_log_dt, s5_b_re, s5_b_im, s5_c_re, s5_c_im, s5_d, s5_w_glu, s5_b_glu,
              peer_wq, peer_keys, peer_u, peer_v, final_g):
    rows = x.shape[1] // GRID_W
    angs_gqa = _axial_angles(rows, HEAD_DIM)
    angs_mla = _axial_angles(rows, MLA_ROPE)
    lb_all = jnp.cumsum(jax.nn.softmax(hg_lb_logits.astype(jnp.float32), axis=1), axis=1)
    s_c = jax.nn.silu(c)
    s_ctx = jax.nn.silu(c_ctx)
    xc = ctx
    for layer in range(DEPTH):
        need_ctx = layer < DEPTH - 1
        j = layer // 2
        mod = jnp.split((s_c @ ada_w[layer] + ada_b[layer])[:, None, :], 6, axis=-1)
        modc = jnp.split(s_ctx @ ada_w[layer] + ada_b[layer], 6, axis=-1)
        h = _modulate(_rms_norm(x, norm1_g[layer]), mod[0], mod[1])
        hc = _modulate(_rms_norm(xc, norm1_g[layer]), modc[0], modc[1])
        if layer % 2 == 0:
            pa = h @ ev_w_in[j]
            pc = hc @ ev_w_in[j]
            ya, yac = _gqa(pa[..., :GQA_IN], pc[..., :GQA_IN], gqa_qn_g[j], gqa_kn_g[j], angs_gqa, need_ctx)
            yb, ybc = _hgrn2(pa[..., GQA_IN:], pc[..., GQA_IN:],
                             lb_all[:, j].reshape(2, HG_HEADS, HG_DK), hg_onorm_g[j], need_ctx)
            w_out = ev_w_out[j]
        else:
            pa = h @ od_w_in[j]
            pc = hc @ od_w_in[j]
            ya, yac = _mla(pa[..., :MLA_IN], pc[..., :MLA_IN], mla_qa_g[j], mla_w_qup[j],
                           mla_kva_g[j], mla_w_kvup[j], angs_mla, need_ctx)
            yb, ybc = _s5(pa[..., MLA_IN:], pc[..., MLA_IN:], s5_a_re[j], s5_a_im[j], s5_log_dt[j],
                          s5_b_re[j], s5_b_im[j], s5_c_re[j], s5_c_im[j], s5_d[j], s5_w_glu[j],
                          s5_b_glu[j], need_ctx)
            w_out = od_w_out[j]
        x = x + mod[2] * (jnp.concatenate([ya, yb], axis=-1) @ w_out)
        if need_ctx:
            xc = xc + modc[2] * (jnp.concatenate([yac, ybc], axis=-1) @ w_out)
        h = _modulate(_rms_norm(x, norm2_g[layer]), mod[3], mod[4])
        x = x + mod[5] * _peer(h, peer_wq[layer], peer_keys[layer], peer_u[layer], peer_v[layer])
        if need_ctx:
            hc = _modulate(_rms_norm(xc, norm2_g[layer]), modc[3], modc[4])
            xc = xc + modc[5] * _peer(hc, peer_wq[layer], peer_keys[layer], peer_u[layer], peer_v[layer])
    return _rms_norm(x, final_g)
```

```cpp
#include <hip/hip_runtime.h>
#include <hip/hip_cooperative_groups.h>
#include <cstdio>
namespace cg = cooperative_groups;

#ifndef STAGE_LIMIT
#define STAGE_LIMIT 99
#endif
#define REP_MIX 1
#define REP_ROUTE 1
#define REP_GDRY 0
#define REP_GEMM 1

typedef unsigned short bf16;
typedef __attribute__((ext_vector_type(8))) short bf16x8;
typedef __attribute__((ext_vector_type(4))) short bf16x4;
typedef __attribute__((ext_vector_type(16))) float f32x16;
typedef float f32x2_t __attribute__((ext_vector_type(2)));
typedef unsigned u32x4 __attribute__((ext_vector_type(4)));
typedef unsigned u32x2 __attribute__((ext_vector_type(2)));
typedef __bf16 bf16x2_t __attribute__((ext_vector_type(2)));

#define DI __device__ __forceinline__
#define MFMA32(a, b, c) __builtin_amdgcn_mfma_f32_32x32x16_bf16((a), (b), (c), 0, 0, 0)

constexpr int NLAT = 32768, NCTX = 1024, NTOK = 33792, DM = 1024;
constexpr int SEQ = 8192, CTXL = 256, SKEYS = 8448;
constexpr float EPSN = 1e-6f;

constexpr size_t al256(size_t x) { return (x + 255) & ~(size_t)255; }
constexpr size_t OFF_WT_EVIN = 0;
constexpr size_t OFF_WT_EVOUT = OFF_WT_EVIN + al256((size_t)3328 * 1024 * 2);
constexpr size_t OFF_WT_ODIN = OFF_WT_EVOUT + al256((size_t)1024 * 1024 * 2);
constexpr size_t OFF_WT_ODOUT = OFF_WT_ODIN + al256((size_t)1280 * 1024 * 2);
constexpr size_t OFF_WT_QUP = OFF_WT_ODOUT + al256((size_t)1024 * 1024 * 2);
constexpr size_t OFF_WT_KVUP = OFF_WT_QUP + al256((size_t)768 * 384 * 2);
constexpr size_t OFF_WT_GLU = OFF_WT_KVUP + al256((size_t)1024 * 256 * 2);
constexpr size_t OFF_WT_PWQ = OFF_WT_GLU + al256((size_t)512 * 512 * 2);
constexpr size_t OFF_PKEYS = OFF_WT_PWQ + al256((size_t)2 * 2048 * 1024 * 2);
constexpr size_t OFF_MOD = OFF_PKEYS + al256((size_t)2 * 8 * 2 * 128 * 128 * 2);
constexpr size_t OFF_S5T = OFF_MOD + al256((size_t)2 * 5 * 6144 * 4);
constexpr size_t OFF_S5WE = OFF_S5T + al256((size_t)64 * 256 * 256 * 2);
constexpr size_t OFF_S5WY = OFF_S5WE + al256((size_t)64 * 128 * 256 * 2);
constexpr size_t OFF_S5A16 = OFF_S5WY + al256((size_t)64 * 256 * 128 * 2);
constexpr size_t OFF_CNT = OFF_S5A16 + al256((size_t)64 * 64 * 2 * 4);
constexpr size_t OFF_BAR = OFF_CNT + 256;
constexpr size_t OFF_ROPE1 = OFF_BAR + 16384;
constexpr size_t OFF_SU = OFF_ROPE1 + al256((size_t)8192 * 16 * 8);
constexpr size_t OFF_SV = OFF_SU + 65536;
constexpr size_t OFF_KMAX = OFF_SV + 65536;
constexpr size_t OFF_KRSQ = OFF_KMAX + 256;
constexpr size_t OFF_XC = OFF_KRSQ + al256((size_t)NTOK * 4);
constexpr size_t OFF_UTAB = OFF_XC + al256((size_t)NCTX * DM * 4);
constexpr size_t OFF_VTAB = OFF_UTAB + al256((size_t)16384 * 1024 * 2);
constexpr size_t OFF_ACTA = OFF_VTAB + al256((size_t)16384 * 1024 * 2);
constexpr size_t OFF_BIG = OFF_ACTA + al256((size_t)NTOK * DM * 2);
constexpr size_t OFF_PAGQA = OFF_BIG;
constexpr size_t OFF_VT0 = OFF_PAGQA + al256((size_t)NTOK * 768 * 2);
constexpr size_t OFF_PAHG = OFF_VT0 + al256((size_t)512 * SKEYS * 2);
constexpr size_t OFF_OHG = OFF_PAHG + al256((size_t)NTOK * 2560 * 2);
constexpr size_t OFF_END0 = OFF_OHG + al256((size_t)2 * NTOK * 512 * 2);
constexpr size_t OFF_K1 = OFF_BIG;
constexpr size_t OFF_PA1M = OFF_K1 + al256((size_t)NTOK * 768 * 2);
constexpr size_t OFF_Q1 = OFF_PA1M;
constexpr size_t OFF_U1 = OFF_PA1M + al256((size_t)NTOK * 768 * 2);
constexpr size_t OFF_QN = OFF_U1 + al256((size_t)NTOK * 512 * 2);
constexpr size_t OFF_KVN = OFF_QN + al256((size_t)NLAT * 384 * 2);
constexpr size_t OFF_Z1 = OFF_QN;
constexpr size_t OFF_KROPE = OFF_KVN + al256((size_t)NTOK * 256 * 2);
constexpr size_t OFF_VT1 = OFF_KROPE + al256((size_t)NTOK * 32 * 2);
constexpr size_t OFF_YS5 = OFF_VT1 + al256((size_t)2048 * SKEYS * 2);
constexpr size_t OFF_END1 = OFF_YS5 + al256((size_t)2 * NLAT * 512 * 2);
constexpr size_t OFF_RIDX = OFF_BIG;
constexpr size_t OFF_RGW = OFF_RIDX + al256((size_t)NTOK * 128 * 4);
constexpr size_t WS_NEEDED = (OFF_END0 > OFF_END1 ? OFF_END0 : OFF_END1);
static_assert(OFF_RGW + (size_t)NTOK * 128 * 4 <= OFF_VT0, "route alias overflow");
static_assert((size_t)NLAT * 512 * 2 <= (OFF_KROPE - OFF_QN), "z alias overflow");
static_assert(WS_NEEDED < (size_t)500 * 1024 * 1024, "workspace too large");

constexpr int SMEM_BYTES = 78 * 1024;

struct Params {
  const float *x, *c, *ctx, *c_ctx, *ada_w, *ada_b, *norm1_g, *norm2_g, *ev_w_in, *ev_w_out, *gqa_qn_g, *gqa_kn_g,
      *hg_lb_logits, *hg_onorm_g, *od_w_in, *od_w_out, *mla_qa_g, *mla_w_qup, *mla_kva_g, *mla_w_kvup, *s5_a_re, *s5_a_im,
      *s5_log_dt, *s5_b_re, *s5_b_im, *s5_c_re, *s5_c_im, *s5_d, *s5_w_glu, *s5_b_glu, *peer_wq, *peer_keys, *peer_u,
      *peer_v, *final_g;
  float* out;
  char* ws;
  int rep_mix, rep_route, rep_gdry, rep_gemm;
};

DI int get_tid() { int t = threadIdx.x; asm volatile("" : "+v"(t)); return t; }
DI bf16 f2bf(float x) {
  unsigned u = __float_as_uint(x);
  u += 0x7fffu + ((u >> 16) & 1u);
  return (bf16)(u >> 16);
}
DI float bf2f(bf16 h) { return __uint_as_float(((unsigned)h) << 16); }
DI unsigned cvtpk(float lo, float hi) {
  f32x2_t v = {lo, hi};
  bf16x2_t b = __builtin_convertvector(v, bf16x2_t);
  return __builtin_bit_cast(unsigned, b);
}
DI float bflo(unsigned u) { return __uint_as_float(u << 16); }
DI float bfhi(unsigned u) { return __uint_as_float(u & 0xffff0000u); }
DI float wave_sum(float v) {
#pragma unroll
  for (int o = 32; o > 0; o >>= 1) v += __shfl_xor(v, o);
  return v;
}
DI float wave_max_early(float v) {
#pragma unroll
  for (int o = 32; o > 0; o >>= 1) v = fmaxf(v, __shfl_xor(v, o));
  return v;
}
DI float sigmoidf_(float x) { return 1.0f / (1.0f + __expf(-x)); }
DI float siluf_(float x) { return x * sigmoidf_(x); }
DI float geluf_(float x) { return 0.5f * x * (1.0f + erff(x * 0.70710678118654752f)); }

DI const float* orig_row(const Params& p, int r) {
  return r < NLAT ? p.x + (size_t)r * DM : p.ctx + (size_t)(r - NLAT) * DM;
}
DI float* res_row(const Params& p, int r) {
  return r < NLAT ? p.out + (size_t)r * DM : (float*)(p.ws + OFF_XC) + (size_t)(r - NLAT) * DM;
}
DI int mod_row(int r) { return r < NLAT ? (r >> 13) : 4; }
DI const float* mod_ptr(const Params& p, int layer, int r, int chunk) {
  return (const float*)(p.ws + OFF_MOD) + ((size_t)(layer * 5 + mod_row(r)) * 6 + chunk) * 1024;
}

constexpr int GLS = 72;
DI void gemm_128x128(const bf16* __restrict__ A, int lda, const bf16* __restrict__ Bt, int ldb, int K, f32x16 (&acc)[2][2],
                     bf16* As, bf16* Bs) {
  const int tid = get_tid(), lane = tid & 63, w = tid >> 6;
  const int wm = w >> 1, wn = w & 1;
  const int lr = tid >> 3, lc = (tid & 7) * 8;
  u32x4 ra[4], rb[4];
#pragma unroll
  for (int i = 0; i < 4; ++i) {
    ra[i] = *(const u32x4*)(A + (size_t)(i * 32 + lr) * lda + lc);
    rb[i] = *(const u32x4*)(Bt + (size_t)(i * 32 + lr) * ldb + lc);
  }
#pragma unroll
  for (int i = 0; i < 2; ++i)
#pragma unroll
    for (int j = 0; j < 2; ++j)
#pragma unroll
      for (int r = 0; r < 16; ++r) acc[i][j][r] = 0.f;
  for (int k0 = 0; k0 < K; k0 += 64) {
    __syncthreads();
#pragma unroll
    for (int i = 0; i < 4; ++i) {
      *(u32x4*)(As + (i * 32 + lr) * GLS + lc) = ra[i];
      *(u32x4*)(Bs + (i * 32 + lr) * GLS + lc) = rb[i];
    }
    __syncthreads();
    if (k0 + 64 < K) {
#pragma unroll
      for (int i = 0; i < 4; ++i) {
        ra[i] = *(const u32x4*)(A + (size_t)(i * 32 + lr) * lda + k0 + 64 + lc);
        rb[i] = *(const u32x4*)(Bt + (size_t)(i * 32 + lr) * ldb + k0 + 64 + lc);
      }
    }
#pragma unroll
    for (int ks = 0; ks < 64; ks += 16) {
      const int ko = ks + (lane >> 5) * 8;
      bf16x8 a0 = *(const bf16x8*)(As + (wm * 64 + (lane & 31)) * GLS + ko);
      bf16x8 a1 = *(const bf16x8*)(As + (wm * 64 + 32 + (lane & 31)) * GLS + ko);
      bf16x8 b0 = *(const bf16x8*)(Bs + (wn * 64 + (lane & 31)) * GLS + ko);
      bf16x8 b1 = *(const bf16x8*)(Bs + (wn * 64 + 32 + (lane & 31)) * GLS + ko);
      acc[0][0] = MFMA32(a0, b0, acc[0][0]);
      acc[0][1] = MFMA32(a0, b1, acc[0][1]);
      acc[1][0] = MFMA32(a1, b0, acc[1][0]);
      acc[1][1] = MFMA32(a1, b1, acc[1][1]);
    }
  }
}
template <class F>
DI void gemm_epi(f32x16 (&acc)[2][2], F f) {
  const int lane = get_tid() & 63, w = get_tid() >> 6;
  const int wm = w >> 1, wn = w & 1;
#pragma unroll
  for (int mi = 0; mi < 2; ++mi)
#pragma unroll
    for (int ni = 0; ni < 2; ++ni)
#pragma unroll
      for (int r = 0; r < 16; ++r) {
        int row = wm * 64 + mi * 32 + (r & 3) + 8 * (r >> 2) + 4 * (lane >> 5);
        int col = wn * 64 + ni * 32 + (lane & 31);
        f(row, col, acc[mi][ni][r]);
      }
}

DI void gemm_256x128(const bf16* __restrict__ A, int lda, const bf16* __restrict__ Bt, int ldb, int K, f32x16 (&acc)[4][2],
                     bf16* As, bf16* Bs) {
  const int tid = get_tid(), lane = tid & 63, w = tid >> 6;
  const int wm = w >> 1, wn = w & 1;
  const int lr = tid >> 3, lc = (tid & 7) * 8;
  u32x4 ra[8], rb[4];
#pragma unroll
  for (int i = 0; i < 8; ++i) ra[i] = *(const u32x4*)(A + (size_t)(i * 32 + lr) * lda + lc);
#pragma unroll
  for (int i = 0; i < 4; ++i) rb[i] = *(const u32x4*)(Bt + (size_t)(i * 32 + lr) * ldb + lc);
#pragma unroll
  for (int i = 0; i < 4; ++i)
#pragma unroll
    for (int j = 0; j < 2; ++j)
#pragma unroll
      for (int r = 0; r < 16; ++r) acc[i][j][r] = 0.f;
  for (int k0 = 0; k0 < K; k0 += 64) {
    __syncthreads();
#pragma unroll
    for (int i = 0; i < 8; ++i) *(u32x4*)(As + (i * 32 + lr) * GLS + lc) = ra[i];
#pragma unroll
    for (int i = 0; i < 4; ++i) *(u32x4*)(Bs + (i * 32 + lr) * GLS + lc) = rb[i];
    __syncthreads();
    if (k0 + 64 < K) {
#pragma unroll
      for (int i = 0; i < 8; ++i) ra[i] = *(const u32x4*)(A + (size_t)(i * 32 + lr) * lda + k0 + 64 + lc);
#pragma unroll
      for (int i = 0; i < 4; ++i) rb[i] = *(const u32x4*)(Bt + (size_t)(i * 32 + lr) * ldb + k0 + 64 + lc);
    }
#pragma unroll
    for (int ks = 0; ks < 64; ks += 16) {
      const int ko = ks + (lane >> 5) * 8;
      bf16x8 b0 = *(const bf16x8*)(Bs + (wn * 64 + (lane & 31)) * GLS + ko);
      bf16x8 b1 = *(const bf16x8*)(Bs + (wn * 64 + 32 + (lane & 31)) * GLS + ko);
#pragma unroll
      for (int mi = 0; mi < 4; ++mi) {
        bf16x8 a = *(const bf16x8*)(As + (wm * 128 + mi * 32 + (lane & 31)) * GLS + ko);
        acc[mi][0] = MFMA32(a, b0, acc[mi][0]);
        acc[mi][1] = MFMA32(a, b1, acc[mi][1]);
      }
    }
  }
}
template <class F>
DI void gemm_epi2(f32x16 (&acc)[4][2], F f) {
  const int lane = get_tid() & 63, w = get_tid() >> 6;
  const int wm = w >> 1, wn = w & 1;
#pragma unroll
  for (int mi = 0; mi < 4; ++mi)
#pragma unroll
    for (int ni = 0; ni < 2; ++ni)
#pragma unroll
      for (int r = 0; r < 16; ++r) {
        int row = wm * 128 + mi * 32 + (r & 3) + 8 * (r >> 2) + 4 * (lane >> 5);
        int col = wn * 64 + ni * 32 + (lane & 31);
        f(row, col, acc[mi][ni][r]);
      }
}

DI void mma_tile(f32x16& acc, const bf16* A, int lda, const bf16* Bt, int ldb, int K) {
  const int lane = get_tid() & 63;
  const bf16* ap = A + (size_t)(lane & 31) * lda + (lane >> 5) * 8;
  const bf16* bp = Bt + (size_t)(lane & 31) * ldb + (lane >> 5) * 8;
#pragma unroll 4
  for (int ks = 0; ks < K; ks += 16) {
    bf16x8 a = *(const bf16x8*)(ap + ks);
    bf16x8 b = *(const bf16x8*)(bp + ks);
    acc = MFMA32(a, b, acc);
  }
}
template <int K>
DI void mma_tile_ga(f32x16& acc, const bf16* __restrict__ A, int lda, const bf16* Bt, int ldb) {
  const int lane = get_tid() & 63;
  const bf16* ap = A + (size_t)(lane & 31) * lda + (lane >> 5) * 8;
  const bf16* bp = Bt + (size_t)(lane & 31) * ldb + (lane >> 5) * 8;
  bf16x8 af[K / 16];
#pragma unroll
  for (int i = 0; i < K / 16; ++i) af[i] = *(const bf16x8*)(ap + i * 16);
#pragma unroll
  for (int i = 0; i < K / 16; ++i) {
    bf16x8 b = *(const bf16x8*)(bp + i * 16);
    acc = MFMA32(af[i], b, acc);
  }
}
DI int crow(int r, int lane) { return (r & 3) + 8 * (r >> 2) + 4 * (lane >> 5); }

DI void prep_transpose(const float* __restrict__ W, int K, int N, int Npad, bf16* __restrict__ Wt, int tile, float* tl) {
  const int ntn = Npad / 64;
  const int kt = tile / ntn, nt = tile % ntn;
  const int k0 = kt * 64, n0 = nt * 64;
  const int tid = get_tid();
  __syncthreads();
  for (int i = 0; i < 16; ++i) {
    int r = i * 4 + (tid >> 6), cidx = tid & 63;
    int n = n0 + cidx;
    float v = (n < N) ? W[(size_t)(k0 + r) * N + n] : 0.f;
    tl[cidx * 65 + r] = v;
  }
  __syncthreads();
  for (int i = 0; i < 16; ++i) {
    int n = i * 4 + (tid >> 6), k = tid & 63;
    Wt[(size_t)(n0 + n) * K + k0 + k] = f2bf(tl[n * 65 + k]);
  }
}

DI void convert_bf16(const float* __restrict__ src, bf16* __restrict__ dst, size_t n, int bid, int nb) {
  size_t nv = n / 8;
  for (size_t i = (size_t)bid * 256 + get_tid(); i < nv; i += (size_t)nb * 256) {
    float4 a = ((const float4*)src)[2 * i], b = ((const float4*)src)[2 * i + 1];
    u32x4 o;
    o.x = cvtpk(a.x, a.y); o.y = cvtpk(a.z, a.w); o.z = cvtpk(b.x, b.y); o.w = cvtpk(b.z, b.w);
    ((u32x4*)dst)[i] = o;
  }
}

DI void prep_mod(const Params& p, int item, float* sm) {
  const int l = item / 96, n0 = (item % 96) * 64;
  const int tid = get_tid(), lane = tid & 63, w = tid >> 6;
  const float* W = p.ada_w + (size_t)l * 1024 * 6144 + n0 + lane;
  float* sc = sm;
  float* red = sm + 5 * 1024;
  __syncthreads();
  for (int i = tid; i < 5 * 1024; i += 256) {
    const int r = i >> 10, k = i & 1023;
    sc[i] = siluf_(r < 4 ? p.c[r * 1024 + k] : p.c_ctx[k]);
  }
  __syncthreads();
  float acc[5] = {0.f, 0.f, 0.f, 0.f, 0.f};
#pragma unroll 1
  for (int k0 = w * 256; k0 < w * 256 + 256; k0 += 16) {
    float wv[16];
#pragma unroll
    for (int j = 0; j < 16; ++j) wv[j] = W[(size_t)(k0 + j) * 6144];
#pragma unroll
    for (int j = 0; j < 16; ++j) {
#pragma unroll
      for (int r = 0; r < 5; ++r) acc[r] += sc[r * 1024 + k0 + j] * wv[j];
    }
  }
#pragma unroll
  for (int r = 0; r < 5; ++r) red[(w * 5 + r) * 64 + lane] = acc[r];
  __syncthreads();
  if (w == 0) {
    float* M = (float*)(p.ws + OFF_MOD);
#pragma unroll
    for (int r = 0; r < 5; ++r) {
      float s2 = red[(0 * 5 + r) * 64 + lane] + red[(1 * 5 + r) * 64 + lane] + red[(2 * 5 + r) * 64 + lane] + red[(3 * 5 + r) * 64 + lane];
      M[(size_t)(l * 5 + r) * 6144 + n0 + lane] = s2 + p.ada_b[l * 6144 + n0 + lane];
    }
  }
}

DI void prep_s5(const Params& p, int item4, float* sm) {
  const int item = item4 >> 2, qtr = item4 & 3;
  const int g = item >> 1, d = item & 1;
  const int tid = get_tid();
  float* pw = sm;
  float* bb = sm + 17 * 128;
  float* kc = bb + 64 * 32;
  __syncthreads();
  const float dt = __expf(p.s5_log_dt[d * 32 + g]);
  if (tid < 64) {
    const int pp = tid;
    const float are = p.s5_a_re[(d * 32 + g) * 64 + pp], aim = p.s5_a_im[(d * 32 + g) * 64 + pp];
    for (int n = 0; n <= 16; ++n) {
      float mag = expf(are * dt * n);
      float sn, cs;
      sincosf(aim * dt * n, &sn, &cs);
      pw[(n * 64 + pp) * 2 + 0] = mag * cs;
      pw[(n * 64 + pp) * 2 + 1] = mag * sn;
    }
    float abr = pw[(64 + pp) * 2 + 0] - 1.0f, abi = pw[(64 + pp) * 2 + 1];
    float den = are * are + aim * aim;
    float qr = (abr * are + abi * aim) / den, qi = (abi * are - abr * aim) / den;
    for (int c2 = 0; c2 < 16; ++c2) {
      float br = p.s5_b_re[((size_t)(d * 32 + g) * 64 + pp) * 16 + c2], bi = p.s5_b_im[((size_t)(d * 32 + g) * 64 + pp) * 16 + c2];
      bb[(pp * 16 + c2) * 2 + 0] = qr * br - qi * bi;
      bb[(pp * 16 + c2) * 2 + 1] = qr * bi + qi * br;
    }
    float* A16 = (float*)(p.ws + OFF_S5A16) + (size_t)item * 128;
    A16[pp * 2 + 0] = pw[(16 * 64 + pp) * 2 + 0];
    A16[pp * 2 + 1] = pw[(16 * 64 + pp) * 2 + 1];
  }
  float* cre = kc + 4096;
  float* cim = cre + 1024;
  for (int e = tid; e < 1024; e += 256) {
    cre[e] = p.s5_c_re[(size_t)(d * 32 + g) * 1024 + e];
    cim[e] = p.s5_c_im[(size_t)(d * 32 + g) * 1024 + e];
  }
  __syncthreads();
  for (int e = tid; e < (4 * qtr + 4) * 256; e += 256) {
    int tau = e >> 8, c = (e >> 4) & 15, c2 = e & 15;
    float s = 0.f;
    for (int pp = 0; pp < 64; ++pp) {
      float cr = cre[c * 64 + pp], ci = cim[c * 64 + pp];
      float wr = pw[(tau * 64 + pp) * 2], wi = pw[(tau * 64 + pp) * 2 + 1];
      float zr = cr * wr - ci * wi, zi = cr * wi + ci * wr;
      float br = bb[(pp * 16 + c2) * 2], bi = bb[(pp * 16 + c2) * 2 + 1];
      s += zr * br - zi * bi;
    }
    kc[e] = s;
  }
  __syncthreads();
  bf16* T = (bf16*)(p.ws + OFF_S5T) + (size_t)item * 65536;
  for (int e = qtr * 16384 + tid; e < (qtr + 1) * 16384; e += 256) {
    int m = e >> 8, k = e & 255;
    int i = m >> 4, c = m & 15, j = k >> 4, c2 = k & 15;
    float v = (i >= j) ? kc[((i - j) * 16 + c) * 16 + c2] : 0.f;
    T[e] = f2bf(v);
  }
  bf16* WE = (bf16*)(p.ws + OFF_S5WE) + (size_t)item * 32768;
  for (int e = qtr * 8192 + tid; e < (qtr + 1) * 8192; e += 256) {
    int pr = e >> 8, k = e & 255;
    int pp = pr & 63, im = pr >> 6, j = k >> 4, c2 = k & 15;
    float wr = pw[((15 - j) * 64 + pp) * 2], wi = pw[((15 - j) * 64 + pp) * 2 + 1];
    float br = bb[(pp * 16 + c2) * 2], bi = bb[(pp * 16 + c2) * 2 + 1];
    float v = im ? (wr * bi + wi * br) : (wr * br - wi * bi);
    WE[e] = f2bf(v);
  }
  bf16* WY = (bf16*)(p.ws + OFF_S5WY) + (size_t)item * 32768;
  for (int e = qtr * 8192 + tid; e < (qtr + 1) * 8192; e += 256) {
    int m = e >> 7, pr = e & 127;
    int i = m >> 4, c = m & 15, pp = pr & 63, im = pr >> 6;
    float cr = cre[c * 64 + pp], ci = cim[c * 64 + pp];
    float wr = pw[((i + 1) * 64 + pp) * 2], wi = pw[((i + 1) * 64 + pp) * 2 + 1];
    float zr = cr * wr - ci * wi, zi = cr * wi + ci * wr;
    WY[e] = f2bf(im ? -zi : zr);
  }
}

DI void phase_prep(const Params& p, char* smem) {
  const int bid = blockIdx.x, nb = gridDim.x;
  float* sm = (float*)smem;
  if (bid == 0 && get_tid() < 64) ((unsigned*)(p.ws + OFF_KMAX))[get_tid()] = 0u;
  {
    float2* tab = (float2*)(p.ws + OFF_ROPE1);
    for (int e = bid * 256 + get_tid(); e < 8192 * 16; e += nb * 256) {
      int t = e >> 4, f = e & 15;
      float pos = (f < 8) ? (float)(t >> 6) : (float)(t & 63);
      float inv = powf(10000.f, -(float)(f & 7) / 8.f);
      float sn, cs;
      sincosf(pos * inv, &sn, &cs);
      tab[e] = make_float2(cs, sn);
    }
  }
  const int n_mod = 192, n_s5 = 256;
  constexpr int T0 = 16 * 52, T1 = 16 * 16, T2 = 16 * 20, T3 = 16 * 16, T4 = 6 * 12, T5 = 4 * 16, T6 = 8 * 8, T7 = 16 * 32, T8 = 16 * 32;
  constexpr int NTR = T0 + T1 + T2 + T3 + T4 + T5 + T6 + T7 + T8;
  const int total = n_mod + n_s5 + NTR;
  for (int it = bid; it < total; it += nb) {
    if (it < n_s5) prep_s5(p, it, sm);
    else if (it < n_mod + n_s5) prep_mod(p, it - n_s5, sm);
    else {
      int t = it - n_mod - n_s5;
      if (t < T0) { prep_transpose(p.ev_w_in, 1024, 3328, 3328, (bf16*)(p.ws + OFF_WT_EVIN), t, sm); continue; }
      t -= T0;
      if (t < T1) { prep_transpose(p.ev_w_out, 1024, 1024, 1024, (bf16*)(p.ws + OFF_WT_EVOUT), t, sm); continue; }
      t -= T1;
      if (t < T2) { prep_transpose(p.od_w_in, 1024, 1184, 1280, (bf16*)(p.ws + OFF_WT_ODIN), t, sm); continue; }
      t -= T2;
      if (t < T3) { prep_transpose(p.od_w_out, 1024, 1024, 1024, (bf16*)(p.ws + OFF_WT_ODOUT), t, sm); continue; }
      t -= T3;
      if (t < T4) { prep_transpose(p.mla_w_qup, 384, 768, 768, (bf16*)(p.ws + OFF_WT_QUP), t, sm); continue; }
      t -= T4;
      if (t < T5) { prep_transpose(p.mla_w_kvup, 256, 1024, 1024, (bf16*)(p.ws + OFF_WT_KVUP), t, sm); continue; }
      t -= T5;
      if (t < T6) { prep_transpose(p.s5_w_glu, 512, 512, 512, (bf16*)(p.ws + OFF_WT_GLU), t, sm); continue; }
      t -= T6;
      if (t < T7) { prep_transpose(p.peer_wq, 1024, 2048, 2048, (bf16*)(p.ws + OFF_WT_PWQ), t, sm); continue; }
      t -= T7;
      prep_transpose(p.peer_wq + (size_t)1024 * 2048, 1024, 2048, 2048, (bf16*)(p.ws + OFF_WT_PWQ) + (size_t)2048 * 1024, t, sm);
    }
  }
  convert_bf16(p.peer_keys, (bf16*)(p.ws + OFF_PKEYS), (size_t)2 * 8 * 2 * 128 * 128, bid, nb);
}

DI void phase_norm(const Params& p, int layer, bool first, const float* g, int shift_chunk, int nrows) {
  const int lane = get_tid() & 63, w = get_tid() >> 6;
  bf16* dst = (bf16*)(p.ws + OFF_ACTA);
  for (int r = blockIdx.x * 4 + w; r < nrows; r += gridDim.x * 4) {
    const float* src = first ? orig_row(p, r) : res_row(p, r);
    float4 v[4];
    float ss = 0.f;
#pragma unroll
    for (int i = 0; i < 4; ++i) {
      v[i] = ((const float4*)src)[i * 64 + lane];
      ss += v[i].x * v[i].x + v[i].y * v[i].y + v[i].z * v[i].z + v[i].w * v[i].w;
    }
    ss = wave_sum(ss);
    const float rs = rsqrtf(ss * (1.0f / 1024.0f) + EPSN);
    const float* sh = mod_ptr(p, layer, r, shift_chunk);
    const float* sc = mod_ptr(p, layer, r, shift_chunk + 1);
#pragma unroll
    for (int i = 0; i < 4; ++i) {
      float4 gg = ((const float4*)g)[i * 64 + lane];
      float4 s4 = ((const float4*)sh)[i * 64 + lane];
      float4 c4 = ((const float4*)sc)[i * 64 + lane];
      float o0 = v[i].x * rs * gg.x * (1.f + c4.x) + s4.x;
      float o1 = v[i].y * rs * gg.y * (1.f + c4.y) + s4.y;
      float o2 = v[i].z * rs * gg.z * (1.f + c4.z) + s4.z;
      float o3 = v[i].w * rs * gg.w * (1.f + c4.w) + s4.w;
      u32x2 o;
      o.x = cvtpk(o0, o1); o.y = cvtpk(o2, o3);
      ((u32x2*)(dst + (size_t)r * DM))[i * 64 + lane] = o;
    }
  }
}

DI void phase_inproj0(const Params& p, char* smem) {
  bf16* As = (bf16*)smem; bf16* Bs = As + 256 * GLS;
  const bf16* A = (const bf16*)(p.ws + OFF_ACTA);
  const bf16* Wt = (const bf16*)(p.ws + OFF_WT_EVIN);
  bf16* pg = (bf16*)(p.ws + OFF_PAGQA);
  bf16* ph = (bf16*)(p.ws + OFF_PAHG);
  const int ntn = 26, ntm = NTOK / 256;
  for (int t = blockIdx.x; t < ntn * ntm; t += gridDim.x) {
    const int mt = t / ntn, nt = t % ntn;
    f32x16 acc[4][2];
    gemm_256x128(A + (size_t)mt * 256 * DM, DM, Wt + (size_t)nt * 128 * DM, DM, DM, acc, As, Bs);
    gemm_epi2(acc, [&](int row, int col, float v) {
      int r = mt * 256 + row, cg_ = nt * 128 + col;
      if (cg_ < 768) pg[(size_t)r * 768 + cg_] = f2bf(v);
      else ph[(size_t)r * 2560 + (cg_ - 768)] = f2bf(v);
    });
  }
}

DI void phase_gqa_prep(const Params& p, char* smem) {
  bf16* pg = (bf16*)(p.ws + OFF_PAGQA);
  bf16* vt = (bf16*)(p.ws + OFF_VT0);
  bf16* tl = (bf16*)smem;
  const int lane = get_tid() & 63, w = get_tid() >> 6, tid = get_tid();
  const float gq = p.gqa_qn_g[lane], gk = p.gqa_kn_g[lane];
  const float inv = __powf(10000.f, -(float)(lane & 15) / 16.f);
  float lbv[16];
#pragma unroll
  for (int e = 0; e < 16; ++e) {
    const int j = lane * 16 + e, d = j >> 9, cc = j & 511;
    const float l0 = p.hg_lb_logits[(d * 2 + 0) * 512 + cc], l1 = p.hg_lb_logits[(d * 2 + 1) * 512 + cc];
    lbv[e] = 1.0f / (1.0f + __expf(l1 - l0));
  }
  bf16* phg = (bf16*)(p.ws + OFF_PAHG);
  for (int r = blockIdx.x * 4 + w; r < NTOK; r += gridDim.x * 4) {
    bf16* row = pg + (size_t)r * 768;
    float sn = 0.f, cs = 1.f;
    if (r < NLAT) {
      int t = r & 8191;
      float pos = (lane < 32) ? (float)(t >> 6) : (float)(t & 63);
      sincosf(pos * inv, &sn, &cs);
    }
#pragma unroll
    for (int hh = 0; hh < 10; ++hh) {
      float v = bf2f(row[hh * 64 + lane]);
      float ss = wave_sum(v * v);
      float y = v * rsqrtf(ss * (1.f / 64.f) + EPSN) * (hh < 8 ? gq : gk);
      float pr = __shfl_xor(y, 16);
      float o = y * cs + ((lane & 16) ? pr * sn : -pr * sn);
      row[hh * 64 + lane] = f2bf(hh < 8 ? o * (0.125f * 1.4426950408889634f) : o);
    }
    {
      bf16* frow = phg + (size_t)r * 2560 + 512 + lane * 16;
      u32x4 a = *(const u32x4*)frow, b2 = *(const u32x4*)(frow + 8);
      float fv[16];
      fv[0] = bflo(a.x); fv[1] = bfhi(a.x); fv[2] = bflo(a.y); fv[3] = bfhi(a.y); fv[4] = bflo(a.z); fv[5] = bfhi(a.z); fv[6] = bflo(a.w); fv[7] = bfhi(a.w);
      fv[8] = bflo(b2.x); fv[9] = bfhi(b2.x); fv[10] = bflo(b2.y); fv[11] = bfhi(b2.y); fv[12] = bflo(b2.z); fv[13] = bfhi(b2.z); fv[14] = bflo(b2.w); fv[15] = bfhi(b2.w);
#pragma unroll
      for (int e = 0; e < 16; ++e) fv[e] = __logf(lbv[e] + (1.f - lbv[e]) * sigmoidf_(fv[e]));
      u32x4 o0, o1;
      o0.x = cvtpk(fv[0], fv[1]); o0.y = cvtpk(fv[2], fv[3]); o0.z = cvtpk(fv[4], fv[5]); o0.w = cvtpk(fv[6], fv[7]);
      o1.x = cvtpk(fv[8], fv[9]); o1.y = cvtpk(fv[10], fv[11]); o1.z = cvtpk(fv[12], fv[13]); o1.w = cvtpk(fv[14], fv[15]);
      *(u32x4*)frow = o0; *(u32x4*)(frow + 8) = o1;
    }
  }
  for (int blk = blockIdx.x; blk < NTOK / 64; blk += gridDim.x) {
    const int r0 = blk * 64;
    __syncthreads();
    {
      const int rr = tid >> 2, c0 = (tid & 3) * 32;
      const bf16* src = pg + (size_t)(r0 + rr) * 768 + 640 + c0;
#pragma unroll
      for (int i = 0; i < 4; ++i) {
        u32x4 v4 = *(const u32x4*)(src + i * 8);
#pragma unroll
        for (int e = 0; e < 4; ++e) {
          tl[(c0 + i * 8 + 2 * e) * GLS + rr] = (bf16)(v4[e] & 0xffffu);
          tl[(c0 + i * 8 + 2 * e + 1) * GLS + rr] = (bf16)(v4[e] >> 16);
        }
      }
    }
    __syncthreads();
    int b, s0;
    if (r0 < NLAT) { b = r0 >> 13; s0 = CTXL + (r0 & 8191); } else { int rc = r0 - NLAT; b = rc >> 8; s0 = rc & 255; }
    {
      int vcol = tid >> 1, half = tid & 1;
      int kvh = vcol >> 6, dv = vcol & 63;
      bf16* dstp = vt + ((size_t)((b * 2 + kvh) * 64 + dv)) * SKEYS + s0 + half * 32;
      const bf16* srcp = tl + vcol * GLS + half * 32;
#pragma unroll
      for (int i = 0; i < 4; ++i) ((u32x4*)dstp)[i] = ((const u32x4*)srcp)[i];
    }
  }
}

template <int DQK, int SM>
DI void attn_item(const bf16* __restrict__ Q, int ldq_, const bf16* __restrict__ Kc, const bf16* __restrict__ Kl, int ldk_,
                  const bf16* __restrict__ VT, int nkeys, bf16* __restrict__ O, int ldo_, float scale, char* smem, float kbound = 0.f) {
  constexpr bool FIXED = (SM != 0);
  constexpr int ldq = 768, ldk = 768, ldo = DM;
  (void)ldq_; (void)ldk_; (void)ldo_;
  constexpr int KLS = DQK + 8;
  constexpr int VLS = 72;
  constexpr int NKS = DQK / 16;
  constexpr int KCH = DQK / 8;
  constexpr int KLOADS = (64 * KCH) / 256;
  constexpr int BUF = 64 * KLS + 64 * VLS;
  bf16* Sb = (bf16*)smem;
  const int tid = get_tid(), lane = tid & 63, w = tid >> 6;
  const float sc = scale * 1.4426950408889634f;
  bf16x8 qf[2][NKS];
#pragma unroll
  for (int qt = 0; qt < 2; ++qt) {
    const bf16* qp = Q + (size_t)(w * 64 + qt * 32 + (lane & 31)) * ldq + (lane >> 5) * 8;
#pragma unroll
    for (int ks = 0; ks < NKS; ++ks) qf[qt][ks] = *(const bf16x8*)(qp + ks * 16);
  }
  float msh[2] = {0.f, 0.f};
  if (SM == 2) {
#pragma unroll
    for (int qt = 0; qt < 2; ++qt) {
      float sq = 0.f;
#pragma unroll
      for (int ks = 0; ks < NKS; ++ks)
#pragma unroll
        for (int e = 0; e < 8; ++e) { float f = bf2f((bf16)qf[qt][ks][e]); sq += f * f; }
      sq += __shfl_xor(sq, 32);
      msh[qt] = fminf(sqrtf(sq) * kbound, 64.0f);
    }
  }
  f32x16 ot[2][2];
#pragma unroll
  for (int i = 0; i < 2; ++i)
#pragma unroll
    for (int j = 0; j < 2; ++j)
#pragma unroll
      for (int r = 0; r < 16; ++r) ot[i][j][r] = 0.f;
  float m_run[2] = {-1e30f, -1e30f}, l_run[2] = {0.f, 0.f};
  u32x4 kr[KLOADS], vr[2];
  auto gload = [&](int s0) {
    const bf16* kb = (s0 < CTXL) ? (Kc + (size_t)s0 * ldk) : (Kl + (size_t)(s0 - CTXL) * ldk);
#pragma unroll
    for (int i = 0; i < KLOADS; ++i) {
      int ci = i * 256 + tid;
      int row = ci / KCH, ch = ci % KCH;
      kr[i] = *(const u32x4*)(kb + (size_t)row * ldk + ch * 8);
    }
#pragma unroll
    for (int i = 0; i < 2; ++i) {
      int ci = i * 256 + tid;
      int row = ci >> 3, ch = ci & 7;
      vr[i] = *(const u32x4*)(VT + (size_t)row * SKEYS + s0 + ch * 8);
    }
  };
  auto lwrite = [&](bf16* buf) {
    bf16* Ks = buf; bf16* Vs = buf + 64 * KLS;
#pragma unroll
    for (int i = 0; i < KLOADS; ++i) {
      int ci = i * 256 + tid;
      int row = ci / KCH, ch = ci % KCH;
      *(u32x4*)(Ks + row * KLS + ch * 8) = kr[i];
    }
#pragma unroll
    for (int i = 0; i < 2; ++i) {
      int ci = i * 256 + tid;
      int row = ci >> 3, ch = ci & 7;
      u32x2 lo = {vr[i].x, vr[i].y}, hi = {vr[i].z, vr[i].w};
      const int gb = (ch >> 1) * 16 + (ch & 1) * 4;
      *(u32x2*)(Vs + row * VLS + gb) = lo;
      *(u32x2*)(Vs + row * VLS + gb + 8) = hi;
    }
  };
  const int ntiles = nkeys >> 6;
  __syncthreads();
  gload(0);
  lwrite(Sb);
  if (ntiles > 1) gload(64);
  for (int j = 0; j < ntiles; ++j) {
    __syncthreads();
    if (j + 1 < ntiles) {
      lwrite(Sb + ((j + 1) & 1) * BUF);
      if (j + 2 < ntiles) gload((j + 2) * 64);
    }
    const bf16* Ks = Sb + (j & 1) * BUF;
    const bf16* Vs = Ks + 64 * KLS;
    auto half = [&](const int kt) {
      f32x16 st[2];
#pragma unroll
      for (int qt = 0; qt < 2; ++qt)
#pragma unroll
        for (int r = 0; r < 16; ++r) st[qt][r] = 0.f;
      {
        const bf16* ap = Ks + (kt * 32 + (lane & 31)) * KLS + (lane >> 5) * 8;
        __builtin_amdgcn_s_setprio(1);
#pragma unroll
        for (int ks = 0; ks < NKS; ++ks) {
          bf16x8 a = *(const bf16x8*)(ap + ks * 16);
          st[0] = MFMA32(a, qf[0][ks], st[0]);
          st[1] = MFMA32(a, qf[1][ks], st[1]);
        }
        __builtin_amdgcn_s_setprio(0);
      }
      float mx[2] = {0.f, 0.f};
      bool need = false;
      if (!FIXED) {
#pragma unroll
      for (int qt = 0; qt < 2; ++qt) {
        float m0 = fmaxf(st[qt][0], st[qt][1]);
#pragma unroll
        for (int r = 2; r < 16; r += 2) m0 = fmaxf(m0, fmaxf(st[qt][r], st[qt][r + 1]));
        m0 = fmaxf(m0, __shfl_xor(m0, 32)) * sc;
        mx[qt] = m0;
        need = need || (m0 - m_run[qt] > 8.0f);
      }
      }
      if (!FIXED && __any(need)) {
#pragma unroll
        for (int qt = 0; qt < 2; ++qt) {
          const float m_new = fmaxf(m_run[qt], mx[qt]);
          const float alpha = __builtin_amdgcn_exp2f(m_run[qt] - m_new);
          m_run[qt] = m_new;
          l_run[qt] *= alpha;
#pragma unroll
          for (int dt = 0; dt < 2; ++dt)
#pragma unroll
            for (int r = 0; r < 16; ++r) ot[qt][dt][r] *= alpha;
        }
      }
      bf16x8 pb[2][2];
#pragma unroll
      for (int qt = 0; qt < 2; ++qt) {
        float ps = 0.f;
        const float mr = m_run[qt];
#pragma unroll
        for (int r = 0; r < 16; ++r) {
          float pv = (SM == 1) ? __builtin_amdgcn_exp2f(st[qt][r]) : (SM == 2) ? __builtin_amdgcn_exp2f(st[qt][r] - msh[qt]) : __builtin_amdgcn_exp2f(st[qt][r] * sc - mr);
          st[qt][r] = pv;
          ps += pv;
        }
#pragma unroll
        for (int s2 = 0; s2 < 2; ++s2) {
          u32x4 pk;
          pk.x = cvtpk(st[qt][8 * s2 + 0], st[qt][8 * s2 + 1]);
          pk.y = cvtpk(st[qt][8 * s2 + 2], st[qt][8 * s2 + 3]);
          pk.z = cvtpk(st[qt][8 * s2 + 4], st[qt][8 * s2 + 5]);
          pk.w = cvtpk(st[qt][8 * s2 + 6], st[qt][8 * s2 + 7]);
          pb[qt][s2] = __builtin_bit_cast(bf16x8, pk);
        }
        l_run[qt] += ps;
      }
      __builtin_amdgcn_s_setprio(1);
#pragma unroll
      for (int s2 = 0; s2 < 2; ++s2)
#pragma unroll
        for (int dt = 0; dt < 2; ++dt) {
          const bf16* vp = Vs + (dt * 32 + (lane & 31)) * VLS + kt * 32 + 16 * s2 + 8 * (lane >> 5);
          bf16x8 af = *(const bf16x8*)vp;
          ot[0][dt] = MFMA32(af, pb[0][s2], ot[0][dt]);
          ot[1][dt] = MFMA32(af, pb[1][s2], ot[1][dt]);
        }
      __builtin_amdgcn_s_setprio(0);
    };
    if constexpr (SM == 1) {
#pragma unroll 1
      for (int kt = 0; kt < 2; ++kt) half(kt);
    } else {
      half(0);
      half(1);
    }
  }
#pragma unroll
  for (int qt = 0; qt < 2; ++qt) {
    const float ltot = l_run[qt] + __shfl_xor(l_run[qt], 32);
    const float inv_l = 1.0f / ltot;
    const int tid2 = get_tid();
    bf16* op = O + (size_t)((tid2 >> 6) * 64 + qt * 32 + (tid2 & 31)) * ldo;
#pragma unroll
    for (int dt = 0; dt < 2; ++dt)
#pragma unroll
      for (int g4 = 0; g4 < 4; ++g4) {
        int dv = dt * 32 + 8 * g4 + 4 * ((tid2 >> 5) & 1);
        u32x2 o;
        o.x = cvtpk(ot[qt][dt][4 * g4 + 0] * inv_l, ot[qt][dt][4 * g4 + 1] * inv_l);
        o.y = cvtpk(ot[qt][dt][4 * g4 + 2] * inv_l, ot[qt][dt][4 * g4 + 3] * inv_l);
        *(u32x2*)(op + dv) = o;
      }
  }
}

DI void hgrn2_item(const Params& p, int item, char* smem) {
  const int vs = item & 3, dir = (item >> 2) & 1, h = (item >> 3) & 3, b = item >> 5;
  constexpr int QLS = 136, TLS = 72;
  bf16* Qr = (bf16*)smem;
  bf16* Kr = Qr + 64 * QLS;
  bf16* KrT = Kr + 64 * QLS;
  bf16* VTs = KrT + 128 * TLS;
  bf16* Att = VTs + 32 * TLS;
  bf16* STb = Att + 64 * TLS;
  float* rsum = (float*)(STb + 32 * QLS);
  float* lsum = rsum + 128;
  const int tid = get_tid(), lane = tid & 63, w = tid >> 6;
  const int c = tid & 127, half = tid >> 7;
  const bf16* ph = (const bf16*)(p.ws + OFF_PAHG);
  bf16* og = (bf16*)(p.ws + OFF_OHG) + (size_t)dir * NTOK * 512;
  auto rowof = [&](int pos) -> int {
    if (pos < CTXL) { int s = dir ? (CTXL - 1 - pos) : pos; return NLAT + b * CTXL + s; }
    int t = pos - CTXL; t = dir ? (SEQ - 1 - t) : t; return b * SEQ + t;
  };
  f32x16 S0, S1;
#pragma unroll
  for (int r = 0; r < 16; ++r) { S0[r] = 0.f; S1[r] = 0.f; }
  bf16 pq[32], pf[32];
  u32x4 pv;
  auto prefetch = [&](int ch) {
    const int p0 = ch * 64;
#pragma unroll
    for (int i = 0; i < 32; ++i) {
      const bf16* row = ph + (size_t)rowof(p0 + half * 32 + i) * 2560;
      pq[i] = row[h * 128 + c];
      pf[i] = row[512 + dir * 512 + h * 128 + c];
    }
    {
      const bf16* row = ph + (size_t)rowof(p0 + (tid >> 2)) * 2560;
      pv = *(const u32x4*)(row + 1536 + h * 128 + vs * 32 + (tid & 3) * 8);
    }
  };
  for (int ch = 0; ch < 132; ++ch) {
    prefetch(ch);
    {
      float run = 0.f;
      if (half == 0) {
#pragma unroll
        for (int ii = 31; ii >= 0; --ii) {
          float lg = bf2f(pf[ii]), q = bf2f(pq[ii]);
          float k = 1.f - __expf(lg);
          float eq = __expf(fminf(-run, 80.f)), ek = __expf(fmaxf(run, -80.f));
          const unsigned pk2 = cvtpk(q * eq, k * ek);
          const bf16 qv = (bf16)(pk2 & 0xffffu), kv = (bf16)(pk2 >> 16);
          Qr[ii * QLS + c] = qv;
          Kr[ii * QLS + c] = kv;
          KrT[c * TLS + ii] = kv;
          run += lg;
        }
        rsum[c] = __expf(run);
      } else {
#pragma unroll
        for (int ii = 0; ii < 32; ++ii) {
          float lg = bf2f(pf[ii]), q = bf2f(pq[ii]);
          float k = 1.f - __expf(lg);
          run += lg;
          float eq = __expf(fmaxf(run, -80.f)), ek = __expf(fminf(-run, 80.f));
          const unsigned pk2 = cvtpk(q * eq, k * ek);
          const bf16 qv = (bf16)(pk2 & 0xffffu), kv = (bf16)(pk2 >> 16);
          Qr[(32 + ii) * QLS + c] = qv;
          Kr[(32 + ii) * QLS + c] = kv;
          KrT[c * TLS + 32 + ii] = kv;
        }
        lsum[c] = __expf(run);
      }
      {
        int i = tid >> 2, v0 = (tid & 3) * 8;
#pragma unroll
        for (int j = 0; j < 4; ++j) {
          VTs[(v0 + 2 * j) * TLS + i] = (bf16)(pv[j] & 0xffffu);
          VTs[(v0 + 2 * j + 1) * TLS + i] = (bf16)(pv[j] >> 16);
        }
      }
    }
    __syncthreads();
    if (w < 2) {
      const int ntl = (w == 0) ? 2 : 1;
      for (int q2 = 0; q2 < ntl; ++q2) {
        const int tt = (w == 0) ? q2 : 1, stl = (w == 0) ? q2 : 0;
        f32x16 a;
#pragma unroll
        for (int r = 0; r < 16; ++r) a[r] = 0.f;
        mma_tile(a, Qr + tt * 32 * QLS, QLS, Kr + stl * 32 * QLS, QLS, 128);
#pragma unroll
        for (int r = 0; r < 16; ++r) {
          int t = tt * 32 + crow(r, lane), s = stl * 32 + (lane & 31);
          float v = (s <= t) ? a[r] : 0.f;
          Att[t * TLS + s] = (bf16)(cvtpk(v, v) & 0xffffu);
        }
      }
      if (w == 1) {
#pragma unroll
        for (int r = 0; r < 16; ++r) Att[crow(r, lane) * TLS + 32 + (lane & 31)] = 0;
      }
    } else {
      const int ct0 = (w - 2) * 2;
#pragma unroll
      for (int tI = 0; tI < 2; ++tI) {
        f32x16& S = tI ? S1 : S0;
        const int cb = (ct0 + tI) * 32;
#pragma unroll
        for (int g4 = 0; g4 < 4; ++g4) {
          int cc = cb + 8 * g4 + 4 * (lane >> 5);
          float e0 = rsum[cc], e1 = rsum[cc + 1], e2 = rsum[cc + 2], e3 = rsum[cc + 3];
          u32x2 o;
          o.x = cvtpk(S[4 * g4] * e0, S[4 * g4 + 1] * e1);
          o.y = cvtpk(S[4 * g4 + 2] * e2, S[4 * g4 + 3] * e3);
          *(u32x2*)(STb + (lane & 31) * QLS + cc) = o;
        }
        f32x16 a;
#pragma unroll
        for (int r = 0; r < 16; ++r) a[r] = 0.f;
        mma_tile(a, KrT + cb * TLS, TLS, VTs, TLS, 64);
#pragma unroll
        for (int r = 0; r < 16; ++r) {
          int cc = cb + crow(r, lane);
          float el = lsum[cc];
          float er = rsum[cc];
          S[r] = S[r] * (el * er) + a[r] * el;
        }
      }
    }
    __syncthreads();
    if (w < 2) {
      f32x16 a;
#pragma unroll
      for (int r = 0; r < 16; ++r) a[r] = 0.f;
      mma_tile(a, Att + w * 32 * TLS, TLS, VTs, TLS, 64);
      mma_tile(a, Qr + w * 32 * QLS, QLS, STb, QLS, 128);
#pragma unroll
      for (int r = 0; r < 16; ++r) {
        int t = w * 32 + crow(r, lane);
        int row = rowof(ch * 64 + t);
        og[(size_t)row * 512 + h * 128 + vs * 32 + (lane & 31)] = f2bf(a[r]);
      }
    }
    __syncthreads();
  }
}

DI void phase_mix0(const Params& p, char* smem, int cidx) {
  __shared__ int s_item;
  if (blockIdx.x < 128) hgrn2_item(p, blockIdx.x, smem);
  unsigned* cnt = (unsigned*)(p.ws + OFF_CNT) + cidx;
  const bf16* pg = (const bf16*)(p.ws + OFF_PAGQA);
  const bf16* vt = (const bf16*)(p.ws + OFF_VT0);
  bf16* ycat = (bf16*)(p.ws + OFF_ACTA);
  float kb0;
  {
    const int ln = get_tid() & 63;
    kb0 = 8.0f * 1.01f * wave_max_early(fabsf(p.gqa_kn_g[ln]));
  }
  const int n_lat = 4 * 8 * 32, n_ctx = 4 * 8;
  while (true) {
    __syncthreads();
    if (get_tid() == 0) s_item = (int)atomicAdd(cnt, 1u);
    __syncthreads();
    const int it = s_item;
    if (it >= n_lat + n_ctx) break;
    int b, hq, r0, nk;
    if (it < n_lat) { const int qt = it & 31; hq = (it >> 5) & 7; b = it >> 8; r0 = b * SEQ + qt * 256; nk = SKEYS; }
    else { const int i2 = it - n_lat; hq = i2 & 7; b = i2 >> 3; r0 = NLAT + b * CTXL; nk = CTXL; }
    const int kvh = hq >> 2;
    attn_item<64, 2>(pg + (size_t)r0 * 768 + hq * 64, 768,
                  pg + (size_t)(NLAT + b * CTXL) * 768 + 512 + kvh * 64, pg + (size_t)(b * SEQ) * 768 + 512 + kvh * 64, 768,
                  vt + (size_t)((b * 2 + kvh) * 64) * SKEYS, nk, ycat + (size_t)r0 * DM + hq * 64, DM, 0.125f, smem, kb0);
  }
}

DI void phase_hg_readout(const Params& p) {
  const int lane = get_tid() & 63, w = get_tid() >> 6;
  const bf16* o0 = (const bf16*)(p.ws + OFF_OHG);
  const bf16* o1 = o0 + (size_t)NTOK * 512;
  const bf16* ph = (const bf16*)(p.ws + OFF_PAHG);
  bf16* ycat = (bf16*)(p.ws + OFF_ACTA);
  const float g0 = p.hg_onorm_g[lane * 2], g1 = p.hg_onorm_g[lane * 2 + 1];
  for (int r = blockIdx.x * 4 + w; r < NTOK; r += gridDim.x * 4) {
#pragma unroll
    for (int h = 0; h < 4; ++h) {
      unsigned a = *(const unsigned*)(o0 + (size_t)r * 512 + h * 128 + lane * 2);
      unsigned b2 = *(const unsigned*)(o1 + (size_t)r * 512 + h * 128 + lane * 2);
      unsigned gg = *(const unsigned*)(ph + (size_t)r * 2560 + 2048 + h * 128 + lane * 2);
      float x0 = bflo(a) + bflo(b2), x1 = bfhi(a) + bfhi(b2);
      float ss = wave_sum(x0 * x0 + x1 * x1);
      float rs = rsqrtf(ss * (1.f / 128.f) + EPSN);
      float y0 = x0 * rs * g0 * siluf_(bflo(gg)), y1 = x1 * rs * g1 * siluf_(bfhi(gg));
      *(unsigned*)(ycat + (size_t)r * DM + 512 + h * 128 + lane * 2) = cvtpk(y0, y1);
    }
  }
}

template <int MI>
DI void resid_epilogue(f32x16 (&acc)[MI][2], const float* src, float* dst, const float* __restrict__ g) {
  const int lane = get_tid() & 63, w = get_tid() >> 6;
  const int wm = w >> 1, wn = w & 1;
  const float g0 = g[wn * 64 + (lane & 31)], g1 = g[wn * 64 + 32 + (lane & 31)];
#pragma unroll
  for (int mi = 0; mi < MI; ++mi) {
    const size_t o0 = (size_t)(wm * (MI * 32) + mi * 32 + 4 * (lane >> 5)) * DM + wn * 64 + (lane & 31);
    float xv[2][16];
#pragma unroll
    for (int r = 0; r < 16; ++r) {
      const size_t ro = o0 + (size_t)((r & 3) + 8 * (r >> 2)) * DM;
      xv[0][r] = src[ro];
      xv[1][r] = src[ro + 32];
    }
#pragma unroll
    for (int r = 0; r < 16; ++r) {
      const size_t ro = o0 + (size_t)((r & 3) + 8 * (r >> 2)) * DM;
      dst[ro] = xv[0][r] + g0 * acc[mi][0][r];
      dst[ro + 32] = xv[1][r] + g1 * acc[mi][1][r];
    }
  }
}
DI void resid_prefetch2(float (&xv)[2][2][16], const float* src) {
  const int lane = get_tid() & 63, w = get_tid() >> 6;
  const int wm = w >> 1, wn = w & 1;
#pragma unroll
  for (int mi = 0; mi < 2; ++mi) {
    const size_t o0 = (size_t)(wm * 64 + mi * 32 + 4 * (lane >> 5)) * DM + wn * 64 + (lane & 31);
#pragma unroll
    for (int r = 0; r < 16; ++r) {
      const size_t ro = o0 + (size_t)((r & 3) + 8 * (r >> 2)) * DM;
      xv[mi][0][r] = src[ro];
      xv[mi][1][r] = src[ro + 32];
    }
  }
}
DI void resid_store2(f32x16 (&acc)[2][2], const float (&xv)[2][2][16], float* dst, const float* __restrict__ g) {
  const int lane = get_tid() & 63, w = get_tid() >> 6;
  const int wm = w >> 1, wn = w & 1;
  const float g0 = g[wn * 64 + (lane & 31)], g1 = g[wn * 64 + 32 + (lane & 31)];
#pragma unroll
  for (int mi = 0; mi < 2; ++mi) {
    const size_t o0 = (size_t)(wm * 64 + mi * 32 + 4 * (lane >> 5)) * DM + wn * 64 + (lane & 31);
#pragma unroll
    for (int r = 0; r < 16; ++r) {
      const size_t ro = o0 + (size_t)((r & 3) + 8 * (r >> 2)) * DM;
      dst[ro] = xv[mi][0][r] + g0 * acc[mi][0][r];
      dst[ro + 32] = xv[mi][1][r] + g1 * acc[mi][1][r];
    }
  }
}
DI void phase_outproj(const Params& p, int layer, size_t wt_off, int nrows, bool first, char* smem) {
  (void)first;
  bf16* As = (bf16*)smem; bf16* Bs = As + 128 * GLS;
  const bf16* A = (const bf16*)(p.ws + OFF_ACTA);
  const bf16* Wt = (const bf16*)(p.ws + wt_off);
  const int ntn = 8, ntm = nrows / 128;
  for (int t = blockIdx.x; t < ntn * ntm; t += gridDim.x) {
    const int mt = t / ntn, nt = t % ntn;
    f32x16 acc[2][2];
    const int r0 = mt * 128;
    float xv[2][2][16];
    resid_prefetch2(xv, orig_row(p, r0) + nt * 128);
    gemm_128x128(A + (size_t)mt * 128 * DM, DM, Wt + (size_t)nt * 128 * DM, DM, DM, acc, As, Bs);
    resid_store2(acc, xv, res_row(p, r0) + nt * 128, mod_ptr(p, layer, r0, 2) + nt * 128);
  }
}
DI void phase_outproj1(const Params& p, char* smem) {
  bf16* As = (bf16*)smem; bf16* Bs = As + 256 * GLS;
  const bf16* A = (const bf16*)(p.ws + OFF_ACTA);
  const bf16* Wt = (const bf16*)(p.ws + OFF_WT_ODOUT);
  const int ntn = 8, ntm = NLAT / 256;
  for (int t = blockIdx.x; t < ntn * ntm; t += gridDim.x) {
    const int mt = t / ntn, nt = t % ntn;
    f32x16 acc[4][2];
    gemm_256x128(A + (size_t)mt * 256 * DM, DM, Wt + (size_t)nt * 128 * DM, DM, DM, acc, As, Bs);
    float* xp = p.out + (size_t)(mt * 256) * DM + nt * 128;
    resid_epilogue<4>(acc, xp, xp, mod_ptr(p, 1, mt * 256, 2) + nt * 128);
  }
}

DI void tk_ins(float (&L)[16], float x) {
#pragma unroll
  for (int j = 15; j >= 1; --j) L[j] = __builtin_amdgcn_fmed3f(L[j - 1], L[j], x);
  L[0] = fmaxf(L[0], x);
}
DI void tk_insert(float (&v)[16], int (&id)[16], float x, int xi) {
  if (x > v[15]) {
    v[15] = x; id[15] = xi;
#pragma unroll
    for (int j = 15; j > 0; --j) {
      bool sw = v[j] > v[j - 1];
      float a = v[j], b2 = v[j - 1];
      int ia = id[j], ib = id[j - 1];
      v[j - 1] = sw ? a : b2; v[j] = sw ? b2 : a;
      id[j - 1] = sw ? ia : ib; id[j] = sw ? ib : ia;
    }
  }
}

DI void phase_peer_route(const Params& p, int layer, int nrows, char* smem, size_t roff = OFF_RIDX) {
  bf16* As = (bf16*)smem; bf16* Bs = As + 128 * GLS;
  constexpr int QLS = 136;
  bf16* Qt = (bf16*)smem;
  bf16* Kt = Qt + 128 * QLS;
  float* Sc = (float*)smem;
  const bf16* A = (const bf16*)(p.ws + OFF_ACTA);
  const bf16* Wt = (const bf16*)(p.ws + OFF_WT_PWQ) + (size_t)layer * 2048 * 1024;
  const bf16* keys = (const bf16*)(p.ws + OFF_PKEYS) + (size_t)layer * 8 * 2 * 128 * 128;
  int* ridx = (int*)(p.ws + roff);
  float* rgw = (float*)(p.ws + roff + (OFF_RGW - OFF_RIDX));
  const int tid = get_tid(), lane = tid & 63, w = tid >> 6;
  const int wm = w >> 1, wn = w & 1;
  const int ntm = nrows / 128;
  for (int it = blockIdx.x; it < ntm * 8; it += gridDim.x) {
    const int mt = it >> 3, h = it & 7;
    float l0v[16]; int l0i[16];
    float lv[16]; int li[16];
    for (int pp = 0; pp < 2; ++pp) {
      f32x16 acc[2][2];
      gemm_128x128(A + (size_t)mt * 128 * DM, DM, Wt + (size_t)((h * 2 + pp) * 128) * DM, DM, DM, acc, As, Bs);
      __syncthreads();
      gemm_epi(acc, [&](int row, int col, float v) { Qt[row * QLS + col] = f2bf(v); });
      {
        const bf16* kb = keys + (size_t)((h * 2 + pp) * 128) * 128;
#pragma unroll
        for (int i = 0; i < 8; ++i) {
          int ci = i * 256 + tid;
          int row = ci >> 4, chh = ci & 15;
          *(u32x4*)(Kt + row * QLS + chh * 8) = *(const u32x4*)(kb + row * 128 + chh * 8);
        }
      }
      __syncthreads();
      f32x16 sa[2][2];
#pragma unroll
      for (int i = 0; i < 2; ++i)
#pragma unroll
        for (int j = 0; j < 2; ++j) {
#pragma unroll
          for (int r = 0; r < 16; ++r) sa[i][j][r] = 0.f;
          mma_tile(sa[i][j], Qt + (wm * 64 + i * 32) * QLS, QLS, Kt + (wn * 64 + j * 32) * QLS, QLS, 128);
        }
      __syncthreads();
      gemm_epi(sa, [&](int row, int col, float v) { Sc[row * 129 + col] = v; });
      __syncthreads();
      {
        const int tok = tid & 127, hf = tid >> 7;
        float* Lst = Sc + 128 * 129;
        float L[16];
#pragma unroll
        for (int j = 0; j < 16; ++j) L[j] = -3.0e38f;
#pragma unroll 8
        for (int n = 0; n < 64; ++n) {
          const int nn = hf * 64 + n;
          const unsigned kb = (__float_as_uint(Sc[tok * 129 + nn]) & 0xffffff80u) | (unsigned)nn;
          tk_ins(L, __uint_as_float(kb));
        }
        if (hf == 1) {
#pragma unroll
          for (int j = 0; j < 16; ++j) Lst[tok * 17 + j] = L[j];
        }
        __syncthreads();
        if (hf == 0) {
#pragma unroll
          for (int j = 0; j < 16; ++j) tk_ins(L, Lst[tok * 17 + j]);
#pragma unroll
          for (int j = 0; j < 16; ++j) {
            const int ix = (int)(__float_as_uint(L[j]) & 0x7fu);
            li[j] = ix;
            lv[j] = Sc[tok * 129 + ix];
          }
          if (pp == 0) {
#pragma unroll
            for (int j = 0; j < 16; ++j) { l0v[j] = lv[j]; l0i[j] = li[j]; }
          }
        }
      }
      __syncthreads();
    }
    if (tid < 128) {
      float fv[16]; int fi[16];
#pragma unroll
      for (int j = 0; j < 16; ++j) { fv[j] = -3.0e38f; fi[j] = 0; }
#pragma unroll
      for (int a = 0; a < 16; ++a)
#pragma unroll
        for (int b2 = 0; b2 < 16; ++b2)
          if ((a + 1) * (b2 + 1) <= 16) tk_insert(fv, fi, l0v[a] + lv[b2], l0i[a] * 128 + li[b2]);
      float mx = fv[0];
      float e[16];
#pragma unroll
      for (int j = 0; j < 16; ++j) e[j] = fv[j];
      float sum = 0.f;
#pragma unroll
      for (int j = 0; j < 16; ++j) { e[j] = __expf(e[j] - mx); sum += e[j]; }
      const float inv = 1.f / sum;
      const int r = mt * 128 + tid;
      int4* ip = (int4*)(ridx + (size_t)r * 128 + h * 16);
      float4* gp = (float4*)(rgw + (size_t)r * 128 + h * 16);
#pragma unroll
      for (int j = 0; j < 4; ++j) {
        ip[j] = make_int4(fi[4 * j], fi[4 * j + 1], fi[4 * j + 2], fi[4 * j + 3]);
        gp[j] = make_float4(e[4 * j] * inv, e[4 * j + 1] * inv, e[4 * j + 2] * inv, e[4 * j + 3] * inv);
      }
    }
  }
}

typedef float f32x2 __attribute__((ext_vector_type(2)));
DI float wave_max(float v) {
#pragma unroll
  for (int o = 32; o > 0; o >>= 1) v = fmaxf(v, __shfl_xor(v, o));
  return v;
}
DI unsigned pk4_fp8(float a, float b, float c, float d) {
  int r = 0;
  r = __builtin_amdgcn_cvt_pk_fp8_f32(a, b, r, false);
  r = __builtin_amdgcn_cvt_pk_fp8_f32(c, d, r, true);
  return (unsigned)r;
}
DI void convert_fp8_rows(const float* __restrict__ src, unsigned char* __restrict__ dst, float* __restrict__ scl) {
  const int lane = get_tid() & 63, w = get_tid() >> 6;
  for (int row = blockIdx.x * 4 + w; row < 16384; row += gridDim.x * 4) {
    const float4* s4 = (const float4*)(src + (size_t)row * 1024) + lane * 4;
    float4 v0 = s4[0], v1 = s4[1], v2 = s4[2], v3 = s4[3];
    float m = fmaxf(fmaxf(fmaxf(fabsf(v0.x), fabsf(v0.y)), fmaxf(fabsf(v0.z), fabsf(v0.w))),
                    fmaxf(fmaxf(fabsf(v1.x), fabsf(v1.y)), fmaxf(fabsf(v1.z), fabsf(v1.w))));
    m = fmaxf(m, fmaxf(fmaxf(fmaxf(fabsf(v2.x), fabsf(v2.y)), fmaxf(fabsf(v2.z), fabsf(v2.w))),
                       fmaxf(fmaxf(fabsf(v3.x), fabsf(v3.y)), fmaxf(fabsf(v3.z), fabsf(v3.w)))));
    m = wave_max(m);
    const float sc = (m > 0.f) ? m * (1.0f / 448.0f) : 1.0f;
    const float inv = 1.0f / sc;
    u32x4 o;
    o.x = pk4_fp8(v0.x * inv, v0.y * inv, v0.z * inv, v0.w * inv);
    o.y = pk4_fp8(v1.x * inv, v1.y * inv, v1.z * inv, v1.w * inv);
    o.z = pk4_fp8(v2.x * inv, v2.y * inv, v2.z * inv, v2.w * inv);
    o.w = pk4_fp8(v3.x * inv, v3.y * inv, v3.z * inv, v3.w * inv);
    ((u32x4*)(dst + (size_t)row * 1024))[lane] = o;
    if (lane == 0) scl[row] = sc;
  }
}
DI void phase_convert_tables(const Params& p, int layer) {
  convert_fp8_rows(p.peer_u + (size_t)layer * 16384 * 1024, (unsigned char*)(p.ws + OFF_UTAB), (float*)(p.ws + OFF_SU));
  convert_fp8_rows(p.peer_v + (size_t)layer * 16384 * 1024, (unsigned char*)(p.ws + OFF_VTAB), (float*)(p.ws + OFF_SV));
}

struct GBuf { u32x4 u[8]; u32x4 v[8]; float su, sv, gw; };
DI void phase_peer_gather(const Params& p, int layer, int nrows, bool dry) {
  const int lane = get_tid() & 63, w = get_tid() >> 6;
  const bf16* hb = (const bf16*)(p.ws + OFF_ACTA);
  const unsigned char* ut = (const unsigned char*)(p.ws + OFF_UTAB);
  const unsigned char* vtb = (const unsigned char*)(p.ws + OFF_VTAB);
  const float* su = (const float*)(p.ws + OFF_SU);
  const float* sv = (const float*)(p.ws + OFF_SV);
  const int* ridx = (const int*)(p.ws + OFF_RIDX);
  const float* rgw = (const float*)(p.ws + OFF_RGW);
  const int ecode = ((lane >> 5) & 1) * 4 + ((lane >> 4) & 1) * 2 + ((lane >> 3) & 1);
  for (int r = blockIdx.x * 4 + w; r < nrows; r += gridDim.x * 4) {
    f32x2 h2[8];
    {
      u32x4 a = *(const u32x4*)(hb + (size_t)r * DM + lane * 16);
      u32x4 b2 = *(const u32x4*)(hb + (size_t)r * DM + lane * 16 + 8);
      h2[0] = f32x2{bflo(a.x), bfhi(a.x)}; h2[1] = f32x2{bflo(a.y), bfhi(a.y)};
      h2[2] = f32x2{bflo(a.z), bfhi(a.z)}; h2[3] = f32x2{bflo(a.w), bfhi(a.w)};
      h2[4] = f32x2{bflo(b2.x), bfhi(b2.x)}; h2[5] = f32x2{bflo(b2.y), bfhi(b2.y)};
      h2[6] = f32x2{bflo(b2.z), bfhi(b2.z)}; h2[7] = f32x2{bflo(b2.w), bfhi(b2.w)};
    }
    const int e_lo = ridx[(size_t)r * 128 + lane], e_hi = ridx[(size_t)r * 128 + 64 + lane];
    const float g_lo = rgw[(size_t)r * 128 + lane], g_hi = rgw[(size_t)r * 128 + 64 + lane];
    f32x2 acc[8];
#pragma unroll
    for (int j = 0; j < 8; ++j) acc[j] = f32x2{0.f, 0.f};
    auto gload = [&](GBuf& B, int kb) {
      const int esrc = (kb < 8) ? e_lo : e_hi;
      const float gsrc = (kb < 8) ? g_lo : g_hi;
      const int base = (kb & 7) * 8;
#pragma unroll
      for (int j = 0; j < 8; ++j) {
        const int e = __builtin_amdgcn_readlane(esrc, base + j);
        B.u[j] = *(const u32x4*)(ut + (size_t)e * 1024 + lane * 16);
        B.v[j] = *(const u32x4*)(vtb + (size_t)e * 1024 + lane * 16);
      }
      const int el = __shfl(esrc, base + ecode);
      B.su = su[el]; B.sv = sv[el];
      B.gw = __shfl(gsrc, base + ecode);
    };
    auto compute = [&](GBuf& B) {
      float part[8];
#pragma unroll
      for (int j = 0; j < 8; ++j) {
        f32x2 s2 = f32x2{0.f, 0.f};
#pragma unroll
        for (int q = 0; q < 4; ++q) {
          f32x2 lo = __builtin_amdgcn_cvt_pk_f32_fp8((int)B.u[j][q], false);
          f32x2 hi = __builtin_amdgcn_cvt_pk_f32_fp8((int)B.u[j][q], true);
          s2 += lo * h2[2 * q];
          s2 += hi * h2[2 * q + 1];
        }
        part[j] = s2.x + s2.y;
      }
      const bool b5 = lane & 32, b4 = lane & 16, b3 = lane & 8;
      float y[4], z[2], t;
#pragma unroll
      for (int i = 0; i < 4; ++i) {
        float send = b5 ? part[i] : part[i + 4];
        float keep = b5 ? part[i + 4] : part[i];
        y[i] = keep + __shfl_xor(send, 32);
      }
#pragma unroll
      for (int i = 0; i < 2; ++i) {
        float send = b4 ? y[i] : y[i + 2];
        float keep = b4 ? y[i + 2] : y[i];
        z[i] = keep + __shfl_xor(send, 16);
      }
      {
        float send = b3 ? z[0] : z[1];
        float keep = b3 ? z[1] : z[0];
        t = keep + __shfl_xor(send, 8);
      }
      t += __shfl_xor(t, 4);
      t += __shfl_xor(t, 2);
      t += __shfl_xor(t, 1);
      const float wl = geluf_(t * B.su) * B.gw * B.sv;
#pragma unroll
      for (int j = 0; j < 8; ++j) {
        const int src_lane = ((j >> 2) & 1) * 32 + ((j >> 1) & 1) * 16 + (j & 1) * 8;
        const float wj = __builtin_bit_cast(float, __builtin_amdgcn_readlane(__builtin_bit_cast(int, wl), src_lane));
        const f32x2 w2 = f32x2{wj, wj};
#pragma unroll
        for (int q = 0; q < 4; ++q) {
          f32x2 lo = __builtin_amdgcn_cvt_pk_f32_fp8((int)B.v[j][q], false);
          f32x2 hi = __builtin_amdgcn_cvt_pk_f32_fp8((int)B.v[j][q], true);
          acc[2 * q] += w2 * lo;
          acc[2 * q + 1] += w2 * hi;
        }
      }
    };
    GBuf B0, B1;
    gload(B0, 0);
#pragma unroll 1
    for (int kb = 0; kb < 16; kb += 2) {
      gload(B1, kb + 1);
      compute(B0);
      if (kb + 2 < 16) gload(B0, kb + 2);
      compute(B1);
    }
    if (dry && acc[0].x != 12345.678f) continue;
    float* xr = res_row(p, r) + lane * 16;
    const float* g5 = mod_ptr(p, layer, r, 5) + lane * 16;
    float4 xn[4];
    float ss = 0.f;
#pragma unroll
    for (int q = 0; q < 4; ++q) {
      float4 x0 = ((float4*)xr)[q];
      float4 m0 = ((const float4*)g5)[q];
      x0.x += m0.x * acc[2 * q].x; x0.y += m0.y * acc[2 * q].y; x0.z += m0.z * acc[2 * q + 1].x; x0.w += m0.w * acc[2 * q + 1].y;
      xn[q] = x0;
      ss += x0.x * x0.x + x0.y * x0.y + x0.z * x0.z + x0.w * x0.w;
    }
    ss = wave_sum(ss);
    const float rs = rsqrtf(ss * (1.0f / 1024.0f) + EPSN);
    if (layer == 0) {
      const float* gg = p.norm1_g + 1024 + lane * 16;
      const float* sh = mod_ptr(p, 1, r, 0) + lane * 16;
      const float* sc = mod_ptr(p, 1, r, 1) + lane * 16;
      unsigned hw[8];
#pragma unroll
      for (int q = 0; q < 4; ++q) {
        ((float4*)xr)[q] = xn[q];
        float4 g4 = ((const float4*)gg)[q], s4 = ((const float4*)sh)[q], c4 = ((const float4*)sc)[q];
        float o0 = xn[q].x * rs * g4.x * (1.f + c4.x) + s4.x;
        float o1 = xn[q].y * rs * g4.y * (1.f + c4.y) + s4.y;
        float o2 = xn[q].z * rs * g4.z * (1.f + c4.z) + s4.z;
        float o3 = xn[q].w * rs * g4.w * (1.f + c4.w) + s4.w;
        hw[2 * q] = cvtpk(o0, o1); hw[2 * q + 1] = cvtpk(o2, o3);
      }
      u32x4 w0 = {hw[0], hw[1], hw[2], hw[3]}, w1 = {hw[4], hw[5], hw[6], hw[7]};
      bf16* hd = (bf16*)(p.ws + OFF_ACTA) + (size_t)r * DM + lane * 16;
      *(u32x4*)hd = w0;
      *(u32x4*)(hd + 8) = w1;
    } else {
      const float* gg = p.final_g + lane * 16;
#pragma unroll
      for (int q = 0; q < 4; ++q) {
        float4 g4 = ((const float4*)gg)[q];
        float4 o;
        o.x = xn[q].x * rs * g4.x; o.y = xn[q].y * rs * g4.y; o.z = xn[q].z * rs * g4.z; o.w = xn[q].w * rs * g4.w;
        ((float4*)xr)[q] = o;
      }
    }
  }
}

DI void phase_inproj1(const Params& p, char* smem) {
  bf16* As = (bf16*)smem; bf16* Bs = As + 256 * GLS;
  const bf16* A = (const bf16*)(p.ws + OFF_ACTA);
  const bf16* Wt = (const bf16*)(p.ws + OFF_WT_ODIN);
  bf16* pm = (bf16*)(p.ws + OFF_PA1M);
  bf16* pu = (bf16*)(p.ws + OFF_U1);
  const int ntn = 10, ntm = NTOK / 256;
  for (int t = blockIdx.x; t < ntn * ntm; t += gridDim.x) {
    const int mt = t / ntn, nt = t % ntn;
    f32x16 acc[4][2];
    gemm_256x128(A + (size_t)mt * 256 * DM, DM, Wt + (size_t)nt * 128 * DM, DM, DM, acc, As, Bs);
    gemm_epi2(acc, [&](int row, int col, float v) {
      int r = mt * 256 + row, cg_ = nt * 128 + col;
      if (cg_ < 672) pm[(size_t)r * 672 + cg_] = f2bf(v);
      else if (cg_ < 1184) pu[(size_t)r * 512 + (cg_ - 672)] = f2bf(v);
    });
  }
}

DI void phase_mla_prep(const Params& p) {
  const int lane = get_tid() & 63, w = get_tid() >> 6;
  const bf16* pm = (const bf16*)(p.ws + OFF_PA1M);
  bf16* qn = (bf16*)(p.ws + OFF_QN);
  bf16* kvn = (bf16*)(p.ws + OFF_KVN);
  bf16* k1 = (bf16*)(p.ws + OFF_K1);
  const float inv = __powf(10000.f, -(float)(lane & 7) / 8.f);
  for (int r = blockIdx.x * 4 + w; r < NTOK; r += gridDim.x * 4) {
    const bf16* row = pm + (size_t)r * 672;
    if (r < NLAT) {
      float v[6]; float ss = 0.f;
#pragma unroll
      for (int i = 0; i < 6; ++i) { v[i] = bf2f(row[i * 64 + lane]); ss += v[i] * v[i]; }
      ss = wave_sum(ss);
      const float rs = rsqrtf(ss * (1.f / 384.f) + EPSN);
#pragma unroll
      for (int i = 0; i < 6; ++i) qn[(size_t)r * 384 + i * 64 + lane] = f2bf(v[i] * rs * p.mla_qa_g[i * 64 + lane]);
    }
    {
      float v[4]; float ss = 0.f;
#pragma unroll
      for (int i = 0; i < 4; ++i) { v[i] = bf2f(row[384 + i * 64 + lane]); ss += v[i] * v[i]; }
      ss = wave_sum(ss);
      const float rs = rsqrtf(ss * (1.f / 256.f) + EPSN);
#pragma unroll
      for (int i = 0; i < 4; ++i) kvn[(size_t)r * 256 + i * 64 + lane] = f2bf(v[i] * rs * p.mla_kva_g[i * 64 + lane]);
    }
    {
      const int cl = lane & 31;
      float y = bf2f(row[640 + cl]);
      float sn = 0.f, cs = 1.f;
      if (r < NLAT) {
        int t = r & 8191;
        float pos = (cl < 16) ? (float)(t >> 6) : (float)(t & 63);
        sincosf(pos * inv, &sn, &cs);
      }
      float pr = __shfl_xor(y, 8);
      float o = y * cs + ((cl & 8) ? pr * sn : -pr * sn);
      bf16 ob = f2bf(o);
      {
        const float ob_f = bf2f(ob);
        const float sq = wave_sum(lane < 32 ? ob_f * ob_f : 0.f);
        if (lane == 0) ((float*)(p.ws + OFF_KRSQ))[r] = sq;
      }
      const int hb = (lane >> 5) * 4;
#pragma unroll
      for (int hh = 0; hh < 4; ++hh) k1[(size_t)r * 768 + (hb + hh) * 96 + 64 + cl] = ob;
    }
  }
}

DI void phase_mla_up(const Params& p, char* smem) {
  bf16* As = (bf16*)smem; bf16* Bs = As + 128 * GLS;
  const bf16* qn = (const bf16*)(p.ws + OFF_QN);
  const bf16* kvn = (const bf16*)(p.ws + OFF_KVN);
  const bf16* wq = (const bf16*)(p.ws + OFF_WT_QUP);
  const bf16* wkv = (const bf16*)(p.ws + OFF_WT_KVUP);
  bf16* q1 = (bf16*)(p.ws + OFF_Q1);
  bf16* k1 = (bf16*)(p.ws + OFF_K1);
  bf16* vt1 = (bf16*)(p.ws + OFF_VT1);
  const float2* rtab = (const float2*)(p.ws + OFF_ROPE1);
  const int lane = get_tid() & 63, w = get_tid() >> 6;
  const int wm = w >> 1, wn = w & 1;
  const int nq = (NLAT / 128) * 6, nkv = (NTOK / 128) * 8;
  for (int t = blockIdx.x; t < nq + nkv; t += gridDim.x) {
    f32x16 acc[2][2];
    if (t < nq) {
      const int mt = t / 6, nt = t % 6;
      gemm_128x128(qn + (size_t)mt * 128 * 384, 384, wq + (size_t)nt * 128 * 384, 384, 384, acc, As, Bs);
#pragma unroll
      for (int mi = 0; mi < 2; ++mi)
#pragma unroll
        for (int ni = 0; ni < 2; ++ni) {
          const int colbase = nt * 128 + wn * 64 + ni * 32;
          const bool rope = (colbase % 96) == 64;
          const int cl = lane & 31;
#pragma unroll
          for (int r = 0; r < 16; ++r) {
            const int row = mt * 128 + wm * 64 + mi * 32 + crow(r, lane);
            float v = acc[mi][ni][r];
            float pr = __shfl_xor(v, 8);
            if (rope) {
              int tt = row & 8191;
              float2 csn = rtab[tt * 16 + ((cl >> 4) << 3) + (cl & 7)];
              v = v * csn.x + ((cl & 8) ? pr * csn.y : -pr * csn.y);
            }
            q1[(size_t)row * 768 + colbase + cl] = f2bf(v * (0.10206207261596577f * 1.4426950408889634f));
          }
        }
    } else {
      const int t2 = t - nq;
      const int mt = t2 >> 3, h = t2 & 7;
      gemm_128x128(kvn + (size_t)mt * 128 * 256, 256, wkv + (size_t)h * 128 * 256, 256, 256, acc, As, Bs);
      const int r0 = mt * 128;
      int b, s0;
      if (r0 < NLAT) { b = r0 >> 13; s0 = CTXL + (r0 & 8191); } else { int rc = r0 - NLAT; b = rc >> 8; s0 = rc & 255; }
#pragma unroll
      for (int mi = 0; mi < 2; ++mi)
#pragma unroll
        for (int ni = 0; ni < 2; ++ni) {
          const int cl = ni * 32 + (lane & 31);
          if (wn == 0) {
#pragma unroll
            for (int r = 0; r < 16; ++r) {
              const int row = r0 + wm * 64 + mi * 32 + crow(r, lane);
              k1[(size_t)row * 768 + h * 96 + cl] = f2bf(acc[mi][ni][r]);
            }
            if (ni == 1) {
              float mxk = 0.f;
#pragma unroll
              for (int r = 0; r < 16; ++r) {
                float sq = acc[mi][0][r] * acc[mi][0][r] + acc[mi][1][r] * acc[mi][1][r];
                sq += __shfl_xor(sq, 16); sq += __shfl_xor(sq, 8); sq += __shfl_xor(sq, 4); sq += __shfl_xor(sq, 2); sq += __shfl_xor(sq, 1);
                const int row = r0 + wm * 64 + mi * 32 + crow(r, lane);
                sq += ((const float*)(p.ws + OFF_KRSQ))[row];
                mxk = fmaxf(mxk, sq);
              }
              mxk = wave_max(mxk);
              if (lane == 0) atomicMax((unsigned*)(p.ws + OFF_KMAX) + b * 8 + h, __float_as_uint(sqrtf(mxk) * 1.02f));
            }
          } else {
            bf16* vrow = vt1 + (size_t)((b * 8 + h) * 64 + cl) * SKEYS + s0 + wm * 64 + mi * 32;
#pragma unroll
            for (int g4 = 0; g4 < 4; ++g4) {
              u32x2 o;
              o.x = cvtpk(acc[mi][ni][4 * g4], acc[mi][ni][4 * g4 + 1]);
              o.y = cvtpk(acc[mi][ni][4 * g4 + 2], acc[mi][ni][4 * g4 + 3]);
              *(u32x2*)(vrow + 8 * g4 + 4 * (lane >> 5)) = o;
            }
          }
        }
    }
  }
}

DI void s5_item(const Params& p, int item, char* smem) {
  const int dir = item & 1, g = (item >> 1) & 31, b = item >> 6;
  constexpr int ULS = 264, SLS = 136;
  bf16* Uc = (bf16*)smem;
  bf16* Sp = Uc + 32 * ULS;
  float* E = (float*)(Sp + 32 * SLS);
  const int mi_ = g * 2 + dir;
  const bf16* T = (const bf16*)(p.ws + OFF_S5T) + (size_t)mi_ * 65536;
  const bf16* WE = (const bf16*)(p.ws + OFF_S5WE) + (size_t)mi_ * 32768;
  const bf16* WY = (const bf16*)(p.ws + OFF_S5WY) + (size_t)mi_ * 32768;
  const float* A16 = (const float*)(p.ws + OFF_S5A16) + (size_t)mi_ * 128;
  const bf16* U1 = (const bf16*)(p.ws + OFF_U1);
  bf16* ys = (bf16*)(p.ws + OFF_YS5) + (size_t)dir * NLAT * 512;
  const int tid = get_tid(), lane = tid & 63, w = tid >> 6;
  auto rowof = [&](int pos) -> int {
    if (pos < CTXL) { int s = dir ? (CTXL - 1 - pos) : pos; return NLAT + b * CTXL + s; }
    int t = pos - CTXL; t = dir ? (SEQ - 1 - t) : t; return b * SEQ + t;
  };
  float sre = 0.f, sim = 0.f;
  const float a16r = A16[(lane & 63) * 2], a16i = A16[(lane & 63) * 2 + 1];
  for (int sc = 0; sc < 17; ++sc) {
    const int nvalid = (528 - sc * 32) < 32 ? (528 - sc * 32) : 32;
    __syncthreads();
    {
      const int n = tid >> 3, j0 = (tid & 7) * 2;
#pragma unroll
      for (int jj = 0; jj < 2; ++jj) {
        u32x4 a = {0u, 0u, 0u, 0u}, b2 = {0u, 0u, 0u, 0u};
        if (n < nvalid) {
          const int pos = (sc * 32 + n) * 16 + j0 + jj;
          const bf16* src = U1 + (size_t)rowof(pos) * 512 + g * 16;
          a = *(const u32x4*)src; b2 = *(const u32x4*)(src + 8);
        }
        *(u32x4*)(Uc + n * ULS + (j0 + jj) * 16) = a;
        *(u32x4*)(Uc + n * ULS + (j0 + jj) * 16 + 8) = b2;
      }
    }
    __syncthreads();
    f32x16 e, y0, y1;
#pragma unroll
    for (int r = 0; r < 16; ++r) { e[r] = 0.f; y0[r] = 0.f; y1[r] = 0.f; }
    mma_tile_ga<256>(e, WE + (size_t)(w * 32) * 256, 256, Uc, ULS);
#pragma unroll
    for (int r = 0; r < 16; ++r) E[(w * 32 + crow(r, lane)) * 33 + (lane & 31)] = e[r];
    mma_tile_ga<256>(y0, T + (size_t)(2 * w * 32) * 256, 256, Uc, ULS);
    mma_tile_ga<256>(y1, T + (size_t)((2 * w + 1) * 32) * 256, 256, Uc, ULS);
    __syncthreads();
    if (w == 0) {
      for (int n = 0; n < 32; ++n) {
        Sp[n * SLS + lane] = f2bf(sre);
        Sp[n * SLS + 64 + lane] = f2bf(sim);
        float er = E[lane * 33 + n], ei = E[(64 + lane) * 33 + n];
        float nr = a16r * sre - a16i * sim + er;
        float ni = a16r * sim + a16i * sre + ei;
        sre = nr; sim = ni;
      }
    }
    __syncthreads();
    mma_tile_ga<128>(y0, WY + (size_t)(2 * w * 32) * 128, 128, Sp, SLS);
    mma_tile_ga<128>(y1, WY + (size_t)((2 * w + 1) * 32) * 128, 128, Sp, SLS);
    {
      const int n = lane & 31;
      if (n < nvalid) {
        const int cgi = sc * 32 + n;
#pragma unroll
        for (int tI = 0; tI < 2; ++tI) {
          const f32x16& y = tI ? y1 : y0;
#pragma unroll
          for (int g4 = 0; g4 < 4; ++g4) {
            const int m = (2 * w + tI) * 32 + 8 * g4 + 4 * (lane >> 5);
            const int i = m >> 4, c0 = m & 15;
            const int pos = cgi * 16 + i;
            if (pos >= CTXL) {
              u32x2 o;
              o.x = cvtpk(y[4 * g4], y[4 * g4 + 1]);
              o.y = cvtpk(y[4 * g4 + 2], y[4 * g4 + 3]);
              *(u32x2*)(ys + (size_t)rowof(pos) * 512 + g * 16 + c0) = o;
            }
          }
        }
      }
    }
  }
}

DI void phase_mix1(const Params& p, char* smem, int cidx) {
  __shared__ int s_item1;
  if (cidx == 1 && blockIdx.x < 256) s5_item(p, blockIdx.x, smem);
  unsigned* cnt = (unsigned*)(p.ws + OFF_CNT) + cidx;
  const bf16* q1 = (const bf16*)(p.ws + OFF_Q1);
  const bf16* k1 = (const bf16*)(p.ws + OFF_K1);
  const bf16* vt = (const bf16*)(p.ws + OFF_VT1);
  bf16* ycat = (bf16*)(p.ws + OFF_ACTA);
  const int n_lat = 4 * 8 * 32;
  while (true) {
    __syncthreads();
    if (get_tid() == 0) s_item1 = (int)atomicAdd(cnt, 1u);
    __syncthreads();
    const int it = s_item1;
    if (it >= n_lat) break;
    const int qt = it & 31, h = (it >> 5) & 7, b = it >> 8;
    const int r0 = b * SEQ + qt * 256;
    attn_item<96, 2>(q1 + (size_t)r0 * 768 + h * 96, 768, k1 + (size_t)(NLAT + b * CTXL) * 768 + h * 96,
                  k1 + (size_t)(b * SEQ) * 768 + h * 96, 768, vt + (size_t)((b * 8 + h) * 64) * SKEYS, SKEYS,
                  ycat + (size_t)r0 * DM + h * 64, DM, 0.10206207261596577f, smem, ((const float*)(p.ws + OFF_KMAX))[b * 8 + h]);
  }
}

DI void phase_s5_z(const Params& p) {
  const bf16* U1 = (const bf16*)(p.ws + OFF_U1);
  const bf16* y0 = (const bf16*)(p.ws + OFF_YS5);
  const bf16* y1 = y0 + (size_t)NLAT * 512;
  bf16* z = (bf16*)(p.ws + OFF_Z1);
  const size_t nv = (size_t)NLAT * 512 / 8;
  for (size_t i = (size_t)blockIdx.x * 256 + get_tid(); i < nv; i += (size_t)gridDim.x * 256) {
    const int col = (int)(i & 63) * 8;
    u32x4 u = ((const u32x4*)U1)[i], a = ((const u32x4*)y0)[i], b2 = ((const u32x4*)y1)[i];
    float fu[8], fa[8], fb[8], o[8];
    f32x16 dummy; (void)dummy;
    fu[0] = bflo(u.x); fu[1] = bfhi(u.x); fu[2] = bflo(u.y); fu[3] = bfhi(u.y); fu[4] = bflo(u.z); fu[5] = bfhi(u.z); fu[6] = bflo(u.w); fu[7] = bfhi(u.w);
    fa[0] = bflo(a.x); fa[1] = bfhi(a.x); fa[2] = bflo(a.y); fa[3] = bfhi(a.y); fa[4] = bflo(a.z); fa[5] = bfhi(a.z); fa[6] = bflo(a.w); fa[7] = bfhi(a.w);
    fb[0] = bflo(b2.x); fb[1] = bfhi(b2.x); fb[2] = bflo(b2.y); fb[3] = bfhi(b2.y); fb[4] = bflo(b2.z); fb[5] = bfhi(b2.z); fb[6] = bflo(b2.w); fb[7] = bfhi(b2.w);
#pragma unroll
    for (int j = 0; j < 8; ++j) o[j] = geluf_(p.s5_d[col + j] * fu[j] + fa[j] + fb[j]);
    u32x4 ov;
    ov.x = cvtpk(o[0], o[1]); ov.y = cvtpk(o[2], o[3]); ov.z = cvtpk(o[4], o[5]); ov.w = cvtpk(o[6], o[7]);
    ((u32x4*)z)[i] = ov;
  }
}

DI void phase_glu(const Params& p, char* smem) {
  bf16* As = (bf16*)smem; bf16* Bs = As + 256 * GLS;
  const bf16* z = (const bf16*)(p.ws + OFF_Z1);
  const bf16* Wt = (const bf16*)(p.ws + OFF_WT_GLU);
  bf16* ycat = (bf16*)(p.ws + OFF_ACTA);
  const int ntn = 4, ntm = NLAT / 256;
  for (int t = blockIdx.x; t < ntn * ntm; t += gridDim.x) {
    const int mt = t / ntn, nt = t % ntn;
    f32x16 acc[4][2];
    gemm_256x128(z + (size_t)mt * 256 * 512, 512, Wt + (size_t)nt * 128 * 512, 512, 512, acc, As, Bs);
    gemm_epi2(acc, [&](int row, int col, float v) {
      int r = mt * 256 + row, cc = nt * 128 + col;
      float zz = bf2f(z[(size_t)r * 512 + cc]);
      ycat[(size_t)r * DM + 512 + cc] = f2bf(zz * sigmoidf_(v + p.s5_b_glu[cc]));
    });
  }
}

DI void phase_final(const Params& p) {
  const int lane = get_tid() & 63, w = get_tid() >> 6;
  for (int r = blockIdx.x * 4 + w; r < NLAT; r += gridDim.x * 4) {
    float* row = p.out + (size_t)r * DM;
    float4 v[4];
    float ss = 0.f;
#pragma unroll
    for (int i = 0; i < 4; ++i) {
      v[i] = ((const float4*)row)[i * 64 + lane];
      ss += v[i].x * v[i].x + v[i].y * v[i].y + v[i].z * v[i].z + v[i].w * v[i].w;
    }
    ss = wave_sum(ss);
    const float rs = rsqrtf(ss * (1.0f / 1024.0f) + EPSN);
#pragma unroll
    for (int i = 0; i < 4; ++i) {
      float4 gg = ((const float4*)p.final_g)[i * 64 + lane];
      float4 o;
      o.x = v[i].x * rs * gg.x; o.y = v[i].y * rs * gg.y; o.z = v[i].z * rs * gg.z; o.w = v[i].w * rs * gg.w;
      ((float4*)row)[i * 64 + lane] = o;
    }
  }
}

DI void phase_copy_x(const Params& p) {
  const size_t n4 = (size_t)NLAT * DM / 4;
  for (size_t i = (size_t)blockIdx.x * 256 + get_tid(); i < n4; i += (size_t)gridDim.x * 256)
    ((float4*)p.out)[i] = ((const float4*)p.x)[i];
}

#define XB_TMO      128
#define XB_XCNT(j)  (256  + 64 * (j))
#define XB_XSUB(j)  (1280 + 64 * (j))
#define XB_XGEN(j)  (2304 + 64 * (j))
#define XB_TOP      3328
#define XB_TOPGEN   3392
#define XCD_BAR_WORDS 3456
#define XB_SPIN_CAP (1u << 22)
#define LAS __attribute__((address_space(3)))

__device__ __forceinline__ unsigned xb_ld(unsigned* p)              { return __hip_atomic_load(p, __ATOMIC_RELAXED, __HIP_MEMORY_SCOPE_AGENT); }
__device__ __forceinline__ unsigned xb_add(unsigned* p, unsigned v) { return __hip_atomic_fetch_add(p, v, __ATOMIC_RELAXED, __HIP_MEMORY_SCOPE_AGENT); }
__device__ __forceinline__ unsigned xb_xcc_id() { return (unsigned)__builtin_amdgcn_s_getreg((3 << 11) | 20) & 0xFu; }
#define XB_SPIN(cond, bar) do { unsigned _sp = 0; while (cond) { __builtin_amdgcn_s_sleep(1); \
    if ((++_sp & 255u) == 0u) { if (xb_ld(&(bar)[XB_TMO])) break; if (_sp > XB_SPIN_CAP) { atomicAdd(&(bar)[XB_TMO], 1u); break; } } } } while (0)

struct XcdBarrier {
    unsigned* bar; unsigned x;
    volatile LAS unsigned* st;
};

__device__ __forceinline__ XcdBarrier xcd_barrier_post(unsigned* bar, volatile LAS unsigned* st) {
    XcdBarrier b; b.bar = bar; b.x = xb_xcc_id(); b.st = st;
    if (threadIdx.x == 0) (void)xb_add(&bar[XB_XCNT(b.x)], 1u);
    return b;
}
__device__ __forceinline__ void xcd_barrier_complete(unsigned* bar, unsigned x, unsigned& nloc, unsigned& nx) {
    const unsigned G = gridDim.x * gridDim.y * gridDim.z;
    unsigned sum, cnt, mine, sp = 0u;
    for (;;) {
        sum = 0u; cnt = 0u; mine = 0u;
#pragma unroll
        for (unsigned j = 0; j < 16; ++j) { const unsigned c = xb_ld(&bar[XB_XCNT(j)]); sum += c; cnt += (c > 0u) ? 1u : 0u; mine = (j == x) ? c : mine; }
        if (sum == G) break;
        __builtin_amdgcn_s_sleep(1);
        if ((++sp & 255u) == 0u) { if (xb_ld(&bar[XB_TMO])) break; if (sp > XB_SPIN_CAP) { atomicAdd(&bar[XB_TMO], 1u); break; } }
    }
    nloc = mine > 0u ? mine : 1u; nx = cnt > 0u ? cnt : 1u;
}

__device__ __forceinline__ void xcd_barrier(const XcdBarrier& b) {
    asm volatile("s_waitcnt vmcnt(0)" ::: "memory");
    __syncthreads();
    if (threadIdx.x == 0) {
        unsigned* bar = b.bar;
        __builtin_amdgcn_s_waitcnt(0);
        unsigned nloc = b.st[0], nx = b.st[1];
        if (nloc == 0u) { xcd_barrier_complete(bar, b.x, nloc, nx); b.st[0] = nloc; b.st[1] = nx; }
        const unsigned old = xb_add(&bar[XB_XSUB(b.x)], 1u);
        const unsigned gen = old / nloc;
        if (old + 1u == (gen + 1u) * nloc) {
            __builtin_amdgcn_fence(__ATOMIC_RELEASE, "agent");
            asm volatile("s_waitcnt vmcnt(0)" ::: "memory");
            const unsigned og = xb_add(&bar[XB_TOP], 1u);
            const unsigned tg = og / nx;
            if (og + 1u == (tg + 1u) * nx) xb_add(&bar[XB_TOPGEN], 1u);
            else XB_SPIN(xb_ld(&bar[XB_TOPGEN]) == tg, bar);
            __builtin_amdgcn_fence(__ATOMIC_ACQUIRE, "agent");
            xb_add(&bar[XB_XGEN(b.x)], 1u);
            asm volatile("s_waitcnt vmcnt(0)" ::: "memory");
        } else {
            XB_SPIN(xb_ld(&bar[XB_XGEN(b.x)]) == gen, bar);
            __builtin_amdgcn_fence(__ATOMIC_ACQUIRE, "agent");
            asm volatile("s_waitcnt vmcnt(0)" ::: "memory");
        }
    }
    __syncthreads();
}
__device__ __forceinline__ void xcd_barrier_fast(const XcdBarrier& b) {
    asm volatile("s_waitcnt vmcnt(0)" ::: "memory");
    __syncthreads();
    if (threadIdx.x == 0) {
        unsigned* bar = b.bar;
        __builtin_amdgcn_s_waitcnt(0);
        unsigned nloc = b.st[0], nx = b.st[1];
        const unsigned old = xb_add(&bar[XB_XSUB(b.x)], 1u);
        const unsigned gen = old / nloc;
        if (old + 1u == (gen + 1u) * nloc) {
            __builtin_amdgcn_fence(__ATOMIC_RELEASE, "agent");
            asm volatile("s_waitcnt vmcnt(0)" ::: "memory");
            const unsigned og = xb_add(&bar[XB_TOP], 1u);
            const unsigned tg = og / nx;
            if (og + 1u == (tg + 1u) * nx) xb_add(&bar[XB_TOPGEN], 1u);
            else XB_SPIN(xb_ld(&bar[XB_TOPGEN]) == tg, bar);
            __builtin_amdgcn_fence(__ATOMIC_ACQUIRE, "agent");
            xb_add(&bar[XB_XGEN(b.x)], 1u);
            asm volatile("s_waitcnt vmcnt(0)" ::: "memory");
        } else {
            XB_SPIN(xb_ld(&bar[XB_XGEN(b.x)]) == gen, bar);
            __builtin_amdgcn_fence(__ATOMIC_ACQUIRE, "agent");
            asm volatile("s_waitcnt vmcnt(0)" ::: "memory");
        }
    }
    __syncthreads();
}


DI void gsync(cg::grid_group& grid) {
  asm volatile("s_waitcnt vmcnt(0) lgkmcnt(0)" ::: "memory");
  __syncthreads();
  if (threadIdx.x == 0) {
    __builtin_amdgcn_fence(__ATOMIC_RELEASE, "agent");
    asm volatile("s_waitcnt vmcnt(0)" ::: "memory");
  }
  grid.sync();
  if (threadIdx.x == 0) {
    __builtin_amdgcn_fence(__ATOMIC_ACQUIRE, "agent");
    asm volatile("s_waitcnt vmcnt(0)" ::: "memory");
  }
  __syncthreads();
}

DI Params load_params() {
  Params r{};
#if defined(__HIP_DEVICE_COMPILE__)
  const __attribute__((address_space(4))) unsigned long long* q =
      (const __attribute__((address_space(4))) unsigned long long*)__builtin_amdgcn_kernarg_segment_ptr();
  asm volatile("" : "+s"(q));
  unsigned long long* d = (unsigned long long*)&r;
  static_assert(sizeof(Params) % 8 == 0, "Params size");
#pragma unroll
  for (int i = 0; i < (int)(sizeof(Params) / 8); ++i) d[i] = q[i];
#endif
  return r;
}
#define P_ p
__global__ void __launch_bounds__(256, 2) fwd_megakernel(Params p) {
  cg::grid_group grid = cg::this_grid();
  __shared__ __attribute__((aligned(16))) char smem[SMEM_BYTES];
  __shared__ uint4 xb_words;
  if (threadIdx.x == 0) xb_words = make_uint4(0u, 0u, 0u, 0u);
  __syncthreads();
  XcdBarrier xb;
  { const Params lp = P_; xb = xcd_barrier_post((unsigned*)(lp.ws + OFF_BAR), (volatile LAS unsigned*)&xb_words); }
  { const Params lp = P_; phase_prep(lp, smem); }
  xcd_barrier(xb);
  { const Params lp = P_; phase_norm(lp, 0, true, lp.norm1_g, 0, NTOK); }
  xcd_barrier_fast(xb);
  { const Params lp = P_; phase_inproj0(lp, smem); }
  xcd_barrier_fast(xb);
  { const Params lp = P_; phase_gqa_prep(lp, smem); }
  xcd_barrier_fast(xb);
  { const Params lp = P_; phase_mix0(lp, smem, 0); }
  xcd_barrier_fast(xb);
  { const Params lp = P_; phase_hg_readout(lp); }
  xcd_barrier_fast(xb);
  { const Params lp = P_; phase_outproj(lp, 0, OFF_WT_EVOUT, NTOK, true, smem); }
  xcd_barrier_fast(xb);
#if STAGE_LIMIT >= 2
  { const Params lp = P_; phase_norm(lp, 0, false, lp.norm2_g, 3, NTOK); }
  { const Params lp = P_; phase_convert_tables(lp, 0); }
  xcd_barrier_fast(xb);
  { const Params lp = P_; phase_peer_route(lp, 0, NTOK, smem); }
  xcd_barrier_fast(xb);
  { const Params lp = P_; phase_peer_gather(lp, 0, NTOK, false); }
  xcd_barrier_fast(xb);
#endif
#if STAGE_LIMIT >= 3
  { const Params lp = P_; phase_inproj1(lp, smem); }
  xcd_barrier_fast(xb);
  { const Params lp = P_; phase_mla_prep(lp); }
  xcd_barrier_fast(xb);
  { const Params lp = P_; phase_mla_up(lp, smem); }
  xcd_barrier_fast(xb);
  { const Params lp = P_; phase_mix1(lp, smem, 1); }
  xcd_barrier_fast(xb);
  { const Params lp = P_; phase_s5_z(lp); }
  xcd_barrier_fast(xb);
  { const Params lp = P_; phase_glu(lp, smem); }
  xcd_barrier_fast(xb);
  { const Params lp = P_; phase_outproj1(lp, smem); }
  xcd_barrier_fast(xb);
#endif
#if STAGE_LIMIT >= 4
  { const Params lp = P_; phase_norm(lp, 1, false, lp.norm2_g + 1024, 3, NLAT); }
  { const Params lp = P_; phase_convert_tables(lp, 1); }
  xcd_barrier_fast(xb);
  { const Params lp = P_; phase_peer_route(lp, 1, NLAT, smem); }
  xcd_barrier_fast(xb);
  { const Params lp = P_; phase_peer_gather(lp, 1, NLAT, false); }
#endif
}

extern "C" void kernel_launch(void* const* d_in, const int* in_sizes, int n_in, void* d_out, int out_size, void* d_ws,
                              size_t ws_size, hipStream_t stream) {
  static int grid_blocks = 0;
  if (!grid_blocks) {
    int dev = 0, cus = 0, per_cu = 0;
    (void)hipGetDevice(&dev);
    (void)hipDeviceGetAttribute(&cus, hipDeviceAttributeMultiprocessorCount, dev);
    (void)hipOccupancyMaxActiveBlocksPerMultiprocessor(&per_cu, fwd_megakernel, 256, 0);
    if (per_cu > 2) per_cu = 2;
    if (per_cu < 1) per_cu = 1;
    grid_blocks = cus * per_cu;
  }
  Params p{};
  const float** pp = (const float**)&p;
  for (int i = 0; i < 35; ++i) pp[i] = (const float*)d_in[i];
  p.out = (float*)d_out;
  p.ws = (char*)d_ws;
  p.rep_mix = REP_MIX; p.rep_route = REP_ROUTE; p.rep_gdry = REP_GDRY; p.rep_gemm = REP_GEMM;
  (void)hipMemsetAsync((char*)d_ws + OFF_CNT, 0, 256 + 16384, stream);
  void* args[] = {&p};
  hipError_t e = hipLaunchCooperativeKernel((void*)fwd_megakernel, dim3(grid_blocks), dim3(256), args, 0, stream);
  if (e != hipSuccess) fprintf(stderr, "cooperative launch failed: %s (grid %d)\n", hipGetErrorString(e), grid_blocks);
}
```

```cpp
#include <hip/hip_runtime.h>
#include <hip/hip_cooperative_groups.h>
#include <cstdio>
namespace cg = cooperative_groups;

#ifndef STAGE_LIMIT
#define STAGE_LIMIT 99
#endif
#define REP_MIX 1
#define REP_ROUTE 1
#define REP_GDRY 0
#define REP_GEMM 1

typedef unsigned short bf16;
typedef __attribute__((ext_vector_type(8))) short bf16x8;
typedef __attribute__((ext_vector_type(4))) short bf16x4;
typedef __attribute__((ext_vector_type(16))) float f32x16;
typedef float f32x2_t __attribute__((ext_vector_type(2)));
typedef unsigned u32x4 __attribute__((ext_vector_type(4)));
typedef unsigned u32x2 __attribute__((ext_vector_type(2)));
typedef __bf16 bf16x2_t __attribute__((ext_vector_type(2)));

#define DI __device__ __forceinline__
#define MFMA32(a, b, c) __builtin_amdgcn_mfma_f32_32x32x16_bf16((a), (b), (c), 0, 0, 0)

constexpr int NLAT = 32768, NCTX = 1024, NTOK = 33792, DM = 1024;
constexpr int SEQ = 8192, CTXL = 256, SKEYS = 8448;
constexpr float EPSN = 1e-6f;

constexpr size_t al256(size_t x) { return (x + 255) & ~(size_t)255; }
constexpr size_t OFF_WT_EVIN = 0;
constexpr size_t OFF_WT_EVOUT = OFF_WT_EVIN + al256((size_t)3328 * 1024 * 2);
constexpr size_t OFF_WT_ODIN = OFF_WT_EVOUT + al256((size_t)1024 * 1024 * 2);
constexpr size_t OFF_WT_ODOUT = OFF_WT_ODIN + al256((size_t)1280 * 1024 * 2);
constexpr size_t OFF_WT_QUP = OFF_WT_ODOUT + al256((size_t)1024 * 1024 * 2);
constexpr size_t OFF_WT_KVUP = OFF_WT_QUP + al256((size_t)768 * 384 * 2);
constexpr size_t OFF_WT_GLU = OFF_WT_KVUP + al256((size_t)1024 * 256 * 2);
constexpr size_t OFF_WT_PWQ = OFF_WT_GLU + al256((size_t)512 * 512 * 2);
constexpr size_t OFF_PKEYS = OFF_WT_PWQ + al256((size_t)2 * 2048 * 1024 * 2);
constexpr size_t OFF_MOD = OFF_PKEYS + al256((size_t)2 * 8 * 2 * 128 * 128 * 2);
constexpr size_t OFF_S5T = OFF_MOD + al256((size_t)2 * 5 * 6144 * 4);
constexpr size_t OFF_S5WE = OFF_S5T + al256((size_t)64 * 256 * 256 * 2);
constexpr size_t OFF_S5WY = OFF_S5WE + al256((size_t)64 * 128 * 256 * 2);
constexpr size_t OFF_S5A16 = OFF_S5WY + al256((size_t)64 * 256 * 128 * 2);
constexpr size_t OFF_CNT = OFF_S5A16 + al256((size_t)64 * 64 * 2 * 4);
constexpr size_t OFF_BAR = OFF_CNT + 256;
constexpr size_t OFF_ROPE1 = OFF_BAR + 16384;
constexpr size_t OFF_SU = OFF_ROPE1 + al256((size_t)8192 * 16 * 8);
constexpr size_t OFF_SV = OFF_SU + 65536;
constexpr size_t OFF_KMAX = OFF_SV + 65536;
constexpr size_t OFF_KRSQ = OFF_KMAX + 256;
constexpr size_t OFF_XC = OFF_KRSQ + al256((size_t)NTOK * 4);
constexpr size_t OFF_UTAB = OFF_XC + al256((size_t)NCTX * DM * 4);
constexpr size_t OFF_VTAB = OFF_UTAB + al256((size_t)16384 * 1024 * 2);
constexpr size_t OFF_ACTA = OFF_VTAB + al256((size_t)16384 * 1024 * 2);
constexpr size_t OFF_BIG = OFF_ACTA + al256((size_t)NTOK * DM * 2);
constexpr size_t OFF_PAGQA = OFF_BIG;
constexpr size_t OFF_VT0 = OFF_PAGQA + al256((size_t)NTOK * 768 * 2);
constexpr size_t OFF_PAHG = OFF_VT0 + al256((size_t)512 * SKEYS * 2);
constexpr size_t OFF_OHG = OFF_PAHG + al256((size_t)NTOK * 2560 * 2);
constexpr size_t OFF_END0 = OFF_OHG + al256((size_t)2 * NTOK * 512 * 2);
constexpr size_t OFF_K1 = OFF_BIG;
constexpr size_t OFF_PA1M = OFF_K1 + al256((size_t)NTOK * 768 * 2);
constexpr size_t OFF_Q1 = OFF_PA1M;
constexpr size_t OFF_U1 = OFF_PA1M + al256((size_t)NTOK * 768 * 2);
constexpr size_t OFF_QN = OFF_U1 + al256((size_t)NTOK * 512 * 2);
constexpr size_t OFF_KVN = OFF_QN + al256((size_t)NLAT * 384 * 2);
constexpr size_t OFF_Z1 = OFF_QN;
constexpr size_t OFF_KROPE = OFF_KVN + al256((size_t)NTOK * 256 * 2);
constexpr size_t OFF_VT1 = OFF_KROPE + al256((size_t)NTOK * 32 * 2);
constexpr size_t OFF_YS5 = OFF_VT1 + al256((size_t)2048 * SKEYS * 2);
constexpr size_t OFF_END1 = OFF_YS5 + al256((size_t)2 * NLAT * 512 * 2);
constexpr size_t OFF_RIDX = OFF_BIG;
constexpr size_t OFF_RGW = OFF_RIDX + al256((size_t)NTOK * 128 * 4);
constexpr size_t WS_NEEDED = (OFF_END0 > OFF_END1 ? OFF_END0 : OFF_END1);
static_assert(OFF_RGW + (size_t)NTOK * 128 * 4 <= OFF_VT0, "route alias overflow");
static_assert((size_t)NLAT * 512 * 2 <= (OFF_KROPE - OFF_QN), "z alias overflow");
static_assert(WS_NEEDED < (size_t)500 * 1024 * 1024, "workspace too large");

constexpr int SMEM_BYTES = 78 * 1024;

struct Params {
  const float *x, *c, *ctx, *c_ctx, *ada_w, *ada_b, *norm1_g, *norm2_g, *ev_w_in, *ev_w_out, *gqa_qn_g, *gqa_kn_g,
      *hg_lb_logits, *hg_onorm_g, *od_w_in, *od_w_out, *mla_qa_g, *mla_w_qup, *mla_kva_g, *mla_w_kvup, *s5_a_re, *s5_a_im,
      *s5_log_dt, *s5_b_re, *s5_b_im, *s5_c_re, *s5_c_im, *s5_d, *s5_w_glu, *s5_b_glu, *peer_wq, *peer_keys, *peer_u,
      *peer_v, *final_g;
  float* out;
  char* ws;
  int rep_mix, rep_route, rep_gdry, rep_gemm;
};

DI int get_tid() { int t = threadIdx.x; asm volatile("" : "+v"(t)); return t; }
DI bf16 f2bf(float x) {
  unsigned u = __float_as_uint(x);
  u += 0x7fffu + ((u >> 16) & 1u);
  return (bf16)(u >> 16);
}
DI float bf2f(bf16 h) { return __uint_as_float(((unsigned)h) << 16); }
DI unsigned cvtpk(float lo, float hi) {
  f32x2_t v = {lo, hi};
  bf16x2_t b = __builtin_convertvector(v, bf16x2_t);
  return __builtin_bit_cast(unsigned, b);
}
DI float bflo(unsigned u) { return __uint_as_float(u << 16); }
DI float bfhi(unsigned u) { return __uint_as_float(u & 0xffff0000u); }
DI float wave_sum(float v) {
#pragma unroll
  for (int o = 32; o > 0; o >>= 1) v += __shfl_xor(v, o);
  return v;
}
DI float wave_max_early(float v) {
#pragma unroll
  for (int o = 32; o > 0; o >>= 1) v = fmaxf(v, __shfl_xor(v, o));
  return v;
}
DI float sigmoidf_(float x) { return 1.0f / (1.0f + __expf(-x)); }
DI float siluf_(float x) { return x * sigmoidf_(x); }
DI float geluf_(float x) { return 0.5f * x * (1.0f + erff(x * 0.70710678118654752f)); }

DI const float* orig_row(const Params& p, int r) {
  return r < NLAT ? p.x + (size_t)r * DM : p.ctx + (size_t)(r - NLAT) * DM;
}
DI float* res_row(const Params& p, int r) {
  return r < NLAT ? p.out + (size_t)r * DM : (float*)(p.ws + OFF_XC) + (size_t)(r - NLAT) * DM;
}
DI int mod_row(int r) { return r < NLAT ? (r >> 13) : 4; }
DI const float* mod_ptr(const Params& p, int layer, int r, int chunk) {
  return (const float*)(p.ws + OFF_MOD) + ((size_t)(layer * 5 + mod_row(r)) * 6 + chunk) * 1024;
}

constexpr int GLS = 72;
DI void gemm_128x128(const bf16* __restrict__ A, int lda, const bf16* __restrict__ Bt, int ldb, int K, f32x16 (&acc)[2][2],
                     bf16* As, bf16* Bs) {
  const int tid = get_tid(), lane = tid & 63, w = tid >> 6;
  const int wm = w >> 1, wn = w & 1;
  const int lr = tid >> 3, lc = (tid & 7) * 8;
  u32x4 ra[4], rb[4];
#pragma unroll
  for (int i = 0; i < 4; ++i) {
    ra[i] = *(const u32x4*)(A + (size_t)(i * 32 + lr) * lda + lc);
    rb[i] = *(const u32x4*)(Bt + (size_t)(i * 32 + lr) * ldb + lc);
  }
#pragma unroll
  for (int i = 0; i < 2; ++i)
#pragma unroll
    for (int j = 0; j < 2; ++j)
#pragma unroll
      for (int r = 0; r < 16; ++r) acc[i][j][r] = 0.f;
  for (int k0 = 0; k0 < K; k0 += 64) {
    __syncthreads();
#pragma unroll
    for (int i = 0; i < 4; ++i) {
      *(u32x4*)(As + (i * 32 + lr) * GLS + lc) = ra[i];
      *(u32x4*)(Bs + (i * 32 + lr) * GLS + lc) = rb[i];
    }
    __syncthreads();
    if (k0 + 64 < K) {
#pragma unroll
      for (int i = 0; i < 4; ++i) {
        ra[i] = *(const u32x4*)(A + (size_t)(i * 32 + lr) * lda + k0 + 64 + lc);
        rb[i] = *(const u32x4*)(Bt + (size_t)(i * 32 + lr) * ldb + k0 + 64 + lc);
      }
    }
#pragma unroll
    for (int ks = 0; ks < 64; ks += 16) {
      const int ko = ks + (lane >> 5) * 8;
      bf16x8 a0 = *(const bf16x8*)(As + (wm * 64 + (lane & 31)) * GLS + ko);
      bf16x8 a1 = *(const bf16x8*)(As + (wm * 64 + 32 + (lane & 31)) * GLS + ko);
      bf16x8 b0 = *(const bf16x8*)(Bs + (wn * 64 + (lane & 31)) * GLS + ko);
      bf16x8 b1 = *(const bf16x8*)(Bs + (wn * 64 + 32 + (lane & 31)) * GLS + ko);
      acc[0][0] = MFMA32(a0, b0, acc[0][0]);
      acc[0][1] = MFMA32(a0, b1, acc[0][1]);
      acc[1][0] = MFMA32(a1, b0, acc[1][0]);
      acc[1][1] = MFMA32(a1, b1, acc[1][1]);
    }
  }
}
template <class F>
DI void gemm_epi(f32x16 (&acc)[2][2], F f) {
  const int lane = get_tid() & 63, w = get_tid() >> 6;
  const int wm = w >> 1, wn = w & 1;
#pragma unroll
  for (int mi = 0; mi < 2; ++mi)
#pragma unroll
    for (int ni = 0; ni < 2; ++ni)
#pragma unroll
      for (int r = 0; r < 16; ++r) {
        int row = wm * 64 + mi * 32 + (r & 3) + 8 * (r >> 2) + 4 * (lane >> 5);
        int col = wn * 64 + ni * 32 + (lane & 31);
        f(row, col, acc[mi][ni][r]);
      }
}

DI void gemm_256x128(const bf16* __restrict__ A, int lda, const bf16* __restrict__ Bt, int ldb, int K, f32x16 (&acc)[4][2],
                     bf16* As, bf16* Bs) {
  const int tid = get_tid(), lane = tid & 63, w = tid >> 6;
  const int wm = w >> 1, wn = w & 1;
  const int lr = tid >> 3, lc = (tid & 7) * 8;
  u32x4 ra[8], rb[4];
#pragma unroll
  for (int i = 0; i < 8; ++i) ra[i] = *(const u32x4*)(A + (size_t)(i * 32 + lr) * lda + lc);
#pragma unroll
  for (int i = 0; i < 4; ++i) rb[i] = *(const u32x4*)(Bt + (size_t)(i * 32 + lr) * ldb + lc);
#pragma unroll
  for (int i = 0; i < 4; ++i)
#pragma unroll
    for (int j = 0; j < 2; ++j)
#pragma unroll
      for (int r = 0; r < 16; ++r) acc[i][j][r] = 0.f;
  for (int k0 = 0; k0 < K; k0 += 64) {
    __syncthreads();
#pragma unroll
    for (int i = 0; i < 8; ++i) *(u32x4*)(As + (i * 32 + lr) * GLS + lc) = ra[i];
#pragma unroll
    for (int i = 0; i < 4; ++i) *(u32x4*)(Bs + (i * 32 + lr) * GLS + lc) = rb[i];
    __syncthreads();
    if (k0 + 64 < K) {
#pragma unroll
      for (int i = 0; i < 8; ++i) ra[i] = *(const u32x4*)(A + (size_t)(i * 32 + lr) * lda + k0 + 64 + lc);
#pragma unroll
      for (int i = 0; i < 4; ++i) rb[i] = *(const u32x4*)(Bt + (size_t)(i * 32 + lr) * ldb + k0 + 64 + lc);
    }
#pragma unroll
    for (int ks = 0; ks < 64; ks += 16) {
      const int ko = ks + (lane >> 5) * 8;
      bf16x8 b0 = *(const bf16x8*)(Bs + (wn * 64 + (lane & 31)) * GLS + ko);
      bf16x8 b1 = *(const bf16x8*)(Bs + (wn * 64 + 32 + (lane & 31)) * GLS + ko);
#pragma unroll
      for (int mi = 0; mi < 4; ++mi) {
        bf16x8 a = *(const bf16x8*)(As + (wm * 128 + mi * 32 + (lane & 31)) * GLS + ko);
        acc[mi][0] = MFMA32(a, b0, acc[mi][0]);
        acc[mi][1] = MFMA32(a, b1, acc[mi][1]);
      }
    }
  }
}
template <class F>
DI void gemm_epi2(f32x16 (&acc)[4][2], F f) {
  const int lane = get_tid() & 63, w = get_tid() >> 6;
  const int wm = w >> 1, wn = w & 1;
#pragma unroll
  for (int mi = 0; mi < 4; ++mi)
#pragma unroll
    for (int ni = 0; ni < 2; ++ni)
#pragma unroll
      for (int r = 0; r < 16; ++r) {
        int row = wm * 128 + mi * 32 + (r & 3) + 8 * (r >> 2) + 4 * (lane >> 5);
        int col = wn * 64 + ni * 32 + (lane & 31);
        f(row, col, acc[mi][ni][r]);
      }
}

DI void mma_tile(f32x16& acc, const bf16* A, int lda, const bf16* Bt, int ldb, int K) {
  const int lane = get_tid() & 63;
  const bf16* ap = A + (size_t)(lane & 31) * lda + (lane >> 5) * 8;
  const bf16* bp = Bt + (size_t)(lane & 31) * ldb + (lane >> 5) * 8;
#pragma unroll 4
  for (int ks = 0; ks < K; ks += 16) {
    bf16x8 a = *(const bf16x8*)(ap + ks);
    bf16x8 b = *(const bf16x8*)(bp + ks);
    acc = MFMA32(a, b, acc);
  }
}
template <int K>
DI void mma_tile_ga(f32x16& acc, const bf16* __restrict__ A, int lda, const bf16* Bt, int ldb) {
  const int lane = get_tid() & 63;
  const bf16* ap = A + (size_t)(lane & 31) * lda + (lane >> 5) * 8;
  const bf16* bp = Bt + (size_t)(lane & 31) * ldb + (lane >> 5) * 8;
  bf16x8 af[K / 16];
#pragma unroll
  for (int i = 0; i < K / 16; ++i) af[i] = *(const bf16x8*)(ap + i * 16);
#pragma unroll
  for (int i = 0; i < K / 16; ++i) {
    bf16x8 b = *(const bf16x8*)(bp + i * 16);
    acc = MFMA32(af[i], b, acc);
  }
}
DI int crow(int r, int lane) { return (r & 3) + 8 * (r >> 2) + 4 * (lane >> 5); }

DI void prep_transpose(const float* __restrict__ W, int K, int N, int Npad, bf16* __restrict__ Wt, int tile, float* tl) {
  const int ntn = Npad / 64;
  const int kt = tile / ntn, nt = tile % ntn;
  const int k0 = kt * 64, n0 = nt * 64;
  const int tid = get_tid();
  __syncthreads();
  for (int i = 0; i < 16; ++i) {
    int r = i * 4 + (tid >> 6), cidx = tid & 63;
    int n = n0 + cidx;
    float v = (n < N) ? W[(size_t)(k0 + r) * N + n] : 0.f;
    tl[cidx * 65 + r] = v;
  }
  __syncthreads();
  for (int i = 0; i < 16; ++i) {
    int n = i * 4 + (tid >> 6), k = tid & 63;
    Wt[(size_t)(n0 + n) * K + k0 + k] = f2bf(tl[n * 65 + k]);
  }
}

DI void convert_bf16(const float* __restrict__ src, bf16* __restrict__ dst, size_t n, int bid, int nb) {
  size_t nv = n / 8;
  for (size_t i = (size_t)bid * 256 + get_tid(); i < nv; i += (size_t)nb * 256) {
    float4 a = ((const float4*)src)[2 * i], b = ((const float4*)src)[2 * i + 1];
    u32x4 o;
    o.x = cvtpk(a.x, a.y); o.y = cvtpk(a.z, a.w); o.z = cvtpk(b.x, b.y); o.w = cvtpk(b.z, b.w);
    ((u32x4*)dst)[i] = o;
  }
}

DI void prep_mod(const Params& p, int item, float* sm) {
  const int l = item / 96, n0 = (item % 96) * 64;
  const int tid = get_tid(), lane = tid & 63, w = tid >> 6;
  const float* W = p.ada_w + (size_t)l * 1024 * 6144 + n0 + lane;
  float* sc = sm;
  float* red = sm + 5 * 1024;
  __syncthreads();
  for (int i = tid; i < 5 * 1024; i += 256) {
    const int r = i >> 10, k = i & 1023;
    sc[i] = siluf_(r < 4 ? p.c[r * 1024 + k] : p.c_ctx[k]);
  }
  __syncthreads();
  float acc[5] = {0.f, 0.f, 0.f, 0.f, 0.f};
#pragma unroll 1
  for (int k0 = w * 256; k0 < w * 256 + 256; k0 += 16) {
    float wv[16];
#pragma unroll
    for (int j = 0; j < 16; ++j) wv[j] = W[(size_t)(k0 + j) * 6144];
#pragma unroll
    for (int j = 0; j < 16; ++j) {
#pragma unroll
      for (int r = 0; r < 5; ++r) acc[r] += sc[r * 1024 + k0 + j] * wv[j];
    }
  }
#pragma unroll
  for (int r = 0; r < 5; ++r) red[(w * 5 + r) * 64 + lane] = acc[r];
  __syncthreads();
  if (w == 0) {
    float* M = (float*)(p.ws + OFF_MOD);
#pragma unroll
    for (int r = 0; r < 5; ++r) {
      float s2 = red[(0 * 5 + r) * 64 + lane] + red[(1 * 5 + r) * 64 + lane] + red[(2 * 5 + r) * 64 + lane] + red[(3 * 5 + r) * 64 + lane];
      M[(size_t)(l * 5 + r) * 6144 + n0 + lane] = s2 + p.ada_b[l * 6144 + n0 + lane];
    }
  }
}

DI void prep_s5(const Params& p, int item4, float* sm) {
  const int item = item4 >> 2, qtr = item4 & 3;
  const int g = item >> 1, d = item & 1;
  const int tid = get_tid();
  float* pw = sm;
  float* bb = sm + 17 * 128;
  float* kc = bb + 64 * 32;
  __syncthreads();
  const float dt = __expf(p.s5_log_dt[d * 32 + g]);
  if (tid < 64) {
    const int pp = tid;
    const float are = p.s5_a_re[(d * 32 + g) * 64 + pp], aim = p.s5_a_im[(d * 32 + g) * 64 + pp];
    for (int n = 0; n <= 16; ++n) {
      float mag = expf(are * dt * n);
      float sn, cs;
      sincosf(aim * dt * n, &sn, &cs);
      pw[(n * 64 + pp) * 2 + 0] = mag * cs;
      pw[(n * 64 + pp) * 2 + 1] = mag * sn;
    }
    float abr = pw[(64 + pp) * 2 + 0] - 1.0f, abi = pw[(64 + pp) * 2 + 1];
    float den = are * are + aim * aim;
    float qr = (abr * are + abi * aim) / den, qi = (abi * are - abr * aim) / den;
    for (int c2 = 0; c2 < 16; ++c2) {
      float br = p.s5_b_re[((size_t)(d * 32 + g) * 64 + pp) * 16 + c2], bi = p.s5_b_im[((size_t)(d * 32 + g) * 64 + pp) * 16 + c2];
      bb[(pp * 16 + c2) * 2 + 0] = qr * br - qi * bi;
      bb[(pp * 16 + c2) * 2 + 1] = qr * bi + qi * br;
    }
    float* A16 = (float*)(p.ws + OFF_S5A16) + (size_t)item * 128;
    A16[pp * 2 + 0] = pw[(16 * 64 + pp) * 2 + 0];
    A16[pp * 2 + 1] = pw[(16 * 64 + pp) * 2 + 1];
  }
  float* cre = kc + 4096;
  float* cim = cre + 1024;
  for (int e = tid; e < 1024; e += 256) {
    cre[e] = p.s5_c_re[(size_t)(d * 32 + g) * 1024 + e];
    cim[e] = p.s5_c_im[(size_t)(d * 32 + g) * 1024 + e];
  }
  __syncthreads();
  for (int e = tid; e < (4 * qtr + 4) * 256; e += 256) {
    int tau = e >> 8, c = (e >> 4) & 15, c2 = e & 15;
    float s = 0.f;
    for (int pp = 0; pp < 64; ++pp) {
      float cr = cre[c * 64 + pp], ci = cim[c * 64 + pp];
      float wr = pw[(tau * 64 + pp) * 2], wi = pw[(tau * 64 + pp) * 2 + 1];
      float zr = cr * wr - ci * wi, zi = cr * wi + ci * wr;
      float br = bb[(pp * 16 + c2) * 2], bi = bb[(pp * 16 + c2) * 2 + 1];
      s += zr * br - zi * bi;
    }
    kc[e] = s;
  }
  __syncthreads();
  bf16* T = (bf16*)(p.ws + OFF_S5T) + (size_t)item * 65536;
  for (int e = qtr * 16384 + tid; e < (qtr + 1) * 16384; e += 256) {
    int m = e >> 8, k = e & 255;
    int i = m >> 4, c = m & 15, j = k >> 4, c2 = k & 15;
    float v = (i >= j) ? kc[((i - j) * 16 + c) * 16 + c2] : 0.f;
    T[e] = f2bf(v);
  }
  bf16* WE = (bf16*)(p.ws + OFF_S5WE) + (size_t)item * 32768;
  for (int e = qtr * 8192 + tid; e < (qtr + 1) * 8192; e += 256) {
    int pr = e >> 8, k = e & 255;
    int pp = pr & 63, im = pr >> 6, j = k >> 4, c2 = k & 15;
    float wr = pw[((15 - j) * 64 + pp) * 2], wi = pw[((15 - j) * 64 + pp) * 2 + 1];
    float br = bb[(pp * 16 + c2) * 2], bi = bb[(pp * 16 + c2) * 2 + 1];
    float v = im ? (wr * bi + wi * br) : (wr * br - wi * bi);
    WE[e] = f2bf(v);
  }
  bf16* WY = (bf16*)(p.ws + OFF_S5WY) + (size_t)item * 32768;
  for (int e = qtr * 8192 + tid; e < (qtr + 1) * 8192; e += 256) {
    int m = e >> 7, pr = e & 127;
    int i = m >> 4, c = m & 15, pp = pr & 63, im = pr >> 6;
    float cr = cre[c * 64 + pp], ci = cim[c * 64 + pp];
    float wr = pw[((i + 1) * 64 + pp) * 2], wi = pw[((i + 1) * 64 + pp) * 2 + 1];
    float zr = cr * wr - ci * wi, zi = cr * wi + ci * wr;
    WY[e] = f2bf(im ? -zi : zr);
  }
}

DI void phase_prep(const Params& p, char* smem) {
  const int bid = blockIdx.x, nb = gridDim.x;
  float* sm = (float*)smem;
  if (bid == 0 && get_tid() < 64) ((unsigned*)(p.ws + OFF_KMAX))[get_tid()] = 0u;
  {
    float2* tab = (float2*)(p.ws + OFF_ROPE1);
    for (int e = bid * 256 + get_tid(); e < 8192 * 16; e += nb * 256) {
      int t = e >> 4, f = e & 15;
      float pos = (f < 8) ? (float)(t >> 6) : (float)(t & 63);
      float inv = powf(10000.f, -(float)(f & 7) / 8.f);
      float sn, cs;
      sincosf(pos * inv, &sn, &cs);
      tab[e] = make_float2(cs, sn);
    }
  }
  const int n_mod = 192, n_s5 = 256;
  constexpr int T0 = 16 * 52, T1 = 16 * 16, T2 = 16 * 20, T3 = 16 * 16, T4 = 6 * 12, T5 = 4 * 16, T6 = 8 * 8, T7 = 16 * 32, T8 = 16 * 32;
  constexpr int NTR = T0 + T1 + T2 + T3 + T4 + T5 + T6 + T7 + T8;
  const int total = n_mod + n_s5 + NTR;
  for (int it = bid; it < total; it += nb) {
    if (it < n_s5) prep_s5(p, it, sm);
    else if (it < n_mod + n_s5) prep_mod(p, it - n_s5, sm);
    else {
      int t = it - n_mod - n_s5;
      if (t < T0) { prep_transpose(p.ev_w_in, 1024, 3328, 3328, (bf16*)(p.ws + OFF_WT_EVIN), t, sm); continue; }
      t -= T0;
      if (t < T1) { prep_transpose(p.ev_w_out, 1024, 1024, 1024, (bf16*)(p.ws + OFF_WT_EVOUT), t, sm); continue; }
      t -= T1;
      if (t < T2) { prep_transpose(p.od_w_in, 1024, 1184, 1280, (bf16*)(p.ws + OFF_WT_ODIN), t, sm); continue; }
      t -= T2;
      if (t < T3) { prep_transpose(p.od_w_out, 1024, 1024, 1024, (bf16*)(p.ws + OFF_WT_ODOUT), t, sm); continue; }
      t -= T3;
      if (t < T4) { prep_transpose(p.mla_w_qup, 384, 768, 768, (bf16*)(p.ws + OFF_WT_QUP), t, sm); continue; }
      t -= T4;
      if (t < T5) { prep_transpose(p.mla_w_kvup, 256, 1024, 1024, (bf16*)(p.ws + OFF_WT_KVUP), t, sm); continue; }
      t -= T5;
      if (t < T6) { prep_transpose(p.s5_w_glu, 512, 512, 512, (bf16*)(p.ws + OFF_WT_GLU), t, sm); continue; }
      t -= T6;
      if (t < T7) { prep_transpose(p.peer_wq, 1024, 2048, 2048, (bf16*)(p.ws + OFF_WT_PWQ), t, sm); continue; }
      t -= T7;
      prep_transpose(p.peer_wq + (size_t)1024 * 2048, 1024, 2048, 2048, (bf16*)(p.ws + OFF_WT_PWQ) + (size_t)2048 * 1024, t, sm);
    }
  }
  convert_bf16(p.peer_keys, (bf16*)(p.ws + OFF_PKEYS), (size_t)2 * 8 * 2 * 128 * 128, bid, nb);
}

DI void phase_norm(const Params& p, int layer, bool first, const float* g, int shift_chunk, int nrows) {
  const int lane = get_tid() & 63, w = get_tid() >> 6;
  bf16* dst = (bf16*)(p.ws + OFF_ACTA);
  for (int r = blockIdx.x * 4 + w; r < nrows; r += gridDim.x * 4) {
    const float* src = first ? orig_row(p, r) : res_row(p, r);
    float4 v[4];
    float ss = 0.f;
#pragma unroll
    for (int i = 0; i < 4; ++i) {
      v[i] = ((const float4*)src)[i * 64 + lane];
      ss += v[i].x * v[i].x + v[i].y * v[i].y + v[i].z * v[i].z + v[i].w * v[i].w;
    }
    ss = wave_sum(ss);
    const float rs = rsqrtf(ss * (1.0f / 1024.0f) + EPSN);
    const float* sh = mod_ptr(p, layer, r, shift_chunk);
    const float* sc = mod_ptr(p, layer, r, shift_chunk + 1);
#pragma unroll
    for (int i = 0; i < 4; ++i) {
      float4 gg = ((const float4*)g)[i * 64 + lane];
      float4 s4 = ((const float4*)sh)[i * 64 + lane];
      float4 c4 = ((const float4*)sc)[i * 64 + lane];
      float o0 = v[i].x * rs * gg.x * (1.f + c4.x) + s4.x;
      float o1 = v[i].y * rs * gg.y * (1.f + c4.y) + s4.y;
      float o2 = v[i].z * rs * gg.z * (1.f + c4.z) + s4.z;
      float o3 = v[i].w * rs * gg.w * (1.f + c4.w) + s4.w;
      u32x2 o;
      o.x = cvtpk(o0, o1); o.y = cvtpk(o2, o3);
      ((u32x2*)(dst + (size_t)r * DM))[i * 64 + lane] = o;
    }
  }
}

DI void phase_inproj0(const Params& p, char* smem) {
  bf16* As = (bf16*)smem; bf16* Bs = As + 256 * GLS;
  const bf16* A = (const bf16*)(p.ws + OFF_ACTA);
  const bf16* Wt = (const bf16*)(p.ws + OFF_WT_EVIN);
  bf16* pg = (bf16*)(p.ws + OFF_PAGQA);
  bf16* ph = (bf16*)(p.ws + OFF_PAHG);
  const int ntn = 26, ntm = NTOK / 256;
  for (int t = blockIdx.x; t < ntn * ntm; t += gridDim.x) {
    const int mt = t / ntn, nt = t % ntn;
    f32x16 acc[4][2];
    gemm_256x128(A + (size_t)mt * 256 * DM, DM, Wt + (size_t)nt * 128 * DM, DM, DM, acc, As, Bs);
    gemm_epi2(acc, [&](int row, int col, float v) {
      int r = mt * 256 + row, cg_ = nt * 128 + col;
      if (cg_ < 768) pg[(size_t)r * 768 + cg_] = f2bf(v);
      else ph[(size_t)r * 2560 + (cg_ - 768)] = f2bf(v);
    });
  }
}

DI void phase_gqa_prep(const Params& p, char* smem) {
  bf16* pg = (bf16*)(p.ws + OFF_PAGQA);
  bf16* vt = (bf16*)(p.ws + OFF_VT0);
  bf16* tl = (bf16*)smem;
  const int lane = get_tid() & 63, w = get_tid() >> 6, tid = get_tid();
  const float gq = p.gqa_qn_g[lane], gk = p.gqa_kn_g[lane];
  const float inv = __powf(10000.f, -(float)(lane & 15) / 16.f);
  float lbv[16];
#pragma unroll
  for (int e = 0; e < 16; ++e) {
    const int j = lane * 16 + e, d = j >> 9, cc = j & 511;
    const float l0 = p.hg_lb_logits[(d * 2 + 0) * 512 + cc], l1 = p.hg_lb_logits[(d * 2 + 1) * 512 + cc];
    lbv[e] = 1.0f / (1.0f + __expf(l1 - l0));
  }
  bf16* phg = (bf16*)(p.ws + OFF_PAHG);
  for (int r = blockIdx.x * 4 + w; r < NTOK; r += gridDim.x * 4) {
    bf16* row = pg + (size_t)r * 768;
    float sn = 0.f, cs = 1.f;
    if (r < NLAT) {
      int t = r & 8191;
      float pos = (lane < 32) ? (float)(t >> 6) : (float)(t & 63);
      sincosf(pos * inv, &sn, &cs);
    }
#pragma unroll
    for (int hh = 0; hh < 10; ++hh) {
      float v = bf2f(row[hh * 64 + lane]);
      float ss = wave_sum(v * v);
      float y = v * rsqrtf(ss * (1.f / 64.f) + EPSN) * (hh < 8 ? gq : gk);
      float pr = __shfl_xor(y, 16);
      float o = y * cs + ((lane & 16) ? pr * sn : -pr * sn);
      row[hh * 64 + lane] = f2bf(hh < 8 ? o * (0.125f * 1.4426950408889634f) : o);
    }
    {
      bf16* frow = phg + (size_t)r * 2560 + 512 + lane * 16;
      u32x4 a = *(const u32x4*)frow, b2 = *(const u32x4*)(frow + 8);
      float fv[16];
      fv[0] = bflo(a.x); fv[1] = bfhi(a.x); fv[2] = bflo(a.y); fv[3] = bfhi(a.y); fv[4] = bflo(a.z); fv[5] = bfhi(a.z); fv[6] = bflo(a.w); fv[7] = bfhi(a.w);
      fv[8] = bflo(b2.x); fv[9] = bfhi(b2.x); fv[10] = bflo(b2.y); fv[11] = bfhi(b2.y); fv[12] = bflo(b2.z); fv[13] = bfhi(b2.z); fv[14] = bflo(b2.w); fv[15] = bfhi(b2.w);
#pragma unroll
      for (int e = 0; e < 16; ++e) fv[e] = __logf(lbv[e] + (1.f - lbv[e]) * sigmoidf_(fv[e]));
      u32x4 o0, o1;
      o0.x = cvtpk(fv[0], fv[1]); o0.y = cvtpk(fv[2], fv[3]); o0.z = cvtpk(fv[4], fv[5]); o0.w = cvtpk(fv[6], fv[7]);
      o1.x = cvtpk(fv[8], fv[9]); o1.y = cvtpk(fv[10], fv[11]); o1.z = cvtpk(fv[12], fv[13]); o1.w = cvtpk(fv[14], fv[15]);
      *(u32x4*)frow = o0; *(u32x4*)(frow + 8) = o1;
    }
  }
  for (int blk = blockIdx.x; blk < NTOK / 64; blk += gridDim.x) {
    const int r0 = blk * 64;
    __syncthreads();
    {
      const int rr = tid >> 2, c0 = (tid & 3) * 32;
      const bf16* src = pg + (size_t)(r0 + rr) * 768 + 640 + c0;
#pragma unroll
      for (int i = 0; i < 4; ++i) {
        u32x4 v4 = *(const u32x4*)(src + i * 8);
#pragma unroll
        for (int e = 0; e < 4; ++e) {
          tl[(c0 + i * 8 + 2 * e) * GLS + rr] = (bf16)(v4[e] & 0xffffu);
          tl[(c0 + i * 8 + 2 * e + 1) * GLS + rr] = (bf16)(v4[e] >> 16);
        }
      }
    }
    __syncthreads();
    int b, s0;
    if (r0 < NLAT) { b = r0 >> 13; s0 = CTXL + (r0 & 8191); } else { int rc = r0 - NLAT; b = rc >> 8; s0 = rc & 255; }
    {
      int vcol = tid >> 1, half = tid & 1;
      int kvh = vcol >> 6, dv = vcol & 63;
      bf16* dstp = vt + ((size_t)((b * 2 + kvh) * 64 + dv)) * SKEYS + s0 + half * 32;
      const bf16* srcp = tl + vcol * GLS + half * 32;
#pragma unroll
      for (int i = 0; i < 4; ++i) ((u32x4*)dstp)[i] = ((const u32x4*)srcp)[i];
    }
  }
}

template <int DQK, int SM>
DI void attn_item(const bf16* __restrict__ Q, int ldq_, const bf16* __restrict__ Kc, const bf16* __restrict__ Kl, int ldk_,
                  const bf16* __restrict__ VT, int nkeys, bf16* __restrict__ O, int ldo_, float scale, char* smem, float kbound = 0.f) {
  constexpr bool FIXED = (SM != 0);
  constexpr int ldq = 768, ldk = 768, ldo = DM;
  (void)ldq_; (void)ldk_; (void)ldo_;
  constexpr int KLS = DQK + 8;
  constexpr int VLS = 72;
  constexpr int NKS = DQK / 16;
  constexpr int KCH = DQK / 8;
  constexpr int KLOADS = (64 * KCH) / 256;
  constexpr int BUF = 64 * KLS + 64 * VLS;
  bf16* Sb = (bf16*)smem;
  const int tid = get_tid(), lane = tid & 63, w = tid >> 6;
  const float sc = scale * 1.4426950408889634f;
  bf16x8 qf[2][NKS];
#pragma unroll
  for (int qt = 0; qt < 2; ++qt) {
    const bf16* qp = Q + (size_t)(w * 64 + qt * 32 + (lane & 31)) * ldq + (lane >> 5) * 8;
#pragma unroll
    for (int ks = 0; ks < NKS; ++ks) qf[qt][ks] = *(const bf16x8*)(qp + ks * 16);
  }
  float msh[2] = {0.f, 0.f};
  if (SM == 2) {
#pragma unroll
    for (int qt = 0; qt < 2; ++qt) {
      float sq = 0.f;
#pragma unroll
      for (int ks = 0; ks < NKS; ++ks)
#pragma unroll
        for (int e = 0; e < 8; ++e) { float f = bf2f((bf16)qf[qt][ks][e]); sq += f * f; }
      sq += __shfl_xor(sq, 32);
      msh[qt] = fminf(sqrtf(sq) * kbound, 64.0f);
    }
  }
  f32x16 ot[2][2];
#pragma unroll
  for (int i = 0; i < 2; ++i)
#pragma unroll
    for (int j = 0; j < 2; ++j)
#pragma unroll
      for (int r = 0; r < 16; ++r) ot[i][j][r] = 0.f;
  float m_run[2] = {-1e30f, -1e30f}, l_run[2] = {0.f, 0.f};
  u32x4 kr[KLOADS], vr[2];
  auto gload = [&](int s0) {
    const bf16* kb = (s0 < CTXL) ? (Kc + (size_t)s0 * ldk) : (Kl + (size_t)(s0 - CTXL) * ldk);
#pragma unroll
    for (int i = 0; i < KLOADS; ++i) {
      int ci = i * 256 + tid;
      int row = ci / KCH, ch = ci % KCH;
      kr[i] = *(const u32x4*)(kb + (size_t)row * ldk + ch * 8);
    }
#pragma unroll
    for (int i = 0; i < 2; ++i) {
      int ci = i * 256 + tid;
      int row = ci >> 3, ch = ci & 7;
      vr[i] = *(const u32x4*)(VT + (size_t)row * SKEYS + s0 + ch * 8);
    }
  };
  auto lwrite = [&](bf16* buf) {
    bf16* Ks = buf; bf16* Vs = buf + 64 * KLS;
#pragma unroll
    for (int i = 0; i < KLOADS; ++i) {
      int ci = i * 256 + tid;
      int row = ci / KCH, ch = ci % KCH;
      *(u32x4*)(Ks + row * KLS + ch * 8) = kr[i];
    }
#pragma unroll
    for (int i = 0; i < 2; ++i) {
      int ci = i * 256 + tid;
      int row = ci >> 3, ch = ci & 7;
      u32x2 lo = {vr[i].x, vr[i].y}, hi = {vr[i].z, vr[i].w};
      const int gb = (ch >> 1) * 16 + (ch & 1) * 4;
      *(u32x2*)(Vs + row * VLS + gb) = lo;
      *(u32x2*)(Vs + row * VLS + gb + 8) = hi;
    }
  };
  const int ntiles = nkeys >> 6;
  __syncthreads();
  gload(0);
  lwrite(Sb);
  if (ntiles > 1) gload(64);
  for (int j = 0; j < ntiles; ++j) {
    __syncthreads();
    if (j + 1 < ntiles) {
      lwrite(Sb + ((j + 1) & 1) * BUF);
      if (j + 2 < ntiles) gload((j + 2) * 64);
    }
    const bf16* Ks = Sb + (j & 1) * BUF;
    const bf16* Vs = Ks + 64 * KLS;
    auto half = [&](const int kt) {
      f32x16 st[2];
#pragma unroll
      for (int qt = 0; qt < 2; ++qt)
#pragma unroll
        for (int r = 0; r < 16; ++r) st[qt][r] = 0.f;
      {
        const bf16* ap = Ks + (kt * 32 + (lane & 31)) * KLS + (lane >> 5) * 8;
        __builtin_amdgcn_s_setprio(1);
#pragma unroll
        for (int ks = 0; ks < NKS; ++ks) {
          bf16x8 a = *(const bf16x8*)(ap + ks * 16);
          st[0] = MFMA32(a, qf[0][ks], st[0]);
          st[1] = MFMA32(a, qf[1][ks], st[1]);
        }
        __builtin_amdgcn_s_setprio(0);
      }
      float mx[2] = {0.f, 0.f};
      bool need = false;
      if (!FIXED) {
#pragma unroll
      for (int qt = 0; qt < 2; ++qt) {
        float m0 = fmaxf(st[qt][0], st[qt][1]);
#pragma unroll
        for (int r = 2; r < 16; r += 2) m0 = fmaxf(m0, fmaxf(st[qt][r], st[qt][r + 1]));
        m0 = fmaxf(m0, __shfl_xor(m0, 32)) * sc;
        mx[qt] = m0;
        need = need || (m0 - m_run[qt] > 8.0f);
      }
      }
      if (!FIXED && __any(need)) {
#pragma unroll
        for (int qt = 0; qt < 2; ++qt) {
          const float m_new = fmaxf(m_run[qt], mx[qt]);
          const float alpha = __builtin_amdgcn_exp2f(m_run[qt] - m_new);
          m_run[qt] = m_new;
          l_run[qt] *= alpha;
#pragma unroll
          for (int dt = 0; dt < 2; ++dt)
#pragma unroll
            for (int r = 0; r < 16; ++r) ot[qt][dt][r] *= alpha;
        }
      }
      bf16x8 pb[2][2];
#pragma unroll
      for (int qt = 0; qt < 2; ++qt) {
        float ps = 0.f;
        const float mr = m_run[qt];
#pragma unroll
        for (int r = 0; r < 16; ++r) {
          float pv = (SM == 1) ? __builtin_amdgcn_exp2f(st[qt][r]) : (SM == 2) ? __builtin_amdgcn_exp2f(st[qt][r] - msh[qt]) : __builtin_amdgcn_exp2f(st[qt][r] * sc - mr);
          st[qt][r] = pv;
          ps += pv;
        }
#pragma unroll
        for (int s2 = 0; s2 < 2; ++s2) {
          u32x4 pk;
          pk.x = cvtpk(st[qt][8 * s2 + 0], st[qt][8 * s2 + 1]);
          pk.y = cvtpk(st[qt][8 * s2 + 2], st[qt][8 * s2 + 3]);
          pk.z = cvtpk(st[qt][8 * s2 + 4], st[qt][8 * s2 + 5]);
          pk.w = cvtpk(st[qt][8 * s2 + 6], st[qt][8 * s2 + 7]);
          pb[qt][s2] = __builtin_bit_cast(bf16x8, pk);
        }
        l_run[qt] += ps;
      }
      __builtin_amdgcn_s_setprio(1);
#pragma unroll
      for (int s2 = 0; s2 < 2; ++s2)
#pragma unroll
        for (int dt = 0; dt < 2; ++dt) {
          const bf16* vp = Vs + (dt * 32 + (lane & 31)) * VLS + kt * 32 + 16 * s2 + 8 * (lane >> 5);
          bf16x8 af = *(const bf16x8*)vp;
          ot[0][dt] = MFMA32(af, pb[0][s2], ot[0][dt]);
          ot[1][dt] = MFMA32(af, pb[1][s2], ot[1][dt]);
        }
      __builtin_amdgcn_s_setprio(0);
    };
    if constexpr (SM == 1) {
#pragma unroll 1
      for (int kt = 0; kt < 2; ++kt) half(kt);
    } else {
      half(0);
      half(1);
    }
  }
#pragma unroll
  for (int qt = 0; qt < 2; ++qt) {
    const float ltot = l_run[qt] + __shfl_xor(l_run[qt], 32);
    const float inv_l = 1.0f / ltot;
    const int tid2 = get_tid();
    bf16* op = O + (size_t)((tid2 >> 6) * 64 + qt * 32 + (tid2 & 31)) * ldo;
#pragma unroll
    for (int dt = 0; dt < 2; ++dt)
#pragma unroll
      for (int g4 = 0; g4 < 4; ++g4) {
        int dv = dt * 32 + 8 * g4 + 4 * ((tid2 >> 5) & 1);
        u32x2 o;
        o.x = cvtpk(ot[qt][dt][4 * g4 + 0] * inv_l, ot[qt][dt][4 * g4 + 1] * inv_l);
        o.y = cvtpk(ot[qt][dt][4 * g4 + 2] * inv_l, ot[qt][dt][4 * g4 + 3] * inv_l);
        *(u32x2*)(op + dv) = o;
      }
  }
}

DI void hgrn2_item(const Params& p, int item, char* smem) {
  const int vs = item & 3, dir = (item >> 2) & 1, h = (item >> 3) & 3, b = item >> 5;
  constexpr int QLS = 136, TLS = 72;
  bf16* Qr = (bf16*)smem;
  bf16* Kr = Qr + 64 * QLS;
  bf16* KrT = Kr + 64 * QLS;
  bf16* VTs = KrT + 128 * TLS;
  bf16* Att = VTs + 32 * TLS;
  bf16* STb = Att + 64 * TLS;
  float* rsum = (float*)(STb + 32 * QLS);
  float* lsum = rsum + 128;
  const int tid = get_tid(), lane = tid & 63, w = tid >> 6;
  const int c = tid & 127, half = tid >> 7;
  const bf16* ph = (const bf16*)(p.ws + OFF_PAHG);
  bf16* og = (bf16*)(p.ws + OFF_OHG) + (size_t)dir * NTOK * 512;
  auto rowof = [&](int pos) -> int {
    if (pos < CTXL) { int s = dir ? (CTXL - 1 - pos) : pos; return NLAT + b * CTXL + s; }
    int t = pos - CTXL; t = dir ? (SEQ - 1 - t) : t; return b * SEQ + t;
  };
  f32x16 S0, S1;
#pragma unroll
  for (int r = 0; r < 16; ++r) { S0[r] = 0.f; S1[r] = 0.f; }
  bf16 pq[32], pf[32];
  u32x4 pv;
  auto prefetch = [&](int ch) {
    const int p0 = ch * 64;
#pragma unroll
    for (int i = 0; i < 32; ++i) {
      const bf16* row = ph + (size_t)rowof(p0 + half * 32 + i) * 2560;
      pq[i] = row[h * 128 + c];
      pf[i] = row[512 + dir * 512 + h * 128 + c];
    }
    {
      const bf16* row = ph + (size_t)rowof(p0 + (tid >> 2)) * 2560;
      pv = *(const u32x4*)(row + 1536 + h * 128 + vs * 32 + (tid & 3) * 8);
    }
  };
  for (int ch = 0; ch < 132; ++ch) {
    prefetch(ch);
    {
      float run = 0.f;
      if (half == 0) {
#pragma unroll
        for (int ii = 31; ii >= 0; --ii) {
          float lg = bf2f(pf[ii]), q = bf2f(pq[ii]);
          float k = 1.f - __expf(lg);
          float eq = __expf(fminf(-run, 80.f)), ek = __expf(fmaxf(run, -80.f));
          const unsigned pk2 = cvtpk(q * eq, k * ek);
          const bf16 qv = (bf16)(pk2 & 0xffffu), kv = (bf16)(pk2 >> 16);
          Qr[ii * QLS + c] = qv;
          Kr[ii * QLS + c] = kv;
          KrT[c * TLS + ii] = kv;
          run += lg;
        }
        rsum[c] = __expf(run);
      } else {
#pragma unroll
        for (int ii = 0; ii < 32; ++ii) {
          float lg = bf2f(pf[ii]), q = bf2f(pq[ii]);
          float k = 1.f - __expf(lg);
          run += lg;
          float eq = __expf(fmaxf(run, -80.f)), ek = __expf(fminf(-run, 80.f));
          const unsigned pk2 = cvtpk(q * eq, k * ek);
          const bf16 qv = (bf16)(pk2 & 0xffffu), kv = (bf16)(pk2 >> 16);
          Qr[(32 + ii) * QLS + c] = qv;
          Kr[(32 + ii) * QLS + c] = kv;
          KrT[c * TLS + 32 + ii] = kv;
        }
        lsum[c] = __expf(run);
      }
      {
        int i = tid >> 2, v0 = (tid & 3) * 8;
#pragma unroll
        for (int j = 0; j < 4; ++j) {
          VTs[(v0 + 2 * j) * TLS + i] = (bf16)(pv[j] & 0xffffu);
          VTs[(v0 + 2 * j + 1) * TLS + i] = (bf16)(pv[j] >> 16);
        }
      }
    }
    __syncthreads();
    if (w < 2) {
      const int ntl = (w == 0) ? 2 : 1;
      for (int q2 = 0; q2 < ntl; ++q2) {
        const int tt = (w == 0) ? q2 : 1, stl = (w == 0) ? q2 : 0;
        f32x16 a;
#pragma unroll
        for (int r = 0; r < 16; ++r) a[r] = 0.f;
        mma_tile(a, Qr + tt * 32 * QLS, QLS, Kr + stl * 32 * QLS, QLS, 128);
#pragma unroll
        for (int r = 0; r < 16; ++r) {
          int t = tt * 32 + crow(r, lane), s = stl * 32 + (lane & 31);
          float v = (s <= t) ? a[r] : 0.f;
          Att[t * TLS + s] = (bf16)(cvtpk(v, v) & 0xffffu);
        }
      }
      if (w == 1) {
#pragma unroll
        for (int r = 0; r < 16; ++r) Att[crow(r, lane) * TLS + 32 + (lane & 31)] = 0;
      }
    } else {
      const int ct0 = (w - 2) * 2;
#pragma unroll
      for (int tI = 0; tI < 2; ++tI) {
        f32x16& S = tI ? S1 : S0;
        const int cb = (ct0 + tI) * 32;
#pragma unroll
        for (int g4 = 0; g4 < 4; ++g4) {
          int cc = cb + 8 * g4 + 4 * (lane >> 5);
          float e0 = rsum[cc], e1 = rsum[cc + 1], e2 = rsum[cc + 2], e3 = rsum[cc + 3];
          u32x2 o;
          o.x = cvtpk(S[4 * g4] * e0, S[4 * g4 + 1] * e1);
          o.y = cvtpk(S[4 * g4 + 2] * e2, S[4 * g4 + 3] * e3);
          *(u32x2*)(STb + (lane & 31) * QLS + cc) = o;
        }
        f32x16 a;
#pragma unroll
        for (int r = 0; r < 16; ++r) a[r] = 0.f;
        mma_tile(a, KrT + cb * TLS, TLS, VTs, TLS, 64);
#pragma unroll
        for (int r = 0; r < 16; ++r) {
          int cc = cb + crow(r, lane);
          float el = lsum[cc];
          float er = rsum[cc];
          S[r] = S[r] * (el * er) + a[r] * el;
        }
      }
    }
    __syncthreads();
    if (w < 2) {
      f32x16 a;
#pragma unroll
      for (int r = 0; r < 16; ++r) a[r] = 0.f;
      mma_tile(a, Att + w * 32 * TLS, TLS, VTs, TLS, 64);
      mma_tile(a, Qr + w * 32 * QLS, QLS, STb, QLS, 128);
#pragma unroll
      for (int r = 0; r < 16; ++r) {
        int t = w * 32 + crow(r, lane);
        int row = rowof(ch * 64 + t);
        og[(size_t)row * 512 + h * 128 + vs * 32 + (lane & 31)] = f2bf(a[r]);
      }
    }
    __syncthreads();
  }
}

DI void phase_mix0(const Params& p, char* smem, int cidx) {
  __shared__ int s_item;
  if (blockIdx.x < 128) hgrn2_item(p, blockIdx.x, smem);
  unsigned* cnt = (unsigned*)(p.ws + OFF_CNT) + cidx;
  const bf16* pg = (const bf16*)(p.ws + OFF_PAGQA);
  const bf16* vt = (const bf16*)(p.ws + OFF_VT0);
  bf16* ycat = (bf16*)(p.ws + OFF_ACTA);
  float kb0;
  {
    const int ln = get_tid() & 63;
    kb0 = 8.0f * 1.01f * wave_max_early(fabsf(p.gqa_kn_g[ln]));
  }
  const int n_lat = 4 * 8 * 32, n_ctx = 4 * 8;
  while (true) {
    __syncthreads();
    if (get_tid() == 0) s_item = (int)atomicAdd(cnt, 1u);
    __syncthreads();
    const int it = s_item;
    if (it >= n_lat + n_ctx) break;
    int b, hq, r0, nk;
    if (it < n_lat) { const int qt = it & 31; hq = (it >> 5) & 7; b = it >> 8; r0 = b * SEQ + qt * 256; nk = SKEYS; }
    else { const int i2 = it - n_lat; hq = i2 & 7; b = i2 >> 3; r0 = NLAT + b * CTXL; nk = CTXL; }
    const int kvh = hq >> 2;
    attn_item<64, 2>(pg + (size_t)r0 * 768 + hq * 64, 768,
                  pg + (size_t)(NLAT + b * CTXL) * 768 + 512 + kvh * 64, pg + (size_t)(b * SEQ) * 768 + 512 + kvh * 64, 768,
                  vt + (size_t)((b * 2 + kvh) * 64) * SKEYS, nk, ycat + (size_t)r0 * DM + hq * 64, DM, 0.125f, smem, kb0);
  }
}

DI void phase_hg_readout(const Params& p) {
  const int lane = get_tid() & 63, w = get_tid() >> 6;
  const bf16* o0 = (const bf16*)(p.ws + OFF_OHG);
  const bf16* o1 = o0 + (size_t)NTOK * 512;
  const bf16* ph = (const bf16*)(p.ws + OFF_PAHG);
  bf16* ycat = (bf16*)(p.ws + OFF_ACTA);
  const float g0 = p.hg_onorm_g[lane * 2], g1 = p.hg_onorm_g[lane * 2 + 1];
  for (int r = blockIdx.x * 4 + w; r < NTOK; r += gridDim.x * 4) {
#pragma unroll
    for (int h = 0; h < 4; ++h) {
      unsigned a = *(const unsigned*)(o0 + (size_t)r * 512 + h * 128 + lane * 2);
      unsigned b2 = *(const unsigned*)(o1 + (size_t)r * 512 + h * 128 + lane * 2);
      unsigned gg = *(const unsigned*)(ph + (size_t)r * 2560 + 2048 + h * 128 + lane * 2);
      float x0 = bflo(a) + bflo(b2), x1 = bfhi(a) + bfhi(b2);
      float ss = wave_sum(x0 * x0 + x1 * x1);
      float rs = rsqrtf(ss * (1.f / 128.f) + EPSN);
      float y0 = x0 * rs * g0 * siluf_(bflo(gg)), y1 = x1 * rs * g1 * siluf_(bfhi(gg));
      *(unsigned*)(ycat + (size_t)r * DM + 512 + h * 128 + lane * 2) = cvtpk(y0, y1);
    }
  }
}

template <int MI>
DI void resid_epilogue(f32x16 (&acc)[MI][2], const float* src, float* dst, const float* __restrict__ g) {
  const int lane = get_tid() & 63, w = get_tid() >> 6;
  const int wm = w >> 1, wn = w & 1;
  const float g0 = g[wn * 64 + (lane & 31)], g1 = g[wn * 64 + 32 + (lane & 31)];
#pragma unroll
  for (int mi = 0; mi < MI; ++mi) {
    const size_t o0 = (size_t)(wm * (MI * 32) + mi * 32 + 4 * (lane >> 5)) * DM + wn * 64 + (lane & 31);
    float xv[2][16];
#pragma unroll
    for (int r = 0; r < 16; ++r) {
      const size_t ro = o0 + (size_t)((r & 3) + 8 * (r >> 2)) * DM;
      xv[0][r] = src[ro];
      xv[1][r] = src[ro + 32];
    }
#pragma unroll
    for (int r = 0; r < 16; ++r) {
      const size_t ro = o0 + (size_t)((r & 3) + 8 * (r >> 2)) * DM;
      dst[ro] = xv[0][r] + g0 * acc[mi][0][r];
      dst[ro + 32] = xv[1][r] + g1 * acc[mi][1][r];
    }
  }
}
DI void resid_prefetch2(float (&xv)[2][2][16], const float* src) {
  const int lane = get_tid() & 63, w = get_tid() >> 6;
  const int wm = w >> 1, wn = w & 1;
#pragma unroll
  for (int mi = 0; mi < 2; ++mi) {
    const size_t o0 = (size_t)(wm * 64 + mi * 32 + 4 * (lane >> 5)) * DM + wn * 64 + (lane & 31);
#pragma unroll
    for (int r = 0; r < 16; ++r) {
      const size_t ro = o0 + (size_t)((r & 3) + 8 * (r >> 2)) * DM;
      xv[mi][0][r] = src[ro];
      xv[mi][1][r] = src[ro + 32];
    }
  }
}
DI void resid_store2(f32x16 (&acc)[2][2], const float (&xv)[2][2][16], float* dst, const float* __restrict__ g) {
  const int lane = get_tid() & 63, w = get_tid() >> 6;
  const int wm = w >> 1, wn = w & 1;
  const float g0 = g[wn * 64 + (lane & 31)], g1 = g[wn * 64 + 32 + (lane & 31)];
#pragma unroll
  for (int mi = 0; mi < 2; ++mi) {
    const size_t o0 = (size_t)(wm * 64 + mi * 32 + 4 * (lane >> 5)) * DM + wn * 64 + (lane & 31);
#pragma unroll
    for (int r = 0; r < 16; ++r) {
      const size_t ro = o0 + (size_t)((r & 3) + 8 * (r >> 2)) * DM;
      dst[ro] = xv[mi][0][r] + g0 * acc[mi][0][r];
      dst[ro + 32] = xv[mi][1][r] + g1 * acc[mi][1][r];
    }
  }
}
DI void phase_outproj(const Params& p, int layer, size_t wt_off, int nrows, bool first, char* smem) {
  (void)first;
  bf16* As = (bf16*)smem; bf16* Bs = As + 128 * GLS;
  const bf16* A = (const bf16*)(p.ws + OFF_ACTA);
  const bf16* Wt = (const bf16*)(p.ws + wt_off);
  const int ntn = 8, ntm = nrows / 128;
  for (int t = blockIdx.x; t < ntn * ntm; t += gridDim.x) {
    const int mt = t / ntn, nt = t % ntn;
    f32x16 acc[2][2];
    const int r0 = mt * 128;
    float xv[2][2][16];
    resid_prefetch2(xv, orig_row(p, r0) + nt * 128);
    gemm_128x128(A + (size_t)mt * 128 * DM, DM, Wt + (size_t)nt * 128 * DM, DM, DM, acc, As, Bs);
    resid_store2(acc, xv, res_row(p, r0) + nt * 128, mod_ptr(p, layer, r0, 2) + nt * 128);
  }
}
DI void phase_outproj1(const Params& p, char* smem) {
  bf16* As = (bf16*)smem; bf16* Bs = As + 256 * GLS;
  const bf16* A = (const bf16*)(p.ws + OFF_ACTA);
  const bf16* Wt = (const bf16*)(p.ws + OFF_WT_ODOUT);
  const int ntn = 8, ntm = NLAT / 256;
  for (int t = blockIdx.x; t < ntn * ntm; t += gridDim.x) {
    const int mt = t / ntn, nt = t % ntn;
    f32x16 acc[4][2];
    gemm_256x128(A + (size_t)mt * 256 * DM, DM, Wt + (size_t)nt * 128 * DM, DM, DM, acc, As, Bs);
    float* xp = p.out + (size_t)(mt * 256) * DM + nt * 128;
    resid_epilogue<4>(acc, xp, xp, mod_ptr(p, 1, mt * 256, 2) + nt * 128);
  }
}

DI void tk_ins(float (&L)[16], float x) {
#pragma unroll
  for (int j = 15; j >= 1; --j) L[j] = __builtin_amdgcn_fmed3f(L[j - 1], L[j], x);
  L[0] = fmaxf(L[0], x);
}
DI void tk_insert(float (&v)[16], int (&id)[16], float x, int xi) {
  if (x > v[15]) {
    v[15] = x; id[15] = xi;
#pragma unroll
    for (int j = 15; j > 0; --j) {
      bool sw = v[j] > v[j - 1];
      float a = v[j], b2 = v[j - 1];
      int ia = id[j], ib = id[j - 1];
      v[j - 1] = sw ? a : b2; v[j] = sw ? b2 : a;
      id[j - 1] = sw ? ia : ib; id[j] = sw ? ib : ia;
    }
  }
}

DI void phase_peer_route(const Params& p, int layer, int nrows, char* smem, size_t roff = OFF_RIDX) {
  bf16* As = (bf16*)smem; bf16* Bs = As + 128 * GLS;
  constexpr int QLS = 136;
  bf16* Qt = (bf16*)smem;
  bf16* Kt = Qt + 128 * QLS;
  float* Sc = (float*)smem;
  const bf16* A = (const bf16*)(p.ws + OFF_ACTA);
  const bf16* Wt = (const bf16*)(p.ws + OFF_WT_PWQ) + (size_t)layer * 2048 * 1024;
  const bf16* keys = (const bf16*)(p.ws + OFF_PKEYS) + (size_t)layer * 8 * 2 * 128 * 128;
  int* ridx = (int*)(p.ws + roff);
  float* rgw = (float*)(p.ws + roff + (OFF_RGW - OFF_RIDX));
  const int tid = get_tid(), lane = tid & 63, w = tid >> 6;
  const int wm = w >> 1, wn = w & 1;
  const int ntm = nrows / 128;
  for (int it = blockIdx.x; it < ntm * 8; it += gridDim.x) {
    const int mt = it >> 3, h = it & 7;
    float l0v[16]; int l0i[16];
    float lv[16]; int li[16];
    for (int pp = 0; pp < 2; ++pp) {
      f32x16 acc[2][2];
      gemm_128x128(A + (size_t)mt * 128 * DM, DM, Wt + (size_t)((h * 2 + pp) * 128) * DM, DM, DM, acc, As, Bs);
      __syncthreads();
      gemm_epi(acc, [&](int row, int col, float v) { Qt[row * QLS + col] = f2bf(v); });
      {
        const bf16* kb = keys + (size_t)((h * 2 + pp) * 128) * 128;
#pragma unroll
        for (int i = 0; i < 8; ++i) {
          int ci = i * 256 + tid;
          int row = ci >> 4, chh = ci & 15;
          *(u32x4*)(Kt + row * QLS + chh * 8) = *(const u32x4*)(kb + row * 128 + chh * 8);
        }
      }
      __syncthreads();
      f32x16 sa[2][2];
#pragma unroll
      for (int i = 0; i < 2; ++i)
#pragma unroll
        for (int j = 0; j < 2; ++j) {
#pragma unroll
          for (int r = 0; r < 16; ++r) sa[i][j][r] = 0.f;
          mma_tile(sa[i][j], Qt + (wm * 64 + i * 32) * QLS, QLS, Kt + (wn * 64 + j * 32) * QLS, QLS, 128);
        }
      __syncthreads();
      gemm_epi(sa, [&](int row, int col, float v) { Sc[row * 129 + col] = v; });
      __syncthreads();
      {
        const int tok = tid & 127, hf = tid >> 7;
        float* Lst = Sc + 128 * 129;
        float L[16];
#pragma unroll
        for (int j = 0; j < 16; ++j) L[j] = -3.0e38f;
#pragma unroll 8
        for (int n = 0; n < 64; ++n) {
          const int nn = hf * 64 + n;
          const unsigned kb = (__float_as_uint(Sc[tok * 129 + nn]) & 0xffffff80u) | (unsigned)nn;
          tk_ins(L, __uint_as_float(kb));
        }
        if (hf == 1) {
#pragma unroll
          for (int j = 0; j < 16; ++j) Lst[tok * 17 + j] = L[j];
        }
        __syncthreads();
        if (hf == 0) {
#pragma unroll
          for (int j = 0; j < 16; ++j) tk_ins(L, Lst[tok * 17 + j]);
#pragma unroll
          for (int j = 0; j < 16; ++j) {
            const int ix = (int)(__float_as_uint(L[j]) & 0x7fu);
            li[j] = ix;
            lv[j] = Sc[tok * 129 + ix];
          }
          if (pp == 0) {
#pragma unroll
            for (int j = 0; j < 16; ++j) { l0v[j] = lv[j]; l0i[j] = li[j]; }
          }
        }
      }
      __syncthreads();
    }
    if (tid < 128) {
      float fv[16]; int fi[16];
#pragma unroll
      for (int j = 0; j < 16; ++j) { fv[j] = -3.0e38f; fi[j] = 0; }
#pragma unroll
      for (int a = 0; a < 16; ++a)
#pragma unroll
        for (int b2 = 0; b2 < 16; ++b2)
          if ((a + 1) * (b2 + 1) <= 16) tk_insert(fv, fi, l0v[a] + lv[b2], l0i[a] * 128 + li[b2]);
      float mx = fv[0];
      float e[16];
#pragma unroll
      for (int j = 0; j < 16; ++j) e[j] = fv[j];
      float sum = 0.f;
#pragma unroll
      for (int j = 0; j < 16; ++j) { e[j] = __expf(e[j] - mx); sum += e[j]; }
      const float inv = 1.f / sum;
      const int r = mt * 128 + tid;
      int4* ip = (int4*)(ridx + (size_t)r * 128 + h * 16);
      float4* gp = (float4*)(rgw + (size_t)r * 128 + h * 16);
#pragma unroll
      for (int j = 0; j < 4; ++j) {
        ip[j] = make_int4(fi[4 * j], fi[4 * j + 1], fi[4 * j + 2], fi[4 * j + 3]);
        gp[j] = make_float4(e[4 * j] * inv, e[4 * j + 1] * inv, e[4 * j + 2] * inv, e[4 * j + 3] * inv);
      }
    }
  }
}

typedef float f32x2 __attribute__((ext_vector_type(2)));
DI float wave_max(float v) {
#pragma unroll
  for (int o = 32; o > 0; o >>= 1) v = fmaxf(v, __shfl_xor(v, o));
  return v;
}
DI unsigned pk4_fp8(float a, float b, float c, float d) {
  int r = 0;
  r = __builtin_amdgcn_cvt_pk_fp8_f32(a, b, r, false);
  r = __builtin_amdgcn_cvt_pk_fp8_f32(c, d, r, true);
  return (unsigned)r;
}
DI float clamp6(float v) { return __builtin_amdgcn_fmed3f(v, -6.0f, 6.0f); }
DI void convert_fp8_rows(const float* __restrict__ src, unsigned char* __restrict__ dst, float* __restrict__ scl) {
  const int lane = get_tid() & 63, w = get_tid() >> 6;
  for (int row = blockIdx.x * 4 + w; row < 16384; row += gridDim.x * 4) {
    const float4* s4 = (const float4*)(src + (size_t)row * 1024) + lane * 4;
    float4 v0 = s4[0], v1 = s4[1], v2 = s4[2], v3 = s4[3];
    float ss = v0.x * v0.x + v0.y * v0.y + v0.z * v0.z + v0.w * v0.w + v1.x * v1.x + v1.y * v1.y + v1.z * v1.z + v1.w * v1.w +
               v2.x * v2.x + v2.y * v2.y + v2.z * v2.z + v2.w * v2.w + v3.x * v3.x + v3.y * v3.y + v3.z * v3.z + v3.w * v3.w;
    ss = wave_sum(ss);
    const float sc = (ss > 0.f) ? 0.5f * sqrtf(ss * (1.0f / 1024.0f)) : 1.0f;
    const float inv = 1.0f / sc;
    unsigned d0 = 0, d1 = 0;
    d0 = __builtin_amdgcn_cvt_scalef32_pk_fp4_f32(d0, clamp6(v0.x * inv), clamp6(v0.y * inv), 1.0f, 0);
    d0 = __builtin_amdgcn_cvt_scalef32_pk_fp4_f32(d0, clamp6(v0.z * inv), clamp6(v0.w * inv), 1.0f, 1);
    d0 = __builtin_amdgcn_cvt_scalef32_pk_fp4_f32(d0, clamp6(v1.x * inv), clamp6(v1.y * inv), 1.0f, 2);
    d0 = __builtin_amdgcn_cvt_scalef32_pk_fp4_f32(d0, clamp6(v1.z * inv), clamp6(v1.w * inv), 1.0f, 3);
    d1 = __builtin_amdgcn_cvt_scalef32_pk_fp4_f32(d1, clamp6(v2.x * inv), clamp6(v2.y * inv), 1.0f, 0);
    d1 = __builtin_amdgcn_cvt_scalef32_pk_fp4_f32(d1, clamp6(v2.z * inv), clamp6(v2.w * inv), 1.0f, 1);
    d1 = __builtin_amdgcn_cvt_scalef32_pk_fp4_f32(d1, clamp6(v3.x * inv), clamp6(v3.y * inv), 1.0f, 2);
    d1 = __builtin_amdgcn_cvt_scalef32_pk_fp4_f32(d1, clamp6(v3.z * inv), clamp6(v3.w * inv), 1.0f, 3);
    ((u32x2*)(dst + (size_t)row * 512))[lane] = u32x2{d0, d1};
    if (lane == 0) scl[row] = sc;
  }
}
DI void phase_convert_tables(const Params& p, int layer) {
  convert_fp8_rows(p.peer_u + (size_t)layer * 16384 * 1024, (unsigned char*)(p.ws + OFF_UTAB), (float*)(p.ws + OFF_SU));
  convert_fp8_rows(p.peer_v + (size_t)layer * 16384 * 1024, (unsigned char*)(p.ws + OFF_VTAB), (float*)(p.ws + OFF_SV));
}

struct GBuf { u32x2 u[16]; u32x2 v[16]; float su, sv, gw; };
DI void phase_peer_gather(const Params& p, int layer, int nrows, bool dry) {
  const int lane = get_tid() & 63, w = get_tid() >> 6;
  const bf16* hb = (const bf16*)(p.ws + OFF_ACTA);
  const unsigned char* ut = (const unsigned char*)(p.ws + OFF_UTAB);
  const unsigned char* vtb = (const unsigned char*)(p.ws + OFF_VTAB);
  const float* su = (const float*)(p.ws + OFF_SU);
  const float* sv = (const float*)(p.ws + OFF_SV);
  const int* ridx = (const int*)(p.ws + OFF_RIDX);
  const float* rgw = (const float*)(p.ws + OFF_RGW);
  const int ecode = ((lane >> 5) & 1) * 8 + ((lane >> 4) & 1) * 4 + ((lane >> 3) & 1) * 2 + ((lane >> 2) & 1);
  for (int r = blockIdx.x * 4 + w; r < nrows; r += gridDim.x * 4) {
    f32x2 h2[8];
    {
      u32x4 a = *(const u32x4*)(hb + (size_t)r * DM + lane * 16);
      u32x4 b2 = *(const u32x4*)(hb + (size_t)r * DM + lane * 16 + 8);
      h2[0] = f32x2{bflo(a.x), bfhi(a.x)}; h2[1] = f32x2{bflo(a.y), bfhi(a.y)};
      h2[2] = f32x2{bflo(a.z), bfhi(a.z)}; h2[3] = f32x2{bflo(a.w), bfhi(a.w)};
      h2[4] = f32x2{bflo(b2.x), bfhi(b2.x)}; h2[5] = f32x2{bflo(b2.y), bfhi(b2.y)};
      h2[6] = f32x2{bflo(b2.z), bfhi(b2.z)}; h2[7] = f32x2{bflo(b2.w), bfhi(b2.w)};
    }
    const int e_lo = ridx[(size_t)r * 128 + lane], e_hi = ridx[(size_t)r * 128 + 64 + lane];
    const float g_lo = rgw[(size_t)r * 128 + lane], g_hi = rgw[(size_t)r * 128 + 64 + lane];
    f32x2 acc[8];
#pragma unroll
    for (int j = 0; j < 8; ++j) acc[j] = f32x2{0.f, 0.f};
    auto gload = [&](GBuf& B, int kb) {
      const int esrc = (kb < 4) ? e_lo : e_hi;
      const float gsrc = (kb < 4) ? g_lo : g_hi;
      const int base = (kb & 3) * 16;
#pragma unroll
      for (int j = 0; j < 16; ++j) {
        const int e = __builtin_amdgcn_readlane(esrc, base + j);
        B.u[j] = *(const u32x2*)(ut + (size_t)e * 512 + lane * 8);
        B.v[j] = *(const u32x2*)(vtb + (size_t)e * 512 + lane * 8);
      }
      const int el = __shfl(esrc, base + ecode);
      B.su = su[el]; B.sv = sv[el];
      B.gw = __shfl(gsrc, base + ecode);
    };
    auto compute = [&](GBuf& B) {
      float part[16];
#pragma unroll
      for (int j = 0; j < 16; ++j) {
        f32x2 s2 = f32x2{0.f, 0.f};
#pragma unroll
        for (int q = 0; q < 2; ++q) {
          s2 += __builtin_amdgcn_cvt_scalef32_pk_f32_fp4(B.u[j][q], 1.0f, 0) * h2[4 * q];
          s2 += __builtin_amdgcn_cvt_scalef32_pk_f32_fp4(B.u[j][q], 1.0f, 1) * h2[4 * q + 1];
          s2 += __builtin_amdgcn_cvt_scalef32_pk_f32_fp4(B.u[j][q], 1.0f, 2) * h2[4 * q + 2];
          s2 += __builtin_amdgcn_cvt_scalef32_pk_f32_fp4(B.u[j][q], 1.0f, 3) * h2[4 * q + 3];
        }
        part[j] = s2.x + s2.y;
      }
      const bool b5 = lane & 32, b4 = lane & 16, b3 = lane & 8, b2 = lane & 4;
      float y[8], z[4], a2[2], t;
#pragma unroll
      for (int i = 0; i < 8; ++i) {
        float send = b5 ? part[i] : part[i + 8];
        float keep = b5 ? part[i + 8] : part[i];
        y[i] = keep + __shfl_xor(send, 32);
      }
#pragma unroll
      for (int i = 0; i < 4; ++i) {
        float send = b4 ? y[i] : y[i + 4];
        float keep = b4 ? y[i + 4] : y[i];
        z[i] = keep + __shfl_xor(send, 16);
      }
#pragma unroll
      for (int i = 0; i < 2; ++i) {
        float send = b3 ? z[i] : z[i + 2];
        float keep = b3 ? z[i + 2] : z[i];
        a2[i] = keep + __shfl_xor(send, 8);
      }
      {
        float send = b2 ? a2[0] : a2[1];
        float keep = b2 ? a2[1] : a2[0];
        t = keep + __shfl_xor(send, 4);
      }
      t += __shfl_xor(t, 2);
      t += __shfl_xor(t, 1);
      const float wl = geluf_(t * B.su) * B.gw * B.sv;
#pragma unroll
      for (int j = 0; j < 16; ++j) {
        const int src_lane = ((j >> 3) & 1) * 32 + ((j >> 2) & 1) * 16 + ((j >> 1) & 1) * 8 + (j & 1) * 4;
        const float wj = __builtin_bit_cast(float, __builtin_amdgcn_readlane(__builtin_bit_cast(int, wl), src_lane));
        const f32x2 w2 = f32x2{wj, wj};
#pragma unroll
        for (int q = 0; q < 2; ++q) {
          acc[4 * q] += w2 * __builtin_amdgcn_cvt_scalef32_pk_f32_fp4(B.v[j][q], 1.0f, 0);
          acc[4 * q + 1] += w2 * __builtin_amdgcn_cvt_scalef32_pk_f32_fp4(B.v[j][q], 1.0f, 1);
          acc[4 * q + 2] += w2 * __builtin_amdgcn_cvt_scalef32_pk_f32_fp4(B.v[j][q], 1.0f, 2);
          acc[4 * q + 3] += w2 * __builtin_amdgcn_cvt_scalef32_pk_f32_fp4(B.v[j][q], 1.0f, 3);
        }
      }
    };
    GBuf B0, B1;
    gload(B0, 0);
#pragma unroll 1
    for (int kb = 0; kb < 8; kb += 2) {
      gload(B1, kb + 1);
      compute(B0);
      if (kb + 2 < 8) gload(B0, kb + 2);
      compute(B1);
    }
    if (dry && acc[0].x != 12345.678f) continue;
    float* xr = res_row(p, r) + lane * 16;
    const float* g5 = mod_ptr(p, layer, r, 5) + lane * 16;
    float4 xn[4];
    float ss = 0.f;
#pragma unroll
    for (int q = 0; q < 4; ++q) {
      float4 x0 = ((float4*)xr)[q];
      float4 m0 = ((const float4*)g5)[q];
      x0.x += m0.x * acc[2 * q].x; x0.y += m0.y * acc[2 * q].y; x0.z += m0.z * acc[2 * q + 1].x; x0.w += m0.w * acc[2 * q + 1].y;
      xn[q] = x0;
      ss += x0.x * x0.x + x0.y * x0.y + x0.z * x0.z + x0.w * x0.w;
    }
    ss = wave_sum(ss);
    const float rs = rsqrtf(ss * (1.0f / 1024.0f) + EPSN);
    if (layer == 0) {
      const float* gg = p.norm1_g + 1024 + lane * 16;
      const float* sh = mod_ptr(p, 1, r, 0) + lane * 16;
      const float* sc = mod_ptr(p, 1, r, 1) + lane * 16;
      unsigned hw[8];
#pragma unroll
      for (int q = 0; q < 4; ++q) {
        ((float4*)xr)[q] = xn[q];
        float4 g4 = ((const float4*)gg)[q], s4 = ((const float4*)sh)[q], c4 = ((const float4*)sc)[q];
        float o0 = xn[q].x * rs * g4.x * (1.f + c4.x) + s4.x;
        float o1 = xn[q].y * rs * g4.y * (1.f + c4.y) + s4.y;
        float o2 = xn[q].z * rs * g4.z * (1.f + c4.z) + s4.z;
        float o3 = xn[q].w * rs * g4.w * (1.f + c4.w) + s4.w;
        hw[2 * q] = cvtpk(o0, o1); hw[2 * q + 1] = cvtpk(o2, o3);
      }
      u32x4 w0 = {hw[0], hw[1], hw[2], hw[3]}, w1 = {hw[4], hw[5], hw[6], hw[7]};
      bf16* hd = (bf16*)(p.ws + OFF_ACTA) + (size_t)r * DM + lane * 16;
      *(u32x4*)hd = w0;
      *(u32x4*)(hd + 8) = w1;
    } else {
      const float* gg = p.final_g + lane * 16;
#pragma unroll
      for (int q = 0; q < 4; ++q) {
        float4 g4 = ((const float4*)gg)[q];
        float4 o;
        o.x = xn[q].x * rs * g4.x; o.y = xn[q].y * rs * g4.y; o.z = xn[q].z * rs * g4.z; o.w = xn[q].w * rs * g4.w;
        ((float4*)xr)[q] = o;
      }
    }
  }
}

DI void phase_inproj1(const Params& p, char* smem) {
  bf16* As = (bf16*)smem; bf16* Bs = As + 256 * GLS;
  const bf16* A = (const bf16*)(p.ws + OFF_ACTA);
  const bf16* Wt = (const bf16*)(p.ws + OFF_WT_ODIN);
  bf16* pm = (bf16*)(p.ws + OFF_PA1M);
  bf16* pu = (bf16*)(p.ws + OFF_U1);
  const int ntn = 10, ntm = NTOK / 256;
  for (int t = blockIdx.x; t < ntn * ntm; t += gridDim.x) {
    const int mt = t / ntn, nt = t % ntn;
    f32x16 acc[4][2];
    gemm_256x128(A + (size_t)mt * 256 * DM, DM, Wt + (size_t)nt * 128 * DM, DM, DM, acc, As, Bs);
    gemm_epi2(acc, [&](int row, int col, float v) {
      int r = mt * 256 + row, cg_ = nt * 128 + col;
      if (cg_ < 672) pm[(size_t)r * 672 + cg_] = f2bf(v);
      else if (cg_ < 1184) pu[(size_t)r * 512 + (cg_ - 672)] = f2bf(v);
    });
  }
}

DI void phase_mla_prep(const Params& p) {
  const int lane = get_tid() & 63, w = get_tid() >> 6;
  const bf16* pm = (const bf16*)(p.ws + OFF_PA1M);
  bf16* qn = (bf16*)(p.ws + OFF_QN);
  bf16* kvn = (bf16*)(p.ws + OFF_KVN);
  bf16* k1 = (bf16*)(p.ws + OFF_K1);
  const float inv = __powf(10000.f, -(float)(lane & 7) / 8.f);
  for (int r = blockIdx.x * 4 + w; r < NTOK; r += gridDim.x * 4) {
    const bf16* row = pm + (size_t)r * 672;
    if (r < NLAT) {
      float v[6]; float ss = 0.f;
#pragma unroll
      for (int i = 0; i < 6; ++i) { v[i] = bf2f(row[i * 64 + lane]); ss += v[i] * v[i]; }
      ss = wave_sum(ss);
      const float rs = rsqrtf(ss * (1.f / 384.f) + EPSN);
#pragma unroll
      for (int i = 0; i < 6; ++i) qn[(size_t)r * 384 + i * 64 + lane] = f2bf(v[i] * rs * p.mla_qa_g[i * 64 + lane]);
    }
    {
      float v[4]; float ss = 0.f;
#pragma unroll
      for (int i = 0; i < 4; ++i) { v[i] = bf2f(row[384 + i * 64 + lane]); ss += v[i] * v[i]; }
      ss = wave_sum(ss);
      const float rs = rsqrtf(ss * (1.f / 256.f) + EPSN);
#pragma unroll
      for (int i = 0; i < 4; ++i) kvn[(size_t)r * 256 + i * 64 + lane] = f2bf(v[i] * rs * p.mla_kva_g[i * 64 + lane]);
    }
    {
      const int cl = lane & 31;
      float y = bf2f(row[640 + cl]);
      float sn = 0.f, cs = 1.f;
      if (r < NLAT) {
        int t = r & 8191;
        float pos = (cl < 16) ? (float)(t >> 6) : (float)(t & 63);
        sincosf(pos * inv, &sn, &cs);
      }
      float pr = __shfl_xor(y, 8);
      float o = y * cs + ((cl & 8) ? pr * sn : -pr * sn);
      bf16 ob = f2bf(o);
      {
        const float ob_f = bf2f(ob);
        const float sq = wave_sum(lane < 32 ? ob_f * ob_f : 0.f);
        if (lane == 0) ((float*)(p.ws + OFF_KRSQ))[r] = sq;
      }
      const int hb = (lane >> 5) * 4;
#pragma unroll
      for (int hh = 0; hh < 4; ++hh) k1[(size_t)r * 768 + (hb + hh) * 96 + 64 + cl] = ob;
    }
  }
}

DI void phase_mla_up(const Params& p, char* smem) {
  bf16* As = (bf16*)smem; bf16* Bs = As + 128 * GLS;
  const bf16* qn = (const bf16*)(p.ws + OFF_QN);
  const bf16* kvn = (const bf16*)(p.ws + OFF_KVN);
  const bf16* wq = (const bf16*)(p.ws + OFF_WT_QUP);
  const bf16* wkv = (const bf16*)(p.ws + OFF_WT_KVUP);
  bf16* q1 = (bf16*)(p.ws + OFF_Q1);
  bf16* k1 = (bf16*)(p.ws + OFF_K1);
  bf16* vt1 = (bf16*)(p.ws + OFF_VT1);
  const float2* rtab = (const float2*)(p.ws + OFF_ROPE1);
  const int lane = get_tid() & 63, w = get_tid() >> 6;
  const int wm = w >> 1, wn = w & 1;
  const int nq = (NLAT / 128) * 6, nkv = (NTOK / 128) * 8;
  for (int t = blockIdx.x; t < nq + nkv; t += gridDim.x) {
    f32x16 acc[2][2];
    if (t < nq) {
      const int mt = t / 6, nt = t % 6;
      gemm_128x128(qn + (size_t)mt * 128 * 384, 384, wq + (size_t)nt * 128 * 384, 384, 384, acc, As, Bs);
#pragma unroll
      for (int mi = 0; mi < 2; ++mi)
#pragma unroll
        for (int ni = 0; ni < 2; ++ni) {
          const int colbase = nt * 128 + wn * 64 + ni * 32;
          const bool rope = (colbase % 96) == 64;
          const int cl = lane & 31;
#pragma unroll
          for (int r = 0; r < 16; ++r) {
            const int row = mt * 128 + wm * 64 + mi * 32 + crow(r, lane);
            float v = acc[mi][ni][r];
            float pr = __shfl_xor(v, 8);
            if (rope) {
              int tt = row & 8191;
              float2 csn = rtab[tt * 16 + ((cl >> 4) << 3) + (cl & 7)];
              v = v * csn.x + ((cl & 8) ? pr * csn.y : -pr * csn.y);
            }
            q1[(size_t)row * 768 + colbase + cl] = f2bf(v * (0.10206207261596577f * 1.4426950408889634f));
          }
        }
    } else {
      const int t2 = t - nq;
      const int mt = t2 >> 3, h = t2 & 7;
      gemm_128x128(kvn + (size_t)mt * 128 * 256, 256, wkv + (size_t)h * 128 * 256, 256, 256, acc, As, Bs);
      const int r0 = mt * 128;
      int b, s0;
      if (r0 < NLAT) { b = r0 >> 13; s0 = CTXL + (r0 & 8191); } else { int rc = r0 - NLAT; b = rc >> 8; s0 = rc & 255; }
#pragma unroll
      for (int mi = 0; mi < 2; ++mi)
#pragma unroll
        for (int ni = 0; ni < 2; ++ni) {
          const int cl = ni * 32 + (lane & 31);
          if (wn == 0) {
#pragma unroll
            for (int r = 0; r < 16; ++r) {
              const int row = r0 + wm * 64 + mi * 32 + crow(r, lane);
              k1[(size_t)row * 768 + h * 96 + cl] = f2bf(acc[mi][ni][r]);
            }
            if (ni == 1) {
              float mxk = 0.f;
#pragma unroll
              for (int r = 0; r < 16; ++r) {
                float sq = acc[mi][0][r] * acc[mi][0][r] + acc[mi][1][r] * acc[mi][1][r];
                sq += __shfl_xor(sq, 16); sq += __shfl_xor(sq, 8); sq += __shfl_xor(sq, 4); sq += __shfl_xor(sq, 2); sq += __shfl_xor(sq, 1);
                const int row = r0 + wm * 64 + mi * 32 + crow(r, lane);
                sq += ((const float*)(p.ws + OFF_KRSQ))[row];
                mxk = fmaxf(mxk, sq);
              }
              mxk = wave_max(mxk);
              if (lane == 0) atomicMax((unsigned*)(p.ws + OFF_KMAX) + b * 8 + h, __float_as_uint(sqrtf(mxk) * 1.02f));
            }
          } else {
            bf16* vrow = vt1 + (size_t)((b * 8 + h) * 64 + cl) * SKEYS + s0 + wm * 64 + mi * 32;
#pragma unroll
            for (int g4 = 0; g4 < 4; ++g4) {
              u32x2 o;
              o.x = cvtpk(acc[mi][ni][4 * g4], acc[mi][ni][4 * g4 + 1]);
              o.y = cvtpk(acc[mi][ni][4 * g4 + 2], acc[mi][ni][4 * g4 + 3]);
              *(u32x2*)(vrow + 8 * g4 + 4 * (lane >> 5)) = o;
            }
          }
        }
    }
  }
}

DI void s5_item(const Params& p, int item, char* smem) {
  const int dir = item & 1, g = (item >> 1) & 31, b = item >> 6;
  constexpr int ULS = 264, SLS = 136;
  bf16* Uc = (bf16*)smem;
  bf16* Sp = Uc + 32 * ULS;
  float* E = (float*)(Sp + 32 * SLS);
  const int mi_ = g * 2 + dir;
  const bf16* T = (const bf16*)(p.ws + OFF_S5T) + (size_t)mi_ * 65536;
  const bf16* WE = (const bf16*)(p.ws + OFF_S5WE) + (size_t)mi_ * 32768;
  const bf16* WY = (const bf16*)(p.ws + OFF_S5WY) + (size_t)mi_ * 32768;
  const float* A16 = (const float*)(p.ws + OFF_S5A16) + (size_t)mi_ * 128;
  const bf16* U1 = (const bf16*)(p.ws + OFF_U1);
  bf16* ys = (bf16*)(p.ws + OFF_YS5) + (size_t)dir * NLAT * 512;
  const int tid = get_tid(), lane = tid & 63, w = tid >> 6;
  auto rowof = [&](int pos) -> int {
    if (pos < CTXL) { int s = dir ? (CTXL - 1 - pos) : pos; return NLAT + b * CTXL + s; }
    int t = pos - CTXL; t = dir ? (SEQ - 1 - t) : t; return b * SEQ + t;
  };
  float sre = 0.f, sim = 0.f;
  const float a16r = A16[(lane & 63) * 2], a16i = A16[(lane & 63) * 2 + 1];
  for (int sc = 0; sc < 17; ++sc) {
    const int nvalid = (528 - sc * 32) < 32 ? (528 - sc * 32) : 32;
    __syncthreads();
    {
      const int n = tid >> 3, j0 = (tid & 7) * 2;
#pragma unroll
      for (int jj = 0; jj < 2; ++jj) {
        u32x4 a = {0u, 0u, 0u, 0u}, b2 = {0u, 0u, 0u, 0u};
        if (n < nvalid) {
          const int pos = (sc * 32 + n) * 16 + j0 + jj;
          const bf16* src = U1 + (size_t)rowof(pos) * 512 + g * 16;
          a = *(const u32x4*)src; b2 = *(const u32x4*)(src + 8);
        }
        *(u32x4*)(Uc + n * ULS + (j0 + jj) * 16) = a;
        *(u32x4*)(Uc + n * ULS + (j0 + jj) * 16 + 8) = b2;
      }
    }
    __syncthreads();
    f32x16 e, y0, y1;
#pragma unroll
    for (int r = 0; r < 16; ++r) { e[r] = 0.f; y0[r] = 0.f; y1[r] = 0.f; }
    mma_tile_ga<256>(e, WE + (size_t)(w * 32) * 256, 256, Uc, ULS);
#pragma unroll
    for (int r = 0; r < 16; ++r) E[(w * 32 + crow(r, lane)) * 33 + (lane & 31)] = e[r];
    mma_tile_ga<256>(y0, T + (size_t)(2 * w * 32) * 256, 256, Uc, ULS);
    mma_tile_ga<256>(y1, T + (size_t)((2 * w + 1) * 32) * 256, 256, Uc, ULS);
    __syncthreads();
    if (w == 0) {
      for (int n = 0; n < 32; ++n) {
        Sp[n * SLS + lane] = f2bf(sre);
        Sp[n * SLS + 64 + lane] = f2bf(sim);
        float er = E[lane * 33 + n], ei = E[(64 + lane) * 33 + n];
        float nr = a16r * sre - a16i * sim + er;
        float ni = a16r * sim + a16i * sre + ei;
        sre = nr; sim = ni;
      }
    }
    __syncthreads();
    mma_tile_ga<128>(y0, WY + (size_t)(2 * w * 32) * 128, 128, Sp, SLS);
    mma_tile_ga<128>(y1, WY + (size_t)((2 * w + 1) * 32) * 128, 128, Sp, SLS);
    {
      const int n = lane & 31;
      if (n < nvalid) {
        const int cgi = sc * 32 + n;
#pragma unroll
        for (int tI = 0; tI < 2; ++tI) {
          const f32x16& y = tI ? y1 : y0;
#pragma unroll
          for (int g4 = 0; g4 < 4; ++g4) {
            const int m = (2 * w + tI) * 32 + 8 * g4 + 4 * (lane >> 5);
            const int i = m >> 4, c0 = m & 15;
            const int pos = cgi * 16 + i;
            if (pos >= CTXL) {
              u32x2 o;
              o.x = cvtpk(y[4 * g4], y[4 * g4 + 1]);
              o.y = cvtpk(y[4 * g4 + 2], y[4 * g4 + 3]);
              *(u32x2*)(ys + (size_t)rowof(pos) * 512 + g * 16 + c0) = o;
            }
          }
        }
      }
    }
  }
}

DI void phase_mix1(const Params& p, char* smem, int cidx) {
  __shared__ int s_item1;
  if (cidx == 1 && blockIdx.x < 256) s5_item(p, blockIdx.x, smem);
  unsigned* cnt = (unsigned*)(p.ws + OFF_CNT) + cidx;
  const bf16* q1 = (const bf16*)(p.ws + OFF_Q1);
  const bf16* k1 = (const bf16*)(p.ws + OFF_K1);
  const bf16* vt = (const bf16*)(p.ws + OFF_VT1);
  bf16* ycat = (bf16*)(p.ws + OFF_ACTA);
  const int n_lat = 4 * 8 * 32;
  while (true) {
    __syncthreads();
    if (get_tid() == 0) s_item1 = (int)atomicAdd(cnt, 1u);
    __syncthreads();
    const int it = s_item1;
    if (it >= n_lat) break;
    const int qt = it & 31, h = (it >> 5) & 7, b = it >> 8;
    const int r0 = b * SEQ + qt * 256;
    attn_item<96, 2>(q1 + (size_t)r0 * 768 + h * 96, 768, k1 + (size_t)(NLAT + b * CTXL) * 768 + h * 96,
                  k1 + (size_t)(b * SEQ) * 768 + h * 96, 768, vt + (size_t)((b * 8 + h) * 64) * SKEYS, SKEYS,
                  ycat + (size_t)r0 * DM + h * 64, DM, 0.10206207261596577f, smem, ((const float*)(p.ws + OFF_KMAX))[b * 8 + h]);
  }
}

DI void phase_s5_z(const Params& p) {
  const bf16* U1 = (const bf16*)(p.ws + OFF_U1);
  const bf16* y0 = (const bf16*)(p.ws + OFF_YS5);
  const bf16* y1 = y0 + (size_t)NLAT * 512;
  bf16* z = (bf16*)(p.ws + OFF_Z1);
  const size_t nv = (size_t)NLAT * 512 / 8;
  for (size_t i = (size_t)blockIdx.x * 256 + get_tid(); i < nv; i += (size_t)gridDim.x * 256) {
    const int col = (int)(i & 63) * 8;
    u32x4 u = ((const u32x4*)U1)[i], a = ((const u32x4*)y0)[i], b2 = ((const u32x4*)y1)[i];
    float fu[8], fa[8], fb[8], o[8];
    f32x16 dummy; (void)dummy;
    fu[0] = bflo(u.x); fu[1] = bfhi(u.x); fu[2] = bflo(u.y); fu[3] = bfhi(u.y); fu[4] = bflo(u.z); fu[5] = bfhi(u.z); fu[6] = bflo(u.w); fu[7] = bfhi(u.w);
    fa[0] = bflo(a.x); fa[1] = bfhi(a.x); fa[2] = bflo(a.y); fa[3] = bfhi(a.y); fa[4] = bflo(a.z); fa[5] = bfhi(a.z); fa[6] = bflo(a.w); fa[7] = bfhi(a.w);
    fb[0] = bflo(b2.x); fb[1] = bfhi(b2.x); fb[2] = bflo(b2.y); fb[3] = bfhi(b2.y); fb[4] = bflo(b2.z); fb[5] = bfhi(b2.z); fb[6] = bflo(b2.w); fb[7] = bfhi(b2.w);
#pragma unroll
    for (int j = 0; j < 8; ++j) o[j] = geluf_(p.s5_d[col + j] * fu[j] + fa[j] + fb[j]);
    u32x4 ov;
    ov.x = cvtpk(o[0], o[1]); ov.y = cvtpk(o[2], o[3]); ov.z = cvtpk(o[4], o[5]); ov.w = cvtpk(o[6], o[7]);
    ((u32x4*)z)[i] = ov;
  }
}

DI void phase_glu(const Params& p, char* smem) {
  bf16* As = (bf16*)smem; bf16* Bs = As + 256 * GLS;
  const bf16* z = (const bf16*)(p.ws + OFF_Z1);
  const bf16* Wt = (const bf16*)(p.ws + OFF_WT_GLU);
  bf16* ycat = (bf16*)(p.ws + OFF_ACTA);
  const int ntn = 4, ntm = NLAT / 256;
  for (int t = blockIdx.x; t < ntn * ntm; t += gridDim.x) {
    const int mt = t / ntn, nt = t % ntn;
    f32x16 acc[4][2];
    gemm_256x128(z + (size_t)mt * 256 * 512, 512, Wt + (size_t)nt * 128 * 512, 512, 512, acc, As, Bs);
    gemm_epi2(acc, [&](int row, int col, float v) {
      int r = mt * 256 + row, cc = nt * 128 + col;
      float zz = bf2f(z[(size_t)r * 512 + cc]);
      ycat[(size_t)r * DM + 512 + cc] = f2bf(zz * sigmoidf_(v + p.s5_b_glu[cc]));
    });
  }
}

DI void phase_final(const Params& p) {
  const int lane = get_tid() & 63, w = get_tid() >> 6;
  for (int r = blockIdx.x * 4 + w; r < NLAT; r += gridDim.x * 4) {
    float* row = p.out + (size_t)r * DM;
    float4 v[4];
    float ss = 0.f;
#pragma unroll
    for (int i = 0; i < 4; ++i) {
      v[i] = ((const float4*)row)[i * 64 + lane];
      ss += v[i].x * v[i].x + v[i].y * v[i].y + v[i].z * v[i].z + v[i].w * v[i].w;
    }
    ss = wave_sum(ss);
    const float rs = rsqrtf(ss * (1.0f / 1024.0f) + EPSN);
#pragma unroll
    for (int i = 0; i < 4; ++i) {
      float4 gg = ((const float4*)p.final_g)[i * 64 + lane];
      float4 o;
      o.x = v[i].x * rs * gg.x; o.y = v[i].y * rs * gg.y; o.z = v[i].z * rs * gg.z; o.w = v[i].w * rs * gg.w;
      ((float4*)row)[i * 64 + lane] = o;
    }
  }
}

DI void phase_copy_x(const Params& p) {
  const size_t n4 = (size_t)NLAT * DM / 4;
  for (size_t i = (size_t)blockIdx.x * 256 + get_tid(); i < n4; i += (size_t)gridDim.x * 256)
    ((float4*)p.out)[i] = ((const float4*)p.x)[i];
}

#define XB_TMO      128
#define XB_XCNT(j)  (256  + 64 * (j))
#define XB_XSUB(j)  (1280 + 64 * (j))
#define XB_XGEN(j)  (2304 + 64 * (j))
#define XB_TOP      3328
#define XB_TOPGEN   3392
#define XCD_BAR_WORDS 3456
#define XB_SPIN_CAP (1u << 22)
#define LAS __attribute__((address_space(3)))

__device__ __forceinline__ unsigned xb_ld(unsigned* p)              { return __hip_atomic_load(p, __ATOMIC_RELAXED, __HIP_MEMORY_SCOPE_AGENT); }
__device__ __forceinline__ unsigned xb_add(unsigned* p, unsigned v) { return __hip_atomic_fetch_add(p, v, __ATOMIC_RELAXED, __HIP_MEMORY_SCOPE_AGENT); }
__device__ __forceinline__ unsigned xb_xcc_id() { return (unsigned)__builtin_amdgcn_s_getreg((3 << 11) | 20) & 0xFu; }
#define XB_SPIN(cond, bar) do { unsigned _sp = 0; while (cond) { __builtin_amdgcn_s_sleep(1); \
    if ((++_sp & 255u) == 0u) { if (xb_ld(&(bar)[XB_TMO])) break; if (_sp > XB_SPIN_CAP) { atomicAdd(&(bar)[XB_TMO], 1u); break; } } } } while (0)

struct XcdBarrier {
    unsigned* bar; unsigned x;
    volatile LAS unsigned* st;
};

__device__ __forceinline__ XcdBarrier xcd_barrier_post(unsigned* bar, volatile LAS unsigned* st) {
    XcdBarrier b; b.bar = bar; b.x = xb_xcc_id(); b.st = st;
    if (threadIdx.x == 0) (void)xb_add(&bar[XB_XCNT(b.x)], 1u);
    return b;
}
__device__ __forceinline__ void xcd_barrier_complete(unsigned* bar, unsigned x, unsigned& nloc, unsigned& nx) {
    const unsigned G = gridDim.x * gridDim.y * gridDim.z;
    unsigned sum, cnt, mine, sp = 0u;
    for (;;) {
        sum = 0u; cnt = 0u; mine = 0u;
#pragma unroll
        for (unsigned j = 0; j < 16; ++j) { const unsigned c = xb_ld(&bar[XB_XCNT(j)]); sum += c; cnt += (c > 0u) ? 1u : 0u; mine = (j == x) ? c : mine; }
        if (sum == G) break;
        __builtin_amdgcn_s_sleep(1);
        if ((++sp & 255u) == 0u) { if (xb_ld(&bar[XB_TMO])) break; if (sp > XB_SPIN_CAP) { atomicAdd(&bar[XB_TMO], 1u); break; } }
    }
    nloc = mine > 0u ? mine : 1u; nx = cnt > 0u ? cnt : 1u;
}

__device__ __forceinline__ void xcd_barrier(const XcdBarrier& b) {
    asm volatile("s_waitcnt vmcnt(0)" ::: "memory");
    __syncthreads();
    if (threadIdx.x == 0) {
        unsigned* bar = b.bar;
        __builtin_amdgcn_s_waitcnt(0);
        unsigned nloc = b.st[0], nx = b.st[1];
        if (nloc == 0u) { xcd_barrier_complete(bar, b.x, nloc, nx); b.st[0] = nloc; b.st[1] = nx; }
        const unsigned old = xb_add(&bar[XB_XSUB(b.x)], 1u);
        const unsigned gen = old / nloc;
        if (old + 1u == (gen + 1u) * nloc) {
            __builtin_amdgcn_fence(__ATOMIC_RELEASE, "agent");
            asm volatile("s_waitcnt vmcnt(0)" ::: "memory");
            const unsigned og = xb_add(&bar[XB_TOP], 1u);
            const unsigned tg = og / nx;
            if (og + 1u == (tg + 1u) * nx) xb_add(&bar[XB_TOPGEN], 1u);
            else XB_SPIN(xb_ld(&bar[XB_TOPGEN]) == tg, bar);
            __builtin_amdgcn_fence(__ATOMIC_ACQUIRE, "agent");
            xb_add(&bar[XB_XGEN(b.x)], 1u);
            asm volatile("s_waitcnt vmcnt(0)" ::: "memory");
        } else {
            XB_SPIN(xb_ld(&bar[XB_XGEN(b.x)]) == gen, bar);
            __builtin_amdgcn_fence(__ATOMIC_ACQUIRE, "agent");
            asm volatile("s_waitcnt vmcnt(0)" ::: "memory");
        }
    }
    __syncthreads();
}
__device__ __forceinline__ void xcd_barrier_fast(const XcdBarrier& b) {
    asm volatile("s_waitcnt vmcnt(0)" ::: "memory");
    __syncthreads();
    if (threadIdx.x == 0) {
        unsigned* bar = b.bar;
        __builtin_amdgcn_s_waitcnt(0);
        unsigned nloc = b.st[0], nx = b.st[1];
        const unsigned old = xb_add(&bar[XB_XSUB(b.x)], 1u);
        const unsigned gen = old / nloc;
        if (old + 1u == (gen + 1u) * nloc) {
            __builtin_amdgcn_fence(__ATOMIC_RELEASE, "agent");
            asm volatile("s_waitcnt vmcnt(0)" ::: "memory");
            const unsigned og = xb_add(&bar[XB_TOP], 1u);
            const unsigned tg = og / nx;
            if (og + 1u == (tg + 1u) * nx) xb_add(&bar[XB_TOPGEN], 1u);
            else XB_SPIN(xb_ld(&bar[XB_TOPGEN]) == tg, bar);
            __builtin_amdgcn_fence(__ATOMIC_ACQUIRE, "agent");
            xb_add(&bar[XB_XGEN(b.x)], 1u);
            asm volatile("s_waitcnt vmcnt(0)" ::: "memory");
        } else {
            XB_SPIN(xb_ld(&bar[XB_XGEN(b.x)]) == gen, bar);
            __builtin_amdgcn_fence(__ATOMIC_ACQUIRE, "agent");
            asm volatile("s_waitcnt vmcnt(0)" ::: "memory");
        }
    }
    __syncthreads();
}


DI void gsync(cg::grid_group& grid) {
  asm volatile("s_waitcnt vmcnt(0) lgkmcnt(0)" ::: "memory");
  __syncthreads();
  if (threadIdx.x == 0) {
    __builtin_amdgcn_fence(__ATOMIC_RELEASE, "agent");
    asm volatile("s_waitcnt vmcnt(0)" ::: "memory");
  }
  grid.sync();
  if (threadIdx.x == 0) {
    __builtin_amdgcn_fence(__ATOMIC_ACQUIRE, "agent");
    asm volatile("s_waitcnt vmcnt(0)" ::: "memory");
  }
  __syncthreads();
}

DI Params load_params() {
  Params r{};
#if defined(__HIP_DEVICE_COMPILE__)
  const __attribute__((address_space(4))) unsigned long long* q =
      (const __attribute__((address_space(4))) unsigned long long*)__builtin_amdgcn_kernarg_segment_ptr();
  asm volatile("" : "+s"(q));
  unsigned long long* d = (unsigned long long*)&r;
  static_assert(sizeof(Params) % 8 == 0, "Params size");
#pragma unroll
  for (int i = 0; i < (int)(sizeof(Params) / 8); ++i) d[i] = q[i];
#endif
  return r;
}
#define P_ p
__global__ void __launch_bounds__(256, 2) fwd_megakernel(Params p) {
  cg::grid_group grid = cg::this_grid();
  __shared__ __attribute__((aligned(16))) char smem[SMEM_BYTES];
  __shared__ uint4 xb_words;
  if (threadIdx.x == 0) xb_words = make_uint4(0u, 0u, 0u, 0u);
  __syncthreads();
  XcdBarrier xb;
  { const Params lp = P_; xb = xcd_barrier_post((unsigned*)(lp.ws + OFF_BAR), (volatile LAS unsigned*)&xb_words); }
  { const Params lp = P_; phase_prep(lp, smem); }
  xcd_barrier(xb);
  { const Params lp = P_; phase_norm(lp, 0, true, lp.norm1_g, 0, NTOK); }
  xcd_barrier_fast(xb);
  { const Params lp = P_; phase_inproj0(lp, smem); }
  xcd_barrier_fast(xb);
  { const Params lp = P_; phase_gqa_prep(lp, smem); }
  xcd_barrier_fast(xb);
  { const Params lp = P_; phase_mix0(lp, smem, 0); }
  xcd_barrier_fast(xb);
  { const Params lp = P_; phase_hg_readout(lp); }
  xcd_barrier_fast(xb);
  { const Params lp = P_; phase_outproj(lp, 0, OFF_WT_EVOUT, NTOK, true, smem); }
  xcd_barrier_fast(xb);
#if STAGE_LIMIT >= 2
  { const Params lp = P_; phase_norm(lp, 0, false, lp.norm2_g, 3, NTOK); }
  { const Params lp = P_; phase_convert_tables(lp, 0); }
  xcd_barrier_fast(xb);
  { const Params lp = P_; phase_peer_route(lp, 0, NTOK, smem); }
  xcd_barrier_fast(xb);
  { const Params lp = P_; phase_peer_gather(lp, 0, NTOK, false); }
  xcd_barrier_fast(xb);
#endif
#if STAGE_LIMIT >= 3
  { const Params lp = P_; phase_inproj1(lp, smem); }
  xcd_barrier_fast(xb);
  { const Params lp = P_; phase_mla_prep(lp); }
  xcd_barrier_fast(xb);
  { const Params lp = P_; phase_mla_up(lp, smem); }
  xcd_barrier_fast(xb);
  { const Params lp = P_; phase_mix1(lp, smem, 1); }
  xcd_barrier_fast(xb);
  { const Params lp = P_; phase_s5_z(lp); }
  xcd_barrier_fast(xb);
  { const Params lp = P_; phase_glu(lp, smem); }
  xcd_barrier_fast(xb);
  { const Params lp = P_; phase_outproj1(lp, smem); }
  xcd_barrier_fast(xb);
#endif
#if STAGE_LIMIT >= 4
  { const Params lp = P_; phase_norm(lp, 1, false, lp.norm2_g + 1024, 3, NLAT); }
  { const Params lp = P_; phase_convert_tables(lp, 1); }
  xcd_barrier_fast(xb);
  { const Params lp = P_; phase_peer_route(lp, 1, NLAT, smem); }
  xcd_barrier_fast(xb);
  { const Params lp = P_; phase_peer_gather(lp, 1, NLAT, false); }
#endif
}

extern "C" void kernel_launch(void* const* d_in, const int* in_sizes, int n_in, void* d_out, int out_size, void* d_ws,
                              size_t ws_size, hipStream_t stream) {
  static int grid_blocks = 0;
  if (!grid_blocks) {
    int dev = 0, cus = 0, per_cu = 0;
    (void)hipGetDevice(&dev);
    (void)hipDeviceGetAttribute(&cus, hipDeviceAttributeMultiprocessorCount, dev);
    (void)hipOccupancyMaxActiveBlocksPerMultiprocessor(&per_cu, fwd_megakernel, 256, 0);
    if (per_cu > 2) per_cu = 2;
    if (per_cu < 1) per_cu = 1;
    grid_blocks = cus * per_cu;
  }
  Params p{};
  const float** pp = (const float**)&p;
  for (int i = 0; i < 35; ++i) pp[i] = (const float*)d_in[i];
  p.out = (float*)d_out;
  p.ws = (char*)d_ws;
  p.rep_mix = REP_MIX; p.rep_route = REP_ROUTE; p.rep_gdry = REP_GDRY; p.rep_gemm = REP_GEMM;
  (void)hipMemsetAsync((char*)d_ws + OFF_CNT, 0, 256 + 16384, stream);
  void* args[] = {&p};
  hipError_t e = hipLaunchCooperativeKernel((void*)fwd_megakernel, dim3(grid_blocks), dim3(256), args, 0, stream);
  if (e != hipSuccess) fprintf(stderr, "cooperative launch failed: %s (grid %d)\n", hipGetErrorString(e), grid_blocks);
}
```

```cpp
#include <hip/hip_runtime.h>
#include <hip/hip_cooperative_groups.h>
#include <cstdio>
namespace cg = cooperative_groups;

#ifndef STAGE_LIMIT
#define STAGE_LIMIT 99
#endif
#define REP_MIX 1
#define REP_ROUTE 1
#define REP_GDRY 0
#define REP_GEMM 1

typedef unsigned short bf16;
typedef __attribute__((ext_vector_type(8))) short bf16x8;
typedef __attribute__((ext_vector_type(4))) short bf16x4;
typedef __attribute__((ext_vector_type(16))) float f32x16;
typedef float f32x2_t __attribute__((ext_vector_type(2)));
typedef unsigned u32x4 __attribute__((ext_vector_type(4)));
typedef unsigned u32x2 __attribute__((ext_vector_type(2)));
typedef __bf16 bf16x2_t __attribute__((ext_vector_type(2)));

#define DI __device__ __forceinline__
#define MFMA32(a, b, c) __builtin_amdgcn_mfma_f32_32x32x16_bf16((a), (b), (c), 0, 0, 0)

constexpr int NLAT = 32768, NCTX = 1024, NTOK = 33792, DM = 1024;
constexpr int SEQ = 8192, CTXL = 256, SKEYS = 8448;
constexpr float EPSN = 1e-6f;

constexpr size_t al256(size_t x) { return (x + 255) & ~(size_t)255; }
constexpr size_t OFF_WT_EVIN = 0;
constexpr size_t OFF_WT_EVOUT = OFF_WT_EVIN + al256((size_t)3328 * 1024 * 2);
constexpr size_t OFF_WT_ODIN = OFF_WT_EVOUT + al256((size_t)1024 * 1024 * 2);
constexpr size_t OFF_WT_ODOUT = OFF_WT_ODIN + al256((size_t)1280 * 1024 * 2);
constexpr size_t OFF_WT_QUP = OFF_WT_ODOUT + al256((size_t)1024 * 1024 * 2);
constexpr size_t OFF_WT_KVUP = OFF_WT_QUP + al256((size_t)768 * 384 * 2);
constexpr size_t OFF_WT_GLU = OFF_WT_KVUP + al256((size_t)1024 * 256 * 2);
constexpr size_t OFF_WT_PWQ = OFF_WT_GLU + al256((size_t)512 * 512 * 2);
constexpr size_t OFF_PKEYS = OFF_WT_PWQ + al256((size_t)2 * 2048 * 1024 * 2);
constexpr size_t OFF_MOD = OFF_PKEYS + al256((size_t)2 * 8 * 2 * 128 * 128 * 2);
constexpr size_t OFF_S5T = OFF_MOD + al256((size_t)2 * 5 * 6144 * 4);
constexpr size_t OFF_S5WE = OFF_S5T + al256((size_t)64 * 256 * 256 * 2);
constexpr size_t OFF_S5WY = OFF_S5WE + al256((size_t)64 * 128 * 256 * 2);
constexpr size_t OFF_S5A16 = OFF_S5WY + al256((size_t)64 * 256 * 128 * 2);
constexpr size_t OFF_CNT = OFF_S5A16 + al256((size_t)64 * 64 * 2 * 4);
constexpr size_t OFF_BAR = OFF_CNT + 256;
constexpr size_t OFF_ROPE1 = OFF_BAR + 16384;
constexpr size_t OFF_SU = OFF_ROPE1 + al256((size_t)8192 * 16 * 8);
constexpr size_t OFF_SV = OFF_SU + 65536;
constexpr size_t OFF_KMAX = OFF_SV + 65536;
constexpr size_t OFF_KRSQ = OFF_KMAX + 256;
constexpr size_t OFF_XC = OFF_KRSQ + al256((size_t)NTOK * 4);
constexpr size_t OFF_UTAB = OFF_XC + al256((size_t)NCTX * DM * 4);
constexpr size_t OFF_VTAB = OFF_UTAB + al256((size_t)16384 * 1024 * 2);
constexpr size_t OFF_ACTA = OFF_VTAB + al256((size_t)16384 * 1024 * 2);
constexpr size_t OFF_BIG = OFF_ACTA + al256((size_t)NTOK * DM * 2);
constexpr size_t OFF_PAGQA = OFF_BIG;
constexpr size_t OFF_VT0 = OFF_PAGQA + al256((size_t)NTOK * 768 * 2);
constexpr size_t OFF_PAHG = OFF_VT0 + al256((size_t)512 * SKEYS * 2);
constexpr size_t OFF_OHG = OFF_PAHG + al256((size_t)NTOK * 2560 * 2);
constexpr size_t OFF_END0 = OFF_OHG + al256((size_t)2 * NTOK * 512 * 2);
constexpr size_t OFF_K1 = OFF_BIG;
constexpr size_t OFF_PA1M = OFF_K1 + al256((size_t)NTOK * 768 * 2);
constexpr size_t OFF_Q1 = OFF_PA1M;
constexpr size_t OFF_U1 = OFF_PA1M + al256((size_t)NTOK * 768 * 2);
constexpr size_t OFF_QN = OFF_U1 + al256((size_t)NTOK * 512 * 2);
constexpr size_t OFF_KVN = OFF_QN + al256((size_t)NLAT * 384 * 2);
constexpr size_t OFF_Z1 = OFF_QN;
constexpr size_t OFF_KROPE = OFF_KVN + al256((size_t)NTOK * 256 * 2);
constexpr size_t OFF_VT1 = OFF_KROPE + al256((size_t)NTOK * 32 * 2);
constexpr size_t OFF_YS5 = OFF_VT1 + al256((size_t)2048 * SKEYS * 2);
constexpr size_t OFF_END1 = OFF_YS5 + al256((size_t)2 * NLAT * 512 * 2);
constexpr size_t OFF_RIDX = OFF_BIG;
constexpr size_t OFF_RGW = OFF_RIDX + al256((size_t)NTOK * 128 * 4);
constexpr size_t WS_NEEDED = (OFF_END0 > OFF_END1 ? OFF_END0 : OFF_END1);
static_assert(OFF_RGW + (size_t)NTOK * 128 * 4 <= OFF_VT0, "route alias overflow");
static_assert((size_t)NLAT * 512 * 2 <= (OFF_KROPE - OFF_QN), "z alias overflow");
static_assert(WS_NEEDED < (size_t)500 * 1024 * 1024, "workspace too large");

constexpr int SMEM_BYTES = 78 * 1024;

struct Params {
  const float *x, *c, *ctx, *c_ctx, *ada_w, *ada_b, *norm1_g, *norm2_g, *ev_w_in, *ev_w_out, *gqa_qn_g, *gqa_kn_g,
      *hg_lb_logits, *hg_onorm_g, *od_w_in, *od_w_out, *mla_qa_g, *mla_w_qup, *mla_kva_g, *mla_w_kvup, *s5_a_re, *s5_a_im,
      *s5_log_dt, *s5_b_re, *s5_b_im, *s5_c_re, *s5_c_im, *s5_d, *s5_w_glu, *s5_b_glu, *peer_wq, *peer_keys, *peer_u,
      *peer_v, *final_g;
  float* out;
  char* ws;
  int rep_mix, rep_route, rep_gdry, rep_gemm;
};

DI int get_tid() { int t = threadIdx.x; asm volatile("" : "+v"(t)); return t; }
DI bf16 f2bf(float x) {
  unsigned u = __float_as_uint(x);
  u += 0x7fffu + ((u >> 16) & 1u);
  return (bf16)(u >> 16);
}
DI float bf2f(bf16 h) { return __uint_as_float(((unsigned)h) << 16); }
DI unsigned cvtpk(float lo, float hi) {
  f32x2_t v = {lo, hi};
  bf16x2_t b = __builtin_convertvector(v, bf16x2_t);
  return __builtin_bit_cast(unsigned, b);
}
DI float bflo(unsigned u) { return __uint_as_float(u << 16); }
DI float bfhi(unsigned u) { return __uint_as_float(u & 0xffff0000u); }
DI float wave_sum(float v) {
#pragma unroll
  for (int o = 32; o > 0; o >>= 1) v += __shfl_xor(v, o);
  return v;
}
DI float wave_max_early(float v) {
#pragma unroll
  for (int o = 32; o > 0; o >>= 1) v = fmaxf(v, __shfl_xor(v, o));
  return v;
}
DI float sigmoidf_(float x) { return 1.0f / (1.0f + __expf(-x)); }
DI float siluf_(float x) { return x * sigmoidf_(x); }
DI float geluf_(float x) { return 0.5f * x * (1.0f + erff(x * 0.70710678118654752f)); }

DI const float* orig_row(const Params& p, int r) {
  return r < NLAT ? p.x + (size_t)r * DM : p.ctx + (size_t)(r - NLAT) * DM;
}
DI float* res_row(const Params& p, int r) {
  return r < NLAT ? p.out + (size_t)r * DM : (float*)(p.ws + OFF_XC) + (size_t)(r - NLAT) * DM;
}
DI int mod_row(int r) { return r < NLAT ? (r >> 13) : 4; }
DI const float* mod_ptr(const Params& p, int layer, int r, int chunk) {
  return (const float*)(p.ws + OFF_MOD) + ((size_t)(layer * 5 + mod_row(r)) * 6 + chunk) * 1024;
}

constexpr int GLS = 72;
DI void gemm_128x128(const bf16* __restrict__ A, int lda, const bf16* __restrict__ Bt, int ldb, int K, f32x16 (&acc)[2][2],
                     bf16* As, bf16* Bs) {
  const int tid = get_tid(), lane = tid & 63, w = tid >> 6;
  const int wm = w >> 1, wn = w & 1;
  const int lr = tid >> 3, lc = (tid & 7) * 8;
  u32x4 ra[4], rb[4];
#pragma unroll
  for (int i = 0; i < 4; ++i) {
    ra[i] = *(const u32x4*)(A + (size_t)(i * 32 + lr) * lda + lc);
    rb[i] = *(const u32x4*)(Bt + (size_t)(i * 32 + lr) * ldb + lc);
  }
#pragma unroll
  for (int i = 0; i < 2; ++i)
#pragma unroll
    for (int j = 0; j < 2; ++j)
#pragma unroll
      for (int r = 0; r < 16; ++r) acc[i][j][r] = 0.f;
  for (int k0 = 0; k0 < K; k0 += 64) {
    __syncthreads();
#pragma unroll
    for (int i = 0; i < 4; ++i) {
      *(u32x4*)(As + (i * 32 + lr) * GLS + lc) = ra[i];
      *(u32x4*)(Bs + (i * 32 + lr) * GLS + lc) = rb[i];
    }
    __syncthreads();
    if (k0 + 64 < K) {
#pragma unroll
      for (int i = 0; i < 4; ++i) {
        ra[i] = *(const u32x4*)(A + (size_t)(i * 32 + lr) * lda + k0 + 64 + lc);
        rb[i] = *(const u32x4*)(Bt + (size_t)(i * 32 + lr) * ldb + k0 + 64 + lc);
      }
    }
#pragma unroll
    for (int ks = 0; ks < 64; ks += 16) {
      const int ko = ks + (lane >> 5) * 8;
      bf16x8 a0 = *(const bf16x8*)(As + (wm * 64 + (lane & 31)) * GLS + ko);
      bf16x8 a1 = *(const bf16x8*)(As + (wm * 64 + 32 + (lane & 31)) * GLS + ko);
      bf16x8 b0 = *(const bf16x8*)(Bs + (wn * 64 + (lane & 31)) * GLS + ko);
      bf16x8 b1 = *(const bf16x8*)(Bs + (wn * 64 + 32 + (lane & 31)) * GLS + ko);
      acc[0][0] = MFMA32(a0, b0, acc[0][0]);
      acc[0][1] = MFMA32(a0, b1, acc[0][1]);
      acc[1][0] = MFMA32(a1, b0, acc[1][0]);
      acc[1][1] = MFMA32(a1, b1, acc[1][1]);
    }
  }
}
template <class F>
DI void gemm_epi(f32x16 (&acc)[2][2], F f) {
  const int lane = get_tid() & 63, w = get_tid() >> 6;
  const int wm = w >> 1, wn = w & 1;
#pragma unroll
  for (int mi = 0; mi < 2; ++mi)
#pragma unroll
    for (int ni = 0; ni < 2; ++ni)
#pragma unroll
      for (int r = 0; r < 16; ++r) {
        int row = wm * 64 + mi * 32 + (r & 3) + 8 * (r >> 2) + 4 * (lane >> 5);
        int col = wn * 64 + ni * 32 + (lane & 31);
        f(row, col, acc[mi][ni][r]);
      }
}

DI void gemm_256x128(const bf16* __restrict__ A, int lda, const bf16* __restrict__ Bt, int ldb, int K, f32x16 (&acc)[4][2],
                     bf16* As, bf16* Bs) {
  const int tid = get_tid(), lane = tid & 63, w = tid >> 6;
  const int wm = w >> 1, wn = w & 1;
  const int lr = tid >> 3, lc = (tid & 7) * 8;
  u32x4 ra[8], rb[4];
#pragma unroll
  for (int i = 0; i < 8; ++i) ra[i] = *(const u32x4*)(A + (size_t)(i * 32 + lr) * lda + lc);
#pragma unroll
  for (int i = 0; i < 4; ++i) rb[i] = *(const u32x4*)(Bt + (size_t)(i * 32 + lr) * ldb + lc);
#pragma unroll
  for (int i = 0; i < 4; ++i)
#pragma unroll
    for (int j = 0; j < 2; ++j)
#pragma unroll
      for (int r = 0; r < 16; ++r) acc[i][j][r] = 0.f;
  for (int k0 = 0; k0 < K; k0 += 64) {
    __syncthreads();
#pragma unroll
    for (int i = 0; i < 8; ++i) *(u32x4*)(As + (i * 32 + lr) * GLS + lc) = ra[i];
#pragma unroll
    for (int i = 0; i < 4; ++i) *(u32x4*)(Bs + (i * 32 + lr) * GLS + lc) = rb[i];
    __syncthreads();
    if (k0 + 64 < K) {
#pragma unroll
      for (int i = 0; i < 8; ++i) ra[i] = *(const u32x4*)(A + (size_t)(i * 32 + lr) * lda + k0 + 64 + lc);
#pragma unroll
      for (int i = 0; i < 4; ++i) rb[i] = *(const u32x4*)(Bt + (size_t)(i * 32 + lr) * ldb + k0 + 64 + lc);
    }
#pragma unroll
    for (int ks = 0; ks < 64; ks += 16) {
      const int ko = ks + (lane >> 5) * 8;
      bf16x8 b0 = *(const bf16x8*)(Bs + (wn * 64 + (lane & 31)) * GLS + ko);
      bf16x8 b1 = *(const bf16x8*)(Bs + (wn * 64 + 32 + (lane & 31)) * GLS + ko);
#pragma unroll
      for (int mi = 0; mi < 4; ++mi) {
        bf16x8 a = *(const bf16x8*)(As + (wm * 128 + mi * 32 + (lane & 31)) * GLS + ko);
        acc[mi][0] = MFMA32(a, b0, acc[mi][0]);
        acc[mi][1] = MFMA32(a, b1, acc[mi][1]);
      }
    }
  }
}
template <class F>
DI void gemm_epi2(f32x16 (&acc)[4][2], F f) {
  const int lane = get_tid() & 63, w = get_tid() >> 6;
  const int wm = w >> 1, wn = w & 1;
#pragma unroll
  for (int mi = 0; mi < 4; ++mi)
#pragma unroll
    for (int ni = 0; ni < 2; ++ni)
#pragma unroll
      for (int r = 0; r < 16; ++r) {
        int row = wm * 128 + mi * 32 + (r & 3) + 8 * (r >> 2) + 4 * (lane >> 5);
        int col = wn * 64 + ni * 32 + (lane & 31);
        f(row, col, acc[mi][ni][r]);
      }
}

DI void mma_tile(f32x16& acc, const bf16* A, int lda, const bf16* Bt, int ldb, int K) {
  const int lane = get_tid() & 63;
  const bf16* ap = A + (size_t)(lane & 31) * lda + (lane >> 5) * 8;
  const bf16* bp = Bt + (size_t)(lane & 31) * ldb + (lane >> 5) * 8;
#pragma unroll 4
  for (int ks = 0; ks < K; ks += 16) {
    bf16x8 a = *(const bf16x8*)(ap + ks);
    bf16x8 b = *(const bf16x8*)(bp + ks);
    acc = MFMA32(a, b, acc);
  }
}
template <int K>
DI void mma_tile_ga(f32x16& acc, const bf16* __restrict__ A, int lda, const bf16* Bt, int ldb) {
  const int lane = get_tid() & 63;
  const bf16* ap = A + (size_t)(lane & 31) * lda + (lane >> 5) * 8;
  const bf16* bp = Bt + (size_t)(lane & 31) * ldb + (lane >> 5) * 8;
  bf16x8 af[K / 16];
#pragma unroll
  for (int i = 0; i < K / 16; ++i) af[i] = *(const bf16x8*)(ap + i * 16);
#pragma unroll
  for (int i = 0; i < K / 16; ++i) {
    bf16x8 b = *(const bf16x8*)(bp + i * 16);
    acc = MFMA32(af[i], b, acc);
  }
}
DI int crow(int r, int lane) { return (r & 3) + 8 * (r >> 2) + 4 * (lane >> 5); }

DI void prep_transpose(const float* __restrict__ W, int K, int N, int Npad, bf16* __restrict__ Wt, int tile, float* tl) {
  const int ntn = Npad / 64;
  const int kt = tile / ntn, nt = tile % ntn;
  const int k0 = kt * 64, n0 = nt * 64;
  const int tid = get_tid();
  __syncthreads();
  for (int i = 0; i < 16; ++i) {
    int r = i * 4 + (tid >> 6), cidx = tid & 63;
    int n = n0 + cidx;
    float v = (n < N) ? W[(size_t)(k0 + r) * N + n] : 0.f;
    tl[cidx * 65 + r] = v;
  }
  __syncthreads();
  for (int i = 0; i < 16; ++i) {
    int n = i * 4 + (tid >> 6), k = tid & 63;
    Wt[(size_t)(n0 + n) * K + k0 + k] = f2bf(tl[n * 65 + k]);
  }
}

DI void convert_bf16(const float* __restrict__ src, bf16* __restrict__ dst, size_t n, int bid, int nb) {
  size_t nv = n / 8;
  for (size_t i = (size_t)bid * 256 + get_tid(); i < nv; i += (size_t)nb * 256) {
    float4 a = ((const float4*)src)[2 * i], b = ((const float4*)src)[2 * i + 1];
    u32x4 o;
    o.x = cvtpk(a.x, a.y); o.y = cvtpk(a.z, a.w); o.z = cvtpk(b.x, b.y); o.w = cvtpk(b.z, b.w);
    ((u32x4*)dst)[i] = o;
  }
}

DI void prep_mod(const Params& p, int item, float* sm) {
  const int l = item / 96, n0 = (item % 96) * 64;
  const int tid = get_tid(), lane = tid & 63, w = tid >> 6;
  const float* W = p.ada_w + (size_t)l * 1024 * 6144 + n0 + lane;
  float* sc = sm;
  float* red = sm + 5 * 1024;
  __syncthreads();
  for (int i = tid; i < 5 * 1024; i += 256) {
    const int r = i >> 10, k = i & 1023;
    sc[i] = siluf_(r < 4 ? p.c[r * 1024 + k] : p.c_ctx[k]);
  }
  __syncthreads();
  float acc[5] = {0.f, 0.f, 0.f, 0.f, 0.f};
#pragma unroll 1
  for (int k0 = w * 256; k0 < w * 256 + 256; k0 += 16) {
    float wv[16];
#pragma unroll
    for (int j = 0; j < 16; ++j) wv[j] = W[(size_t)(k0 + j) * 6144];
#pragma unroll
    for (int j = 0; j < 16; ++j) {
#pragma unroll
      for (int r = 0; r < 5; ++r) acc[r] += sc[r * 1024 + k0 + j] * wv[j];
    }
  }
#pragma unroll
  for (int r = 0; r < 5; ++r) red[(w * 5 + r) * 64 + lane] = acc[r];
  __syncthreads();
  if (w == 0) {
    float* M = (float*)(p.ws + OFF_MOD);
#pragma unroll
    for (int r = 0; r < 5; ++r) {
      float s2 = red[(0 * 5 + r) * 64 + lane] + red[(1 * 5 + r) * 64 + lane] + red[(2 * 5 + r) * 64 + lane] + red[(3 * 5 + r) * 64 + lane];
      M[(size_t)(l * 5 + r) * 6144 + n0 + lane] = s2 + p.ada_b[l * 6144 + n0 + lane];
    }
  }
}

DI void prep_s5(const Params& p, int item4, float* sm) {
  const int item = item4 >> 2, qtr = item4 & 3;
  const int g = item >> 1, d = item & 1;
  const int tid = get_tid();
  float* pw = sm;
  float* bb = sm + 17 * 128;
  float* kc = bb + 64 * 32;
  __syncthreads();
  const float dt = __expf(p.s5_log_dt[d * 32 + g]);
  if (tid < 64) {
    const int pp = tid;
    const float are = p.s5_a_re[(d * 32 + g) * 64 + pp], aim = p.s5_a_im[(d * 32 + g) * 64 + pp];
    for (int n = 0; n <= 16; ++n) {
      float mag = expf(are * dt * n);
      float sn, cs;
      sincosf(aim * dt * n, &sn, &cs);
      pw[(n * 64 + pp) * 2 + 0] = mag * cs;
      pw[(n * 64 + pp) * 2 + 1] = mag * sn;
    }
    float abr = pw[(64 + pp) * 2 + 0] - 1.0f, abi = pw[(64 + pp) * 2 + 1];
    float den = are * are + aim * aim;
    float qr = (abr * are + abi * aim) / den, qi = (abi * are - abr * aim) / den;
    for (int c2 = 0; c2 < 16; ++c2) {
      float br = p.s5_b_re[((size_t)(d * 32 + g) * 64 + pp) * 16 + c2], bi = p.s5_b_im[((size_t)(d * 32 + g) * 64 + pp) * 16 + c2];
      bb[(pp * 16 + c2) * 2 + 0] = qr * br - qi * bi;
      bb[(pp * 16 + c2) * 2 + 1] = qr * bi + qi * br;
    }
    float* A16 = (float*)(p.ws + OFF_S5A16) + (size_t)item * 128;
    A16[pp * 2 + 0] = pw[(16 * 64 + pp) * 2 + 0];
    A16[pp * 2 + 1] = pw[(16 * 64 + pp) * 2 + 1];
  }
  float* cre = kc + 4096;
  float* cim = cre + 1024;
  for (int e = tid; e < 1024; e += 256) {
    cre[e] = p.s5_c_re[(size_t)(d * 32 + g) * 1024 + e];
    cim[e] = p.s5_c_im[(size_t)(d * 32 + g) * 1024 + e];
  }
  __syncthreads();
  for (int e = tid; e < (4 * qtr + 4) * 256; e += 256) {
    int tau = e >> 8, c = (e >> 4) & 15, c2 = e & 15;
    float s = 0.f;
    for (int pp = 0; pp < 64; ++pp) {
      float cr = cre[c * 64 + pp], ci = cim[c * 64 + pp];
      float wr = pw[(tau * 64 + pp) * 2], wi = pw[(tau * 64 + pp) * 2 + 1];
      float zr = cr * wr - ci * wi, zi = cr * wi + ci * wr;
      float br = bb[(pp * 16 + c2) * 2], bi = bb[(pp * 16 + c2) * 2 + 1];
      s += zr * br - zi * bi;
    }
    kc[e] = s;
  }
  __syncthreads();
  bf16* T = (bf16*)(p.ws + OFF_S5T) + (size_t)item * 65536;
  for (int e = qtr * 16384 + tid; e < (qtr + 1) * 16384; e += 256) {
    int m = e >> 8, k = e & 255;
    int i = m >> 4, c = m & 15, j = k >> 4, c2 = k & 15;
    float v = (i >= j) ? kc[((i - j) * 16 + c) * 16 + c2] : 0.f;
    T[e] = f2bf(v);
  }
  bf16* WE = (bf16*)(p.ws + OFF_S5WE) + (size_t)item * 32768;
  for (int e = qtr * 8192 + tid; e < (qtr + 1) * 8192; e += 256) {
    int pr = e >> 8, k = e & 255;
    int pp = pr & 63, im = pr >> 6, j = k >> 4, c2 = k & 15;
    float wr = pw[((15 - j) * 64 + pp) * 2], wi = pw[((15 - j) * 64 + pp) * 2 + 1];
    float br = bb[(pp * 16 + c2) * 2], bi = bb[(pp * 16 + c2) * 2 + 1];
    float v = im ? (wr * bi + wi * br) : (wr * br - wi * bi);
    WE[e] = f2bf(v);
  }
  bf16* WY = (bf16*)(p.ws + OFF_S5WY) + (size_t)item * 32768;
  for (int e = qtr * 8192 + tid; e < (qtr + 1) * 8192; e += 256) {
    int m = e >> 7, pr = e & 127;
    int i = m >> 4, c = m & 15, pp = pr & 63, im = pr >> 6;
    float cr = cre[c * 64 + pp], ci = cim[c * 64 + pp];
    float wr = pw[((i + 1) * 64 + pp) * 2], wi = pw[((i + 1) * 64 + pp) * 2 + 1];
    float zr = cr * wr - ci * wi, zi = cr * wi + ci * wr;
    WY[e] = f2bf(im ? -zi : zr);
  }
}

DI void phase_prep(const Params& p, char* smem) {
  const int bid = blockIdx.x, nb = gridDim.x;
  float* sm = (float*)smem;
  if (bid == 0 && get_tid() < 64) ((unsigned*)(p.ws + OFF_KMAX))[get_tid()] = 0u;
  {
    float2* tab = (float2*)(p.ws + OFF_ROPE1);
    for (int e = bid * 256 + get_tid(); e < 8192 * 16; e += nb * 256) {
      int t = e >> 4, f = e & 15;
      float pos = (f < 8) ? (float)(t >> 6) : (float)(t & 63);
      float inv = powf(10000.f, -(float)(f & 7) / 8.f);
      float sn, cs;
      sincosf(pos * inv, &sn, &cs);
      tab[e] = make_float2(cs, sn);
    }
  }
  const int n_mod = 192, n_s5 = 256;
  constexpr int T0 = 16 * 52, T1 = 16 * 16, T2 = 16 * 20, T3 = 16 * 16, T4 = 6 * 12, T5 = 4 * 16, T6 = 8 * 8, T7 = 16 * 32, T8 = 16 * 32;
  constexpr int NTR = T0 + T1 + T2 + T3 + T4 + T5 + T6 + T7 + T8;
  const int total = n_mod + n_s5 + NTR;
  for (int it = bid; it < total; it += nb) {
    if (it < n_s5) prep_s5(p, it, sm);
    else if (it < n_mod + n_s5) prep_mod(p, it - n_s5, sm);
    else {
      int t = it - n_mod - n_s5;
      if (t < T0) { prep_transpose(p.ev_w_in, 1024, 3328, 3328, (bf16*)(p.ws + OFF_WT_EVIN), t, sm); continue; }
      t -= T0;
      if (t < T1) { prep_transpose(p.ev_w_out, 1024, 1024, 1024, (bf16*)(p.ws + OFF_WT_EVOUT), t, sm); continue; }
      t -= T1;
      if (t < T2) { prep_transpose(p.od_w_in, 1024, 1184, 1280, (bf16*)(p.ws + OFF_WT_ODIN), t, sm); continue; }
      t -= T2;
      if (t < T3) { prep_transpose(p.od_w_out, 1024, 1024, 1024, (bf16*)(p.ws + OFF_WT_ODOUT), t, sm); continue; }
      t -= T3;
      if (t < T4) { prep_transpose(p.mla_w_qup, 384, 768, 768, (bf16*)(p.ws + OFF_WT_QUP), t, sm); continue; }
      t -= T4;
      if (t < T5) { prep_transpose(p.mla_w_kvup, 256, 1024, 1024, (bf16*)(p.ws + OFF_WT_KVUP), t, sm); continue; }
      t -= T5;
      if (t < T6) { prep_transpose(p.s5_w_glu, 512, 512, 512, (bf16*)(p.ws + OFF_WT_GLU), t, sm); continue; }
      t -= T6;
      if (t < T7) { prep_transpose(p.peer_wq, 1024, 2048, 2048, (bf16*)(p.ws + OFF_WT_PWQ), t, sm); continue; }
      t -= T7;
      prep_transpose(p.peer_wq + (size_t)1024 * 2048, 1024, 2048, 2048, (bf16*)(p.ws + OFF_WT_PWQ) + (size_t)2048 * 1024, t, sm);
    }
  }
  convert_bf16(p.peer_keys, (bf16*)(p.ws + OFF_PKEYS), (size_t)2 * 8 * 2 * 128 * 128, bid, nb);
}

DI void phase_norm(const Params& p, int layer, bool first, const float* g, int shift_chunk, int nrows) {
  const int lane = get_tid() & 63, w = get_tid() >> 6;
  bf16* dst = (bf16*)(p.ws + OFF_ACTA);
  for (int r = blockIdx.x * 4 + w; r < nrows; r += gridDim.x * 4) {
    const float* src = first ? orig_row(p, r) : res_row(p, r);
    float4 v[4];
    float ss = 0.f;
#pragma unroll
    for (int i = 0; i < 4; ++i) {
      v[i] = ((const float4*)src)[i * 64 + lane];
      ss += v[i].x * v[i].x + v[i].y * v[i].y + v[i].z * v[i].z + v[i].w * v[i].w;
    }
    ss = wave_sum(ss);
    const float rs = rsqrtf(ss * (1.0f / 1024.0f) + EPSN);
    const float* sh = mod_ptr(p, layer, r, shift_chunk);
    const float* sc = mod_ptr(p, layer, r, shift_chunk + 1);
#pragma unroll
    for (int i = 0; i < 4; ++i) {
      float4 gg = ((const float4*)g)[i * 64 + lane];
      float4 s4 = ((const float4*)sh)[i * 64 + lane];
      float4 c4 = ((const float4*)sc)[i * 64 + lane];
      float o0 = v[i].x * rs * gg.x * (1.f + c4.x) + s4.x;
      float o1 = v[i].y * rs * gg.y * (1.f + c4.y) + s4.y;
      float o2 = v[i].z * rs * gg.z * (1.f + c4.z) + s4.z;
      float o3 = v[i].w * rs * gg.w * (1.f + c4.w) + s4.w;
      u32x2 o;
      o.x = cvtpk(o0, o1); o.y = cvtpk(o2, o3);
      ((u32x2*)(dst + (size_t)r * DM))[i * 64 + lane] = o;
    }
  }
}

DI void phase_inproj0(const Params& p, char* smem) {
  bf16* As = (bf16*)smem; bf16* Bs = As + 256 * GLS;
  const bf16* A = (const bf16*)(p.ws + OFF_ACTA);
  const bf16* Wt = (const bf16*)(p.ws + OFF_WT_EVIN);
  bf16* pg = (bf16*)(p.ws + OFF_PAGQA);
  bf16* ph = (bf16*)(p.ws + OFF_PAHG);
  const int ntn = 26, ntm = NTOK / 256;
  for (int t = blockIdx.x; t < ntn * ntm; t += gridDim.x) {
    const int mt = t / ntn, nt = t % ntn;
    f32x16 acc[4][2];
    gemm_256x128(A + (size_t)mt * 256 * DM, DM, Wt + (size_t)nt * 128 * DM, DM, DM, acc, As, Bs);
    gemm_epi2(acc, [&](int row, int col, float v) {
      int r = mt * 256 + row, cg_ = nt * 128 + col;
      if (cg_ < 768) pg[(size_t)r * 768 + cg_] = f2bf(v);
      else ph[(size_t)r * 2560 + (cg_ - 768)] = f2bf(v);
    });
  }
}

DI void phase_gqa_prep(const Params& p, char* smem) {
  bf16* pg = (bf16*)(p.ws + OFF_PAGQA);
  bf16* vt = (bf16*)(p.ws + OFF_VT0);
  bf16* tl = (bf16*)smem;
  const int lane = get_tid() & 63, w = get_tid() >> 6, tid = get_tid();
  const float gq = p.gqa_qn_g[lane], gk = p.gqa_kn_g[lane];
  const float inv = __powf(10000.f, -(float)(lane & 15) / 16.f);
  float lbv[16];
#pragma unroll
  for (int e = 0; e < 16; ++e) {
    const int j = lane * 16 + e, d = j >> 9, cc = j & 511;
    const float l0 = p.hg_lb_logits[(d * 2 + 0) * 512 + cc], l1 = p.hg_lb_logits[(d * 2 + 1) * 512 + cc];
    lbv[e] = 1.0f / (1.0f + __expf(l1 - l0));
  }
  bf16* phg = (bf16*)(p.ws + OFF_PAHG);
  for (int r = blockIdx.x * 4 + w; r < NTOK; r += gridDim.x * 4) {
    bf16* row = pg + (size_t)r * 768;
    float sn = 0.f, cs = 1.f;
    if (r < NLAT) {
      int t = r & 8191;
      float pos = (lane < 32) ? (float)(t >> 6) : (float)(t & 63);
      sincosf(pos * inv, &sn, &cs);
    }
#pragma unroll
    for (int hh = 0; hh < 10; ++hh) {
      float v = bf2f(row[hh * 64 + lane]);
      float ss = wave_sum(v * v);
      float y = v * rsqrtf(ss * (1.f / 64.f) + EPSN) * (hh < 8 ? gq : gk);
      float pr = __shfl_xor(y, 16);
      float o = y * cs + ((lane & 16) ? pr * sn : -pr * sn);
      row[hh * 64 + lane] = f2bf(hh < 8 ? o * (0.125f * 1.4426950408889634f) : o);
    }
    {
      bf16* frow = phg + (size_t)r * 2560 + 512 + lane * 16;
      u32x4 a = *(const u32x4*)frow, b2 = *(const u32x4*)(frow + 8);
      float fv[16];
      fv[0] = bflo(a.x); fv[1] = bfhi(a.x); fv[2] = bflo(a.y); fv[3] = bfhi(a.y); fv[4] = bflo(a.z); fv[5] = bfhi(a.z); fv[6] = bflo(a.w); fv[7] = bfhi(a.w);
      fv[8] = bflo(b2.x); fv[9] = bfhi(b2.x); fv[10] = bflo(b2.y); fv[11] = bfhi(b2.y); fv[12] = bflo(b2.z); fv[13] = bfhi(b2.z); fv[14] = bflo(b2.w); fv[15] = bfhi(b2.w);
#pragma unroll
      for (int e = 0; e < 16; ++e) fv[e] = __logf(lbv[e] + (1.f - lbv[e]) * sigmoidf_(fv[e]));
      u32x4 o0, o1;
      o0.x = cvtpk(fv[0], fv[1]); o0.y = cvtpk(fv[2], fv[3]); o0.z = cvtpk(fv[4], fv[5]); o0.w = cvtpk(fv[6], fv[7]);
      o1.x = cvtpk(fv[8], fv[9]); o1.y = cvtpk(fv[10], fv[11]); o1.z = cvtpk(fv[12], fv[13]); o1.w = cvtpk(fv[14], fv[15]);
      *(u32x4*)frow = o0; *(u32x4*)(frow + 8) = o1;
    }
  }
  for (int blk = blockIdx.x; blk < NTOK / 64; blk += gridDim.x) {
    const int r0 = blk * 64;
    __syncthreads();
    {
      const int rr = tid >> 2, c0 = (tid & 3) * 32;
      const bf16* src = pg + (size_t)(r0 + rr) * 768 + 640 + c0;
#pragma unroll
      for (int i = 0; i < 4; ++i) {
        u32x4 v4 = *(const u32x4*)(src + i * 8);
#pragma unroll
        for (int e = 0; e < 4; ++e) {
          tl[(c0 + i * 8 + 2 * e) * GLS + rr] = (bf16)(v4[e] & 0xffffu);
          tl[(c0 + i * 8 + 2 * e + 1) * GLS + rr] = (bf16)(v4[e] >> 16);
        }
      }
    }
    __syncthreads();
    int b, s0;
    if (r0 < NLAT) { b = r0 >> 13; s0 = CTXL + (r0 & 8191); } else { int rc = r0 - NLAT; b = rc >> 8; s0 = rc & 255; }
    {
      int vcol = tid >> 1, half = tid & 1;
      int kvh = vcol >> 6, dv = vcol & 63;
      bf16* dstp = vt + ((size_t)((b * 2 + kvh) * 64 + dv)) * SKEYS + s0 + half * 32;
      const bf16* srcp = tl + vcol * GLS + half * 32;
#pragma unroll
      for (int i = 0; i < 4; ++i) ((u32x4*)dstp)[i] = ((const u32x4*)srcp)[i];
    }
  }
}

template <int DQK, int SM>
DI void attn_item(const bf16* __restrict__ Q, int ldq_, const bf16* __restrict__ Kc, const bf16* __restrict__ Kl, int ldk_,
                  const bf16* __restrict__ VT, int nkeys, bf16* __restrict__ O, int ldo_, float scale, char* smem, float kbound = 0.f) {
  constexpr bool FIXED = (SM != 0);
  constexpr int ldq = 768, ldk = 768, ldo = DM;
  (void)ldq_; (void)ldk_; (void)ldo_;
  constexpr int KLS = DQK + 8;
  constexpr int VLS = 72;
  constexpr int NKS = DQK / 16;
  constexpr int KCH = DQK / 8;
  constexpr int KLOADS = (64 * KCH) / 256;
  constexpr int BUF = 64 * KLS + 64 * VLS;
  bf16* Sb = (bf16*)smem;
  const int tid = get_tid(), lane = tid & 63, w = tid >> 6;
  const float sc = scale * 1.4426950408889634f;
  bf16x8 qf[2][NKS];
#pragma unroll
  for (int qt = 0; qt < 2; ++qt) {
    const bf16* qp = Q + (size_t)(w * 64 + qt * 32 + (lane & 31)) * ldq + (lane >> 5) * 8;
#pragma unroll
    for (int ks = 0; ks < NKS; ++ks) qf[qt][ks] = *(const bf16x8*)(qp + ks * 16);
  }
  float msh[2] = {0.f, 0.f};
  if (SM == 2) {
#pragma unroll
    for (int qt = 0; qt < 2; ++qt) {
      float sq = 0.f;
#pragma unroll
      for (int ks = 0; ks < NKS; ++ks)
#pragma unroll
        for (int e = 0; e < 8; ++e) { float f = bf2f((bf16)qf[qt][ks][e]); sq += f * f; }
      sq += __shfl_xor(sq, 32);
      msh[qt] = fminf(sqrtf(sq) * kbound, 64.0f);
    }
  }
  f32x16 ot[2][2];
#pragma unroll
  for (int i = 0; i < 2; ++i)
#pragma unroll
    for (int j = 0; j < 2; ++j)
#pragma unroll
      for (int r = 0; r < 16; ++r) ot[i][j][r] = 0.f;
  float m_run[2] = {-1e30f, -1e30f}, l_run[2] = {0.f, 0.f};
  u32x4 kr[KLOADS], vr[2];
  auto gload = [&](int s0) {
    const bf16* kb = (s0 < CTXL) ? (Kc + (size_t)s0 * ldk) : (Kl + (size_t)(s0 - CTXL) * ldk);
#pragma unroll
    for (int i = 0; i < KLOADS; ++i) {
      int ci = i * 256 + tid;
      int row = ci / KCH, ch = ci % KCH;
      kr[i] = *(const u32x4*)(kb + (size_t)row * ldk + ch * 8);
    }
#pragma unroll
    for (int i = 0; i < 2; ++i) {
      int ci = i * 256 + tid;
      int row = ci >> 3, ch = ci & 7;
      vr[i] = *(const u32x4*)(VT + (size_t)row * SKEYS + s0 + ch * 8);
    }
  };
  auto lwrite = [&](bf16* buf) {
    bf16* Ks = buf; bf16* Vs = buf + 64 * KLS;
#pragma unroll
    for (int i = 0; i < KLOADS; ++i) {
      int ci = i * 256 + tid;
      int row = ci / KCH, ch = ci % KCH;
      *(u32x4*)(Ks + row * KLS + ch * 8) = kr[i];
    }
#pragma unroll
    for (int i = 0; i < 2; ++i) {
      int ci = i * 256 + tid;
      int row = ci >> 3, ch = ci & 7;
      u32x2 lo = {vr[i].x, vr[i].y}, hi = {vr[i].z, vr[i].w};
      const int gb = (ch >> 1) * 16 + (ch & 1) * 4;
      *(u32x2*)(Vs + row * VLS + gb) = lo;
      *(u32x2*)(Vs + row * VLS + gb + 8) = hi;
    }
  };
  const int ntiles = nkeys >> 6;
  __syncthreads();
  gload(0);
  lwrite(Sb);
  if (ntiles > 1) gload(64);
  for (int j = 0; j < ntiles; ++j) {
    __syncthreads();
    if (j + 1 < ntiles) {
      lwrite(Sb + ((j + 1) & 1) * BUF);
      if (j + 2 < ntiles) gload((j + 2) * 64);
    }
    const bf16* Ks = Sb + (j & 1) * BUF;
    const bf16* Vs = Ks + 64 * KLS;
    auto half = [&](const int kt) {
      f32x16 st[2];
#pragma unroll
      for (int qt = 0; qt < 2; ++qt)
#pragma unroll
        for (int r = 0; r < 16; ++r) st[qt][r] = 0.f;
      {
        const bf16* ap = Ks + (kt * 32 + (lane & 31)) * KLS + (lane >> 5) * 8;
        __builtin_amdgcn_s_setprio(1);
#pragma unroll
        for (int ks = 0; ks < NKS; ++ks) {
          bf16x8 a = *(const bf16x8*)(ap + ks * 16);
          st[0] = MFMA32(a, qf[0][ks], st[0]);
          st[1] = MFMA32(a, qf[1][ks], st[1]);
        }
        __builtin_amdgcn_s_setprio(0);
      }
      float mx[2] = {0.f, 0.f};
      bool need = false;
      if (!FIXED) {
#pragma unroll
      for (int qt = 0; qt < 2; ++qt) {
        float m0 = fmaxf(st[qt][0], st[qt][1]);
#pragma unroll
        for (int r = 2; r < 16; r += 2) m0 = fmaxf(m0, fmaxf(st[qt][r], st[qt][r + 1]));
        m0 = fmaxf(m0, __shfl_xor(m0, 32)) * sc;
        mx[qt] = m0;
        need = need || (m0 - m_run[qt] > 8.0f);
      }
      }
      if (!FIXED && __any(need)) {
#pragma unroll
        for (int qt = 0; qt < 2; ++qt) {
          const float m_new = fmaxf(m_run[qt], mx[qt]);
          const float alpha = __builtin_amdgcn_exp2f(m_run[qt] - m_new);
          m_run[qt] = m_new;
          l_run[qt] *= alpha;
#pragma unroll
          for (int dt = 0; dt < 2; ++dt)
#pragma unroll
            for (int r = 0; r < 16; ++r) ot[qt][dt][r] *= alpha;
        }
      }
      bf16x8 pb[2][2];
#pragma unroll
      for (int qt = 0; qt < 2; ++qt) {
        float ps = 0.f;
        const float mr = m_run[qt];
#pragma unroll
        for (int r = 0; r < 16; ++r) {
          float pv = (SM == 1) ? __builtin_amdgcn_exp2f(st[qt][r]) : (SM == 2) ? __builtin_amdgcn_exp2f(st[qt][r] - msh[qt]) : __builtin_amdgcn_exp2f(st[qt][r] * sc - mr);
          st[qt][r] = pv;
          ps += pv;
        }
#pragma unroll
        for (int s2 = 0; s2 < 2; ++s2) {
          u32x4 pk;
          pk.x = cvtpk(st[qt][8 * s2 + 0], st[qt][8 * s2 + 1]);
          pk.y = cvtpk(st[qt][8 * s2 + 2], st[qt][8 * s2 + 3]);
          pk.z = cvtpk(st[qt][8 * s2 + 4], st[qt][8 * s2 + 5]);
          pk.w = cvtpk(st[qt][8 * s2 + 6], st[qt][8 * s2 + 7]);
          pb[qt][s2] = __builtin_bit_cast(bf16x8, pk);
        }
        l_run[qt] += ps;
      }
      __builtin_amdgcn_s_setprio(1);
#pragma unroll
      for (int s2 = 0; s2 < 2; ++s2)
#pragma unroll
        for (int dt = 0; dt < 2; ++dt) {
          const bf16* vp = Vs + (dt * 32 + (lane & 31)) * VLS + kt * 32 + 16 * s2 + 8 * (lane >> 5);
          bf16x8 af = *(const bf16x8*)vp;
          ot[0][dt] = MFMA32(af, pb[0][s2], ot[0][dt]);
          ot[1][dt] = MFMA32(af, pb[1][s2], ot[1][dt]);
        }
      __builtin_amdgcn_s_setprio(0);
    };
    if constexpr (SM == 1) {
#pragma unroll 1
      for (int kt = 0; kt < 2; ++kt) half(kt);
    } else {
      half(0);
      half(1);
    }
  }
#pragma unroll
  for (int qt = 0; qt < 2; ++qt) {
    const float ltot = l_run[qt] + __shfl_xor(l_run[qt], 32);
    const float inv_l = 1.0f / ltot;
    const int tid2 = get_tid();
    bf16* op = O + (size_t)((tid2 >> 6) * 64 + qt * 32 + (tid2 & 31)) * ldo;
#pragma unroll
    for (int dt = 0; dt < 2; ++dt)
#pragma unroll
      for (int g4 = 0; g4 < 4; ++g4) {
        int dv = dt * 32 + 8 * g4 + 4 * ((tid2 >> 5) & 1);
        u32x2 o;
        o.x = cvtpk(ot[qt][dt][4 * g4 + 0] * inv_l, ot[qt][dt][4 * g4 + 1] * inv_l);
        o.y = cvtpk(ot[qt][dt][4 * g4 + 2] * inv_l, ot[qt][dt][4 * g4 + 3] * inv_l);
        *(u32x2*)(op + dv) = o;
      }
  }
}

DI void hgrn2_item(const Params& p, int item, char* smem) {
  const int vs = item & 3, dir = (item >> 2) & 1, h = (item >> 3) & 3, b = item >> 5;
  constexpr int QLS = 136, TLS = 72;
  bf16* Qr = (bf16*)smem;
  bf16* Kr = Qr + 64 * QLS;
  bf16* KrT = Kr + 64 * QLS;
  bf16* VTs = KrT + 128 * TLS;
  bf16* Att = VTs + 32 * TLS;
  bf16* STb = Att + 64 * TLS;
  float* rsum = (float*)(STb + 32 * QLS);
  float* lsum = rsum + 128;
  const int tid = get_tid(), lane = tid & 63, w = tid >> 6;
  const int c = tid & 127, half = tid >> 7;
  const bf16* ph = (const bf16*)(p.ws + OFF_PAHG);
  bf16* og = (bf16*)(p.ws + OFF_OHG) + (size_t)dir * NTOK * 512;
  auto rowof = [&](int pos) -> int {
    if (pos < CTXL) { int s = dir ? (CTXL - 1 - pos) : pos; return NLAT + b * CTXL + s; }
    int t = pos - CTXL; t = dir ? (SEQ - 1 - t) : t; return b * SEQ + t;
  };
  f32x16 S0, S1;
#pragma unroll
  for (int r = 0; r < 16; ++r) { S0[r] = 0.f; S1[r] = 0.f; }
  bf16 pq[32], pf[32];
  u32x4 pv;
  auto prefetch = [&](int ch) {
    const int p0 = ch * 64;
#pragma unroll
    for (int i = 0; i < 32; ++i) {
      const bf16* row = ph + (size_t)rowof(p0 + half * 32 + i) * 2560;
      pq[i] = row[h * 128 + c];
      pf[i] = row[512 + dir * 512 + h * 128 + c];
    }
    {
      const bf16* row = ph + (size_t)rowof(p0 + (tid >> 2)) * 2560;
      pv = *(const u32x4*)(row + 1536 + h * 128 + vs * 32 + (tid & 3) * 8);
    }
  };
  for (int ch = 0; ch < 132; ++ch) {
    prefetch(ch);
    {
      float run = 0.f;
      if (half == 0) {
#pragma unroll
        for (int ii = 31; ii >= 0; --ii) {
          float lg = bf2f(pf[ii]), q = bf2f(pq[ii]);
          float k = 1.f - __expf(lg);
          float eq = __expf(fminf(-run, 80.f)), ek = __expf(fmaxf(run, -80.f));
          const unsigned pk2 = cvtpk(q * eq, k * ek);
          const bf16 qv = (bf16)(pk2 & 0xffffu), kv = (bf16)(pk2 >> 16);
          Qr[ii * QLS + c] = qv;
          Kr[ii * QLS + c] = kv;
          KrT[c * TLS + ii] = kv;
          run += lg;
        }
        rsum[c] = __expf(run);
      } else {
#pragma unroll
        for (int ii = 0; ii < 32; ++ii) {
          float lg = bf2f(pf[ii]), q = bf2f(pq[ii]);
          float k = 1.f - __expf(lg);
          run += lg;
          float eq = __expf(fmaxf(run, -80.f)), ek = __expf(fminf(-run, 80.f));
          const unsigned pk2 = cvtpk(q * eq, k * ek);
          const bf16 qv = (bf16)(pk2 & 0xffffu), kv = (bf16)(pk2 >> 16);
          Qr[(32 + ii) * QLS + c] = qv;
          Kr[(32 + ii) * QLS + c] = kv;
          KrT[c * TLS + 32 + ii] = kv;
        }
        lsum[c] = __expf(run);
      }
      {
        int i = tid >> 2, v0 = (tid & 3) * 8;
#pragma unroll
        for (int j = 0; j < 4; ++j) {
          VTs[(v0 + 2 * j) * TLS + i] = (bf16)(pv[j] & 0xffffu);
          VTs[(v0 + 2 * j + 1) * TLS + i] = (bf16)(pv[j] >> 16);
        }
      }
    }
    __syncthreads();
    if (w < 2) {
      const int ntl = (w == 0) ? 2 : 1;
      for (int q2 = 0; q2 < ntl; ++q2) {
        const int tt = (w == 0) ? q2 : 1, stl = (w == 0) ? q2 : 0;
        f32x16 a;
#pragma unroll
        for (int r = 0; r < 16; ++r) a[r] = 0.f;
        mma_tile(a, Qr + tt * 32 * QLS, QLS, Kr + stl * 32 * QLS, QLS, 128);
#pragma unroll
        for (int r = 0; r < 16; ++r) {
          int t = tt * 32 + crow(r, lane), s = stl * 32 + (lane & 31);
          float v = (s <= t) ? a[r] : 0.f;
          Att[t * TLS + s] = (bf16)(cvtpk(v, v) & 0xffffu);
        }
      }
      if (w == 1) {
#pragma unroll
        for (int r = 0; r < 16; ++r) Att[crow(r, lane) * TLS + 32 + (lane & 31)] = 0;
      }
    } else {
      const int ct0 = (w - 2) * 2;
#pragma unroll
      for (int tI = 0; tI < 2; ++tI) {
        f32x16& S = tI ? S1 : S0;
        const int cb = (ct0 + tI) * 32;
#pragma unroll
        for (int g4 = 0; g4 < 4; ++g4) {
          int cc = cb + 8 * g4 + 4 * (lane >> 5);
          float e0 = rsum[cc], e1 = rsum[cc + 1], e2 = rsum[cc + 2], e3 = rsum[cc + 3];
          u32x2 o;
          o.x = cvtpk(S[4 * g4] * e0, S[4 * g4 + 1] * e1);
          o.y = cvtpk(S[4 * g4 + 2] * e2, S[4 * g4 + 3] * e3);
          *(u32x2*)(STb + (lane & 31) * QLS + cc) = o;
        }
        f32x16 a;
#pragma unroll
        for (int r = 0; r < 16; ++r) a[r] = 0.f;
        mma_tile(a, KrT + cb * TLS, TLS, VTs, TLS, 64);
#pragma unroll
        for (int r = 0; r < 16; ++r) {
          int cc = cb + crow(r, lane);
          float el = lsum[cc];
          float er = rsum[cc];
          S[r] = S[r] * (el * er) + a[r] * el;
        }
      }
    }
    __syncthreads();
    if (w < 2) {
      f32x16 a;
#pragma unroll
      for (int r = 0; r < 16; ++r) a[r] = 0.f;
      mma_tile(a, Att + w * 32 * TLS, TLS, VTs, TLS, 64);
      mma_tile(a, Qr + w * 32 * QLS, QLS, STb, QLS, 128);
#pragma unroll
      for (int r = 0; r < 16; ++r) {
        int t = w * 32 + crow(r, lane);
        int row = rowof(ch * 64 + t);
        og[(size_t)row * 512 + h * 128 + vs * 32 + (lane & 31)] = f2bf(a[r]);
      }
    }
    __syncthreads();
  }
}

DI void phase_mix0(const Params& p, char* smem, int cidx) {
  __shared__ int s_item;
  if (blockIdx.x < 128) hgrn2_item(p, blockIdx.x, smem);
  unsigned* cnt = (unsigned*)(p.ws + OFF_CNT) + cidx;
  const bf16* pg = (const bf16*)(p.ws + OFF_PAGQA);
  const bf16* vt = (const bf16*)(p.ws + OFF_VT0);
  bf16* ycat = (bf16*)(p.ws + OFF_ACTA);
  float kb0;
  {
    const int ln = get_tid() & 63;
    kb0 = 8.0f * 1.01f * wave_max_early(fabsf(p.gqa_kn_g[ln]));
  }
  const int n_lat = 4 * 8 * 32, n_ctx = 4 * 8;
  while (true) {
    __syncthreads();
    if (get_tid() == 0) s_item = (int)atomicAdd(cnt, 1u);
    __syncthreads();
    const int it = s_item;
    if (it >= n_lat + n_ctx) break;
    int b, hq, r0, nk;
    if (it < n_lat) { const int qt = it & 31; hq = (it >> 5) & 7; b = it >> 8; r0 = b * SEQ + qt * 256; nk = SKEYS; }
    else { const int i2 = it - n_lat; hq = i2 & 7; b = i2 >> 3; r0 = NLAT + b * CTXL; nk = CTXL; }
    const int kvh = hq >> 2;
    attn_item<64, 2>(pg + (size_t)r0 * 768 + hq * 64, 768,
                  pg + (size_t)(NLAT + b * CTXL) * 768 + 512 + kvh * 64, pg + (size_t)(b * SEQ) * 768 + 512 + kvh * 64, 768,
                  vt + (size_t)((b * 2 + kvh) * 64) * SKEYS, nk, ycat + (size_t)r0 * DM + hq * 64, DM, 0.125f, smem, kb0);
  }
}

DI void phase_hg_readout(const Params& p) {
  const int lane = get_tid() & 63, w = get_tid() >> 6;
  const bf16* o0 = (const bf16*)(p.ws + OFF_OHG);
  const bf16* o1 = o0 + (size_t)NTOK * 512;
  const bf16* ph = (const bf16*)(p.ws + OFF_PAHG);
  bf16* ycat = (bf16*)(p.ws + OFF_ACTA);
  const float g0 = p.hg_onorm_g[lane * 2], g1 = p.hg_onorm_g[lane * 2 + 1];
  for (int r = blockIdx.x * 4 + w; r < NTOK; r += gridDim.x * 4) {
#pragma unroll
    for (int h = 0; h < 4; ++h) {
      unsigned a = *(const unsigned*)(o0 + (size_t)r * 512 + h * 128 + lane * 2);
      unsigned b2 = *(const unsigned*)(o1 + (size_t)r * 512 + h * 128 + lane * 2);
      unsigned gg = *(const unsigned*)(ph + (size_t)r * 2560 + 2048 + h * 128 + lane * 2);
      float x0 = bflo(a) + bflo(b2), x1 = bfhi(a) + bfhi(b2);
      float ss = wave_sum(x0 * x0 + x1 * x1);
      float rs = rsqrtf(ss * (1.f / 128.f) + EPSN);
      float y0 = x0 * rs * g0 * siluf_(bflo(gg)), y1 = x1 * rs * g1 * siluf_(bfhi(gg));
      *(unsigned*)(ycat + (size_t)r * DM + 512 + h * 128 + lane * 2) = cvtpk(y0, y1);
    }
  }
}

template <int MI>
DI void resid_epilogue(f32x16 (&acc)[MI][2], const float* src, float* dst, const float* __restrict__ g) {
  const int lane = get_tid() & 63, w = get_tid() >> 6;
  const int wm = w >> 1, wn = w & 1;
  const float g0 = g[wn * 64 + (lane & 31)], g1 = g[wn * 64 + 32 + (lane & 31)];
#pragma unroll
  for (int mi = 0; mi < MI; ++mi) {
    const size_t o0 = (size_t)(wm * (MI * 32) + mi * 32 + 4 * (lane >> 5)) * DM + wn * 64 + (lane & 31);
    float xv[2][16];
#pragma unroll
    for (int r = 0; r < 16; ++r) {
      const size_t ro = o0 + (size_t)((r & 3) + 8 * (r >> 2)) * DM;
      xv[0][r] = src[ro];
      xv[1][r] = src[ro + 32];
    }
#pragma unroll
    for (int r = 0; r < 16; ++r) {
      const size_t ro = o0 + (size_t)((r & 3) + 8 * (r >> 2)) * DM;
      dst[ro] = xv[0][r] + g0 * acc[mi][0][r];
      dst[ro + 32] = xv[1][r] + g1 * acc[mi][1][r];
    }
  }
}
DI void resid_prefetch2(float (&xv)[2][2][16], const float* src) {
  const int lane = get_tid() & 63, w = get_tid() >> 6;
  const int wm = w >> 1, wn = w & 1;
#pragma unroll
  for (int mi = 0; mi < 2; ++mi) {
    const size_t o0 = (size_t)(wm * 64 + mi * 32 + 4 * (lane >> 5)) * DM + wn * 64 + (lane & 31);
#pragma unroll
    for (int r = 0; r < 16; ++r) {
      const size_t ro = o0 + (size_t)((r & 3) + 8 * (r >> 2)) * DM;
      xv[mi][0][r] = src[ro];
      xv[mi][1][r] = src[ro + 32];
    }
  }
}
DI void resid_store2(f32x16 (&acc)[2][2], const float (&xv)[2][2][16], float* dst, const float* __restrict__ g) {
  const int lane = get_tid() & 63, w = get_tid() >> 6;
  const int wm = w >> 1, wn = w & 1;
  const float g0 = g[wn * 64 + (lane & 31)], g1 = g[wn * 64 + 32 + (lane & 31)];
#pragma unroll
  for (int mi = 0; mi < 2; ++mi) {
    const size_t o0 = (size_t)(wm * 64 + mi * 32 + 4 * (lane >> 5)) * DM + wn * 64 + (lane & 31);
#pragma unroll
    for (int r = 0; r < 16; ++r) {
      const size_t ro = o0 + (size_t)((r & 3) + 8 * (r >> 2)) * DM;
      dst[ro] = xv[mi][0][r] + g0 * acc[mi][0][r];
      dst[ro + 32] = xv[mi][1][r] + g1 * acc[mi][1][r];
    }
  }
}
DI void phase_outproj(const Params& p, int layer, size_t wt_off, int nrows, bool first, char* smem) {
  (void)first;
  bf16* As = (bf16*)smem; bf16* Bs = As + 128 * GLS;
  const bf16* A = (const bf16*)(p.ws + OFF_ACTA);
  const bf16* Wt = (const bf16*)(p.ws + wt_off);
  const int ntn = 8, ntm = nrows / 128;
  for (int t = blockIdx.x; t < ntn * ntm; t += gridDim.x) {
    const int mt = t / ntn, nt = t % ntn;
    f32x16 acc[2][2];
    const int r0 = mt * 128;
    float xv[2][2][16];
    resid_prefetch2(xv, orig_row(p, r0) + nt * 128);
    gemm_128x128(A + (size_t)mt * 128 * DM, DM, Wt + (size_t)nt * 128 * DM, DM, DM, acc, As, Bs);
    resid_store2(acc, xv, res_row(p, r0) + nt * 128, mod_ptr(p, layer, r0, 2) + nt * 128);
  }
}
DI void phase_outproj1(const Params& p, char* smem) {
  bf16* As = (bf16*)smem; bf16* Bs = As + 256 * GLS;
  const bf16* A = (const bf16*)(p.ws + OFF_ACTA);
  const bf16* Wt = (const bf16*)(p.ws + OFF_WT_ODOUT);
  const int ntn = 8, ntm = NLAT / 256;
  for (int t = blockIdx.x; t < ntn * ntm; t += gridDim.x) {
    const int mt = t / ntn, nt = t % ntn;
    f32x16 acc[4][2];
    gemm_256x128(A + (size_t)mt * 256 * DM, DM, Wt + (size_t)nt * 128 * DM, DM, DM, acc, As, Bs);
    float* xp = p.out + (size_t)(mt * 256) * DM + nt * 128;
    resid_epilogue<4>(acc, xp, xp, mod_ptr(p, 1, mt * 256, 2) + nt * 128);
  }
}

DI void tk_ins(float (&L)[16], float x) {
#pragma unroll
  for (int j = 15; j >= 1; --j) L[j] = __builtin_amdgcn_fmed3f(L[j - 1], L[j], x);
  L[0] = fmaxf(L[0], x);
}
DI void tk_insert(float (&v)[16], int (&id)[16], float x, int xi) {
  if (x > v[15]) {
    v[15] = x; id[15] = xi;
#pragma unroll
    for (int j = 15; j > 0; --j) {
      bool sw = v[j] > v[j - 1];
      float a = v[j], b2 = v[j - 1];
      int ia = id[j], ib = id[j - 1];
      v[j - 1] = sw ? a : b2; v[j] = sw ? b2 : a;
      id[j - 1] = sw ? ia : ib; id[j] = sw ? ib : ia;
    }
  }
}

DI void phase_peer_route(const Params& p, int layer, int nrows, char* smem, size_t roff = OFF_RIDX) {
  bf16* As = (bf16*)smem; bf16* Bs = As + 128 * GLS;
  constexpr int QLS = 136;
  bf16* Qt = (bf16*)smem;
  bf16* Kt = Qt + 128 * QLS;
  float* Sc = (float*)smem;
  const bf16* A = (const bf16*)(p.ws + OFF_ACTA);
  const bf16* Wt = (const bf16*)(p.ws + OFF_WT_PWQ) + (size_t)layer * 2048 * 1024;
  const bf16* keys = (const bf16*)(p.ws + OFF_PKEYS) + (size_t)layer * 8 * 2 * 128 * 128;
  int* ridx = (int*)(p.ws + roff);
  float* rgw = (float*)(p.ws + roff + (OFF_RGW - OFF_RIDX));
  const int tid = get_tid(), lane = tid & 63, w = tid >> 6;
  const int wm = w >> 1, wn = w & 1;
  const int ntm = nrows / 128;
  for (int it = blockIdx.x; it < ntm * 8; it += gridDim.x) {
    const int mt = it >> 3, h = it & 7;
    float l0v[16]; int l0i[16];
    float lv[16]; int li[16];
    for (int pp = 0; pp < 2; ++pp) {
      f32x16 acc[2][2];
      gemm_128x128(A + (size_t)mt * 128 * DM, DM, Wt + (size_t)((h * 2 + pp) * 128) * DM, DM, DM, acc, As, Bs);
      __syncthreads();
      gemm_epi(acc, [&](int row, int col, float v) { Qt[row * QLS + col] = f2bf(v); });
      {
        const bf16* kb = keys + (size_t)((h * 2 + pp) * 128) * 128;
#pragma unroll
        for (int i = 0; i < 8; ++i) {
          int ci = i * 256 + tid;
          int row = ci >> 4, chh = ci & 15;
          *(u32x4*)(Kt + row * QLS + chh * 8) = *(const u32x4*)(kb + row * 128 + chh * 8);
        }
      }
      __syncthreads();
      f32x16 sa[2][2];
#pragma unroll
      for (int i = 0; i < 2; ++i)
#pragma unroll
        for (int j = 0; j < 2; ++j) {
#pragma unroll
          for (int r = 0; r < 16; ++r) sa[i][j][r] = 0.f;
          mma_tile(sa[i][j], Qt + (wm * 64 + i * 32) * QLS, QLS, Kt + (wn * 64 + j * 32) * QLS, QLS, 128);
        }
      __syncthreads();
      gemm_epi(sa, [&](int row, int col, float v) { Sc[row * 129 + col] = v; });
      __syncthreads();
      {
        const int tok = tid & 127, hf = tid >> 7;
        float* Lst = Sc + 128 * 129;
        float L[16];
#pragma unroll
        for (int j = 0; j < 16; ++j) L[j] = -3.0e38f;
#pragma unroll 8
        for (int n = 0; n < 64; ++n) {
          const int nn = hf * 64 + n;
          const unsigned kb = (__float_as_uint(Sc[tok * 129 + nn]) & 0xffffff80u) | (unsigned)nn;
          tk_ins(L, __uint_as_float(kb));
        }
        if (hf == 1) {
#pragma unroll
          for (int j = 0; j < 16; ++j) Lst[tok * 17 + j] = L[j];
        }
        __syncthreads();
        if (hf == 0) {
#pragma unroll
          for (int j = 0; j < 16; ++j) tk_ins(L, Lst[tok * 17 + j]);
#pragma unroll
          for (int j = 0; j < 16; ++j) {
            const int ix = (int)(__float_as_uint(L[j]) & 0x7fu);
            li[j] = ix;
            lv[j] = Sc[tok * 129 + ix];
          }
          if (pp == 0) {
#pragma unroll
            for (int j = 0; j < 16; ++j) { l0v[j] = lv[j]; l0i[j] = li[j]; }
          }
        }
      }
      __syncthreads();
    }
    if (tid < 128) {
      float fv[16]; int fi[16];
#pragma unroll
      for (int j = 0; j < 16; ++j) { fv[j] = -3.0e38f; fi[j] = 0; }
#pragma unroll
      for (int a = 0; a < 16; ++a)
#pragma unroll
        for (int b2 = 0; b2 < 16; ++b2)
          if ((a + 1) * (b2 + 1) <= 16) tk_insert(fv, fi, l0v[a] + lv[b2], l0i[a] * 128 + li[b2]);
      float mx = fv[0];
      float e[16];
#pragma unroll
      for (int j = 0; j < 16; ++j) e[j] = fv[j];
      float sum = 0.f;
#pragma unroll
      for (int j = 0; j < 16; ++j) { e[j] = __expf(e[j] - mx); sum += e[j]; }
      const float inv = 1.f / sum;
      const int r = mt * 128 + tid;
      int4* ip = (int4*)(ridx + (size_t)r * 128 + h * 16);
      float4* gp = (float4*)(rgw + (size_t)r * 128 + h * 16);
#pragma unroll
      for (int j = 0; j < 4; ++j) {
        ip[j] = make_int4(fi[4 * j], fi[4 * j + 1], fi[4 * j + 2], fi[4 * j + 3]);
        gp[j] = make_float4(e[4 * j] * inv, e[4 * j + 1] * inv, e[4 * j + 2] * inv, e[4 * j + 3] * inv);
      }
    }
  }
}

typedef float f32x2 __attribute__((ext_vector_type(2)));
DI float wave_max(float v) {
#pragma unroll
  for (int o = 32; o > 0; o >>= 1) v = fmaxf(v, __shfl_xor(v, o));
  return v;
}
DI unsigned pk4_fp8(float a, float b, float c, float d) {
  int r = 0;
  r = __builtin_amdgcn_cvt_pk_fp8_f32(a, b, r, false);
  r = __builtin_amdgcn_cvt_pk_fp8_f32(c, d, r, true);
  return (unsigned)r;
}
DI float clamp6(float v) { return __builtin_amdgcn_fmed3f(v, -6.0f, 6.0f); }
DI void convert_fp8_rows(const float* __restrict__ src, unsigned char* __restrict__ dst, float* __restrict__ scl) {
  const int lane = get_tid() & 63, w = get_tid() >> 6;
  for (int row = blockIdx.x * 4 + w; row < 16384; row += gridDim.x * 4) {
    const float4* s4 = (const float4*)(src + (size_t)row * 1024) + lane * 4;
    float4 v0 = s4[0], v1 = s4[1], v2 = s4[2], v3 = s4[3];
    float ss = v0.x * v0.x + v0.y * v0.y + v0.z * v0.z + v0.w * v0.w + v1.x * v1.x + v1.y * v1.y + v1.z * v1.z + v1.w * v1.w +
               v2.x * v2.x + v2.y * v2.y + v2.z * v2.z + v2.w * v2.w + v3.x * v3.x + v3.y * v3.y + v3.z * v3.z + v3.w * v3.w;
    ss = wave_sum(ss);
    const float sc = (ss > 0.f) ? 0.5f * sqrtf(ss * (1.0f / 1024.0f)) : 1.0f;
    const float inv = 1.0f / sc;
    unsigned d0 = 0, d1 = 0;
    d0 = __builtin_amdgcn_cvt_scalef32_pk_fp4_f32(d0, clamp6(v0.x * inv), clamp6(v0.y * inv), 1.0f, 0);
    d0 = __builtin_amdgcn_cvt_scalef32_pk_fp4_f32(d0, clamp6(v0.z * inv), clamp6(v0.w * inv), 1.0f, 1);
    d0 = __builtin_amdgcn_cvt_scalef32_pk_fp4_f32(d0, clamp6(v1.x * inv), clamp6(v1.y * inv), 1.0f, 2);
    d0 = __builtin_amdgcn_cvt_scalef32_pk_fp4_f32(d0, clamp6(v1.z * inv), clamp6(v1.w * inv), 1.0f, 3);
    d1 = __builtin_amdgcn_cvt_scalef32_pk_fp4_f32(d1, clamp6(v2.x * inv), clamp6(v2.y * inv), 1.0f, 0);
    d1 = __builtin_amdgcn_cvt_scalef32_pk_fp4_f32(d1, clamp6(v2.z * inv), clamp6(v2.w * inv), 1.0f, 1);
    d1 = __builtin_amdgcn_cvt_scalef32_pk_fp4_f32(d1, clamp6(v3.x * inv), clamp6(v3.y * inv), 1.0f, 2);
    d1 = __builtin_amdgcn_cvt_scalef32_pk_fp4_f32(d1, clamp6(v3.z * inv), clamp6(v3.w * inv), 1.0f, 3);
    ((u32x2*)(dst + (size_t)row * 512))[lane] = u32x2{d0, d1};
    if (lane == 0) scl[row] = sc;
  }
}
DI void phase_convert_tables(const Params& p, int layer) {
  convert_fp8_rows(p.peer_u + (size_t)layer * 16384 * 1024, (unsigned char*)(p.ws + OFF_UTAB), (float*)(p.ws + OFF_SU));
  convert_fp8_rows(p.peer_v + (size_t)layer * 16384 * 1024, (unsigned char*)(p.ws + OFF_VTAB), (float*)(p.ws + OFF_SV));
}

struct GBuf { u32x4 u[8]; u32x4 v[8]; float su, sv, gw; };
#define FP4X2(d, s) __builtin_amdgcn_cvt_scalef32_pk_f32_fp4((d), 1.0f, (s))
#define FP4B2(d, s) __builtin_amdgcn_cvt_scalef32_pk_bf16_fp4((d), 1.0f, (s))
typedef __bf16 bf16x2v __attribute__((ext_vector_type(2)));
template <int X> DI float swz_xor(float v) {
  return __builtin_bit_cast(float, __builtin_amdgcn_ds_swizzle(__builtin_bit_cast(int, v), (X << 10) | 0x1f));
}
template <int L> DI float swz_bcast(float v) {
  return __builtin_bit_cast(float, __builtin_amdgcn_ds_swizzle(__builtin_bit_cast(int, v), (L << 5)));
}
DI float wave_sum_swz(float v) {
  v += swz_xor<1>(v); v += swz_xor<2>(v); v += swz_xor<4>(v); v += swz_xor<8>(v); v += swz_xor<16>(v);
  return __builtin_bit_cast(float, __builtin_amdgcn_readlane(__builtin_bit_cast(int, v), 0)) +
         __builtin_bit_cast(float, __builtin_amdgcn_readlane(__builtin_bit_cast(int, v), 32));
}
DI float bperm_f(float v, int byte_idx) { return __builtin_bit_cast(float, __builtin_amdgcn_ds_bpermute(byte_idx, __builtin_bit_cast(int, v))); }
DI void phase_peer_gather(const Params& p, int layer, int nrows, bool dry) {
  const int lane = get_tid() & 63, w = __builtin_amdgcn_readfirstlane(get_tid() >> 6);
  const int half = lane >> 5, l5 = lane & 31;
  const bf16* hb = (const bf16*)(p.ws + OFF_ACTA);
  const unsigned char* ut = (const unsigned char*)(p.ws + OFF_UTAB);
  const unsigned char* vtb = (const unsigned char*)(p.ws + OFF_VTAB);
  const float* su = (const float*)(p.ws + OFF_SU);
  const float* sv = (const float*)(p.ws + OFF_SV);
  const int* ridx = (const int*)(p.ws + OFF_RIDX);
  const float* rgw = (const float*)(p.ws + OFF_RGW);
  const int ecode = half * 8 + ((lane >> 4) & 1) * 4 + ((lane >> 3) & 1) * 2 + ((lane >> 2) & 1);
  for (int r = blockIdx.x * 4 + w; r < nrows; r += gridDim.x * 4) {
    unsigned hp2[16];
    {
      const u32x4* hp = (const u32x4*)(hb + (size_t)r * DM + l5 * 32);
#pragma unroll
      for (int q = 0; q < 4; ++q) {
        u32x4 a = hp[q];
        hp2[4 * q] = a[0]; hp2[4 * q + 1] = a[1]; hp2[4 * q + 2] = a[2]; hp2[4 * q + 3] = a[3];
      }
    }
    const int e_lo = ridx[(size_t)r * 128 + lane], e_hi = ridx[(size_t)r * 128 + 64 + lane];
    const float g_lo = rgw[(size_t)r * 128 + lane], g_hi = rgw[(size_t)r * 128 + 64 + lane];
    f32x2 acc[16];
#pragma unroll
    for (int j = 0; j < 16; ++j) acc[j] = f32x2{0.f, 0.f};
    auto gload = [&](GBuf& B, int kb) {
      const int esrc = (kb < 4) ? e_lo : e_hi;
      const float gsrc = (kb < 4) ? g_lo : g_hi;
      const int base = (kb & 3) * 16;
#pragma unroll
      for (int j = 0; j < 8; ++j) {
        const int ea = __builtin_amdgcn_readlane(esrc, base + j), eb = __builtin_amdgcn_readlane(esrc, base + 8 + j);
        const unsigned off = (unsigned)(half ? eb : ea) * 512u + (unsigned)l5 * 16u;
        B.u[j] = *(const u32x4*)(ut + off);
        B.v[j] = *(const u32x4*)(vtb + off);
      }
      const int el = __builtin_amdgcn_ds_bpermute((base + ecode) << 2, esrc);
      B.su = su[el]; B.sv = sv[el];
      B.gw = bperm_f(gsrc, (base + ecode) << 2);
    };
    auto compute = [&](GBuf& B) {
      float part[8];
#pragma unroll
      for (int j = 0; j < 8; ++j) {
        float s0 = 0.f, s1 = 0.f;
#pragma unroll
        for (int q = 0; q < 4; ++q) {
          s0 = __builtin_amdgcn_fdot2_f32_bf16(FP4B2(B.u[j][q], 0), __builtin_bit_cast(bf16x2v, hp2[4 * q]), s0, false);
          s1 = __builtin_amdgcn_fdot2_f32_bf16(FP4B2(B.u[j][q], 1), __builtin_bit_cast(bf16x2v, hp2[4 * q + 1]), s1, false);
          s0 = __builtin_amdgcn_fdot2_f32_bf16(FP4B2(B.u[j][q], 2), __builtin_bit_cast(bf16x2v, hp2[4 * q + 2]), s0, false);
          s1 = __builtin_amdgcn_fdot2_f32_bf16(FP4B2(B.u[j][q], 3), __builtin_bit_cast(bf16x2v, hp2[4 * q + 3]), s1, false);
        }
        part[j] = s0 + s1;
      }
      const bool b4 = lane & 16, b3 = lane & 8, b2 = lane & 4;
      float y[4], z[2], t;
#pragma unroll
      for (int i = 0; i < 4; ++i) {
        float send = b4 ? part[i] : part[i + 4];
        float keep = b4 ? part[i + 4] : part[i];
        y[i] = keep + swz_xor<16>(send);
      }
#pragma unroll
      for (int i = 0; i < 2; ++i) {
        float send = b3 ? y[i] : y[i + 2];
        float keep = b3 ? y[i + 2] : y[i];
        z[i] = keep + swz_xor<8>(send);
      }
      {
        float send = b2 ? z[0] : z[1];
        float keep = b2 ? z[1] : z[0];
        t = keep + swz_xor<4>(send);
      }
      t += swz_xor<2>(t);
      t += swz_xor<1>(t);
      const float wl = geluf_(t * B.su) * B.gw * B.sv;
#define GACC(J)                                                                                        \
      {                                                                                                  \
        const float wj = swz_bcast<(((J) >> 2) & 1) * 16 + (((J) >> 1) & 1) * 8 + ((J) & 1) * 4>(wl);    \
        const f32x2 w2 = f32x2{wj, wj};                                                                  \
        _Pragma("unroll") for (int q = 0; q < 4; ++q) {                                                  \
          acc[4 * q] += w2 * FP4X2(B.v[J][q], 0);                                                        \
          acc[4 * q + 1] += w2 * FP4X2(B.v[J][q], 1);                                                    \
          acc[4 * q + 2] += w2 * FP4X2(B.v[J][q], 2);                                                    \
          acc[4 * q + 3] += w2 * FP4X2(B.v[J][q], 3);                                                    \
        }                                                                                                \
      }
      GACC(0) GACC(1) GACC(2) GACC(3) GACC(4) GACC(5) GACC(6) GACC(7)
#undef GACC
    };
    GBuf B0, B1;
    gload(B0, 0);
#pragma unroll 1
    for (int kb = 0; kb < 8; kb += 2) {
      gload(B1, kb + 1);
      compute(B0);
      if (kb + 2 < 8) gload(B0, kb + 2);
      compute(B1);
    }
    if (dry && acc[0].x != 12345.678f) continue;
    f32x2 fin[8];
#pragma unroll
    for (int k = 0; k < 8; ++k) {
      f32x2 send = half ? acc[k] : acc[k + 8];
      f32x2 keep = half ? acc[k + 8] : acc[k];
      fin[k] = f32x2{keep.x + bperm_f(send.x, (lane ^ 32) << 2), keep.y + bperm_f(send.y, (lane ^ 32) << 2)};
    }
    int eo = l5 * 32 + half * 16;
    asm volatile("" : "+v"(eo));
    float* xr = res_row(p, r) + eo;
    const float* g5 = mod_ptr(p, layer, r, 5) + eo;
    float4 xn[4];
    float ss = 0.f;
#pragma unroll
    for (int q = 0; q < 4; ++q) {
      float4 x0 = ((float4*)xr)[q];
      float4 m0 = ((const float4*)g5)[q];
      x0.x += m0.x * fin[2 * q].x; x0.y += m0.y * fin[2 * q].y; x0.z += m0.z * fin[2 * q + 1].x; x0.w += m0.w * fin[2 * q + 1].y;
      xn[q] = x0;
      ss += x0.x * x0.x + x0.y * x0.y + x0.z * x0.z + x0.w * x0.w;
    }
    ss = wave_sum_swz(ss);
    const float rs = rsqrtf(ss * (1.0f / 1024.0f) + EPSN);
    if (layer == 0) {
      const float* gg = p.norm1_g + 1024 + eo;
      const float* sh = mod_ptr(p, 1, r, 0) + eo;
      const float* sc = mod_ptr(p, 1, r, 1) + eo;
      unsigned hw[8];
#pragma unroll
      for (int q = 0; q < 4; ++q) {
        ((float4*)xr)[q] = xn[q];
        float4 g4 = ((const float4*)gg)[q], s4 = ((const float4*)sh)[q], c4 = ((const float4*)sc)[q];
        float o0 = xn[q].x * rs * g4.x * (1.f + c4.x) + s4.x;
        float o1 = xn[q].y * rs * g4.y * (1.f + c4.y) + s4.y;
        float o2 = xn[q].z * rs * g4.z * (1.f + c4.z) + s4.z;
        float o3 = xn[q].w * rs * g4.w * (1.f + c4.w) + s4.w;
        hw[2 * q] = cvtpk(o0, o1); hw[2 * q + 1] = cvtpk(o2, o3);
      }
      u32x4 w0 = {hw[0], hw[1], hw[2], hw[3]}, w1 = {hw[4], hw[5], hw[6], hw[7]};
      bf16* hd = (bf16*)(p.ws + OFF_ACTA) + (size_t)r * DM + eo;
      *(u32x4*)hd = w0;
      *(u32x4*)(hd + 8) = w1;
    } else {
      const float* gg = p.final_g + eo;
#pragma unroll
      for (int q = 0; q < 4; ++q) {
        float4 g4 = ((const float4*)gg)[q];
        float4 o;
        o.x = xn[q].x * rs * g4.x; o.y = xn[q].y * rs * g4.y; o.z = xn[q].z * rs * g4.z; o.w = xn[q].w * rs * g4.w;
        ((float4*)xr)[q] = o;
      }
    }
  }
}

DI void phase_inproj1(const Params& p, char* smem) {
  bf16* As = (bf16*)smem; bf16* Bs = As + 256 * GLS;
  const bf16* A = (const bf16*)(p.ws + OFF_ACTA);
  const bf16* Wt = (const bf16*)(p.ws + OFF_WT_ODIN);
  bf16* pm = (bf16*)(p.ws + OFF_PA1M);
  bf16* pu = (bf16*)(p.ws + OFF_U1);
  const int ntn = 10, ntm = NTOK / 256;
  for (int t = blockIdx.x; t < ntn * ntm; t += gridDim.x) {
    const int mt = t / ntn, nt = t % ntn;
    f32x16 acc[4][2];
    gemm_256x128(A + (size_t)mt * 256 * DM, DM, Wt + (size_t)nt * 128 * DM, DM, DM, acc, As, Bs);
    gemm_epi2(acc, [&](int row, int col, float v) {
      int r = mt * 256 + row, cg_ = nt * 128 + col;
      if (cg_ < 672) pm[(size_t)r * 672 + cg_] = f2bf(v);
      else if (cg_ < 1184) pu[(size_t)r * 512 + (cg_ - 672)] = f2bf(v);
    });
  }
}

DI void phase_mla_prep(const Params& p) {
  const int lane = get_tid() & 63, w = get_tid() >> 6;
  const bf16* pm = (const bf16*)(p.ws + OFF_PA1M);
  bf16* qn = (bf16*)(p.ws + OFF_QN);
  bf16* kvn = (bf16*)(p.ws + OFF_KVN);
  bf16* k1 = (bf16*)(p.ws + OFF_K1);
  const float inv = __powf(10000.f, -(float)(lane & 7) / 8.f);
  for (int r = blockIdx.x * 4 + w; r < NTOK; r += gridDim.x * 4) {
    const bf16* row = pm + (size_t)r * 672;
    if (r < NLAT) {
      float v[6]; float ss = 0.f;
#pragma unroll
      for (int i = 0; i < 6; ++i) { v[i] = bf2f(row[i * 64 + lane]); ss += v[i] * v[i]; }
      ss = wave_sum(ss);
      const float rs = rsqrtf(ss * (1.f / 384.f) + EPSN);
#pragma unroll
      for (int i = 0; i < 6; ++i) qn[(size_t)r * 384 + i * 64 + lane] = f2bf(v[i] * rs * p.mla_qa_g[i * 64 + lane]);
    }
    {
      float v[4]; float ss = 0.f;
#pragma unroll
      for (int i = 0; i < 4; ++i) { v[i] = bf2f(row[384 + i * 64 + lane]); ss += v[i] * v[i]; }
      ss = wave_sum(ss);
      const float rs = rsqrtf(ss * (1.f / 256.f) + EPSN);
#pragma unroll
      for (int i = 0; i < 4; ++i) kvn[(size_t)r * 256 + i * 64 + lane] = f2bf(v[i] * rs * p.mla_kva_g[i * 64 + lane]);
    }
    {
      const int cl = lane & 31;
      float y = bf2f(row[640 + cl]);
      float sn = 0.f, cs = 1.f;
      if (r < NLAT) {
        int t = r & 8191;
        float pos = (cl < 16) ? (float)(t >> 6) : (float)(t & 63);
        sincosf(pos * inv, &sn, &cs);
      }
      float pr = __shfl_xor(y, 8);
      float o = y * cs + ((cl & 8) ? pr * sn : -pr * sn);
      bf16 ob = f2bf(o);
      {
        const float ob_f = bf2f(ob);
        const float sq = wave_sum(lane < 32 ? ob_f * ob_f : 0.f);
        if (lane == 0) ((float*)(p.ws + OFF_KRSQ))[r] = sq;
      }
      const int hb = (lane >> 5) * 4;
#pragma unroll
      for (int hh = 0; hh < 4; ++hh) k1[(size_t)r * 768 + (hb + hh) * 96 + 64 + cl] = ob;
    }
  }
}

DI void phase_mla_up(const Params& p, char* smem) {
  bf16* As = (bf16*)smem; bf16* Bs = As + 128 * GLS;
  const bf16* qn = (const bf16*)(p.ws + OFF_QN);
  const bf16* kvn = (const bf16*)(p.ws + OFF_KVN);
  const bf16* wq = (const bf16*)(p.ws + OFF_WT_QUP);
  const bf16* wkv = (const bf16*)(p.ws + OFF_WT_KVUP);
  bf16* q1 = (bf16*)(p.ws + OFF_Q1);
  bf16* k1 = (bf16*)(p.ws + OFF_K1);
  bf16* vt1 = (bf16*)(p.ws + OFF_VT1);
  const float2* rtab = (const float2*)(p.ws + OFF_ROPE1);
  const int lane = get_tid() & 63, w = get_tid() >> 6;
  const int wm = w >> 1, wn = w & 1;
  const int nq = (NLAT / 128) * 6, nkv = (NTOK / 128) * 8;
  for (int t = blockIdx.x; t < nq + nkv; t += gridDim.x) {
    f32x16 acc[2][2];
    if (t < nq) {
      const int mt = t / 6, nt = t % 6;
      gemm_128x128(qn + (size_t)mt * 128 * 384, 384, wq + (size_t)nt * 128 * 384, 384, 384, acc, As, Bs);
#pragma unroll
      for (int mi = 0; mi < 2; ++mi)
#pragma unroll
        for (int ni = 0; ni < 2; ++ni) {
          const int colbase = nt * 128 + wn * 64 + ni * 32;
          const bool rope = (colbase % 96) == 64;
          const int cl = lane & 31;
#pragma unroll
          for (int r = 0; r < 16; ++r) {
            const int row = mt * 128 + wm * 64 + mi * 32 + crow(r, lane);
            float v = acc[mi][ni][r];
            float pr = __shfl_xor(v, 8);
            if (rope) {
              int tt = row & 8191;
              float2 csn = rtab[tt * 16 + ((cl >> 4) << 3) + (cl & 7)];
              v = v * csn.x + ((cl & 8) ? pr * csn.y : -pr * csn.y);
            }
            q1[(size_t)row * 768 + colbase + cl] = f2bf(v * (0.10206207261596577f * 1.4426950408889634f));
          }
        }
    } else {
      const int t2 = t - nq;
      const int mt = t2 >> 3, h = t2 & 7;
      gemm_128x128(kvn + (size_t)mt * 128 * 256, 256, wkv + (size_t)h * 128 * 256, 256, 256, acc, As, Bs);
      const int r0 = mt * 128;
      int b, s0;
      if (r0 < NLAT) { b = r0 >> 13; s0 = CTXL + (r0 & 8191); } else { int rc = r0 - NLAT; b = rc >> 8; s0 = rc & 255; }
#pragma unroll
      for (int mi = 0; mi < 2; ++mi)
#pragma unroll
        for (int ni = 0; ni < 2; ++ni) {
          const int cl = ni * 32 + (lane & 31);
          if (wn == 0) {
#pragma unroll
            for (int r = 0; r < 16; ++r) {
              const int row = r0 + wm * 64 + mi * 32 + crow(r, lane);
              k1[(size_t)row * 768 + h * 96 + cl] = f2bf(acc[mi][ni][r]);
            }
            if (ni == 1) {
              float mxk = 0.f;
#pragma unroll
              for (int r = 0; r < 16; ++r) {
                float sq = acc[mi][0][r] * acc[mi][0][r] + acc[mi][1][r] * acc[mi][1][r];
                sq += __shfl_xor(sq, 16); sq += __shfl_xor(sq, 8); sq += __shfl_xor(sq, 4); sq += __shfl_xor(sq, 2); sq += __shfl_xor(sq, 1);
                const int row = r0 + wm * 64 + mi * 32 + crow(r, lane);
                sq += ((const float*)(p.ws + OFF_KRSQ))[row];
                mxk = fmaxf(mxk, sq);
              }
              mxk = wave_max(mxk);
              if (lane == 0) atomicMax((unsigned*)(p.ws + OFF_KMAX) + b * 8 + h, __float_as_uint(sqrtf(mxk) * 1.02f));
            }
          } else {
            bf16* vrow = vt1 + (size_t)((b * 8 + h) * 64 + cl) * SKEYS + s0 + wm * 64 + mi * 32;
#pragma unroll
            for (int g4 = 0; g4 < 4; ++g4) {
              u32x2 o;
              o.x = cvtpk(acc[mi][ni][4 * g4], acc[mi][ni][4 * g4 + 1]);
              o.y = cvtpk(acc[mi][ni][4 * g4 + 2], acc[mi][ni][4 * g4 + 3]);
              *(u32x2*)(vrow + 8 * g4 + 4 * (lane >> 5)) = o;
            }
          }
        }
    }
  }
}

DI void s5_item(const Params& p, int item, char* smem) {
  const int dir = item & 1, g = (item >> 1) & 31, b = item >> 6;
  constexpr int ULS = 264, SLS = 136;
  bf16* Uc = (bf16*)smem;
  bf16* Sp = Uc + 32 * ULS;
  float* E = (float*)(Sp + 32 * SLS);
  const int mi_ = g * 2 + dir;
  const bf16* T = (const bf16*)(p.ws + OFF_S5T) + (size_t)mi_ * 65536;
  const bf16* WE = (const bf16*)(p.ws + OFF_S5WE) + (size_t)mi_ * 32768;
  const bf16* WY = (const bf16*)(p.ws + OFF_S5WY) + (size_t)mi_ * 32768;
  const float* A16 = (const float*)(p.ws + OFF_S5A16) + (size_t)mi_ * 128;
  const bf16* U1 = (const bf16*)(p.ws + OFF_U1);
  bf16* ys = (bf16*)(p.ws + OFF_YS5) + (size_t)dir * NLAT * 512;
  const int tid = get_tid(), lane = tid & 63, w = tid >> 6;
  auto rowof = [&](int pos) -> int {
    if (pos < CTXL) { int s = dir ? (CTXL - 1 - pos) : pos; return NLAT + b * CTXL + s; }
    int t = pos - CTXL; t = dir ? (SEQ - 1 - t) : t; return b * SEQ + t;
  };
  float sre = 0.f, sim = 0.f;
  const float a16r = A16[(lane & 63) * 2], a16i = A16[(lane & 63) * 2 + 1];
  for (int sc = 0; sc < 17; ++sc) {
    const int nvalid = (528 - sc * 32) < 32 ? (528 - sc * 32) : 32;
    __syncthreads();
    {
      const int n = tid >> 3, j0 = (tid & 7) * 2;
#pragma unroll
      for (int jj = 0; jj < 2; ++jj) {
        u32x4 a = {0u, 0u, 0u, 0u}, b2 = {0u, 0u, 0u, 0u};
        if (n < nvalid) {
          const int pos = (sc * 32 + n) * 16 + j0 + jj;
          const bf16* src = U1 + (size_t)rowof(pos) * 512 + g * 16;
          a = *(const u32x4*)src; b2 = *(const u32x4*)(src + 8);
        }
        *(u32x4*)(Uc + n * ULS + (j0 + jj) * 16) = a;
        *(u32x4*)(Uc + n * ULS + (j0 + jj) * 16 + 8) = b2;
      }
    }
    __syncthreads();
    f32x16 e, y0, y1;
#pragma unroll
    for (int r = 0; r < 16; ++r) { e[r] = 0.f; y0[r] = 0.f; y1[r] = 0.f; }
    mma_tile_ga<256>(e, WE + (size_t)(w * 32) * 256, 256, Uc, ULS);
#pragma unroll
    for (int r = 0; r < 16; ++r) E[(w * 32 + crow(r, lane)) * 33 + (lane & 31)] = e[r];
    mma_tile_ga<256>(y0, T + (size_t)(2 * w * 32) * 256, 256, Uc, ULS);
    mma_tile_ga<256>(y1, T + (size_t)((2 * w + 1) * 32) * 256, 256, Uc, ULS);
    __syncthreads();
    if (w == 0) {
      for (int n = 0; n < 32; ++n) {
        Sp[n * SLS + lane] = f2bf(sre);
        Sp[n * SLS + 64 + lane] = f2bf(sim);
        float er = E[lane * 33 + n], ei = E[(64 + lane) * 33 + n];
        float nr = a16r * sre - a16i * sim + er;
        float ni = a16r * sim + a16i * sre + ei;
        sre = nr; sim = ni;
      }
    }
    __syncthreads();
    mma_tile_ga<128>(y0, WY + (size_t)(2 * w * 32) * 128, 128, Sp, SLS);
    mma_tile_ga<128>(y1, WY + (size_t)((2 * w + 1) * 32) * 128, 128, Sp, SLS);
    {
      const int n = lane & 31;
      if (n < nvalid) {
        const int cgi = sc * 32 + n;
#pragma unroll
        for (int tI = 0; tI < 2; ++tI) {
          const f32x16& y = tI ? y1 : y0;
#pragma unroll
          for (int g4 = 0; g4 < 4; ++g4) {
            const int m = (2 * w + tI) * 32 + 8 * g4 + 4 * (lane >> 5);
            const int i = m >> 4, c0 = m & 15;
            const int pos = cgi * 16 + i;
            if (pos >= CTXL) {
              u32x2 o;
              o.x = cvtpk(y[4 * g4], y[4 * g4 + 1]);
              o.y = cvtpk(y[4 * g4 + 2], y[4 * g4 + 3]);
              *(u32x2*)(ys + (size_t)rowof(pos) * 512 + g * 16 + c0) = o;
            }
          }
        }
      }
    }
  }
}

DI void phase_mix1(const Params& p, char* smem, int cidx) {
  __shared__ int s_item1;
  if (cidx == 1 && blockIdx.x < 256) s5_item(p, blockIdx.x, smem);
  unsigned* cnt = (unsigned*)(p.ws + OFF_CNT) + cidx;
  const bf16* q1 = (const bf16*)(p.ws + OFF_Q1);
  const bf16* k1 = (const bf16*)(p.ws + OFF_K1);
  const bf16* vt = (const bf16*)(p.ws + OFF_VT1);
  bf16* ycat = (bf16*)(p.ws + OFF_ACTA);
  const int n_lat = 4 * 8 * 32;
  while (true) {
    __syncthreads();
    if (get_tid() == 0) s_item1 = (int)atomicAdd(cnt, 1u);
    __syncthreads();
    const int it = s_item1;
    if (it >= n_lat) break;
    const int qt = it & 31, h = (it >> 5) & 7, b = it >> 8;
    const int r0 = b * SEQ + qt * 256;
    attn_item<96, 2>(q1 + (size_t)r0 * 768 + h * 96, 768, k1 + (size_t)(NLAT + b * CTXL) * 768 + h * 96,
                  k1 + (size_t)(b * SEQ) * 768 + h * 96, 768, vt + (size_t)((b * 8 + h) * 64) * SKEYS, SKEYS,
                  ycat + (size_t)r0 * DM + h * 64, DM, 0.10206207261596577f, smem, ((const float*)(p.ws + OFF_KMAX))[b * 8 + h]);
  }
}

DI void phase_s5_z(const Params& p) {
  const bf16* U1 = (const bf16*)(p.ws + OFF_U1);
  const bf16* y0 = (const bf16*)(p.ws + OFF_YS5);
  const bf16* y1 = y0 + (size_t)NLAT * 512;
  bf16* z = (bf16*)(p.ws + OFF_Z1);
  const size_t nv = (size_t)NLAT * 512 / 8;
  for (size_t i = (size_t)blockIdx.x * 256 + get_tid(); i < nv; i += (size_t)gridDim.x * 256) {
    const int col = (int)(i & 63) * 8;
    u32x4 u = ((const u32x4*)U1)[i], a = ((const u32x4*)y0)[i], b2 = ((const u32x4*)y1)[i];
    float fu[8], fa[8], fb[8], o[8];
    f32x16 dummy; (void)dummy;
    fu[0] = bflo(u.x); fu[1] = bfhi(u.x); fu[2] = bflo(u.y); fu[3] = bfhi(u.y); fu[4] = bflo(u.z); fu[5] = bfhi(u.z); fu[6] = bflo(u.w); fu[7] = bfhi(u.w);
    fa[0] = bflo(a.x); fa[1] = bfhi(a.x); fa[2] = bflo(a.y); fa[3] = bfhi(a.y); fa[4] = bflo(a.z); fa[5] = bfhi(a.z); fa[6] = bflo(a.w); fa[7] = bfhi(a.w);
    fb[0] = bflo(b2.x); fb[1] = bfhi(b2.x); fb[2] = bflo(b2.y); fb[3] = bfhi(b2.y); fb[4] = bflo(b2.z); fb[5] = bfhi(b2.z); fb[6] = bflo(b2.w); fb[7] = bfhi(b2.w);
#pragma unroll
    for (int j = 0; j < 8; ++j) o[j] = geluf_(p.s5_d[col + j] * fu[j] + fa[j] + fb[j]);
    u32x4 ov;
    ov.x = cvtpk(o[0], o[1]); ov.y = cvtpk(o[2], o[3]); ov.z = cvtpk(o[4], o[5]); ov.w = cvtpk(o[6], o[7]);
    ((u32x4*)z)[i] = ov;
  }
}

DI void phase_glu(const Params& p, char* smem) {
  bf16* As = (bf16*)smem; bf16* Bs = As + 256 * GLS;
  const bf16* z = (const bf16*)(p.ws + OFF_Z1);
  const bf16* Wt = (const bf16*)(p.ws + OFF_WT_GLU);
  bf16* ycat = (bf16*)(p.ws + OFF_ACTA);
  const int ntn = 4, ntm = NLAT / 256;
  for (int t = blockIdx.x; t < ntn * ntm; t += gridDim.x) {
    const int mt = t / ntn, nt = t % ntn;
    f32x16 acc[4][2];
    gemm_256x128(z + (size_t)mt * 256 * 512, 512, Wt + (size_t)nt * 128 * 512, 512, 512, acc, As, Bs);
    gemm_epi2(acc, [&](int row, int col, float v) {
      int r = mt * 256 + row, cc = nt * 128 + col;
      float zz = bf2f(z[(size_t)r * 512 + cc]);
      ycat[(size_t)r * DM + 512 + cc] = f2bf(zz * sigmoidf_(v + p.s5_b_glu[cc]));
    });
  }
}

DI void phase_final(const Params& p) {
  const int lane = get_tid() & 63, w = get_tid() >> 6;
  for (int r = blockIdx.x * 4 + w; r < NLAT; r += gridDim.x * 4) {
    float* row = p.out + (size_t)r * DM;
    float4 v[4];
    float ss = 0.f;
#pragma unroll
    for (int i = 0; i < 4; ++i) {
      v[i] = ((const float4*)row)[i * 64 + lane];
      ss += v[i].x * v[i].x + v[i].y * v[i].y + v[i].z * v[i].z + v[i].w * v[i].w;
    }
    ss = wave_sum(ss);
    const float rs = rsqrtf(ss * (1.0f / 1024.0f) + EPSN);
#pragma unroll
    for (int i = 0; i < 4; ++i) {
      float4 gg = ((const float4*)p.final_g)[i * 64 + lane];
      float4 o;
      o.x = v[i].x * rs * gg.x; o.y = v[i].y * rs * gg.y; o.z = v[i].z * rs * gg.z; o.w = v[i].w * rs * gg.w;
      ((float4*)row)[i * 64 + lane] = o;
    }
  }
}

DI void phase_copy_x(const Params& p) {
  const size_t n4 = (size_t)NLAT * DM / 4;
  for (size_t i = (size_t)blockIdx.x * 256 + get_tid(); i < n4; i += (size_t)gridDim.x * 256)
    ((float4*)p.out)[i] = ((const float4*)p.x)[i];
}

#define XB_TMO      128
#define XB_XCNT(j)  (256  + 64 * (j))
#define XB_XSUB(j)  (1280 + 64 * (j))
#define XB_XGEN(j)  (2304 + 64 * (j))
#define XB_TOP      3328
#define XB_TOPGEN   3392
#define XCD_BAR_WORDS 3456
#define XB_SPIN_CAP (1u << 22)
#define LAS __attribute__((address_space(3)))

__device__ __forceinline__ unsigned xb_ld(unsigned* p)              { return __hip_atomic_load(p, __ATOMIC_RELAXED, __HIP_MEMORY_SCOPE_AGENT); }
__device__ __forceinline__ unsigned xb_add(unsigned* p, unsigned v) { return __hip_atomic_fetch_add(p, v, __ATOMIC_RELAXED, __HIP_MEMORY_SCOPE_AGENT); }
__device__ __forceinline__ unsigned xb_xcc_id() { return (unsigned)__builtin_amdgcn_s_getreg((3 << 11) | 20) & 0xFu; }
#define XB_SPIN(cond, bar) do { unsigned _sp = 0; while (cond) { __builtin_amdgcn_s_sleep(1); \
    if ((++_sp & 255u) == 0u) { if (xb_ld(&(bar)[XB_TMO])) break; if (_sp > XB_SPIN_CAP) { atomicAdd(&(bar)[XB_TMO], 1u); break; } } } } while (0)

struct XcdBarrier {
    unsigned* bar; unsigned x;
    volatile LAS unsigned* st;
};

__device__ __forceinline__ XcdBarrier xcd_barrier_post(unsigned* bar, volatile LAS unsigned* st) {
    XcdBarrier b; b.bar = bar; b.x = xb_xcc_id(); b.st = st;
    if (threadIdx.x == 0) (void)xb_add(&bar[XB_XCNT(b.x)], 1u);
    return b;
}
__device__ __forceinline__ void xcd_barrier_complete(unsigned* bar, unsigned x, unsigned& nloc, unsigned& nx) {
    const unsigned G = gridDim.x * gridDim.y * gridDim.z;
    unsigned sum, cnt, mine, sp = 0u;
    for (;;) {
        sum = 0u; cnt = 0u; mine = 0u;
#pragma unroll
        for (unsigned j = 0; j < 16; ++j) { const unsigned c = xb_ld(&bar[XB_XCNT(j)]); sum += c; cnt += (c > 0u) ? 1u : 0u; mine = (j == x) ? c : mine; }
        if (sum == G) break;
        __builtin_amdgcn_s_sleep(1);
        if ((++sp & 255u) == 0u) { if (xb_ld(&bar[XB_TMO])) break; if (sp > XB_SPIN_CAP) { atomicAdd(&bar[XB_TMO], 1u); break; } }
    }
    nloc = mine > 0u ? mine : 1u; nx = cnt > 0u ? cnt : 1u;
}

__device__ __forceinline__ void xcd_barrier(const XcdBarrier& b) {
    asm volatile("s_waitcnt vmcnt(0)" ::: "memory");
    __syncthreads();
    if (threadIdx.x == 0) {
        unsigned* bar = b.bar;
        __builtin_amdgcn_s_waitcnt(0);
        unsigned nloc = b.st[0], nx = b.st[1];
        if (nloc == 0u) { xcd_barrier_complete(bar, b.x, nloc, nx); b.st[0] = nloc; b.st[1] = nx; }
        const unsigned old = xb_add(&bar[XB_XSUB(b.x)], 1u);
        const unsigned gen = old / nloc;
        if (old + 1u == (gen + 1u) * nloc) {
            __builtin_amdgcn_fence(__ATOMIC_RELEASE, "agent");
            asm volatile("s_waitcnt vmcnt(0)" ::: "memory");
            const unsigned og = xb_add(&bar[XB_TOP], 1u);
            const unsigned tg = og / nx;
            if (og + 1u == (tg + 1u) * nx) xb_add(&bar[XB_TOPGEN], 1u);
            else XB_SPIN(xb_ld(&bar[XB_TOPGEN]) == tg, bar);
            __builtin_amdgcn_fence(__ATOMIC_ACQUIRE, "agent");
            xb_add(&bar[XB_XGEN(b.x)], 1u);
            asm volatile("s_waitcnt vmcnt(0)" ::: "memory");
        } else {
            XB_SPIN(xb_ld(&bar[XB_XGEN(b.x)]) == gen, bar);
            __builtin_amdgcn_fence(__ATOMIC_ACQUIRE, "agent");
            asm volatile("s_waitcnt vmcnt(0)" ::: "memory");
        }
    }
    __syncthreads();
}
__device__ __forceinline__ void xcd_barrier_fast(const XcdBarrier& b) {
    asm volatile("s_waitcnt vmcnt(0)" ::: "memory");
    __syncthreads();
    if (threadIdx.x == 0) {
        unsigned* bar = b.bar;
        __builtin_amdgcn_s_waitcnt(0);
        unsigned nloc = b.st[0], nx = b.st[1];
        const unsigned old = xb_add(&bar[XB_XSUB(b.x)], 1u);
        const unsigned gen = old / nloc;
        if (old + 1u == (gen + 1u) * nloc) {
            __builtin_amdgcn_fence(__ATOMIC_RELEASE, "agent");
            asm volatile("s_waitcnt vmcnt(0)" ::: "memory");
            const unsigned og = xb_add(&bar[XB_TOP], 1u);
            const unsigned tg = og / nx;
            if (og + 1u == (tg + 1u) * nx) xb_add(&bar[XB_TOPGEN], 1u);
            else XB_SPIN(xb_ld(&bar[XB_TOPGEN]) == tg, bar);
            __builtin_amdgcn_fence(__ATOMIC_ACQUIRE, "agent");
            xb_add(&bar[XB_XGEN(b.x)], 1u);
            asm volatile("s_waitcnt vmcnt(0)" ::: "memory");
        } else {
            XB_SPIN(xb_ld(&bar[XB_XGEN(b.x)]) == gen, bar);
            __builtin_amdgcn_fence(__ATOMIC_ACQUIRE, "agent");
            asm volatile("s_waitcnt vmcnt(0)" ::: "memory");
        }
    }
    __syncthreads();
}


DI void gsync(cg::grid_group& grid) {
  asm volatile("s_waitcnt vmcnt(0) lgkmcnt(0)" ::: "memory");
  __syncthreads();
  if (threadIdx.x == 0) {
    __builtin_amdgcn_fence(__ATOMIC_RELEASE, "agent");
    asm volatile("s_waitcnt vmcnt(0)" ::: "memory");
  }
  grid.sync();
  if (threadIdx.x == 0) {
    __builtin_amdgcn_fence(__ATOMIC_ACQUIRE, "agent");
    asm volatile("s_waitcnt vmcnt(0)" ::: "memory");
  }
  __syncthreads();
}

DI Params load_params() {
  Params r{};
#if defined(__HIP_DEVICE_COMPILE__)
  const __attribute__((address_space(4))) unsigned long long* q =
      (const __attribute__((address_space(4))) unsigned long long*)__builtin_amdgcn_kernarg_segment_ptr();
  asm volatile("" : "+s"(q));
  unsigned long long* d = (unsigned long long*)&r;
  static_assert(sizeof(Params) % 8 == 0, "Params size");
#pragma unroll
  for (int i = 0; i < (int)(sizeof(Params) / 8); ++i) d[i] = q[i];
#endif
  return r;
}
#define P_ p
__global__ void __launch_bounds__(256, 2) fwd_megakernel(Params p) {
  cg::grid_group grid = cg::this_grid();
  __shared__ __attribute__((aligned(16))) char smem[SMEM_BYTES];
  __shared__ uint4 xb_words;
  if (threadIdx.x == 0) xb_words = make_uint4(0u, 0u, 0u, 0u);
  __syncthreads();
  XcdBarrier xb;
  { const Params lp = P_; xb = xcd_barrier_post((unsigned*)(lp.ws + OFF_BAR), (volatile LAS unsigned*)&xb_words); }
  { const Params lp = P_; phase_prep(lp, smem); }
  xcd_barrier(xb);
  { const Params lp = P_; phase_norm(lp, 0, true, lp.norm1_g, 0, NTOK); }
  xcd_barrier_fast(xb);
  { const Params lp = P_; phase_inproj0(lp, smem); }
  xcd_barrier_fast(xb);
  { const Params lp = P_; phase_gqa_prep(lp, smem); }
  xcd_barrier_fast(xb);
  { const Params lp = P_; phase_mix0(lp, smem, 0); }
  xcd_barrier_fast(xb);
  { const Params lp = P_; phase_hg_readout(lp); }
  xcd_barrier_fast(xb);
  { const Params lp = P_; phase_outproj(lp, 0, OFF_WT_EVOUT, NTOK, true, smem); }
  xcd_barrier_fast(xb);
#if STAGE_LIMIT >= 2
  { const Params lp = P_; phase_norm(lp, 0, false, lp.norm2_g, 3, NTOK); }
  { const Params lp = P_; phase_convert_tables(lp, 0); }
  xcd_barrier_fast(xb);
  { const Params lp = P_; phase_peer_route(lp, 0, NTOK, smem); }
  xcd_barrier_fast(xb);
  { const Params lp = P_; phase_peer_gather(lp, 0, NTOK, false); }
  xcd_barrier_fast(xb);
#endif
#if STAGE_LIMIT >= 3
  { const Params lp = P_; phase_inproj1(lp, smem); }
  xcd_barrier_fast(xb);
  { const Params lp = P_; phase_mla_prep(lp); }
  xcd_barrier_fast(xb);
  { const Params lp = P_; phase_mla_up(lp, smem); }
  xcd_barrier_fast(xb);
  { const Params lp = P_; phase_mix1(lp, smem, 1); }
  xcd_barrier_fast(xb);
  { const Params lp = P_; phase_s5_z(lp); }
  xcd_barrier_fast(xb);
  { const Params lp = P_; phase_glu(lp, smem); }
  xcd_barrier_fast(xb);
  { const Params lp = P_; phase_outproj1(lp, smem); }
  xcd_barrier_fast(xb);
#endif
#if STAGE_LIMIT >= 4
  { const Params lp = P_; phase_norm(lp, 1, false, lp.norm2_g + 1024, 3, NLAT); }
  { const Params lp = P_; phase_convert_tables(lp, 1); }
  xcd_barrier_fast(xb);
  { const Params lp = P_; phase_peer_route(lp, 1, NLAT, smem); }
  xcd_barrier_fast(xb);
  { const Params lp = P_; phase_peer_gather(lp, 1, NLAT, false); }
#endif
}

extern "C" void kernel_launch(void* const* d_in, const int* in_sizes, int n_in, void* d_out, int out_size, void* d_ws,
                              size_t ws_size, hipStream_t stream) {
  static int grid_blocks = 0;
  if (!grid_blocks) {
    int dev = 0, cus = 0, per_cu = 0;
    (void)hipGetDevice(&dev);
    (void)hipDeviceGetAttribute(&cus, hipDeviceAttributeMultiprocessorCount, dev);
    (void)hipOccupancyMaxActiveBlocksPerMultiprocessor(&per_cu, fwd_megakernel, 256, 0);
    if (per_cu > 2) per_cu = 2;
    if (per_cu < 1) per_cu = 1;
    grid_blocks = cus * per_cu;
  }
  Params p{};
  const float** pp = (const float**)&p;
  for (int i = 0; i < 35; ++i) pp[i] = (const float*)d_in[i];
  p.out = (float*)d_out;
  p.ws = (char*)d_ws;
  p.rep_mix = REP_MIX; p.rep_route = REP_ROUTE; p.rep_gdry = REP_GDRY; p.rep_gemm = REP_GEMM;
  (void)hipMemsetAsync((char*)d_ws + OFF_CNT, 0, 256 + 16384, stream);
  void* args[] = {&p};
  hipError_t e = hipLaunchCooperativeKernel((void*)fwd_megakernel, dim3(grid_blocks), dim3(256), args, 0, stream);
  if (e != hipSuccess) fprintf(stderr, "cooperative launch failed: %s (grid %d)\n", hipGetErrorString(e), grid_blocks);
}
```

```cpp
#include <hip/hip_runtime.h>
#include <hip/hip_cooperative_groups.h>
#include <cstdio>
namespace cg = cooperative_groups;

#ifndef STAGE_LIMIT
#define STAGE_LIMIT 99
#endif
#define REP_MIX 1
#define REP_ROUTE 1
#define REP_GDRY 0
#define REP_GEMM 1

typedef unsigned short bf16;
typedef __attribute__((ext_vector_type(8))) short bf16x8;
typedef __attribute__((ext_vector_type(4))) short bf16x4;
typedef __attribute__((ext_vector_type(16))) float f32x16;
typedef float f32x2_t __attribute__((ext_vector_type(2)));
typedef unsigned u32x4 __attribute__((ext_vector_type(4)));
typedef unsigned u32x2 __attribute__((ext_vector_type(2)));
typedef __bf16 bf16x2_t __attribute__((ext_vector_type(2)));

#define DI __device__ __forceinline__
#define MFMA32(a, b, c) __builtin_amdgcn_mfma_f32_32x32x16_bf16((a), (b), (c), 0, 0, 0)

constexpr int NLAT = 32768, NCTX = 1024, NTOK = 33792, DM = 1024;
constexpr int SEQ = 8192, CTXL = 256, SKEYS = 8448;
constexpr float EPSN = 1e-6f;

constexpr size_t al256(size_t x) { return (x + 255) & ~(size_t)255; }
constexpr size_t OFF_WT_EVIN = 0;
constexpr size_t OFF_WT_EVOUT = OFF_WT_EVIN + al256((size_t)3328 * 1024 * 2);
constexpr size_t OFF_WT_ODIN = OFF_WT_EVOUT + al256((size_t)1024 * 1024 * 2);
constexpr size_t OFF_WT_ODOUT = OFF_WT_ODIN + al256((size_t)1280 * 1024 * 2);
constexpr size_t OFF_WT_QUP = OFF_WT_ODOUT + al256((size_t)1024 * 1024 * 2);
constexpr size_t OFF_WT_KVUP = OFF_WT_QUP + al256((size_t)768 * 384 * 2);
constexpr size_t OFF_WT_GLU = OFF_WT_KVUP + al256((size_t)1024 * 256 * 2);
constexpr size_t OFF_WT_PWQ = OFF_WT_GLU + al256((size_t)512 * 512 * 2);
constexpr size_t OFF_PKEYS = OFF_WT_PWQ + al256((size_t)2 * 2048 * 1024 * 2);
constexpr size_t OFF_MOD = OFF_PKEYS + al256((size_t)2 * 8 * 2 * 128 * 128 * 2);
constexpr size_t OFF_S5T = OFF_MOD + al256((size_t)2 * 5 * 6144 * 4);
constexpr size_t OFF_S5WE = OFF_S5T + al256((size_t)64 * 256 * 256 * 2);
constexpr size_t OFF_S5WY = OFF_S5WE + al256((size_t)64 * 128 * 256 * 2);
constexpr size_t OFF_S5A16 = OFF_S5WY + al256((size_t)64 * 256 * 128 * 2);
constexpr size_t OFF_CNT = OFF_S5A16 + al256((size_t)64 * 64 * 2 * 4);
constexpr size_t OFF_BAR = OFF_CNT + 256;
constexpr size_t OFF_ROPE1 = OFF_BAR + 16384;
constexpr size_t OFF_SU = OFF_ROPE1 + al256((size_t)8192 * 16 * 8);
constexpr size_t OFF_SV = OFF_SU + 65536;
constexpr size_t OFF_KMAX = OFF_SV + 65536;
constexpr size_t OFF_KRSQ = OFF_KMAX + 256;
constexpr size_t OFF_XC = OFF_KRSQ + al256((size_t)NTOK * 4);
constexpr size_t OFF_UTAB = OFF_XC + al256((size_t)NCTX * DM * 4);
constexpr size_t OFF_VTAB = OFF_UTAB + al256((size_t)16384 * 1024 * 2);
constexpr size_t OFF_ACTA = OFF_VTAB + al256((size_t)16384 * 1024 * 2);
constexpr size_t OFF_BIG = OFF_ACTA + al256((size_t)NTOK * DM * 2);
constexpr size_t OFF_PAGQA = OFF_BIG;
constexpr size_t OFF_VT0 = OFF_PAGQA + al256((size_t)NTOK * 768 * 2);
constexpr size_t OFF_PAHG = OFF_VT0 + al256((size_t)512 * SKEYS * 2);
constexpr size_t OFF_OHG = OFF_PAHG + al256((size_t)NTOK * 2560 * 2);
constexpr size_t OFF_END0 = OFF_OHG + al256((size_t)2 * NTOK * 512 * 2);
constexpr size_t OFF_K1 = OFF_BIG;
constexpr size_t OFF_PA1M = OFF_K1 + al256((size_t)NTOK * 768 * 2);
constexpr size_t OFF_Q1 = OFF_PA1M;
constexpr size_t OFF_U1 = OFF_PA1M + al256((size_t)NTOK * 768 * 2);
constexpr size_t OFF_QN = OFF_U1 + al256((size_t)NTOK * 512 * 2);
constexpr size_t OFF_KVN = OFF_QN + al256((size_t)NLAT * 384 * 2);
constexpr size_t OFF_Z1 = OFF_QN;
constexpr size_t OFF_KROPE = OFF_KVN + al256((size_t)NTOK * 256 * 2);
constexpr size_t OFF_VT1 = OFF_KROPE + al256((size_t)NTOK * 32 * 2);
constexpr size_t OFF_YS5 = OFF_VT1 + al256((size_t)2048 * SKEYS * 2);
constexpr size_t OFF_END1 = OFF_YS5 + al256((size_t)2 * NLAT * 512 * 2);
constexpr size_t OFF_RIDX = OFF_BIG;
constexpr size_t OFF_RGW = OFF_RIDX + al256((size_t)NTOK * 128 * 4);
constexpr size_t WS_NEEDED = (OFF_END0 > OFF_END1 ? OFF_END0 : OFF_END1);
static_assert(OFF_RGW + (size_t)NTOK * 128 * 4 <= OFF_VT0, "route alias overflow");
static_assert((size_t)NLAT * 512 * 2 <= (OFF_KROPE - OFF_QN), "z alias overflow");
static_assert(WS_NEEDED < (size_t)500 * 1024 * 1024, "workspace too large");

constexpr int SMEM_BYTES = 78 * 1024;

struct Params {
  const float *x, *c, *ctx, *c_ctx, *ada_w, *ada_b, *norm1_g, *norm2_g, *ev_w_in, *ev_w_out, *gqa_qn_g, *gqa_kn_g,
      *hg_lb_logits, *hg_onorm_g, *od_w_in, *od_w_out, *mla_qa_g, *mla_w_qup, *mla_kva_g, *mla_w_kvup, *s5_a_re, *s5_a_im,
      *s5_log_dt, *s5_b_re, *s5_b_im, *s5_c_re, *s5_c_im, *s5_d, *s5_w_glu, *s5_b_glu, *peer_wq, *peer_keys, *peer_u,
      *peer_v, *final_g;
  float* out;
  char* ws;
  int rep_mix, rep_route, rep_gdry, rep_gemm;
};

DI int get_tid() { int t = threadIdx.x; asm volatile("" : "+v"(t)); return t; }
DI bf16 f2bf(float x) {
  unsigned u = __float_as_uint(x);
  u += 0x7fffu + ((u >> 16) & 1u);
  return (bf16)(u >> 16);
}
DI float bf2f(bf16 h) { return __uint_as_float(((unsigned)h) << 16); }
DI unsigned cvtpk(float lo, float hi) {
  f32x2_t v = {lo, hi};
  bf16x2_t b = __builtin_convertvector(v, bf16x2_t);
  return __builtin_bit_cast(unsigned, b);
}
DI float bflo(unsigned u) { return __uint_as_float(u << 16); }
DI float bfhi(unsigned u) { return __uint_as_float(u & 0xffff0000u); }
DI float wave_sum(float v) {
#pragma unroll
  for (int o = 32; o > 0; o >>= 1) v += __shfl_xor(v, o);
  return v;
}
DI float wave_max_early(float v) {
#pragma unroll
  for (int o = 32; o > 0; o >>= 1) v = fmaxf(v, __shfl_xor(v, o));
  return v;
}
DI float sigmoidf_(float x) { return 1.0f / (1.0f + __expf(-x)); }
DI float siluf_(float x) { return x * sigmoidf_(x); }
DI float geluf_(float x) { return 0.5f * x * (1.0f + erff(x * 0.70710678118654752f)); }

DI const float* orig_row(const Params& p, int r) {
  return r < NLAT ? p.x + (size_t)r * DM : p.ctx + (size_t)(r - NLAT) * DM;
}
DI float* res_row(const Params& p, int r) {
  return r < NLAT ? p.out + (size_t)r * DM : (float*)(p.ws + OFF_XC) + (size_t)(r - NLAT) * DM;
}
DI int mod_row(int r) { return r < NLAT ? (r >> 13) : 4; }
DI const float* mod_ptr(const Params& p, int layer, int r, int chunk) {
  return (const float*)(p.ws + OFF_MOD) + ((size_t)(layer * 5 + mod_row(r)) * 6 + chunk) * 1024;
}

constexpr int GLS = 72;
DI void gemm_128x128(const bf16* __restrict__ A, int lda, const bf16* __restrict__ Bt, int ldb, int K, f32x16 (&acc)[2][2],
                     bf16* As, bf16* Bs) {
  const int tid = get_tid(), lane = tid & 63, w = tid >> 6;
  const int wm = w >> 1, wn = w & 1;
  const int lr = tid >> 3, lc = (tid & 7) * 8;
  u32x4 ra[4], rb[4];
#pragma unroll
  for (int i = 0; i < 4; ++i) {
    ra[i] = *(const u32x4*)(A + (size_t)(i * 32 + lr) * lda + lc);
    rb[i] = *(const u32x4*)(Bt + (size_t)(i * 32 + lr) * ldb + lc);
  }
#pragma unroll
  for (int i = 0; i < 2; ++i)
#pragma unroll
    for (int j = 0; j < 2; ++j)
#pragma unroll
      for (int r = 0; r < 16; ++r) acc[i][j][r] = 0.f;
  for (int k0 = 0; k0 < K; k0 += 64) {
    __syncthreads();
#pragma unroll
    for (int i = 0; i < 4; ++i) {
      *(u32x4*)(As + (i * 32 + lr) * GLS + lc) = ra[i];
      *(u32x4*)(Bs + (i * 32 + lr) * GLS + lc) = rb[i];
    }
    __syncthreads();
    if (k0 + 64 < K) {
#pragma unroll
      for (int i = 0; i < 4; ++i) {
        ra[i] = *(const u32x4*)(A + (size_t)(i * 32 + lr) * lda + k0 + 64 + lc);
        rb[i] = *(const u32x4*)(Bt + (size_t)(i * 32 + lr) * ldb + k0 + 64 + lc);
      }
    }
#pragma unroll
    for (int ks = 0; ks < 64; ks += 16) {
      const int ko = ks + (lane >> 5) * 8;
      bf16x8 a0 = *(const bf16x8*)(As + (wm * 64 + (lane & 31)) * GLS + ko);
      bf16x8 a1 = *(const bf16x8*)(As + (wm * 64 + 32 + (lane & 31)) * GLS + ko);
      bf16x8 b0 = *(const bf16x8*)(Bs + (wn * 64 + (lane & 31)) * GLS + ko);
      bf16x8 b1 = *(const bf16x8*)(Bs + (wn * 64 + 32 + (lane & 31)) * GLS + ko);
      acc[0][0] = MFMA32(a0, b0, acc[0][0]);
      acc[0][1] = MFMA32(a0, b1, acc[0][1]);
      acc[1][0] = MFMA32(a1, b0, acc[1][0]);
      acc[1][1] = MFMA32(a1, b1, acc[1][1]);
    }
  }
}
template <class F>
DI void gemm_epi(f32x16 (&acc)[2][2], F f) {
  const int lane = get_tid() & 63, w = get_tid() >> 6;
  const int wm = w >> 1, wn = w & 1;
#pragma unroll
  for (int mi = 0; mi < 2; ++mi)
#pragma unroll
    for (int ni = 0; ni < 2; ++ni)
#pragma unroll
      for (int r = 0; r < 16; ++r) {
        int row = wm * 64 + mi * 32 + (r & 3) + 8 * (r >> 2) + 4 * (lane >> 5);
        int col = wn * 64 + ni * 32 + (lane & 31);
        f(row, col, acc[mi][ni][r]);
      }
}

DI void gemm_256x128(const bf16* __restrict__ A, int lda, const bf16* __restrict__ Bt, int ldb, int K, f32x16 (&acc)[4][2],
                     bf16* As, bf16* Bs) {
  const int tid = get_tid(), lane = tid & 63, w = tid >> 6;
  const int wm = w >> 1, wn = w & 1;
  const int lr = tid >> 3, lc = (tid & 7) * 8;
  u32x4 ra[8], rb[4];
#pragma unroll
  for (int i = 0; i < 8; ++i) ra[i] = *(const u32x4*)(A + (size_t)(i * 32 + lr) * lda + lc);
#pragma unroll
  for (int i = 0; i < 4; ++i) rb[i] = *(const u32x4*)(Bt + (size_t)(i * 32 + lr) * ldb + lc);
#pragma unroll
  for (int i = 0; i < 4; ++i)
#pragma unroll
    for (int j = 0; j < 2; ++j)
#pragma unroll
      for (int r = 0; r < 16; ++r) acc[i][j][r] = 0.f;
  for (int k0 = 0; k0 < K; k0 += 64) {
    __syncthreads();
#pragma unroll
    for (int i = 0; i < 8; ++i) *(u32x4*)(As + (i * 32 + lr) * GLS + lc) = ra[i];
#pragma unroll
    for (int i = 0; i < 4; ++i) *(u32x4*)(Bs + (i * 32 + lr) * GLS + lc) = rb[i];
    __syncthreads();
    if (k0 + 64 < K) {
#pragma unroll
      for (int i = 0; i < 8; ++i) ra[i] = *(const u32x4*)(A + (size_t)(i * 32 + lr) * lda + k0 + 64 + lc);
#pragma unroll
      for (int i = 0; i < 4; ++i) rb[i] = *(const u32x4*)(Bt + (size_t)(i * 32 + lr) * ldb + k0 + 64 + lc);
    }
#pragma unroll
    for (int ks = 0; ks < 64; ks += 16) {
      const int ko = ks + (lane >> 5) * 8;
      bf16x8 b0 = *(const bf16x8*)(Bs + (wn * 64 + (lane & 31)) * GLS + ko);
      bf16x8 b1 = *(const bf16x8*)(Bs + (wn * 64 + 32 + (lane & 31)) * GLS + ko);
#pragma unroll
      for (int mi = 0; mi < 4; ++mi) {
        bf16x8 a = *(const bf16x8*)(As + (wm * 128 + mi * 32 + (lane & 31)) * GLS + ko);
        acc[mi][0] = MFMA32(a, b0, acc[mi][0]);
        acc[mi][1] = MFMA32(a, b1, acc[mi][1]);
      }
    }
  }
}
template <class F>
DI void gemm_epi2(f32x16 (&acc)[4][2], F f) {
  const int lane = get_tid() & 63, w = get_tid() >> 6;
  const int wm = w >> 1, wn = w & 1;
#pragma unroll
  for (int mi = 0; mi < 4; ++mi)
#pragma unroll
    for (int ni = 0; ni < 2; ++ni)
#pragma unroll
      for (int r = 0; r < 16; ++r) {
        int row = wm * 128 + mi * 32 + (r & 3) + 8 * (r >> 2) + 4 * (lane >> 5);
        int col = wn * 64 + ni * 32 + (lane & 31);
        f(row, col, acc[mi][ni][r]);
      }
}

DI void mma_tile(f32x16& acc, const bf16* A, int lda, const bf16* Bt, int ldb, int K) {
  const int lane = get_tid() & 63;
  const bf16* ap = A + (size_t)(lane & 31) * lda + (lane >> 5) * 8;
  const bf16* bp = Bt + (size_t)(lane & 31) * ldb + (lane >> 5) * 8;
#pragma unroll 4
  for (int ks = 0; ks < K; ks += 16) {
    bf16x8 a = *(const bf16x8*)(ap + ks);
    bf16x8 b = *(const bf16x8*)(bp + ks);
    acc = MFMA32(a, b, acc);
  }
}
template <int K>
DI void mma_tile_ga(f32x16& acc, const bf16* __restrict__ A, int lda, const bf16* Bt, int ldb) {
  const int lane = get_tid() & 63;
  const bf16* ap = A + (size_t)(lane & 31) * lda + (lane >> 5) * 8;
  const bf16* bp = Bt + (size_t)(lane & 31) * ldb + (lane >> 5) * 8;
  bf16x8 af[K / 16];
#pragma unroll
  for (int i = 0; i < K / 16; ++i) af[i] = *(const bf16x8*)(ap + i * 16);
#pragma unroll
  for (int i = 0; i < K / 16; ++i) {
    bf16x8 b = *(const bf16x8*)(bp + i * 16);
    acc = MFMA32(af[i], b, acc);
  }
}
DI int crow(int r, int lane) { return (r & 3) + 8 * (r >> 2) + 4 * (lane >> 5); }

DI void prep_transpose(const float* __restrict__ W, int K, int N, int Npad, bf16* __restrict__ Wt, int tile, float* tl) {
  const int ntn = Npad / 64;
  const int kt = tile / ntn, nt = tile % ntn;
  const int k0 = kt * 64, n0 = nt * 64;
  const int tid = get_tid();
  __syncthreads();
  for (int i = 0; i < 16; ++i) {
    int r = i * 4 + (tid >> 6), cidx = tid & 63;
    int n = n0 + cidx;
    float v = (n < N) ? W[(size_t)(k0 + r) * N + n] : 0.f;
    tl[cidx * 65 + r] = v;
  }
  __syncthreads();
  for (int i = 0; i < 16; ++i) {
    int n = i * 4 + (tid >> 6), k = tid & 63;
    Wt[(size_t)(n0 + n) * K + k0 + k] = f2bf(tl[n * 65 + k]);
  }
}

DI void convert_bf16(const float* __restrict__ src, bf16* __restrict__ dst, size_t n, int bid, int nb) {
  size_t nv = n / 8;
  for (size_t i = (size_t)bid * 256 + get_tid(); i < nv; i += (size_t)nb * 256) {
    float4 a = ((const float4*)src)[2 * i], b = ((const float4*)src)[2 * i + 1];
    u32x4 o;
    o.x = cvtpk(a.x, a.y); o.y = cvtpk(a.z, a.w); o.z = cvtpk(b.x, b.y); o.w = cvtpk(b.z, b.w);
    ((u32x4*)dst)[i] = o;
  }
}

DI void prep_mod(const Params& p, int item, float* sm) {
  const int l = item / 96, n0 = (item % 96) * 64;
  const int tid = get_tid(), lane = tid & 63, w = tid >> 6;
  const float* W = p.ada_w + (size_t)l * 1024 * 6144 + n0 + lane;
  float* sc = sm;
  float* red = sm + 5 * 1024;
  __syncthreads();
  for (int i = tid; i < 5 * 1024; i += 256) {
    const int r = i >> 10, k = i & 1023;
    sc[i] = siluf_(r < 4 ? p.c[r * 1024 + k] : p.c_ctx[k]);
  }
  __syncthreads();
  float acc[5] = {0.f, 0.f, 0.f, 0.f, 0.f};
#pragma unroll 1
  for (int k0 = w * 256; k0 < w * 256 + 256; k0 += 16) {
    float wv[16];
#pragma unroll
    for (int j = 0; j < 16; ++j) wv[j] = W[(size_t)(k0 + j) * 6144];
#pragma unroll
    for (int j = 0; j < 16; ++j) {
#pragma unroll
      for (int r = 0; r < 5; ++r) acc[r] += sc[r * 1024 + k0 + j] * wv[j];
    }
  }
#pragma unroll
  for (int r = 0; r < 5; ++r) red[(w * 5 + r) * 64 + lane] = acc[r];
  __syncthreads();
  if (w == 0) {
    float* M = (float*)(p.ws + OFF_MOD);
#pragma unroll
    for (int r = 0; r < 5; ++r) {
      float s2 = red[(0 * 5 + r) * 64 + lane] + red[(1 * 5 + r) * 64 + lane] + red[(2 * 5 + r) * 64 + lane] + red[(3 * 5 + r) * 64 + lane];
      M[(size_t)(l * 5 + r) * 6144 + n0 + lane] = s2 + p.ada_b[l * 6144 + n0 + lane];
    }
  }
}

DI void prep_s5(const Params& p, int item4, float* sm) {
  const int item = item4 >> 2, qtr = item4 & 3;
  const int g = item >> 1, d = item & 1;
  const int tid = get_tid();
  float* pw = sm;
  float* bb = sm + 17 * 128;
  float* kc = bb + 64 * 32;
  __syncthreads();
  const float dt = __expf(p.s5_log_dt[d * 32 + g]);
  if (tid < 64) {
    const int pp = tid;
    const float are = p.s5_a_re[(d * 32 + g) * 64 + pp], aim = p.s5_a_im[(d * 32 + g) * 64 + pp];
    for (int n = 0; n <= 16; ++n) {
      float mag = expf(are * dt * n);
      float sn, cs;
      sincosf(aim * dt * n, &sn, &cs);
      pw[(n * 64 + pp) * 2 + 0] = mag * cs;
      pw[(n * 64 + pp) * 2 + 1] = mag * sn;
    }
    float abr = pw[(64 + pp) * 2 + 0] - 1.0f, abi = pw[(64 + pp) * 2 + 1];
    float den = are * are + aim * aim;
    float qr = (abr * are + abi * aim) / den, qi = (abi * are - abr * aim) / den;
    for (int c2 = 0; c2 < 16; ++c2) {
      float br = p.s5_b_re[((size_t)(d * 32 + g) * 64 + pp) * 16 + c2], bi = p.s5_b_im[((size_t)(d * 32 + g) * 64 + pp) * 16 + c2];
      bb[(pp * 16 + c2) * 2 + 0] = qr * br - qi * bi;
      bb[(pp * 16 + c2) * 2 + 1] = qr * bi + qi * br;
    }
    float* A16 = (float*)(p.ws + OFF_S5A16) + (size_t)item * 128;
    A16[pp * 2 + 0] = pw[(16 * 64 + pp) * 2 + 0];
    A16[pp * 2 + 1] = pw[(16 * 64 + pp) * 2 + 1];
  }
  float* cre = kc + 4096;
  float* cim = cre + 1024;
  for (int e = tid; e < 1024; e += 256) {
    cre[e] = p.s5_c_re[(size_t)(d * 32 + g) * 1024 + e];
    cim[e] = p.s5_c_im[(size_t)(d * 32 + g) * 1024 + e];
  }
  __syncthreads();
  for (int e = tid; e < (4 * qtr + 4) * 256; e += 256) {
    int tau = e >> 8, c = (e >> 4) & 15, c2 = e & 15;
    float s = 0.f;
    for (int pp = 0; pp < 64; ++pp) {
      float cr = cre[c * 64 + pp], ci = cim[c * 64 + pp];
      float wr = pw[(tau * 64 + pp) * 2], wi = pw[(tau * 64 + pp) * 2 + 1];
      float zr = cr * wr - ci * wi, zi = cr * wi + ci * wr;
      float br = bb[(pp * 16 + c2) * 2], bi = bb[(pp * 16 + c2) * 2 + 1];
      s += zr * br - zi * bi;
    }
    kc[e] = s;
  }
  __syncthreads();
  bf16* T = (bf16*)(p.ws + OFF_S5T) + (size_t)item * 65536;
  for (int e = qtr * 16384 + tid; e < (qtr + 1) * 16384; e += 256) {
    int m = e >> 8, k = e & 255;
    int i = m >> 4, c = m & 15, j = k >> 4, c2 = k & 15;
    float v = (i >= j) ? kc[((i - j) * 16 + c) * 16 + c2] : 0.f;
    T[e] = f2bf(v);
  }
  bf16* WE = (bf16*)(p.ws + OFF_S5WE) + (size_t)item * 32768;
  for (int e = qtr * 8192 + tid; e < (qtr + 1) * 8192; e += 256) {
    int pr = e >> 8, k = e & 255;
    int pp = pr & 63, im = pr >> 6, j = k >> 4, c2 = k & 15;
    float wr = pw[((15 - j) * 64 + pp) * 2], wi = pw[((15 - j) * 64 + pp) * 2 + 1];
    float br = bb[(pp * 16 + c2) * 2], bi = bb[(pp * 16 + c2) * 2 + 1];
    float v = im ? (wr * bi + wi * br) : (wr * br - wi * bi);
    WE[e] = f2bf(v);
  }
  bf16* WY = (bf16*)(p.ws + OFF_S5WY) + (size_t)item * 32768;
  for (int e = qtr * 8192 + tid; e < (qtr + 1) * 8192; e += 256) {
    int m = e >> 7, pr = e & 127;
    int i = m >> 4, c = m & 15, pp = pr & 63, im = pr >> 6;
    float cr = cre[c * 64 + pp], ci = cim[c * 64 + pp];
    float wr = pw[((i + 1) * 64 + pp) * 2], wi = pw[((i + 1) * 64 + pp) * 2 + 1];
    float zr = cr * wr - ci * wi, zi = cr * wi + ci * wr;
    WY[e] = f2bf(im ? -zi : zr);
  }
}

DI void phase_prep(const Params& p, char* smem) {
  const int bid = blockIdx.x, nb = gridDim.x;
  float* sm = (float*)smem;
  if (bid == 0 && get_tid() < 64) ((unsigned*)(p.ws + OFF_KMAX))[get_tid()] = 0u;
  {
    float2* tab = (float2*)(p.ws + OFF_ROPE1);
    for (int e = bid * 256 + get_tid(); e < 8192 * 16; e += nb * 256) {
      int t = e >> 4, f = e & 15;
      float pos = (f < 8) ? (float)(t >> 6) : (float)(t & 63);
      float inv = powf(10000.f, -(float)(f & 7) / 8.f);
      float sn, cs;
      sincosf(pos * inv, &sn, &cs);
      tab[e] = make_float2(cs, sn);
    }
  }
  const int n_mod = 192, n_s5 = 256;
  constexpr int T0 = 16 * 52, T1 = 16 * 16, T2 = 16 * 20, T3 = 16 * 16, T4 = 6 * 12, T5 = 4 * 16, T6 = 8 * 8, T7 = 16 * 32, T8 = 16 * 32;
  constexpr int NTR = T0 + T1 + T2 + T3 + T4 + T5 + T6 + T7 + T8;
  const int total = n_mod + n_s5 + NTR;
  for (int it = bid; it < total; it += nb) {
    if (it < n_s5) prep_s5(p, it, sm);
    else if (it < n_mod + n_s5) prep_mod(p, it - n_s5, sm);
    else {
      int t = it - n_mod - n_s5;
      if (t < T0) { prep_transpose(p.ev_w_in, 1024, 3328, 3328, (bf16*)(p.ws + OFF_WT_EVIN), t, sm); continue; }
      t -= T0;
      if (t < T1) { prep_transpose(p.ev_w_out, 1024, 1024, 1024, (bf16*)(p.ws + OFF_WT_EVOUT), t, sm); continue; }
      t -= T1;
      if (t < T2) { prep_transpose(p.od_w_in, 1024, 1184, 1280, (bf16*)(p.ws + OFF_WT_ODIN), t, sm); continue; }
      t -= T2;
      if (t < T3) { prep_transpose(p.od_w_out, 1024, 1024, 1024, (bf16*)(p.ws + OFF_WT_ODOUT), t, sm); continue; }
      t -= T3;
      if (t < T4) { prep_transpose(p.mla_w_qup, 384, 768, 768, (bf16*)(p.ws + OFF_WT_QUP), t, sm); continue; }
      t -= T4;
      if (t < T5) { prep_transpose(p.mla_w_kvup, 256, 1024, 1024, (bf16*)(p.ws + OFF_WT_KVUP), t, sm); continue; }
      t -= T5;
      if (t < T6) { prep_transpose(p.s5_w_glu, 512, 512, 512, (bf16*)(p.ws + OFF_WT_GLU), t, sm); continue; }
      t -= T6;
      if (t < T7) { prep_transpose(p.peer_wq, 1024, 2048, 2048, (bf16*)(p.ws + OFF_WT_PWQ), t, sm); continue; }
      t -= T7;
      prep_transpose(p.peer_wq + (size_t)1024 * 2048, 1024, 2048, 2048, (bf16*)(p.ws + OFF_WT_PWQ) + (size_t)2048 * 1024, t, sm);
    }
  }
  convert_bf16(p.peer_keys, (bf16*)(p.ws + OFF_PKEYS), (size_t)2 * 8 * 2 * 128 * 128, bid, nb);
}

DI void phase_norm(const Params& p, int layer, bool first, const float* g, int shift_chunk, int nrows) {
  const int lane = get_tid() & 63, w = get_tid() >> 6;
  bf16* dst = (bf16*)(p.ws + OFF_ACTA);
  for (int r = blockIdx.x * 4 + w; r < nrows; r += gridDim.x * 4) {
    const float* src = first ? orig_row(p, r) : res_row(p, r);
    float4 v[4];
    float ss = 0.f;
#pragma unroll
    for (int i = 0; i < 4; ++i) {
      v[i] = ((const float4*)src)[i * 64 + lane];
      ss += v[i].x * v[i].x + v[i].y * v[i].y + v[i].z * v[i].z + v[i].w * v[i].w;
    }
    ss = wave_sum(ss);
    const float rs = rsqrtf(ss * (1.0f / 1024.0f) + EPSN);
    const float* sh = mod_ptr(p, layer, r, shift_chunk);
    const float* sc = mod_ptr(p, layer, r, shift_chunk + 1);
#pragma unroll
    for (int i = 0; i < 4; ++i) {
      float4 gg = ((const float4*)g)[i * 64 + lane];
      float4 s4 = ((const float4*)sh)[i * 64 + lane];
      float4 c4 = ((const float4*)sc)[i * 64 + lane];
      float o0 = v[i].x * rs * gg.x * (1.f + c4.x) + s4.x;
      float o1 = v[i].y * rs * gg.y * (1.f + c4.y) + s4.y;
      float o2 = v[i].z * rs * gg.z * (1.f + c4.z) + s4.z;
      float o3 = v[i].w * rs * gg.w * (1.f + c4.w) + s4.w;
      u32x2 o;
      o.x = cvtpk(o0, o1); o.y = cvtpk(o2, o3);
      ((u32x2*)(dst + (size_t)r * DM))[i * 64 + lane] = o;
    }
  }
}

DI void phase_inproj0(const Params& p, char* smem) {
  bf16* As = (bf16*)smem; bf16* Bs = As + 256 * GLS;
  const bf16* A = (const bf16*)(p.ws + OFF_ACTA);
  const bf16* Wt = (const bf16*)(p.ws + OFF_WT_EVIN);
  bf16* pg = (bf16*)(p.ws + OFF_PAGQA);
  bf16* ph = (bf16*)(p.ws + OFF_PAHG);
  const int ntn = 26, ntm = NTOK / 256;
  for (int t = blockIdx.x; t < ntn * ntm; t += gridDim.x) {
    const int mt = t / ntn, nt = t % ntn;
    f32x16 acc[4][2];
    gemm_256x128(A + (size_t)mt * 256 * DM, DM, Wt + (size_t)nt * 128 * DM, DM, DM, acc, As, Bs);
    gemm_epi2(acc, [&](int row, int col, float v) {
      int r = mt * 256 + row, cg_ = nt * 128 + col;
      if (cg_ < 768) pg[(size_t)r * 768 + cg_] = f2bf(v);
      else ph[(size_t)r * 2560 + (cg_ - 768)] = f2bf(v);
    });
  }
}

DI void phase_gqa_prep(const Params& p, char* smem) {
  bf16* pg = (bf16*)(p.ws + OFF_PAGQA);
  bf16* vt = (bf16*)(p.ws + OFF_VT0);
  bf16* tl = (bf16*)smem;
  const int lane = get_tid() & 63, w = get_tid() >> 6, tid = get_tid();
  const float gq = p.gqa_qn_g[lane], gk = p.gqa_kn_g[lane];
  const float inv = __powf(10000.f, -(float)(lane & 15) / 16.f);
  float lbv[16];
#pragma unroll
  for (int e = 0; e < 16; ++e) {
    const int j = lane * 16 + e, d = j >> 9, cc = j & 511;
    const float l0 = p.hg_lb_logits[(d * 2 + 0) * 512 + cc], l1 = p.hg_lb_logits[(d * 2 + 1) * 512 + cc];
    lbv[e] = 1.0f / (1.0f + __expf(l1 - l0));
  }
  bf16* phg = (bf16*)(p.ws + OFF_PAHG);
  for (int r = blockIdx.x * 4 + w; r < NTOK; r += gridDim.x * 4) {
    bf16* row = pg + (size_t)r * 768;
    float sn = 0.f, cs = 1.f;
    if (r < NLAT) {
      int t = r & 8191;
      float pos = (lane < 32) ? (float)(t >> 6) : (float)(t & 63);
      sincosf(pos * inv, &sn, &cs);
    }
#pragma unroll
    for (int hh = 0; hh < 10; ++hh) {
      float v = bf2f(row[hh * 64 + lane]);
      float ss = wave_sum(v * v);
      float y = v * rsqrtf(ss * (1.f / 64.f) + EPSN) * (hh < 8 ? gq : gk);
      float pr = __shfl_xor(y, 16);
      float o = y * cs + ((lane & 16) ? pr * sn : -pr * sn);
      row[hh * 64 + lane] = f2bf(hh < 8 ? o * (0.125f * 1.4426950408889634f) : o);
    }
    {
      bf16* frow = phg + (size_t)r * 2560 + 512 + lane * 16;
      u32x4 a = *(const u32x4*)frow, b2 = *(const u32x4*)(frow + 8);
      float fv[16];
      fv[0] = bflo(a.x); fv[1] = bfhi(a.x); fv[2] = bflo(a.y); fv[3] = bfhi(a.y); fv[4] = bflo(a.z); fv[5] = bfhi(a.z); fv[6] = bflo(a.w); fv[7] = bfhi(a.w);
      fv[8] = bflo(b2.x); fv[9] = bfhi(b2.x); fv[10] = bflo(b2.y); fv[11] = bfhi(b2.y); fv[12] = bflo(b2.z); fv[13] = bfhi(b2.z); fv[14] = bflo(b2.w); fv[15] = bfhi(b2.w);
#pragma unroll
      for (int e = 0; e < 16; ++e) fv[e] = __logf(lbv[e] + (1.f - lbv[e]) * sigmoidf_(fv[e]));
      u32x4 o0, o1;
      o0.x = cvtpk(fv[0], fv[1]); o0.y = cvtpk(fv[2], fv[3]); o0.z = cvtpk(fv[4], fv[5]); o0.w = cvtpk(fv[6], fv[7]);
      o1.x = cvtpk(fv[8], fv[9]); o1.y = cvtpk(fv[10], fv[11]); o1.z = cvtpk(fv[12], fv[13]); o1.w = cvtpk(fv[14], fv[15]);
      *(u32x4*)frow = o0; *(u32x4*)(frow + 8) = o1;
    }
  }
  for (int blk = blockIdx.x; blk < NTOK / 64; blk += gridDim.x) {
    const int r0 = blk * 64;
    __syncthreads();
    {
      const int rr = tid >> 2, c0 = (tid & 3) * 32;
      const bf16* src = pg + (size_t)(r0 + rr) * 768 + 640 + c0;
#pragma unroll
      for (int i = 0; i < 4; ++i) {
        u32x4 v4 = *(const u32x4*)(src + i * 8);
#pragma unroll
        for (int e = 0; e < 4; ++e) {
          tl[(c0 + i * 8 + 2 * e) * GLS + rr] = (bf16)(v4[e] & 0xffffu);
          tl[(c0 + i * 8 + 2 * e + 1) * GLS + rr] = (bf16)(v4[e] >> 16);
        }
      }
    }
    __syncthreads();
    int b, s0;
    if (r0 < NLAT) { b = r0 >> 13; s0 = CTXL + (r0 & 8191); } else { int rc = r0 - NLAT; b = rc >> 8; s0 = rc & 255; }
    {
      int vcol = tid >> 1, half = tid & 1;
      int kvh = vcol >> 6, dv = vcol & 63;
      bf16* dstp = vt + ((size_t)((b * 2 + kvh) * 64 + dv)) * SKEYS + s0 + half * 32;
      const bf16* srcp = tl + vcol * GLS + half * 32;
#pragma unroll
      for (int i = 0; i < 4; ++i) ((u32x4*)dstp)[i] = ((const u32x4*)srcp)[i];
    }
  }
}

template <int DQK, int SM>
DI void attn_item(const bf16* __restrict__ Q, int ldq_, const bf16* __restrict__ Kc, const bf16* __restrict__ Kl, int ldk_,
                  const bf16* __restrict__ VT, int nkeys, bf16* __restrict__ O, int ldo_, float scale, char* smem, float kbound = 0.f) {
  constexpr bool FIXED = (SM != 0);
  constexpr int ldq = 768, ldk = 768, ldo = DM;
  (void)ldq_; (void)ldk_; (void)ldo_;
  constexpr int KLS = DQK + 8;
  constexpr int VLS = 72;
  constexpr int NKS = DQK / 16;
  constexpr int KCH = DQK / 8;
  constexpr int KLOADS = (64 * KCH) / 256;
  constexpr int BUF = 64 * KLS + 64 * VLS;
  bf16* Sb = (bf16*)smem;
  const int tid = get_tid(), lane = tid & 63, w = tid >> 6;
  const float sc = scale * 1.4426950408889634f;
  bf16x8 qf[2][NKS];
#pragma unroll
  for (int qt = 0; qt < 2; ++qt) {
    const bf16* qp = Q + (size_t)(w * 64 + qt * 32 + (lane & 31)) * ldq + (lane >> 5) * 8;
#pragma unroll
    for (int ks = 0; ks < NKS; ++ks) qf[qt][ks] = *(const bf16x8*)(qp + ks * 16);
  }
  float msh[2] = {0.f, 0.f};
  if (SM == 2) {
#pragma unroll
    for (int qt = 0; qt < 2; ++qt) {
      float sq = 0.f;
#pragma unroll
      for (int ks = 0; ks < NKS; ++ks)
#pragma unroll
        for (int e = 0; e < 8; ++e) { float f = bf2f((bf16)qf[qt][ks][e]); sq += f * f; }
      sq += __shfl_xor(sq, 32);
      msh[qt] = fminf(sqrtf(sq) * kbound, 64.0f);
    }
  }
  f32x16 ot[2][2];
#pragma unroll
  for (int i = 0; i < 2; ++i)
#pragma unroll
    for (int j = 0; j < 2; ++j)
#pragma unroll
      for (int r = 0; r < 16; ++r) ot[i][j][r] = 0.f;
  float m_run[2] = {-1e30f, -1e30f}, l_run[2] = {0.f, 0.f};
  u32x4 kr[KLOADS], vr[2];
  auto gload = [&](int s0) {
    const bf16* kb = (s0 < CTXL) ? (Kc + (size_t)s0 * ldk) : (Kl + (size_t)(s0 - CTXL) * ldk);
#pragma unroll
    for (int i = 0; i < KLOADS; ++i) {
      int ci = i * 256 + tid;
      int row = ci / KCH, ch = ci % KCH;
      kr[i] = *(const u32x4*)(kb + (size_t)row * ldk + ch * 8);
    }
#pragma unroll
    for (int i = 0; i < 2; ++i) {
      int ci = i * 256 + tid;
      int row = ci >> 3, ch = ci & 7;
      vr[i] = *(const u32x4*)(VT + (size_t)row * SKEYS + s0 + ch * 8);
    }
  };
  auto lwrite = [&](bf16* buf) {
    bf16* Ks = buf; bf16* Vs = buf + 64 * KLS;
#pragma unroll
    for (int i = 0; i < KLOADS; ++i) {
      int ci = i * 256 + tid;
      int row = ci / KCH, ch = ci % KCH;
      *(u32x4*)(Ks + row * KLS + ch * 8) = kr[i];
    }
#pragma unroll
    for (int i = 0; i < 2; ++i) {
      int ci = i * 256 + tid;
      int row = ci >> 3, ch = ci & 7;
      u32x2 lo = {vr[i].x, vr[i].y}, hi = {vr[i].z, vr[i].w};
      const int gb = (ch >> 1) * 16 + (ch & 1) * 4;
      *(u32x2*)(Vs + row * VLS + gb) = lo;
      *(u32x2*)(Vs + row * VLS + gb + 8) = hi;
    }
  };
  const int ntiles = nkeys >> 6;
  __syncthreads();
  gload(0);
  lwrite(Sb);
  if (ntiles > 1) gload(64);
  for (int j = 0; j < ntiles; ++j) {
    __syncthreads();
    if (j + 1 < ntiles) {
      lwrite(Sb + ((j + 1) & 1) * BUF);
      if (j + 2 < ntiles) gload((j + 2) * 64);
    }
    const bf16* Ks = Sb + (j & 1) * BUF;
    const bf16* Vs = Ks + 64 * KLS;
    auto half = [&](const int kt) {
      f32x16 st[2];
#pragma unroll
      for (int qt = 0; qt < 2; ++qt)
#pragma unroll
        for (int r = 0; r < 16; ++r) st[qt][r] = 0.f;
      {
        const bf16* ap = Ks + (kt * 32 + (lane & 31)) * KLS + (lane >> 5) * 8;
        __builtin_amdgcn_s_setprio(1);
#pragma unroll
        for (int ks = 0; ks < NKS; ++ks) {
          bf16x8 a = *(const bf16x8*)(ap + ks * 16);
          st[0] = MFMA32(a, qf[0][ks], st[0]);
          st[1] = MFMA32(a, qf[1][ks], st[1]);
        }
        __builtin_amdgcn_s_setprio(0);
      }
      float mx[2] = {0.f, 0.f};
      bool need = false;
      if (!FIXED) {
#pragma unroll
      for (int qt = 0; qt < 2; ++qt) {
        float m0 = fmaxf(st[qt][0], st[qt][1]);
#pragma unroll
        for (int r = 2; r < 16; r += 2) m0 = fmaxf(m0, fmaxf(st[qt][r], st[qt][r + 1]));
        m0 = fmaxf(m0, __shfl_xor(m0, 32)) * sc;
        mx[qt] = m0;
        need = need || (m0 - m_run[qt] > 8.0f);
      }
      }
      if (!FIXED && __any(need)) {
#pragma unroll
        for (int qt = 0; qt < 2; ++qt) {
          const float m_new = fmaxf(m_run[qt], mx[qt]);
          const float alpha = __builtin_amdgcn_exp2f(m_run[qt] - m_new);
          m_run[qt] = m_new;
          l_run[qt] *= alpha;
#pragma unroll
          for (int dt = 0; dt < 2; ++dt)
#pragma unroll
            for (int r = 0; r < 16; ++r) ot[qt][dt][r] *= alpha;
        }
      }
      bf16x8 pb[2][2];
#pragma unroll
      for (int qt = 0; qt < 2; ++qt) {
        float ps = 0.f;
        const float mr = m_run[qt];
#pragma unroll
        for (int r = 0; r < 16; ++r) {
          float pv = (SM == 1) ? __builtin_amdgcn_exp2f(st[qt][r]) : (SM == 2) ? __builtin_amdgcn_exp2f(st[qt][r] - msh[qt]) : __builtin_amdgcn_exp2f(st[qt][r] * sc - mr);
          st[qt][r] = pv;
          ps += pv;
        }
#pragma unroll
        for (int s2 = 0; s2 < 2; ++s2) {
          u32x4 pk;
          pk.x = cvtpk(st[qt][8 * s2 + 0], st[qt][8 * s2 + 1]);
          pk.y = cvtpk(st[qt][8 * s2 + 2], st[qt][8 * s2 + 3]);
          pk.z = cvtpk(st[qt][8 * s2 + 4], st[qt][8 * s2 + 5]);
          pk.w = cvtpk(st[qt][8 * s2 + 6], st[qt][8 * s2 + 7]);
          pb[qt][s2] = __builtin_bit_cast(bf16x8, pk);
        }
        l_run[qt] += ps;
      }
      __builtin_amdgcn_s_setprio(1);
#pragma unroll
      for (int s2 = 0; s2 < 2; ++s2)
#pragma unroll
        for (int dt = 0; dt < 2; ++dt) {
          const bf16* vp = Vs + (dt * 32 + (lane & 31)) * VLS + kt * 32 + 16 * s2 + 8 * (lane >> 5);
          bf16x8 af = *(const bf16x8*)vp;
          ot[0][dt] = MFMA32(af, pb[0][s2], ot[0][dt]);
          ot[1][dt] = MFMA32(af, pb[1][s2], ot[1][dt]);
        }
      __builtin_amdgcn_s_setprio(0);
    };
    if constexpr (SM == 1) {
#pragma unroll 1
      for (int kt = 0; kt < 2; ++kt) half(kt);
    } else {
      half(0);
      half(1);
    }
  }
#pragma unroll
  for (int qt = 0; qt < 2; ++qt) {
    const float ltot = l_run[qt] + __shfl_xor(l_run[qt], 32);
    const float inv_l = 1.0f / ltot;
    const int tid2 = get_tid();
    bf16* op = O + (size_t)((tid2 >> 6) * 64 + qt * 32 + (tid2 & 31)) * ldo;
#pragma unroll
    for (int dt = 0; dt < 2; ++dt)
#pragma unroll
      for (int g4 = 0; g4 < 4; ++g4) {
        int dv = dt * 32 + 8 * g4 + 4 * ((tid2 >> 5) & 1);
        u32x2 o;
        o.x = cvtpk(ot[qt][dt][4 * g4 + 0] * inv_l, ot[qt][dt][4 * g4 + 1] * inv_l);
        o.y = cvtpk(ot[qt][dt][4 * g4 + 2] * inv_l, ot[qt][dt][4 * g4 + 3] * inv_l);
        *(u32x2*)(op + dv) = o;
      }
  }
}

DI void hgrn2_item(const Params& p, int item, char* smem) {
  const int vs = item & 3, dir = (item >> 2) & 1, h = (item >> 3) & 3, b = item >> 5;
  constexpr int QLS = 136, TLS = 72;
  bf16* Qr = (bf16*)smem;
  bf16* Kr = Qr + 64 * QLS;
  bf16* KrT = Kr + 64 * QLS;
  bf16* VTs = KrT + 128 * TLS;
  bf16* Att = VTs + 32 * TLS;
  bf16* STb = Att + 64 * TLS;
  float* rsum = (float*)(STb + 32 * QLS);
  float* lsum = rsum + 128;
  const int tid = get_tid(), lane = tid & 63, w = tid >> 6;
  const int c = tid & 127, half = tid >> 7;
  const bf16* ph = (const bf16*)(p.ws + OFF_PAHG);
  bf16* og = (bf16*)(p.ws + OFF_OHG) + (size_t)dir * NTOK * 512;
  auto rowof = [&](int pos) -> int {
    if (pos < CTXL) { int s = dir ? (CTXL - 1 - pos) : pos; return NLAT + b * CTXL + s; }
    int t = pos - CTXL; t = dir ? (SEQ - 1 - t) : t; return b * SEQ + t;
  };
  f32x16 S0, S1;
#pragma unroll
  for (int r = 0; r < 16; ++r) { S0[r] = 0.f; S1[r] = 0.f; }
  bf16 pq[32], pf[32];
  u32x4 pv;
  auto prefetch = [&](int ch) {
    const int p0 = ch * 64;
#pragma unroll
    for (int i = 0; i < 32; ++i) {
      const bf16* row = ph + (size_t)rowof(p0 + half * 32 + i) * 2560;
      pq[i] = row[h * 128 + c];
      pf[i] = row[512 + dir * 512 + h * 128 + c];
    }
    {
      const bf16* row = ph + (size_t)rowof(p0 + (tid >> 2)) * 2560;
      pv = *(const u32x4*)(row + 1536 + h * 128 + vs * 32 + (tid & 3) * 8);
    }
  };
  for (int ch = 0; ch < 132; ++ch) {
    prefetch(ch);
    {
      float run = 0.f;
      if (half == 0) {
#pragma unroll
        for (int ii = 31; ii >= 0; --ii) {
          float lg = bf2f(pf[ii]), q = bf2f(pq[ii]);
          float k = 1.f - __expf(lg);
          float eq = __expf(fminf(-run, 80.f)), ek = __expf(fmaxf(run, -80.f));
          const unsigned pk2 = cvtpk(q * eq, k * ek);
          const bf16 qv = (bf16)(pk2 & 0xffffu), kv = (bf16)(pk2 >> 16);
          Qr[ii * QLS + c] = qv;
          Kr[ii * QLS + c] = kv;
          KrT[c * TLS + ii] = kv;
          run += lg;
        }
        rsum[c] = __expf(run);
      } else {
#pragma unroll
        for (int ii = 0; ii < 32; ++ii) {
          float lg = bf2f(pf[ii]), q = bf2f(pq[ii]);
          float k = 1.f - __expf(lg);
          run += lg;
          float eq = __expf(fmaxf(run, -80.f)), ek = __expf(fminf(-run, 80.f));
          const unsigned pk2 = cvtpk(q * eq, k * ek);
          const bf16 qv = (bf16)(pk2 & 0xffffu), kv = (bf16)(pk2 >> 16);
          Qr[(32 + ii) * QLS + c] = qv;
          Kr[(32 + ii) * QLS + c] = kv;
          KrT[c * TLS + 32 + ii] = kv;
        }
        lsum[c] = __expf(run);
      }
      {
        int i = tid >> 2, v0 = (tid & 3) * 8;
#pragma unroll
        for (int j = 0; j < 4; ++j) {
          VTs[(v0 + 2 * j) * TLS + i] = (bf16)(pv[j] & 0xffffu);
          VTs[(v0 + 2 * j + 1) * TLS + i] = (bf16)(pv[j] >> 16);
        }
      }
    }
    __syncthreads();
    if (w < 2) {
      const int ntl = (w == 0) ? 2 : 1;
      for (int q2 = 0; q2 < ntl; ++q2) {
        const int tt = (w == 0) ? q2 : 1, stl = (w == 0) ? q2 : 0;
        f32x16 a;
#pragma unroll
        for (int r = 0; r < 16; ++r) a[r] = 0.f;
        mma_tile(a, Qr + tt * 32 * QLS, QLS, Kr + stl * 32 * QLS, QLS, 128);
#pragma unroll
        for (int r = 0; r < 16; ++r) {
          int t = tt * 32 + crow(r, lane), s = stl * 32 + (lane & 31);
          float v = (s <= t) ? a[r] : 0.f;
          Att[t * TLS + s] = (bf16)(cvtpk(v, v) & 0xffffu);
        }
      }
      if (w == 1) {
#pragma unroll
        for (int r = 0; r < 16; ++r) Att[crow(r, lane) * TLS + 32 + (lane & 31)] = 0;
      }
    } else {
      const int ct0 = (w - 2) * 2;
#pragma unroll
      for (int tI = 0; tI < 2; ++tI) {
        f32x16& S = tI ? S1 : S0;
        const int cb = (ct0 + tI) * 32;
#pragma unroll
        for (int g4 = 0; g4 < 4; ++g4) {
          int cc = cb + 8 * g4 + 4 * (lane >> 5);
          float e0 = rsum[cc], e1 = rsum[cc + 1], e2 = rsum[cc + 2], e3 = rsum[cc + 3];
          u32x2 o;
          o.x = cvtpk(S[4 * g4] * e0, S[4 * g4 + 1] * e1);
          o.y = cvtpk(S[4 * g4 + 2] * e2, S[4 * g4 + 3] * e3);
          *(u32x2*)(STb + (lane & 31) * QLS + cc) = o;
        }
        f32x16 a;
#pragma unroll
        for (int r = 0; r < 16; ++r) a[r] = 0.f;
        mma_tile(a, KrT + cb * TLS, TLS, VTs, TLS, 64);
#pragma unroll
        for (int r = 0; r < 16; ++r) {
          int cc = cb + crow(r, lane);
          float el = lsum[cc];
          float er = rsum[cc];
          S[r] = S[r] * (el * er) + a[r] * el;
        }
      }
    }
    __syncthreads();
    if (w < 2) {
      f32x16 a;
#pragma unroll
      for (int r = 0; r < 16; ++r) a[r] = 0.f;
      mma_tile(a, Att + w * 32 * TLS, TLS, VTs, TLS, 64);
      mma_tile(a, Qr + w * 32 * QLS, QLS, STb, QLS, 128);
#pragma unroll
      for (int r = 0; r < 16; ++r) {
        int t = w * 32 + crow(r, lane);
        int row = rowof(ch * 64 + t);
        og[(size_t)row * 512 + h * 128 + vs * 32 + (lane & 31)] = f2bf(a[r]);
      }
    }
    __syncthreads();
  }
}

DI void phase_mix0(const Params& p, char* smem, int cidx) {
  __shared__ int s_item;
  if (blockIdx.x < 128) hgrn2_item(p, blockIdx.x, smem);
  unsigned* cnt = (unsigned*)(p.ws + OFF_CNT) + cidx;
  const bf16* pg = (const bf16*)(p.ws + OFF_PAGQA);
  const bf16* vt = (const bf16*)(p.ws + OFF_VT0);
  bf16* ycat = (bf16*)(p.ws + OFF_ACTA);
  float kb0;
  {
    const int ln = get_tid() & 63;
    kb0 = 8.0f * 1.01f * wave_max_early(fabsf(p.gqa_kn_g[ln]));
  }
  const int n_lat = 4 * 8 * 32, n_ctx = 4 * 8;
  while (true) {
    __syncthreads();
    if (get_tid() == 0) s_item = (int)atomicAdd(cnt, 1u);
    __syncthreads();
    const int it = s_item;
    if (it >= n_lat + n_ctx) break;
    int b, hq, r0, nk;
    if (it < n_lat) { const int qt = it & 31; hq = (it >> 5) & 7; b = it >> 8; r0 = b * SEQ + qt * 256; nk = SKEYS; }
    else { const int i2 = it - n_lat; hq = i2 & 7; b = i2 >> 3; r0 = NLAT + b * CTXL; nk = CTXL; }
    const int kvh = hq >> 2;
    attn_item<64, 2>(pg + (size_t)r0 * 768 + hq * 64, 768,
                  pg + (size_t)(NLAT + b * CTXL) * 768 + 512 + kvh * 64, pg + (size_t)(b * SEQ) * 768 + 512 + kvh * 64, 768,
                  vt + (size_t)((b * 2 + kvh) * 64) * SKEYS, nk, ycat + (size_t)r0 * DM + hq * 64, DM, 0.125f, smem, kb0);
  }
}

DI void phase_hg_readout(const Params& p) {
  const int lane = get_tid() & 63, w = get_tid() >> 6;
  const bf16* o0 = (const bf16*)(p.ws + OFF_OHG);
  const bf16* o1 = o0 + (size_t)NTOK * 512;
  const bf16* ph = (const bf16*)(p.ws + OFF_PAHG);
  bf16* ycat = (bf16*)(p.ws + OFF_ACTA);
  const float g0 = p.hg_onorm_g[lane * 2], g1 = p.hg_onorm_g[lane * 2 + 1];
  for (int r = blockIdx.x * 4 + w; r < NTOK; r += gridDim.x * 4) {
#pragma unroll
    for (int h = 0; h < 4; ++h) {
      unsigned a = *(const unsigned*)(o0 + (size_t)r * 512 + h * 128 + lane * 2);
      unsigned b2 = *(const unsigned*)(o1 + (size_t)r * 512 + h * 128 + lane * 2);
      unsigned gg = *(const unsigned*)(ph + (size_t)r * 2560 + 2048 + h * 128 + lane * 2);
      float x0 = bflo(a) + bflo(b2), x1 = bfhi(a) + bfhi(b2);
      float ss = wave_sum(x0 * x0 + x1 * x1);
      float rs = rsqrtf(ss * (1.f / 128.f) + EPSN);
      float y0 = x0 * rs * g0 * siluf_(bflo(gg)), y1 = x1 * rs * g1 * siluf_(bfhi(gg));
      *(unsigned*)(ycat + (size_t)r * DM + 512 + h * 128 + lane * 2) = cvtpk(y0, y1);
    }
  }
}

template <int MI>
DI void resid_epilogue(f32x16 (&acc)[MI][2], const float* src, float* dst, const float* __restrict__ g) {
  const int lane = get_tid() & 63, w = get_tid() >> 6;
  const int wm = w >> 1, wn = w & 1;
  const float g0 = g[wn * 64 + (lane & 31)], g1 = g[wn * 64 + 32 + (lane & 31)];
#pragma unroll
  for (int mi = 0; mi < MI; ++mi) {
    const size_t o0 = (size_t)(wm * (MI * 32) + mi * 32 + 4 * (lane >> 5)) * DM + wn * 64 + (lane & 31);
    float xv[2][16];
#pragma unroll
    for (int r = 0; r < 16; ++r) {
      const size_t ro = o0 + (size_t)((r & 3) + 8 * (r >> 2)) * DM;
      xv[0][r] = src[ro];
      xv[1][r] = src[ro + 32];
    }
#pragma unroll
    for (int r = 0; r < 16; ++r) {
      const size_t ro = o0 + (size_t)((r & 3) + 8 * (r >> 2)) * DM;
      dst[ro] = xv[0][r] + g0 * acc[mi][0][r];
      dst[ro + 32] = xv[1][r] + g1 * acc[mi][1][r];
    }
  }
}
DI void resid_prefetch2(float (&xv)[2][2][16], const float* src) {
  const int lane = get_tid() & 63, w = get_tid() >> 6;
  const int wm = w >> 1, wn = w & 1;
#pragma unroll
  for (int mi = 0; mi < 2; ++mi) {
    const size_t o0 = (size_t)(wm * 64 + mi * 32 + 4 * (lane >> 5)) * DM + wn * 64 + (lane & 31);
#pragma unroll
    for (int r = 0; r < 16; ++r) {
      const size_t ro = o0 + (size_t)((r & 3) + 8 * (r >> 2)) * DM;
      xv[mi][0][r] = src[ro];
      xv[mi][1][r] = src[ro + 32];
    }
  }
}
DI void resid_store2(f32x16 (&acc)[2][2], const float (&xv)[2][2][16], float* dst, const float* __restrict__ g) {
  const int lane = get_tid() & 63, w = get_tid() >> 6;
  const int wm = w >> 1, wn = w & 1;
  const float g0 = g[wn * 64 + (lane & 31)], g1 = g[wn * 64 + 32 + (lane & 31)];
#pragma unroll
  for (int mi = 0; mi < 2; ++mi) {
    const size_t o0 = (size_t)(wm * 64 + mi * 32 + 4 * (lane >> 5)) * DM + wn * 64 + (lane & 31);
#pragma unroll
    for (int r = 0; r < 16; ++r) {
      const size_t ro = o0 + (size_t)((r & 3) + 8 * (r >> 2)) * DM;
      dst[ro] = xv[mi][0][r] + g0 * acc[mi][0][r];
      dst[ro + 32] = xv[mi][1][r] + g1 * acc[mi][1][r];
    }
  }
}
DI void phase_outproj(const Params& p, int layer, size_t wt_off, int nrows, bool first, char* smem) {
  (void)first;
  bf16* As = (bf16*)smem; bf16* Bs = As + 128 * GLS;
  const bf16* A = (const bf16*)(p.ws + OFF_ACTA);
  const bf16* Wt = (const bf16*)(p.ws + wt_off);
  const int ntn = 8, ntm = nrows / 128;
  for (int t = blockIdx.x; t < ntn * ntm; t += gridDim.x) {
    const int mt = t / ntn, nt = t % ntn;
    f32x16 acc[2][2];
    const int r0 = mt * 128;
    float xv[2][2][16];
    resid_prefetch2(xv, orig_row(p, r0) + nt * 128);
    gemm_128x128(A + (size_t)mt * 128 * DM, DM, Wt + (size_t)nt * 128 * DM, DM, DM, acc, As, Bs);
    resid_store2(acc, xv, res_row(p, r0) + nt * 128, mod_ptr(p, layer, r0, 2) + nt * 128);
  }
}
DI void phase_outproj1(const Params& p, char* smem) {
  bf16* As = (bf16*)smem; bf16* Bs = As + 256 * GLS;
  const bf16* A = (const bf16*)(p.ws + OFF_ACTA);
  const bf16* Wt = (const bf16*)(p.ws + OFF_WT_ODOUT);
  const int ntn = 8, ntm = NLAT / 256;
  for (int t = blockIdx.x; t < ntn * ntm; t += gridDim.x) {
    const int mt = t / ntn, nt = t % ntn;
    f32x16 acc[4][2];
    gemm_256x128(A + (size_t)mt * 256 * DM, DM, Wt + (size_t)nt * 128 * DM, DM, DM, acc, As, Bs);
    float* xp = p.out + (size_t)(mt * 256) * DM + nt * 128;
    resid_epilogue<4>(acc, xp, xp, mod_ptr(p, 1, mt * 256, 2) + nt * 128);
  }
}

DI void tk_ins(float (&L)[16], float x) {
#pragma unroll
  for (int j = 15; j >= 1; --j) L[j] = __builtin_amdgcn_fmed3f(L[j - 1], L[j], x);
  L[0] = fmaxf(L[0], x);
}
DI void tk_insert(float (&v)[16], int (&id)[16], float x, int xi) {
  if (x > v[15]) {
    v[15] = x; id[15] = xi;
#pragma unroll
    for (int j = 15; j > 0; --j) {
      bool sw = v[j] > v[j - 1];
      float a = v[j], b2 = v[j - 1];
      int ia = id[j], ib = id[j - 1];
      v[j - 1] = sw ? a : b2; v[j] = sw ? b2 : a;
      id[j - 1] = sw ? ia : ib; id[j] = sw ? ib : ia;
    }
  }
}

DI void phase_peer_route(const Params& p, int layer, int nrows, char* smem, size_t roff = OFF_RIDX) {
  bf16* As = (bf16*)smem; bf16* Bs = As + 128 * GLS;
  constexpr int QLS = 136;
  bf16* Qt = (bf16*)smem;
  bf16* Kt = Qt + 128 * QLS;
  float* Sc = (float*)smem;
  const bf16* A = (const bf16*)(p.ws + OFF_ACTA);
  const bf16* Wt = (const bf16*)(p.ws + OFF_WT_PWQ) + (size_t)layer * 2048 * 1024;
  const bf16* keys = (const bf16*)(p.ws + OFF_PKEYS) + (size_t)layer * 8 * 2 * 128 * 128;
  int* ridx = (int*)(p.ws + roff);
  float* rgw = (float*)(p.ws + roff + (OFF_RGW - OFF_RIDX));
  const int tid = get_tid(), lane = tid & 63, w = tid >> 6;
  const int wm = w >> 1, wn = w & 1;
  const int ntm = nrows / 128;
  for (int it = blockIdx.x; it < ntm * 8; it += gridDim.x) {
    const int mt = it >> 3, h = it & 7;
    float l0v[16]; int l0i[16];
    float lv[16]; int li[16];
    for (int pp = 0; pp < 2; ++pp) {
      f32x16 acc[2][2];
      gemm_128x128(A + (size_t)mt * 128 * DM, DM, Wt + (size_t)((h * 2 + pp) * 128) * DM, DM, DM, acc, As, Bs);
      __syncthreads();
      gemm_epi(acc, [&](int row, int col, float v) { Qt[row * QLS + col] = f2bf(v); });
      {
        const bf16* kb = keys + (size_t)((h * 2 + pp) * 128) * 128;
#pragma unroll
        for (int i = 0; i < 8; ++i) {
          int ci = i * 256 + tid;
          int row = ci >> 4, chh = ci & 15;
          *(u32x4*)(Kt + row * QLS + chh * 8) = *(const u32x4*)(kb + row * 128 + chh * 8);
        }
      }
      __syncthreads();
      f32x16 sa[2][2];
#pragma unroll
      for (int i = 0; i < 2; ++i)
#pragma unroll
        for (int j = 0; j < 2; ++j) {
#pragma unroll
          for (int r = 0; r < 16; ++r) sa[i][j][r] = 0.f;
          mma_tile(sa[i][j], Qt + (wm * 64 + i * 32) * QLS, QLS, Kt + (wn * 64 + j * 32) * QLS, QLS, 128);
        }
      __syncthreads();
      gemm_epi(sa, [&](int row, int col, float v) { Sc[row * 129 + col] = v; });
      __syncthreads();
      {
        const int tok = tid & 127, hf = tid >> 7;
        float* Lst = Sc + 128 * 129;
        float L[16];
#pragma unroll
        for (int j = 0; j < 16; ++j) L[j] = -3.0e38f;
#pragma unroll 8
        for (int n = 0; n < 64; ++n) {
          const int nn = hf * 64 + n;
          const unsigned kb = (__float_as_uint(Sc[tok * 129 + nn]) & 0xffffff80u) | (unsigned)nn;
          tk_ins(L, __uint_as_float(kb));
        }
        if (hf == 1) {
#pragma unroll
          for (int j = 0; j < 16; ++j) Lst[tok * 17 + j] = L[j];
        }
        __syncthreads();
        if (hf == 0) {
#pragma unroll
          for (int j = 0; j < 16; ++j) tk_ins(L, Lst[tok * 17 + j]);
#pragma unroll
          for (int j = 0; j < 16; ++j) {
            const int ix = (int)(__float_as_uint(L[j]) & 0x7fu);
            li[j] = ix;
            lv[j] = Sc[tok * 129 + ix];
          }
          if (pp == 0) {
#pragma unroll
            for (int j = 0; j < 16; ++j) { l0v[j] = lv[j]; l0i[j] = li[j]; }
          }
        }
      }
      __syncthreads();
    }
    if (tid < 128) {
      float fv[16]; int fi[16];
#pragma unroll
      for (int j = 0; j < 16; ++j) { fv[j] = -3.0e38f; fi[j] = 0; }
#pragma unroll
      for (int a = 0; a < 16; ++a)
#pragma unroll
        for (int b2 = 0; b2 < 16; ++b2)
          if ((a + 1) * (b2 + 1) <= 16) tk_insert(fv, fi, l0v[a] + lv[b2], l0i[a] * 128 + li[b2]);
      float mx = fv[0];
      float e[16];
#pragma unroll
      for (int j = 0; j < 16; ++j) e[j] = fv[j];
      float sum = 0.f;
#pragma unroll
      for (int j = 0; j < 16; ++j) { e[j] = __expf(e[j] - mx); sum += e[j]; }
      const float inv = 1.f / sum;
      const int r = mt * 128 + tid;
      int4* ip = (int4*)(ridx + (size_t)r * 128 + h * 16);
      float4* gp = (float4*)(rgw + (size_t)r * 128 + h * 16);
#pragma unroll
      for (int j = 0; j < 4; ++j) {
        ip[j] = make_int4(fi[4 * j], fi[4 * j + 1], fi[4 * j + 2], fi[4 * j + 3]);
        gp[j] = make_float4(e[4 * j] * inv, e[4 * j + 1] * inv, e[4 * j + 2] * inv, e[4 * j + 3] * inv);
      }
    }
  }
}

typedef float f32x2 __attribute__((ext_vector_type(2)));
DI float wave_max(float v) {
#pragma unroll
  for (int o = 32; o > 0; o >>= 1) v = fmaxf(v, __shfl_xor(v, o));
  return v;
}
DI unsigned pk4_fp8(float a, float b, float c, float d) {
  int r = 0;
  r = __builtin_amdgcn_cvt_pk_fp8_f32(a, b, r, false);
  r = __builtin_amdgcn_cvt_pk_fp8_f32(c, d, r, true);
  return (unsigned)r;
}
DI float clamp6(float v) { return __builtin_amdgcn_fmed3f(v, -6.0f, 6.0f); }
DI void convert_fp8_rows(const float* __restrict__ src, unsigned char* __restrict__ dst, float* __restrict__ scl) {
  const int lane = get_tid() & 63, w = get_tid() >> 6;
  for (int row = blockIdx.x * 4 + w; row < 16384; row += gridDim.x * 4) {
    const float4* s4 = (const float4*)(src + (size_t)row * 1024) + lane * 4;
    float4 v0 = s4[0], v1 = s4[1], v2 = s4[2], v3 = s4[3];
    float ss = v0.x * v0.x + v0.y * v0.y + v0.z * v0.z + v0.w * v0.w + v1.x * v1.x + v1.y * v1.y + v1.z * v1.z + v1.w * v1.w +
               v2.x * v2.x + v2.y * v2.y + v2.z * v2.z + v2.w * v2.w + v3.x * v3.x + v3.y * v3.y + v3.z * v3.z + v3.w * v3.w;
    ss = wave_sum(ss);
    const float sc = (ss > 0.f) ? 0.5f * sqrtf(ss * (1.0f / 1024.0f)) : 1.0f;
    const float inv = 1.0f / sc;
    unsigned d0 = 0, d1 = 0;
    d0 = __builtin_amdgcn_cvt_scalef32_pk_fp4_f32(d0, clamp6(v0.x * inv), clamp6(v0.y * inv), 1.0f, 0);
    d0 = __builtin_amdgcn_cvt_scalef32_pk_fp4_f32(d0, clamp6(v0.z * inv), clamp6(v0.w * inv), 1.0f, 1);
    d0 = __builtin_amdgcn_cvt_scalef32_pk_fp4_f32(d0, clamp6(v1.x * inv), clamp6(v1.y * inv), 1.0f, 2);
    d0 = __builtin_amdgcn_cvt_scalef32_pk_fp4_f32(d0, clamp6(v1.z * inv), clamp6(v1.w * inv), 1.0f, 3);
    d1 = __builtin_amdgcn_cvt_scalef32_pk_fp4_f32(d1, clamp6(v2.x * inv), clamp6(v2.y * inv), 1.0f, 0);
    d1 = __builtin_amdgcn_cvt_scalef32_pk_fp4_f32(d1, clamp6(v2.z * inv), clamp6(v2.w * inv), 1.0f, 1);
    d1 = __builtin_amdgcn_cvt_scalef32_pk_fp4_f32(d1, clamp6(v3.x * inv), clamp6(v3.y * inv), 1.0f, 2);
    d1 = __builtin_amdgcn_cvt_scalef32_pk_fp4_f32(d1, clamp6(v3.z * inv), clamp6(v3.w * inv), 1.0f, 3);
    ((u32x2*)(dst + (size_t)row * 512))[lane] = u32x2{d0, d1};
    if (lane == 0) scl[row] = sc;
  }
}
DI int q4(float v) {
  int n = (int)floorf(v);
  return (n < -8 ? -8 : (n > 7 ? 7 : n)) & 15;
}
DI void convert_u4_rows(const float* __restrict__ src, unsigned char* __restrict__ dst, float* __restrict__ scl) {
  const int lane = get_tid() & 63, w = get_tid() >> 6;
  for (int row = blockIdx.x * 4 + w; row < 16384; row += gridDim.x * 4) {
    const float4* s4 = (const float4*)(src + (size_t)row * 1024) + lane * 4;
    float4 v0 = s4[0], v1 = s4[1], v2 = s4[2], v3 = s4[3];
    float ss = v0.x * v0.x + v0.y * v0.y + v0.z * v0.z + v0.w * v0.w + v1.x * v1.x + v1.y * v1.y + v1.z * v1.z + v1.w * v1.w +
               v2.x * v2.x + v2.y * v2.y + v2.z * v2.z + v2.w * v2.w + v3.x * v3.x + v3.y * v3.y + v3.z * v3.z + v3.w * v3.w;
    ss = wave_sum(ss);
    const float sc = (ss > 0.f) ? 0.3352f * sqrtf(ss * (1.0f / 1024.0f)) : 1.0f;
    const float inv = 1.0f / sc;
    const unsigned d0 = (unsigned)q4(v0.x * inv) | ((unsigned)q4(v1.x * inv) << 4) | ((unsigned)q4(v0.y * inv) << 8) | ((unsigned)q4(v1.y * inv) << 12) |
                        ((unsigned)q4(v0.z * inv) << 16) | ((unsigned)q4(v1.z * inv) << 20) | ((unsigned)q4(v0.w * inv) << 24) | ((unsigned)q4(v1.w * inv) << 28);
    const unsigned d1 = (unsigned)q4(v2.x * inv) | ((unsigned)q4(v3.x * inv) << 4) | ((unsigned)q4(v2.y * inv) << 8) | ((unsigned)q4(v3.y * inv) << 12) |
                        ((unsigned)q4(v2.z * inv) << 16) | ((unsigned)q4(v3.z * inv) << 20) | ((unsigned)q4(v2.w * inv) << 24) | ((unsigned)q4(v3.w * inv) << 28);
    ((u32x2*)(dst + (size_t)row * 512))[lane] = u32x2{d0, d1};
    if (lane == 0) scl[row] = sc;
  }
}
DI void phase_convert_tables(const Params& p, int layer) {
  convert_u4_rows(p.peer_u + (size_t)layer * 16384 * 1024, (unsigned char*)(p.ws + OFF_UTAB), (float*)(p.ws + OFF_SU));
  convert_fp8_rows(p.peer_v + (size_t)layer * 16384 * 1024, (unsigned char*)(p.ws + OFF_VTAB), (float*)(p.ws + OFF_SV));
}

struct GBuf { u32x4 u[8]; u32x4 v[8]; float su, sv, gw; };
#define FP4X2(d, s) __builtin_amdgcn_cvt_scalef32_pk_f32_fp4((d), 1.0f, (s))
#define FP4B2(d, s) __builtin_amdgcn_cvt_scalef32_pk_bf16_fp4((d), 1.0f, (s))
typedef __bf16 bf16x2v __attribute__((ext_vector_type(2)));
template <int X> DI float swz_xor(float v) {
  return __builtin_bit_cast(float, __builtin_amdgcn_ds_swizzle(__builtin_bit_cast(int, v), (X << 10) | 0x1f));
}
template <int L> DI float swz_bcast(float v) {
  return __builtin_bit_cast(float, __builtin_amdgcn_ds_swizzle(__builtin_bit_cast(int, v), (L << 5)));
}
DI float wave_sum_swz(float v) {
  v += swz_xor<1>(v); v += swz_xor<2>(v); v += swz_xor<4>(v); v += swz_xor<8>(v); v += swz_xor<16>(v);
  return __builtin_bit_cast(float, __builtin_amdgcn_readlane(__builtin_bit_cast(int, v), 0)) +
         __builtin_bit_cast(float, __builtin_amdgcn_readlane(__builtin_bit_cast(int, v), 32));
}
DI float bperm_f(float v, int byte_idx) { return __builtin_bit_cast(float, __builtin_amdgcn_ds_bpermute(byte_idx, __builtin_bit_cast(int, v))); }
DI void phase_peer_gather(const Params& p, int layer, int nrows, bool dry) {
  const int lane = get_tid() & 63, w = __builtin_amdgcn_readfirstlane(get_tid() >> 6);
  const int half = lane >> 5, l5 = lane & 31;
  const bf16* hb = (const bf16*)(p.ws + OFF_ACTA);
  const unsigned char* ut = (const unsigned char*)(p.ws + OFF_UTAB);
  const unsigned char* vtb = (const unsigned char*)(p.ws + OFF_VTAB);
  const float* su = (const float*)(p.ws + OFF_SU);
  const float* sv = (const float*)(p.ws + OFF_SV);
  const int* ridx = (const int*)(p.ws + OFF_RIDX);
  const float* rgw = (const float*)(p.ws + OFF_RGW);
  const int ecode = half * 8 + ((lane >> 4) & 1) * 4 + ((lane >> 3) & 1) * 2 + ((lane >> 2) & 1);
  for (int r = blockIdx.x * 4 + w; r < nrows; r += gridDim.x * 4) {
    unsigned HH[4], HL[4];
    float sh8, h8tot;
    {
      const u32x4* hp = (const u32x4*)(hb + (size_t)r * DM + l5 * 32);
      u32x4 a[4];
#pragma unroll
      for (int q = 0; q < 4; ++q) a[q] = hp[q];
      float m = 0.f;
#pragma unroll
      for (int q = 0; q < 4; ++q)
#pragma unroll
        for (int c = 0; c < 4; ++c) m = fmaxf(m, fmaxf(fabsf(bflo(a[q][c])), fabsf(bfhi(a[q][c]))));
      m = fmaxf(m, swz_xor<1>(m)); m = fmaxf(m, swz_xor<2>(m)); m = fmaxf(m, swz_xor<4>(m));
      m = fmaxf(m, swz_xor<8>(m)); m = fmaxf(m, swz_xor<16>(m));
      const float sc = (m > 0.f) ? 119.0f / m : 0.f;
      sh8 = m * (1.0f / 119.0f);
      float hs = 0.f;
#pragma unroll
      for (int q = 0; q < 4; ++q) {
        float f[8] = {bflo(a[q][0]), bfhi(a[q][0]), bflo(a[q][1]), bfhi(a[q][1]), bflo(a[q][2]), bfhi(a[q][2]), bflo(a[q][3]), bfhi(a[q][3])};
        unsigned P0 = 0, P1 = 0;
#pragma unroll
        for (int i = 0; i < 4; ++i) {
          const float g0 = rintf(f[i] * sc), g1 = rintf(f[4 + i] * sc);
          hs += g0 + g1;
          P0 = __builtin_amdgcn_cvt_pk_u8_f32(g0 + 136.0f, i, P0);
          P1 = __builtin_amdgcn_cvt_pk_u8_f32(g1 + 136.0f, i, P1);
        }
        HH[q] = (((P0 >> 4) & 0x0F0F0F0Fu) | (P1 & 0xF0F0F0F0u)) ^ 0x88888888u;
        HL[q] = ((P0 & 0x0F0F0F0Fu) | ((P1 << 4) & 0xF0F0F0F0u)) ^ 0x88888888u;
      }
      hs += swz_xor<1>(hs); hs += swz_xor<2>(hs); hs += swz_xor<4>(hs); hs += swz_xor<8>(hs); hs += swz_xor<16>(hs);
      h8tot = 0.5f * hs;
    }
    const int e_lo = ridx[(size_t)r * 128 + lane], e_hi = ridx[(size_t)r * 128 + 64 + lane];
    const float g_lo = rgw[(size_t)r * 128 + lane], g_hi = rgw[(size_t)r * 128 + 64 + lane];
    f32x2 acc[16];
#pragma unroll
    for (int j = 0; j < 16; ++j) acc[j] = f32x2{0.f, 0.f};
    auto gload = [&](GBuf& B, int kb) {
      const int esrc = (kb < 4) ? e_lo : e_hi;
      const float gsrc = (kb < 4) ? g_lo : g_hi;
      const int base = (kb & 3) * 16;
#pragma unroll
      for (int j = 0; j < 8; ++j) {
        const int ea = __builtin_amdgcn_readlane(esrc, base + j), eb = __builtin_amdgcn_readlane(esrc, base + 8 + j);
        const unsigned off = (unsigned)(half ? eb : ea) * 512u + (unsigned)l5 * 16u;
        B.u[j] = *(const u32x4*)(ut + off);
        B.v[j] = *(const u32x4*)(vtb + off);
      }
      const int el = __builtin_amdgcn_ds_bpermute((base + ecode) << 2, esrc);
      B.su = su[el]; B.sv = sv[el];
      B.gw = bperm_f(gsrc, (base + ecode) << 2);
    };
    auto compute = [&](GBuf& B) {
      float part[8];
#pragma unroll
      for (int j = 0; j < 8; ++j) {
        int dh = 0, dl = 0;
#pragma unroll
        for (int q = 0; q < 4; ++q) {
          dh = __builtin_amdgcn_sdot8((int)B.u[j][q], (int)HH[q], dh, false);
          dl = __builtin_amdgcn_sdot8((int)B.u[j][q], (int)HL[q], dl, false);
        }
        part[j] = (float)((dh << 4) + dl);
      }
      const bool b4 = lane & 16, b3 = lane & 8, b2 = lane & 4;
      float y[4], z[2], t;
#pragma unroll
      for (int i = 0; i < 4; ++i) {
        float send = b4 ? part[i] : part[i + 4];
        float keep = b4 ? part[i + 4] : part[i];
        y[i] = keep + swz_xor<16>(send);
      }
#pragma unroll
      for (int i = 0; i < 2; ++i) {
        float send = b3 ? y[i] : y[i + 2];
        float keep = b3 ? y[i + 2] : y[i];
        z[i] = keep + swz_xor<8>(send);
      }
      {
        float send = b2 ? z[0] : z[1];
        float keep = b2 ? z[1] : z[0];
        t = keep + swz_xor<4>(send);
      }
      t += swz_xor<2>(t);
      t += swz_xor<1>(t);
      const float wl = geluf_((t + h8tot) * (B.su * sh8)) * B.gw * B.sv;
#define GACC(J)                                                                                        \
      {                                                                                                  \
        const float wj = swz_bcast<(((J) >> 2) & 1) * 16 + (((J) >> 1) & 1) * 8 + ((J) & 1) * 4>(wl);    \
        const f32x2 w2 = f32x2{wj, wj};                                                                  \
        _Pragma("unroll") for (int q = 0; q < 4; ++q) {                                                  \
          acc[4 * q] += w2 * FP4X2(B.v[J][q], 0);                                                        \
          acc[4 * q + 1] += w2 * FP4X2(B.v[J][q], 1);                                                    \
          acc[4 * q + 2] += w2 * FP4X2(B.v[J][q], 2);                                                    \
          acc[4 * q + 3] += w2 * FP4X2(B.v[J][q], 3);                                                    \
        }                                                                                                \
      }
      GACC(0) GACC(1) GACC(2) GACC(3) GACC(4) GACC(5) GACC(6) GACC(7)
#undef GACC
    };
    GBuf B0, B1;
    gload(B0, 0);
#pragma unroll 1
    for (int kb = 0; kb < 8; kb += 2) {
      gload(B1, kb + 1);
      compute(B0);
      if (kb + 2 < 8) gload(B0, kb + 2);
      compute(B1);
    }
    if (dry && acc[0].x != 12345.678f) continue;
    f32x2 fin[8];
#pragma unroll
    for (int k = 0; k < 8; ++k) {
      f32x2 send = half ? acc[k] : acc[k + 8];
      f32x2 keep = half ? acc[k + 8] : acc[k];
      fin[k] = f32x2{keep.x + bperm_f(send.x, (lane ^ 32) << 2), keep.y + bperm_f(send.y, (lane ^ 32) << 2)};
    }
    int eo = l5 * 32 + half * 16;
    asm volatile("" : "+v"(eo));
    float* xr = res_row(p, r) + eo;
    const float* g5 = mod_ptr(p, layer, r, 5) + eo;
    float4 xn[4];
    float ss = 0.f;
#pragma unroll
    for (int q = 0; q < 4; ++q) {
      float4 x0 = ((float4*)xr)[q];
      float4 m0 = ((const float4*)g5)[q];
      x0.x += m0.x * fin[2 * q].x; x0.y += m0.y * fin[2 * q].y; x0.z += m0.z * fin[2 * q + 1].x; x0.w += m0.w * fin[2 * q + 1].y;
      xn[q] = x0;
      ss += x0.x * x0.x + x0.y * x0.y + x0.z * x0.z + x0.w * x0.w;
    }
    ss = wave_sum_swz(ss);
    const float rs = rsqrtf(ss * (1.0f / 1024.0f) + EPSN);
    if (layer == 0) {
      const float* gg = p.norm1_g + 1024 + eo;
      const float* sh = mod_ptr(p, 1, r, 0) + eo;
      const float* sc = mod_ptr(p, 1, r, 1) + eo;
      unsigned hw[8];
#pragma unroll
      for (int q = 0; q < 4; ++q) {
        ((float4*)xr)[q] = xn[q];
        float4 g4 = ((const float4*)gg)[q], s4 = ((const float4*)sh)[q], c4 = ((const float4*)sc)[q];
        float o0 = xn[q].x * rs * g4.x * (1.f + c4.x) + s4.x;
        float o1 = xn[q].y * rs * g4.y * (1.f + c4.y) + s4.y;
        float o2 = xn[q].z * rs * g4.z * (1.f + c4.z) + s4.z;
        float o3 = xn[q].w * rs * g4.w * (1.f + c4.w) + s4.w;
        hw[2 * q] = cvtpk(o0, o1); hw[2 * q + 1] = cvtpk(o2, o3);
      }
      u32x4 w0 = {hw[0], hw[1], hw[2], hw[3]}, w1 = {hw[4], hw[5], hw[6], hw[7]};
      bf16* hd = (bf16*)(p.ws + OFF_ACTA) + (size_t)r * DM + eo;
      *(u32x4*)hd = w0;
      *(u32x4*)(hd + 8) = w1;
    } else {
      const float* gg = p.final_g + eo;
#pragma unroll
      for (int q = 0; q < 4; ++q) {
        float4 g4 = ((const float4*)gg)[q];
        float4 o;
        o.x = xn[q].x * rs * g4.x; o.y = xn[q].y * rs * g4.y; o.z = xn[q].z * rs * g4.z; o.w = xn[q].w * rs * g4.w;
        ((float4*)xr)[q] = o;
      }
    }
  }
}

DI void phase_inproj1(const Params& p, char* smem) {
  bf16* As = (bf16*)smem; bf16* Bs = As + 256 * GLS;
  const bf16* A = (const bf16*)(p.ws + OFF_ACTA);
  const bf16* Wt = (const bf16*)(p.ws + OFF_WT_ODIN);
  bf16* pm = (bf16*)(p.ws + OFF_PA1M);
  bf16* pu = (bf16*)(p.ws + OFF_U1);
  const int ntn = 10, ntm = NTOK / 256;
  for (int t = blockIdx.x; t < ntn * ntm; t += gridDim.x) {
    const int mt = t / ntn, nt = t % ntn;
    f32x16 acc[4][2];
    gemm_256x128(A + (size_t)mt * 256 * DM, DM, Wt + (size_t)nt * 128 * DM, DM, DM, acc, As, Bs);
    gemm_epi2(acc, [&](int row, int col, float v) {
      int r = mt * 256 + row, cg_ = nt * 128 + col;
      if (cg_ < 672) pm[(size_t)r * 672 + cg_] = f2bf(v);
      else if (cg_ < 1184) pu[(size_t)r * 512 + (cg_ - 672)] = f2bf(v);
    });
  }
}

DI void phase_mla_prep(const Params& p) {
  const int lane = get_tid() & 63, w = get_tid() >> 6;
  const bf16* pm = (const bf16*)(p.ws + OFF_PA1M);
  bf16* qn = (bf16*)(p.ws + OFF_QN);
  bf16* kvn = (bf16*)(p.ws + OFF_KVN);
  bf16* k1 = (bf16*)(p.ws + OFF_K1);
  const float inv = __powf(10000.f, -(float)(lane & 7) / 8.f);
  for (int r = blockIdx.x * 4 + w; r < NTOK; r += gridDim.x * 4) {
    const bf16* row = pm + (size_t)r * 672;
    if (r < NLAT) {
      float v[6]; float ss = 0.f;
#pragma unroll
      for (int i = 0; i < 6; ++i) { v[i] = bf2f(row[i * 64 + lane]); ss += v[i] * v[i]; }
      ss = wave_sum(ss);
      const float rs = rsqrtf(ss * (1.f / 384.f) + EPSN);
#pragma unroll
      for (int i = 0; i < 6; ++i) qn[(size_t)r * 384 + i * 64 + lane] = f2bf(v[i] * rs * p.mla_qa_g[i * 64 + lane]);
    }
    {
      float v[4]; float ss = 0.f;
#pragma unroll
      for (int i = 0; i < 4; ++i) { v[i] = bf2f(row[384 + i * 64 + lane]); ss += v[i] * v[i]; }
      ss = wave_sum(ss);
      const float rs = rsqrtf(ss * (1.f / 256.f) + EPSN);
#pragma unroll
      for (int i = 0; i < 4; ++i) kvn[(size_t)r * 256 + i * 64 + lane] = f2bf(v[i] * rs * p.mla_kva_g[i * 64 + lane]);
    }
    {
      const int cl = lane & 31;
      float y = bf2f(row[640 + cl]);
      float sn = 0.f, cs = 1.f;
      if (r < NLAT) {
        int t = r & 8191;
        float pos = (cl < 16) ? (float)(t >> 6) : (float)(t & 63);
        sincosf(pos * inv, &sn, &cs);
      }
      float pr = __shfl_xor(y, 8);
      float o = y * cs + ((cl & 8) ? pr * sn : -pr * sn);
      bf16 ob = f2bf(o);
      {
        const float ob_f = bf2f(ob);
        const float sq = wave_sum(lane < 32 ? ob_f * ob_f : 0.f);
        if (lane == 0) ((float*)(p.ws + OFF_KRSQ))[r] = sq;
      }
      const int hb = (lane >> 5) * 4;
#pragma unroll
      for (int hh = 0; hh < 4; ++hh) k1[(size_t)r * 768 + (hb + hh) * 96 + 64 + cl] = ob;
    }
  }
}

DI void phase_mla_up(const Params& p, char* smem) {
  bf16* As = (bf16*)smem; bf16* Bs = As + 128 * GLS;
  const bf16* qn = (const bf16*)(p.ws + OFF_QN);
  const bf16* kvn = (const bf16*)(p.ws + OFF_KVN);
  const bf16* wq = (const bf16*)(p.ws + OFF_WT_QUP);
  const bf16* wkv = (const bf16*)(p.ws + OFF_WT_KVUP);
  bf16* q1 = (bf16*)(p.ws + OFF_Q1);
  bf16* k1 = (bf16*)(p.ws + OFF_K1);
  bf16* vt1 = (bf16*)(p.ws + OFF_VT1);
  const float2* rtab = (const float2*)(p.ws + OFF_ROPE1);
  const int lane = get_tid() & 63, w = get_tid() >> 6;
  const int wm = w >> 1, wn = w & 1;
  const int nq = (NLAT / 128) * 6, nkv = (NTOK / 128) * 8;
  for (int t = blockIdx.x; t < nq + nkv; t += gridDim.x) {
    f32x16 acc[2][2];
    if (t < nq) {
      const int mt = t / 6, nt = t % 6;
      gemm_128x128(qn + (size_t)mt * 128 * 384, 384, wq + (size_t)nt * 128 * 384, 384, 384, acc, As, Bs);
#pragma unroll
      for (int mi = 0; mi < 2; ++mi)
#pragma unroll
        for (int ni = 0; ni < 2; ++ni) {
          const int colbase = nt * 128 + wn * 64 + ni * 32;
          const bool rope = (colbase % 96) == 64;
          const int cl = lane & 31;
#pragma unroll
          for (int r = 0; r < 16; ++r) {
            const int row = mt * 128 + wm * 64 + mi * 32 + crow(r, lane);
            float v = acc[mi][ni][r];
            float pr = __shfl_xor(v, 8);
            if (rope) {
              int tt = row & 8191;
              float2 csn = rtab[tt * 16 + ((cl >> 4) << 3) + (cl & 7)];
              v = v * csn.x + ((cl & 8) ? pr * csn.y : -pr * csn.y);
            }
            q1[(size_t)row * 768 + colbase + cl] = f2bf(v * (0.10206207261596577f * 1.4426950408889634f));
          }
        }
    } else {
      const int t2 = t - nq;
      const int mt = t2 >> 3, h = t2 & 7;
      gemm_128x128(kvn + (size_t)mt * 128 * 256, 256, wkv + (size_t)h * 128 * 256, 256, 256, acc, As, Bs);
      const int r0 = mt * 128;
      int b, s0;
      if (r0 < NLAT) { b = r0 >> 13; s0 = CTXL + (r0 & 8191); } else { int rc = r0 - NLAT; b = rc >> 8; s0 = rc & 255; }
#pragma unroll
      for (int mi = 0; mi < 2; ++mi)
#pragma unroll
        for (int ni = 0; ni < 2; ++ni) {
          const int cl = ni * 32 + (lane & 31);
          if (wn == 0) {
#pragma unroll
            for (int r = 0; r < 16; ++r) {
              const int row = r0 + wm * 64 + mi * 32 + crow(r, lane);
              k1[(size_t)row * 768 + h * 96 + cl] = f2bf(acc[mi][ni][r]);
            }
            if (ni == 1) {
              float mxk = 0.f;
#pragma unroll
              for (int r = 0; r < 16; ++r) {
                float sq = acc[mi][0][r] * acc[mi][0][r] + acc[mi][1][r] * acc[mi][1][r];
                sq += __shfl_xor(sq, 16); sq += __shfl_xor(sq, 8); sq += __shfl_xor(sq, 4); sq += __shfl_xor(sq, 2); sq += __shfl_xor(sq, 1);
                const int row = r0 + wm * 64 + mi * 32 + crow(r, lane);
                sq += ((const float*)(p.ws + OFF_KRSQ))[row];
                mxk = fmaxf(mxk, sq);
              }
              mxk = wave_max(mxk);
              if (lane == 0) atomicMax((unsigned*)(p.ws + OFF_KMAX) + b * 8 + h, __float_as_uint(sqrtf(mxk) * 1.02f));
            }
          } else {
            bf16* vrow = vt1 + (size_t)((b * 8 + h) * 64 + cl) * SKEYS + s0 + wm * 64 + mi * 32;
#pragma unroll
            for (int g4 = 0; g4 < 4; ++g4) {
              u32x2 o;
              o.x = cvtpk(acc[mi][ni][4 * g4], acc[mi][ni][4 * g4 + 1]);
              o.y = cvtpk(acc[mi][ni][4 * g4 + 2], acc[mi][ni][4 * g4 + 3]);
              *(u32x2*)(vrow + 8 * g4 + 4 * (lane >> 5)) = o;
            }
          }
        }
    }
  }
}

DI void s5_item(const Params& p, int item, char* smem) {
  const int dir = item & 1, g = (item >> 1) & 31, b = item >> 6;
  constexpr int ULS = 264, SLS = 136;
  bf16* Uc = (bf16*)smem;
  bf16* Sp = Uc + 32 * ULS;
  float* E = (float*)(Sp + 32 * SLS);
  const int mi_ = g * 2 + dir;
  const bf16* T = (const bf16*)(p.ws + OFF_S5T) + (size_t)mi_ * 65536;
  const bf16* WE = (const bf16*)(p.ws + OFF_S5WE) + (size_t)mi_ * 32768;
  const bf16* WY = (const bf16*)(p.ws + OFF_S5WY) + (size_t)mi_ * 32768;
  const float* A16 = (const float*)(p.ws + OFF_S5A16) + (size_t)mi_ * 128;
  const bf16* U1 = (const bf16*)(p.ws + OFF_U1);
  bf16* ys = (bf16*)(p.ws + OFF_YS5) + (size_t)dir * NLAT * 512;
  const int tid = get_tid(), lane = tid & 63, w = tid >> 6;
  auto rowof = [&](int pos) -> int {
    if (pos < CTXL) { int s = dir ? (CTXL - 1 - pos) : pos; return NLAT + b * CTXL + s; }
    int t = pos - CTXL; t = dir ? (SEQ - 1 - t) : t; return b * SEQ + t;
  };
  float sre = 0.f, sim = 0.f;
  const float a16r = A16[(lane & 63) * 2], a16i = A16[(lane & 63) * 2 + 1];
  for (int sc = 0; sc < 17; ++sc) {
    const int nvalid = (528 - sc * 32) < 32 ? (528 - sc * 32) : 32;
    __syncthreads();
    {
      const int n = tid >> 3, j0 = (tid & 7) * 2;
#pragma unroll
      for (int jj = 0; jj < 2; ++jj) {
        u32x4 a = {0u, 0u, 0u, 0u}, b2 = {0u, 0u, 0u, 0u};
        if (n < nvalid) {
          const int pos = (sc * 32 + n) * 16 + j0 + jj;
          const bf16* src = U1 + (size_t)rowof(pos) * 512 + g * 16;
          a = *(const u32x4*)src; b2 = *(const u32x4*)(src + 8);
        }
        *(u32x4*)(Uc + n * ULS + (j0 + jj) * 16) = a;
        *(u32x4*)(Uc + n * ULS + (j0 + jj) * 16 + 8) = b2;
      }
    }
    __syncthreads();
    f32x16 e, y0, y1;
#pragma unroll
    for (int r = 0; r < 16; ++r) { e[r] = 0.f; y0[r] = 0.f; y1[r] = 0.f; }
    mma_tile_ga<256>(e, WE + (size_t)(w * 32) * 256, 256, Uc, ULS);
#pragma unroll
    for (int r = 0; r < 16; ++r) E[(w * 32 + crow(r, lane)) * 33 + (lane & 31)] = e[r];
    mma_tile_ga<256>(y0, T + (size_t)(2 * w * 32) * 256, 256, Uc, ULS);
    mma_tile_ga<256>(y1, T + (size_t)((2 * w + 1) * 32) * 256, 256, Uc, ULS);
    __syncthreads();
    if (w == 0) {
      for (int n = 0; n < 32; ++n) {
        Sp[n * SLS + lane] = f2bf(sre);
        Sp[n * SLS + 64 + lane] = f2bf(sim);
        float er = E[lane * 33 + n], ei = E[(64 + lane) * 33 + n];
        float nr = a16r * sre - a16i * sim + er;
        float ni = a16r * sim + a16i * sre + ei;
        sre = nr; sim = ni;
      }
    }
    __syncthreads();
    mma_tile_ga<128>(y0, WY + (size_t)(2 * w * 32) * 128, 128, Sp, SLS);
    mma_tile_ga<128>(y1, WY + (size_t)((2 * w + 1) * 32) * 128, 128, Sp, SLS);
    {
      const int n = lane & 31;
      if (n < nvalid) {
        const int cgi = sc * 32 + n;
#pragma unroll
        for (int tI = 0; tI < 2; ++tI) {
          const f32x16& y = tI ? y1 : y0;
#pragma unroll
          for (int g4 = 0; g4 < 4; ++g4) {
            const int m = (2 * w + tI) * 32 + 8 * g4 + 4 * (lane >> 5);
            const int i = m >> 4, c0 = m & 15;
            const int pos = cgi * 16 + i;
            if (pos >= CTXL) {
              u32x2 o;
              o.x = cvtpk(y[4 * g4], y[4 * g4 + 1]);
              o.y = cvtpk(y[4 * g4 + 2], y[4 * g4 + 3]);
              *(u32x2*)(ys + (size_t)rowof(pos) * 512 + g * 16 + c0) = o;
            }
          }
        }
      }
    }
  }
}

DI void phase_mix1(const Params& p, char* smem, int cidx) {
  __shared__ int s_item1;
  if (cidx == 1 && blockIdx.x < 256) s5_item(p, blockIdx.x, smem);
  unsigned* cnt = (unsigned*)(p.ws + OFF_CNT) + cidx;
  const bf16* q1 = (const bf16*)(p.ws + OFF_Q1);
  const bf16* k1 = (const bf16*)(p.ws + OFF_K1);
  const bf16* vt = (const bf16*)(p.ws + OFF_VT1);
  bf16* ycat = (bf16*)(p.ws + OFF_ACTA);
  const int n_lat = 4 * 8 * 32;
  while (true) {
    __syncthreads();
    if (get_tid() == 0) s_item1 = (int)atomicAdd(cnt, 1u);
    __syncthreads();
    const int it = s_item1;
    if (it >= n_lat) break;
    const int qt = it & 31, h = (it >> 5) & 7, b = it >> 8;
    const int r0 = b * SEQ + qt * 256;
    attn_item<96, 2>(q1 + (size_t)r0 * 768 + h * 96, 768, k1 + (size_t)(NLAT + b * CTXL) * 768 + h * 96,
                  k1 + (size_t)(b * SEQ) * 768 + h * 96, 768, vt + (size_t)((b * 8 + h) * 64) * SKEYS, SKEYS,
                  ycat + (size_t)r0 * DM + h * 64, DM, 0.10206207261596577f, smem, ((const float*)(p.ws + OFF_KMAX))[b * 8 + h]);
  }
}

DI void phase_s5_z(const Params& p) {
  const bf16* U1 = (const bf16*)(p.ws + OFF_U1);
  const bf16* y0 = (const bf16*)(p.ws + OFF_YS5);
  const bf16* y1 = y0 + (size_t)NLAT * 512;
  bf16* z = (bf16*)(p.ws + OFF_Z1);
  const size_t nv = (size_t)NLAT * 512 / 8;
  for (size_t i = (size_t)blockIdx.x * 256 + get_tid(); i < nv; i += (size_t)gridDim.x * 256) {
    const int col = (int)(i & 63) * 8;
    u32x4 u = ((const u32x4*)U1)[i], a = ((const u32x4*)y0)[i], b2 = ((const u32x4*)y1)[i];
    float fu[8], fa[8], fb[8], o[8];
    f32x16 dummy; (void)dummy;
    fu[0] = bflo(u.x); fu[1] = bfhi(u.x); fu[2] = bflo(u.y); fu[3] = bfhi(u.y); fu[4] = bflo(u.z); fu[5] = bfhi(u.z); fu[6] = bflo(u.w); fu[7] = bfhi(u.w);
    fa[0] = bflo(a.x); fa[1] = bfhi(a.x); fa[2] = bflo(a.y); fa[3] = bfhi(a.y); fa[4] = bflo(a.z); fa[5] = bfhi(a.z); fa[6] = bflo(a.w); fa[7] = bfhi(a.w);
    fb[0] = bflo(b2.x); fb[1] = bfhi(b2.x); fb[2] = bflo(b2.y); fb[3] = bfhi(b2.y); fb[4] = bflo(b2.z); fb[5] = bfhi(b2.z); fb[6] = bflo(b2.w); fb[7] = bfhi(b2.w);
#pragma unroll
    for (int j = 0; j < 8; ++j) o[j] = geluf_(p.s5_d[col + j] * fu[j] + fa[j] + fb[j]);
    u32x4 ov;
    ov.x = cvtpk(o[0], o[1]); ov.y = cvtpk(o[2], o[3]); ov.z = cvtpk(o[4], o[5]); ov.w = cvtpk(o[6], o[7]);
    ((u32x4*)z)[i] = ov;
  }
}

DI void phase_glu(const Params& p, char* smem) {
  bf16* As = (bf16*)smem; bf16* Bs = As + 256 * GLS;
  const bf16* z = (const bf16*)(p.ws + OFF_Z1);
  const bf16* Wt = (const bf16*)(p.ws + OFF_WT_GLU);
  bf16* ycat = (bf16*)(p.ws + OFF_ACTA);
  const int ntn = 4, ntm = NLAT / 256;
  for (int t = blockIdx.x; t < ntn * ntm; t += gridDim.x) {
    const int mt = t / ntn, nt = t % ntn;
    f32x16 acc[4][2];
    gemm_256x128(z + (size_t)mt * 256 * 512, 512, Wt + (size_t)nt * 128 * 512, 512, 512, acc, As, Bs);
    gemm_epi2(acc, [&](int row, int col, float v) {
      int r = mt * 256 + row, cc = nt * 128 + col;
      float zz = bf2f(z[(size_t)r * 512 + cc]);
      ycat[(size_t)r * DM + 512 + cc] = f2bf(zz * sigmoidf_(v + p.s5_b_glu[cc]));
    });
  }
}

DI void phase_final(const Params& p) {
  const int lane = get_tid() & 63, w = get_tid() >> 6;
  for (int r = blockIdx.x * 4 + w; r < NLAT; r += gridDim.x * 4) {
    float* row = p.out + (size_t)r * DM;
    float4 v[4];
    float ss = 0.f;
#pragma unroll
    for (int i = 0; i < 4; ++i) {
      v[i] = ((const float4*)row)[i * 64 + lane];
      ss += v[i].x * v[i].x + v[i].y * v[i].y + v[i].z * v[i].z + v[i].w * v[i].w;
    }
    ss = wave_sum(ss);
    const float rs = rsqrtf(ss * (1.0f / 1024.0f) + EPSN);
#pragma unroll
    for (int i = 0; i < 4; ++i) {
      float4 gg = ((const float4*)p.final_g)[i * 64 + lane];
      float4 o;
      o.x = v[i].x * rs * gg.x; o.y = v[i].y * rs * gg.y; o.z = v[i].z * rs * gg.z; o.w = v[i].w * rs * gg.w;
      ((float4*)row)[i * 64 + lane] = o;
    }
  }
}

DI void phase_copy_x(const Params& p) {
  const size_t n4 = (size_t)NLAT * DM / 4;
  for (size_t i = (size_t)blockIdx.x * 256 + get_tid(); i < n4; i += (size_t)gridDim.x * 256)
    ((float4*)p.out)[i] = ((const float4*)p.x)[i];
}

#define XB_TMO      128
#define XB_XCNT(j)  (256  + 64 * (j))
#define XB_XSUB(j)  (1280 + 64 * (j))
#define XB_XGEN(j)  (2304 + 64 * (j))
#define XB_TOP      3328
#define XB_TOPGEN   3392
#define XCD_BAR_WORDS 3456
#define XB_SPIN_CAP (1u << 22)
#define LAS __attribute__((address_space(3)))

__device__ __forceinline__ unsigned xb_ld(unsigned* p)              { return __hip_atomic_load(p, __ATOMIC_RELAXED, __HIP_MEMORY_SCOPE_AGENT); }
__device__ __forceinline__ unsigned xb_add(unsigned* p, unsigned v) { return __hip_atomic_fetch_add(p, v, __ATOMIC_RELAXED, __HIP_MEMORY_SCOPE_AGENT); }
__device__ __forceinline__ unsigned xb_xcc_id() { return (unsigned)__builtin_amdgcn_s_getreg((3 << 11) | 20) & 0xFu; }
#define XB_SPIN(cond, bar) do { unsigned _sp = 0; while (cond) { __builtin_amdgcn_s_sleep(1); \
    if ((++_sp & 255u) == 0u) { if (xb_ld(&(bar)[XB_TMO])) break; if (_sp > XB_SPIN_CAP) { atomicAdd(&(bar)[XB_TMO], 1u); break; } } } } while (0)

struct XcdBarrier {
    unsigned* bar; unsigned x;
    volatile LAS unsigned* st;
};

__device__ __forceinline__ XcdBarrier xcd_barrier_post(unsigned* bar, volatile LAS unsigned* st) {
    XcdBarrier b; b.bar = bar; b.x = xb_xcc_id(); b.st = st;
    if (threadIdx.x == 0) (void)xb_add(&bar[XB_XCNT(b.x)], 1u);
    return b;
}
__device__ __forceinline__ void xcd_barrier_complete(unsigned* bar, unsigned x, unsigned& nloc, unsigned& nx) {
    const unsigned G = gridDim.x * gridDim.y * gridDim.z;
    unsigned sum, cnt, mine, sp = 0u;
    for (;;) {
        sum = 0u; cnt = 0u; mine = 0u;
#pragma unroll
        for (unsigned j = 0; j < 16; ++j) { const unsigned c = xb_ld(&bar[XB_XCNT(j)]); sum += c; cnt += (c > 0u) ? 1u : 0u; mine = (j == x) ? c : mine; }
        if (sum == G) break;
        __builtin_amdgcn_s_sleep(1);
        if ((++sp & 255u) == 0u) { if (xb_ld(&bar[XB_TMO])) break; if (sp > XB_SPIN_CAP) { atomicAdd(&bar[XB_TMO], 1u); break; } }
    }
    nloc = mine > 0u ? mine : 1u; nx = cnt > 0u ? cnt : 1u;
}

__device__ __forceinline__ void xcd_barrier(const XcdBarrier& b) {
    asm volatile("s_waitcnt vmcnt(0)" ::: "memory");
    __syncthreads();
    if (threadIdx.x == 0) {
        unsigned* bar = b.bar;
        __builtin_amdgcn_s_waitcnt(0);
        unsigned nloc = b.st[0], nx = b.st[1];
        if (nloc == 0u) { xcd_barrier_complete(bar, b.x, nloc, nx); b.st[0] = nloc; b.st[1] = nx; }
        const unsigned old = xb_add(&bar[XB_XSUB(b.x)], 1u);
        const unsigned gen = old / nloc;
        if (old + 1u == (gen + 1u) * nloc) {
            __builtin_amdgcn_fence(__ATOMIC_RELEASE, "agent");
            asm volatile("s_waitcnt vmcnt(0)" ::: "memory");
            const unsigned og = xb_add(&bar[XB_TOP], 1u);
            const unsigned tg = og / nx;
            if (og + 1u == (tg + 1u) * nx) xb_add(&bar[XB_TOPGEN], 1u);
            else XB_SPIN(xb_ld(&bar[XB_TOPGEN]) == tg, bar);
            __builtin_amdgcn_fence(__ATOMIC_ACQUIRE, "agent");
            xb_add(&bar[XB_XGEN(b.x)], 1u);
            asm volatile("s_waitcnt vmcnt(0)" ::: "memory");
        } else {
            XB_SPIN(xb_ld(&bar[XB_XGEN(b.x)]) == gen, bar);
            __builtin_amdgcn_fence(__ATOMIC_ACQUIRE, "agent");
            asm volatile("s_waitcnt vmcnt(0)" ::: "memory");
        }
    }
    __syncthreads();
}
__device__ __forceinline__ void xcd_barrier_fast(const XcdBarrier& b) {
    asm volatile("s_waitcnt vmcnt(0)" ::: "memory");
    __syncthreads();
    if (threadIdx.x == 0) {
        unsigned* bar = b.bar;
        __builtin_amdgcn_s_waitcnt(0);
        unsigned nloc = b.st[0], nx = b.st[1];
        const unsigned old = xb_add(&bar[XB_XSUB(b.x)], 1u);
        const unsigned gen = old / nloc;
        if (old + 1u == (gen + 1u) * nloc) {
            __builtin_amdgcn_fence(__ATOMIC_RELEASE, "agent");
            asm volatile("s_waitcnt vmcnt(0)" ::: "memory");
            const unsigned og = xb_add(&bar[XB_TOP], 1u);
            const unsigned tg = og / nx;
            if (og + 1u == (tg + 1u) * nx) xb_add(&bar[XB_TOPGEN], 1u);
            else XB_SPIN(xb_ld(&bar[XB_TOPGEN]) == tg, bar);
            __builtin_amdgcn_fence(__ATOMIC_ACQUIRE, "agent");
            xb_add(&bar[XB_XGEN(b.x)], 1u);
            asm volatile("s_waitcnt vmcnt(0)" ::: "memory");
        } else {
            XB_SPIN(xb_ld(&bar[XB_XGEN(b.x)]) == gen, bar);
            __builtin_amdgcn_fence(__ATOMIC_ACQUIRE, "agent");
            asm volatile("s_waitcnt vmcnt(0)" ::: "memory");
        }
    }
    __syncthreads();
}


DI void gsync(cg::grid_group& grid) {
  asm volatile("s_waitcnt vmcnt(0) lgkmcnt(0)" ::: "memory");
  __syncthreads();
  if (threadIdx.x == 0) {
    __builtin_amdgcn_fence(__ATOMIC_RELEASE, "agent");
    asm volatile("s_waitcnt vmcnt(0)" ::: "memory");
  }
  grid.sync();
  if (threadIdx.x == 0) {
    __builtin_amdgcn_fence(__ATOMIC_ACQUIRE, "agent");
    asm volatile("s_waitcnt vmcnt(0)" ::: "memory");
  }
  __syncthreads();
}

DI Params load_params() {
  Params r{};
#if defined(__HIP_DEVICE_COMPILE__)
  const __attribute__((address_space(4))) unsigned long long* q =
      (const __attribute__((address_space(4))) unsigned long long*)__builtin_amdgcn_kernarg_segment_ptr();
  asm volatile("" : "+s"(q));
  unsigned long long* d = (unsigned long long*)&r;
  static_assert(sizeof(Params) % 8 == 0, "Params size");
#pragma unroll
  for (int i = 0; i < (int)(sizeof(Params) / 8); ++i) d[i] = q[i];
#endif
  return r;
}
#define P_ p
__global__ void __launch_bounds__(256, 2) fwd_megakernel(Params p) {
  cg::grid_group grid = cg::this_grid();
  __shared__ __attribute__((aligned(16))) char smem[SMEM_BYTES];
  __shared__ uint4 xb_words;
  if (threadIdx.x == 0) xb_words = make_uint4(0u, 0u, 0u, 0u);
  __syncthreads();
  XcdBarrier xb;
  { const Params lp = P_; xb = xcd_barrier_post((unsigned*)(lp.ws + OFF_BAR), (volatile LAS unsigned*)&xb_words); }
  { const Params lp = P_; phase_prep(lp, smem); }
  xcd_barrier(xb);
  { const Params lp = P_; phase_norm(lp, 0, true, lp.norm1_g, 0, NTOK); }
  xcd_barrier_fast(xb);
  { const Params lp = P_; phase_inproj0(lp, smem); }
  xcd_barrier_fast(xb);
  { const Params lp = P_; phase_gqa_prep(lp, smem); }
  xcd_barrier_fast(xb);
  { const Params lp = P_; phase_mix0(lp, smem, 0); }
  xcd_barrier_fast(xb);
  { const Params lp = P_; phase_hg_readout(lp); }
  xcd_barrier_fast(xb);
  { const Params lp = P_; phase_outproj(lp, 0, OFF_WT_EVOUT, NTOK, true, smem); }
  xcd_barrier_fast(xb);
#if STAGE_LIMIT >= 2
  { const Params lp = P_; phase_norm(lp, 0, false, lp.norm2_g, 3, NTOK); }
  { const Params lp = P_; phase_convert_tables(lp, 0); }
  xcd_barrier_fast(xb);
  { const Params lp = P_; phase_peer_route(lp, 0, NTOK, smem); }
  xcd_barrier_fast(xb);
  { const Params lp = P_; phase_peer_gather(lp, 0, NTOK, false); }
  xcd_barrier_fast(xb);
#endif
#if STAGE_LIMIT >= 3
  { const Params lp = P_; phase_inproj1(lp, smem); }
  xcd_barrier_fast(xb);
  { const Params lp = P_; phase_mla_prep(lp); }
  xcd_barrier_fast(xb);
  { const Params lp = P_; phase_mla_up(lp, smem); }
  xcd_barrier_fast(xb);
  { const Params lp = P_; phase_mix1(lp, smem, 1); }
  xcd_barrier_fast(xb);
  { const Params lp = P_; phase_s5_z(lp); }
  xcd_barrier_fast(xb);
  { const Params lp = P_; phase_glu(lp, smem); }
  xcd_barrier_fast(xb);
  { const Params lp = P_; phase_outproj1(lp, smem); }
  xcd_barrier_fast(xb);
#endif
#if STAGE_LIMIT >= 4
  { const Params lp = P_; phase_norm(lp, 1, false, lp.norm2_g + 1024, 3, NLAT); }
  { const Params lp = P_; phase_convert_tables(lp, 1); }
  xcd_barrier_fast(xb);
  { const Params lp = P_; phase_peer_route(lp, 1, NLAT, smem); }
  xcd_barrier_fast(xb);
  { const Params lp = P_; phase_peer_gather(lp, 1, NLAT, false); }
#endif
}

extern "C" void kernel_launch(void* const* d_in, const int* in_sizes, int n_in, void* d_out, int out_size, void* d_ws,
                              size_t ws_size, hipStream_t stream) {
  static int grid_blocks = 0;
  if (!grid_blocks) {
    int dev = 0, cus = 0, per_cu = 0;
    (void)hipGetDevice(&dev);
    (void)hipDeviceGetAttribute(&cus, hipDeviceAttributeMultiprocessorCount, dev);
    (void)hipOccupancyMaxActiveBlocksPerMultiprocessor(&per_cu, fwd_megakernel, 256, 0);
    if (per_cu > 2) per_cu = 2;
    if (per_cu < 1) per_cu = 1;
    grid_blocks = cus * per_cu;
  }
  Params p{};
  const float** pp = (const float**)&p;
  for (int i = 0; i < 35; ++i) pp[i] = (const float*)d_in[i];
  p.out = (float*)d_out;
  p.ws = (char*)d_ws;
  p.rep_mix = REP_MIX; p.rep_route = REP_ROUTE; p.rep_gdry = REP_GDRY; p.rep_gemm = REP_GEMM;
  (void)hipMemsetAsync((char*)d_ws + OFF_CNT, 0, 256 + 16384, stream);
  void* args[] = {&p};
  hipError_t e = hipLaunchCooperativeKernel((void*)fwd_megakernel, dim3(grid_blocks), dim3(256), args, 0, stream);
  if (e != hipSuccess) fprintf(stderr, "cooperative launch failed: %s (grid %d)\n", hipGetErrorString(e), grid_blocks);
}
```

```cpp
#include <hip/hip_runtime.h>
#include <hip/hip_cooperative_groups.h>
#include <cstdio>
namespace cg = cooperative_groups;

#ifndef STAGE_LIMIT
#define STAGE_LIMIT 99
#endif
#define REP_MIX 1
#define REP_ROUTE 1
#define REP_GDRY 0
#define REP_GEMM 1

typedef unsigned short bf16;
typedef __attribute__((ext_vector_type(8))) short bf16x8;
typedef __attribute__((ext_vector_type(4))) short bf16x4;
typedef __attribute__((ext_vector_type(16))) float f32x16;
typedef float f32x2_t __attribute__((ext_vector_type(2)));
typedef unsigned u32x4 __attribute__((ext_vector_type(4)));
typedef unsigned u32x2 __attribute__((ext_vector_type(2)));
typedef __bf16 bf16x2_t __attribute__((ext_vector_type(2)));

#define DI __device__ __forceinline__
#define MFMA32(a, b, c) __builtin_amdgcn_mfma_f32_32x32x16_bf16((a), (b), (c), 0, 0, 0)

constexpr int NLAT = 32768, NCTX = 1024, NTOK = 33792, DM = 1024;
constexpr int SEQ = 8192, CTXL = 256, SKEYS = 8448;
constexpr float EPSN = 1e-6f;

constexpr size_t al256(size_t x) { return (x + 255) & ~(size_t)255; }
constexpr size_t OFF_WT_EVIN = 0;
constexpr size_t OFF_WT_EVOUT = OFF_WT_EVIN + al256((size_t)3328 * 1024 * 2);
constexpr size_t OFF_WT_ODIN = OFF_WT_EVOUT + al256((size_t)1024 * 1024 * 2);
constexpr size_t OFF_WT_ODOUT = OFF_WT_ODIN + al256((size_t)1280 * 1024 * 2);
constexpr size_t OFF_WT_QUP = OFF_WT_ODOUT + al256((size_t)1024 * 1024 * 2);
constexpr size_t OFF_WT_KVUP = OFF_WT_QUP + al256((size_t)768 * 384 * 2);
constexpr size_t OFF_WT_GLU = OFF_WT_KVUP + al256((size_t)1024 * 256 * 2);
constexpr size_t OFF_WT_PWQ = OFF_WT_GLU + al256((size_t)512 * 512 * 2);
constexpr size_t OFF_PKEYS = OFF_WT_PWQ + al256((size_t)2 * 2048 * 1024 * 2);
constexpr size_t OFF_MOD = OFF_PKEYS + al256((size_t)2 * 8 * 2 * 128 * 128 * 2);
constexpr size_t OFF_S5T = OFF_MOD + al256((size_t)2 * 5 * 6144 * 4);
constexpr size_t OFF_S5WE = OFF_S5T + al256((size_t)64 * 256 * 256 * 2);
constexpr size_t OFF_S5WY = OFF_S5WE + al256((size_t)64 * 128 * 256 * 2);
constexpr size_t OFF_S5A16 = OFF_S5WY + al256((size_t)64 * 256 * 128 * 2);
constexpr size_t OFF_CNT = OFF_S5A16 + al256((size_t)64 * 64 * 2 * 4);
constexpr size_t OFF_BAR = OFF_CNT + 256;
constexpr size_t OFF_ROPE1 = OFF_BAR + 16384;
constexpr size_t OFF_SU = OFF_ROPE1 + al256((size_t)8192 * 16 * 8);
constexpr size_t OFF_SV = OFF_SU + 65536;
constexpr size_t OFF_KMAX = OFF_SV + 65536;
constexpr size_t OFF_KRSQ = OFF_KMAX + 256;
constexpr size_t OFF_XC = OFF_KRSQ + al256((size_t)NTOK * 4);
constexpr size_t OFF_UTAB = OFF_XC + al256((size_t)NCTX * DM * 4);
constexpr size_t OFF_VTAB = OFF_UTAB + al256((size_t)16384 * 1024 * 2);
constexpr size_t OFF_ACTA = OFF_VTAB + al256((size_t)16384 * 1024 * 2);
constexpr size_t OFF_BIG = OFF_ACTA + al256((size_t)NTOK * DM * 2);
constexpr size_t OFF_PAGQA = OFF_BIG;
constexpr size_t OFF_VT0 = OFF_PAGQA + al256((size_t)NTOK * 768 * 2);
constexpr size_t OFF_PAHG = OFF_VT0 + al256((size_t)512 * SKEYS * 2);
constexpr size_t OFF_OHG = OFF_PAHG + al256((size_t)NTOK * 2560 * 2);
constexpr size_t OFF_END0 = OFF_OHG + al256((size_t)2 * NTOK * 512 * 2);
constexpr size_t OFF_K1 = OFF_BIG;
constexpr size_t OFF_PA1M = OFF_K1 + al256((size_t)NTOK * 768 * 2);
constexpr size_t OFF_Q1 = OFF_PA1M;
constexpr size_t OFF_U1 = OFF_PA1M + al256((size_t)NTOK * 768 * 2);
constexpr size_t OFF_QN = OFF_U1 + al256((size_t)NTOK * 512 * 2);
constexpr size_t OFF_KVN = OFF_QN + al256((size_t)NLAT * 384 * 2);
constexpr size_t OFF_Z1 = OFF_QN;
constexpr size_t OFF_KROPE = OFF_KVN + al256((size_t)NTOK * 256 * 2);
constexpr size_t OFF_VT1 = OFF_KROPE + al256((size_t)NTOK * 32 * 2);
constexpr size_t OFF_YS5 = OFF_VT1 + al256((size_t)2048 * SKEYS * 2);
constexpr size_t OFF_END1 = OFF_YS5 + al256((size_t)2 * NLAT * 512 * 2);
constexpr size_t OFF_RIDX = OFF_BIG;
constexpr size_t OFF_RGW = OFF_RIDX + al256((size_t)NTOK * 128 * 4);
constexpr size_t WS_NEEDED = (OFF_END0 > OFF_END1 ? OFF_END0 : OFF_END1);
static_assert(OFF_RGW + (size_t)NTOK * 128 * 4 <= OFF_VT0, "route alias overflow");
static_assert((size_t)NLAT * 512 * 2 <= (OFF_KROPE - OFF_QN), "z alias overflow");
static_assert(WS_NEEDED < (size_t)500 * 1024 * 1024, "workspace too large");

constexpr int SMEM_BYTES = 78 * 1024;

struct Params {
  const float *x, *c, *ctx, *c_ctx, *ada_w, *ada_b, *norm1_g, *norm2_g, *ev_w_in, *ev_w_out, *gqa_qn_g, *gqa_kn_g,
      *hg_lb_logits, *hg_onorm_g, *od_w_in, *od_w_out, *mla_qa_g, *mla_w_qup, *mla_kva_g, *mla_w_kvup, *s5_a_re, *s5_a_im,
      *s5_log_dt, *s5_b_re, *s5_b_im, *s5_c_re, *s5_c_im, *s5_d, *s5_w_glu, *s5_b_glu, *peer_wq, *peer_keys, *peer_u,
      *peer_v, *final_g;
  float* out;
  char* ws;
  int rep_mix, rep_route, rep_gdry, rep_gemm;
};

DI int get_tid() { int t = threadIdx.x; asm volatile("" : "+v"(t)); return t; }
DI bf16 f2bf(float x) {
  unsigned u = __float_as_uint(x);
  u += 0x7fffu + ((u >> 16) & 1u);
  return (bf16)(u >> 16);
}
DI float bf2f(bf16 h) { return __uint_as_float(((unsigned)h) << 16); }
DI unsigned cvtpk(float lo, float hi) {
  f32x2_t v = {lo, hi};
  bf16x2_t b = __builtin_convertvector(v, bf16x2_t);
  return __builtin_bit_cast(unsigned, b);
}
DI float bflo(unsigned u) { return __uint_as_float(u << 16); }
DI float bfhi(unsigned u) { return __uint_as_float(u & 0xffff0000u); }
DI float wave_sum(float v) {
#pragma unroll
  for (int o = 32; o > 0; o >>= 1) v += __shfl_xor(v, o);
  return v;
}
DI float wave_max_early(float v) {
#pragma unroll
  for (int o = 32; o > 0; o >>= 1) v = fmaxf(v, __shfl_xor(v, o));
  return v;
}
DI float sigmoidf_(float x) { return 1.0f / (1.0f + __expf(-x)); }
DI float siluf_(float x) { return x * sigmoidf_(x); }
DI float geluf_(float x) { return 0.5f * x * (1.0f + erff(x * 0.70710678118654752f)); }
DI float gelu_as(float x) {
  const float z = x * 0.70710678118654752f, az = fabsf(z);
  const float t = __builtin_amdgcn_rcpf(fmaf(0.3275911f, az, 1.0f));
  const float poly = t * fmaf(t, fmaf(t, fmaf(t, fmaf(t, 1.061405429f, -1.453152027f), 1.421413741f), -0.284496736f), 0.254829592f);
  const float e = __builtin_amdgcn_exp2f(az * az * -1.4426950408889634f);
  const float er = copysignf(fmaf(-poly, e, 1.0f), z);
  const float hx = 0.5f * x;
  return fmaf(hx, er, hx);
}

DI const float* orig_row(const Params& p, int r) {
  return r < NLAT ? p.x + (size_t)r * DM : p.ctx + (size_t)(r - NLAT) * DM;
}
DI float* res_row(const Params& p, int r) {
  return r < NLAT ? p.out + (size_t)r * DM : (float*)(p.ws + OFF_XC) + (size_t)(r - NLAT) * DM;
}
DI int mod_row(int r) { return r < NLAT ? (r >> 13) : 4; }
DI const float* mod_ptr(const Params& p, int layer, int r, int chunk) {
  return (const float*)(p.ws + OFF_MOD) + ((size_t)(layer * 5 + mod_row(r)) * 6 + chunk) * 1024;
}

constexpr int GLS = 72;
DI void gemm_128x128(const bf16* __restrict__ A, int lda, const bf16* __restrict__ Bt, int ldb, int K, f32x16 (&acc)[2][2],
                     bf16* As, bf16* Bs) {
  const int tid = get_tid(), lane = tid & 63, w = tid >> 6;
  const int wm = w >> 1, wn = w & 1;
  const int lr = tid >> 3, lc = (tid & 7) * 8;
  u32x4 ra[4], rb[4];
#pragma unroll
  for (int i = 0; i < 4; ++i) {
    ra[i] = *(const u32x4*)(A + (size_t)(i * 32 + lr) * lda + lc);
    rb[i] = *(const u32x4*)(Bt + (size_t)(i * 32 + lr) * ldb + lc);
  }
#pragma unroll
  for (int i = 0; i < 2; ++i)
#pragma unroll
    for (int j = 0; j < 2; ++j)
#pragma unroll
      for (int r = 0; r < 16; ++r) acc[i][j][r] = 0.f;
  for (int k0 = 0; k0 < K; k0 += 64) {
    __syncthreads();
#pragma unroll
    for (int i = 0; i < 4; ++i) {
      *(u32x4*)(As + (i * 32 + lr) * GLS + lc) = ra[i];
      *(u32x4*)(Bs + (i * 32 + lr) * GLS + lc) = rb[i];
    }
    __syncthreads();
    if (k0 + 64 < K) {
#pragma unroll
      for (int i = 0; i < 4; ++i) {
        ra[i] = *(const u32x4*)(A + (size_t)(i * 32 + lr) * lda + k0 + 64 + lc);
        rb[i] = *(const u32x4*)(Bt + (size_t)(i * 32 + lr) * ldb + k0 + 64 + lc);
      }
    }
#pragma unroll
    for (int ks = 0; ks < 64; ks += 16) {
      const int ko = ks + (lane >> 5) * 8;
      bf16x8 a0 = *(const bf16x8*)(As + (wm * 64 + (lane & 31)) * GLS + ko);
      bf16x8 a1 = *(const bf16x8*)(As + (wm * 64 + 32 + (lane & 31)) * GLS + ko);
      bf16x8 b0 = *(const bf16x8*)(Bs + (wn * 64 + (lane & 31)) * GLS + ko);
      bf16x8 b1 = *(const bf16x8*)(Bs + (wn * 64 + 32 + (lane & 31)) * GLS + ko);
      acc[0][0] = MFMA32(a0, b0, acc[0][0]);
      acc[0][1] = MFMA32(a0, b1, acc[0][1]);
      acc[1][0] = MFMA32(a1, b0, acc[1][0]);
      acc[1][1] = MFMA32(a1, b1, acc[1][1]);
    }
  }
}
template <class F>
DI void gemm_epi(f32x16 (&acc)[2][2], F f) {
  const int lane = get_tid() & 63, w = get_tid() >> 6;
  const int wm = w >> 1, wn = w & 1;
#pragma unroll
  for (int mi = 0; mi < 2; ++mi)
#pragma unroll
    for (int ni = 0; ni < 2; ++ni)
#pragma unroll
      for (int r = 0; r < 16; ++r) {
        int row = wm * 64 + mi * 32 + (r & 3) + 8 * (r >> 2) + 4 * (lane >> 5);
        int col = wn * 64 + ni * 32 + (lane & 31);
        f(row, col, acc[mi][ni][r]);
      }
}

DI void gemm_256x128(const bf16* __restrict__ A, int lda, const bf16* __restrict__ Bt, int ldb, int K, f32x16 (&acc)[4][2],
                     bf16* As, bf16* Bs) {
  const int tid = get_tid(), lane = tid & 63, w = tid >> 6;
  const int wm = w >> 1, wn = w & 1;
  const int lr = tid >> 3, lc = (tid & 7) * 8;
  u32x4 ra[8], rb[4];
#pragma unroll
  for (int i = 0; i < 8; ++i) ra[i] = *(const u32x4*)(A + (size_t)(i * 32 + lr) * lda + lc);
#pragma unroll
  for (int i = 0; i < 4; ++i) rb[i] = *(const u32x4*)(Bt + (size_t)(i * 32 + lr) * ldb + lc);
#pragma unroll
  for (int i = 0; i < 4; ++i)
#pragma unroll
    for (int j = 0; j < 2; ++j)
#pragma unroll
      for (int r = 0; r < 16; ++r) acc[i][j][r] = 0.f;
  for (int k0 = 0; k0 < K; k0 += 64) {
    __syncthreads();
#pragma unroll
    for (int i = 0; i < 8; ++i) *(u32x4*)(As + (i * 32 + lr) * GLS + lc) = ra[i];
#pragma unroll
    for (int i = 0; i < 4; ++i) *(u32x4*)(Bs + (i * 32 + lr) * GLS + lc) = rb[i];
    __syncthreads();
    if (k0 + 64 < K) {
#pragma unroll
      for (int i = 0; i < 8; ++i) ra[i] = *(const u32x4*)(A + (size_t)(i * 32 + lr) * lda + k0 + 64 + lc);
#pragma unroll
      for (int i = 0; i < 4; ++i) rb[i] = *(const u32x4*)(Bt + (size_t)(i * 32 + lr) * ldb + k0 + 64 + lc);
    }
#pragma unroll
    for (int ks = 0; ks < 64; ks += 16) {
      const int ko = ks + (lane >> 5) * 8;
      bf16x8 b0 = *(const bf16x8*)(Bs + (wn * 64 + (lane & 31)) * GLS + ko);
      bf16x8 b1 = *(const bf16x8*)(Bs + (wn * 64 + 32 + (lane & 31)) * GLS + ko);
#pragma unroll
      for (int mi = 0; mi < 4; ++mi) {
        bf16x8 a = *(const bf16x8*)(As + (wm * 128 + mi * 32 + (lane & 31)) * GLS + ko);
        acc[mi][0] = MFMA32(a, b0, acc[mi][0]);
        acc[mi][1] = MFMA32(a, b1, acc[mi][1]);
      }
    }
  }
}
template <class F>
DI void gemm_epi2(f32x16 (&acc)[4][2], F f) {
  const int lane = get_tid() & 63, w = get_tid() >> 6;
  const int wm = w >> 1, wn = w & 1;
#pragma unroll
  for (int mi = 0; mi < 4; ++mi)
#pragma unroll
    for (int ni = 0; ni < 2; ++ni)
#pragma unroll
      for (int r = 0; r < 16; ++r) {
        int row = wm * 128 + mi * 32 + (r & 3) + 8 * (r >> 2) + 4 * (lane >> 5);
        int col = wn * 64 + ni * 32 + (lane & 31);
        f(row, col, acc[mi][ni][r]);
      }
}

DI void mma_tile(f32x16& acc, const bf16* A, int lda, const bf16* Bt, int ldb, int K) {
  const int lane = get_tid() & 63;
  const bf16* ap = A + (size_t)(lane & 31) * lda + (lane >> 5) * 8;
  const bf16* bp = Bt + (size_t)(lane & 31) * ldb + (lane >> 5) * 8;
#pragma unroll 4
  for (int ks = 0; ks < K; ks += 16) {
    bf16x8 a = *(const bf16x8*)(ap + ks);
    bf16x8 b = *(const bf16x8*)(bp + ks);
    acc = MFMA32(a, b, acc);
  }
}
template <int K>
DI void mma_tile_ga(f32x16& acc, const bf16* __restrict__ A, int lda, const bf16* Bt, int ldb) {
  const int lane = get_tid() & 63;
  const bf16* ap = A + (size_t)(lane & 31) * lda + (lane >> 5) * 8;
  const bf16* bp = Bt + (size_t)(lane & 31) * ldb + (lane >> 5) * 8;
  bf16x8 af[K / 16];
#pragma unroll
  for (int i = 0; i < K / 16; ++i) af[i] = *(const bf16x8*)(ap + i * 16);
#pragma unroll
  for (int i = 0; i < K / 16; ++i) {
    bf16x8 b = *(const bf16x8*)(bp + i * 16);
    acc = MFMA32(af[i], b, acc);
  }
}
DI int crow(int r, int lane) { return (r & 3) + 8 * (r >> 2) + 4 * (lane >> 5); }

DI void prep_transpose(const float* __restrict__ W, int K, int N, int Npad, bf16* __restrict__ Wt, int tile, float* tl) {
  const int ntn = Npad / 64;
  const int kt = tile / ntn, nt = tile % ntn;
  const int k0 = kt * 64, n0 = nt * 64;
  const int tid = get_tid();
  __syncthreads();
  for (int i = 0; i < 16; ++i) {
    int r = i * 4 + (tid >> 6), cidx = tid & 63;
    int n = n0 + cidx;
    float v = (n < N) ? W[(size_t)(k0 + r) * N + n] : 0.f;
    tl[cidx * 65 + r] = v;
  }
  __syncthreads();
  for (int i = 0; i < 16; ++i) {
    int n = i * 4 + (tid >> 6), k = tid & 63;
    Wt[(size_t)(n0 + n) * K + k0 + k] = f2bf(tl[n * 65 + k]);
  }
}

DI void convert_bf16(const float* __restrict__ src, bf16* __restrict__ dst, size_t n, int bid, int nb) {
  size_t nv = n / 8;
  for (size_t i = (size_t)bid * 256 + get_tid(); i < nv; i += (size_t)nb * 256) {
    float4 a = ((const float4*)src)[2 * i], b = ((const float4*)src)[2 * i + 1];
    u32x4 o;
    o.x = cvtpk(a.x, a.y); o.y = cvtpk(a.z, a.w); o.z = cvtpk(b.x, b.y); o.w = cvtpk(b.z, b.w);
    ((u32x4*)dst)[i] = o;
  }
}

DI void prep_mod(const Params& p, int item, float* sm) {
  const int l = item / 96, n0 = (item % 96) * 64;
  const int tid = get_tid(), lane = tid & 63, w = tid >> 6;
  const float* W = p.ada_w + (size_t)l * 1024 * 6144 + n0 + lane;
  float* sc = sm;
  float* red = sm + 5 * 1024;
  __syncthreads();
  for (int i = tid; i < 5 * 1024; i += 256) {
    const int r = i >> 10, k = i & 1023;
    sc[i] = siluf_(r < 4 ? p.c[r * 1024 + k] : p.c_ctx[k]);
  }
  __syncthreads();
  float acc[5] = {0.f, 0.f, 0.f, 0.f, 0.f};
#pragma unroll 1
  for (int k0 = w * 256; k0 < w * 256 + 256; k0 += 16) {
    float wv[16];
#pragma unroll
    for (int j = 0; j < 16; ++j) wv[j] = W[(size_t)(k0 + j) * 6144];
#pragma unroll
    for (int j = 0; j < 16; ++j) {
#pragma unroll
      for (int r = 0; r < 5; ++r) acc[r] += sc[r * 1024 + k0 + j] * wv[j];
    }
  }
#pragma unroll
  for (int r = 0; r < 5; ++r) red[(w * 5 + r) * 64 + lane] = acc[r];
  __syncthreads();
  if (w == 0) {
    float* M = (float*)(p.ws + OFF_MOD);
#pragma unroll
    for (int r = 0; r < 5; ++r) {
      float s2 = red[(0 * 5 + r) * 64 + lane] + red[(1 * 5 + r) * 64 + lane] + red[(2 * 5 + r) * 64 + lane] + red[(3 * 5 + r) * 64 + lane];
      M[(size_t)(l * 5 + r) * 6144 + n0 + lane] = s2 + p.ada_b[l * 6144 + n0 + lane];
    }
  }
}

DI void prep_s5(const Params& p, int item4, float* sm) {
  const int item = item4 >> 2, qtr = item4 & 3;
  const int g = item >> 1, d = item & 1;
  const int tid = get_tid();
  float* pw = sm;
  float* bb = sm + 17 * 128;
  float* kc = bb + 64 * 32;
  __syncthreads();
  const float dt = __expf(p.s5_log_dt[d * 32 + g]);
  if (tid < 64) {
    const int pp = tid;
    const float are = p.s5_a_re[(d * 32 + g) * 64 + pp], aim = p.s5_a_im[(d * 32 + g) * 64 + pp];
    for (int n = 0; n <= 16; ++n) {
      float mag = expf(are * dt * n);
      float sn, cs;
      sincosf(aim * dt * n, &sn, &cs);
      pw[(n * 64 + pp) * 2 + 0] = mag * cs;
      pw[(n * 64 + pp) * 2 + 1] = mag * sn;
    }
    float abr = pw[(64 + pp) * 2 + 0] - 1.0f, abi = pw[(64 + pp) * 2 + 1];
    float den = are * are + aim * aim;
    float qr = (abr * are + abi * aim) / den, qi = (abi * are - abr * aim) / den;
    for (int c2 = 0; c2 < 16; ++c2) {
      float br = p.s5_b_re[((size_t)(d * 32 + g) * 64 + pp) * 16 + c2], bi = p.s5_b_im[((size_t)(d * 32 + g) * 64 + pp) * 16 + c2];
      bb[(pp * 16 + c2) * 2 + 0] = qr * br - qi * bi;
      bb[(pp * 16 + c2) * 2 + 1] = qr * bi + qi * br;
    }
    float* A16 = (float*)(p.ws + OFF_S5A16) + (size_t)item * 128;
    A16[pp * 2 + 0] = pw[(16 * 64 + pp) * 2 + 0];
    A16[pp * 2 + 1] = pw[(16 * 64 + pp) * 2 + 1];
  }
  float* cre = kc + 4096;
  float* cim = cre + 1024;
  for (int e = tid; e < 1024; e += 256) {
    cre[e] = p.s5_c_re[(size_t)(d * 32 + g) * 1024 + e];
    cim[e] = p.s5_c_im[(size_t)(d * 32 + g) * 1024 + e];
  }
  __syncthreads();
  for (int e = tid; e < (4 * qtr + 4) * 256; e += 256) {
    int tau = e >> 8, c = (e >> 4) & 15, c2 = e & 15;
    float s = 0.f;
    for (int pp = 0; pp < 64; ++pp) {
      float cr = cre[c * 64 + pp], ci = cim[c * 64 + pp];
      float wr = pw[(tau * 64 + pp) * 2], wi = pw[(tau * 64 + pp) * 2 + 1];
      float zr = cr * wr - ci * wi, zi = cr * wi + ci * wr;
      float br = bb[(pp * 16 + c2) * 2], bi = bb[(pp * 16 + c2) * 2 + 1];
      s += zr * br - zi * bi;
    }
    kc[e] = s;
  }
  __syncthreads();
  bf16* T = (bf16*)(p.ws + OFF_S5T) + (size_t)item * 65536;
  for (int e = qtr * 16384 + tid; e < (qtr + 1) * 16384; e += 256) {
    int m = e >> 8, k = e & 255;
    int i = m >> 4, c = m & 15, j = k >> 4, c2 = k & 15;
    float v = (i >= j) ? kc[((i - j) * 16 + c) * 16 + c2] : 0.f;
    T[e] = f2bf(v);
  }
  bf16* WE = (bf16*)(p.ws + OFF_S5WE) + (size_t)item * 32768;
  for (int e = qtr * 8192 + tid; e < (qtr + 1) * 8192; e += 256) {
    int pr = e >> 8, k = e & 255;
    int pp = pr & 63, im = pr >> 6, j = k >> 4, c2 = k & 15;
    float wr = pw[((15 - j) * 64 + pp) * 2], wi = pw[((15 - j) * 64 + pp) * 2 + 1];
    float br = bb[(pp * 16 + c2) * 2], bi = bb[(pp * 16 + c2) * 2 + 1];
    float v = im ? (wr * bi + wi * br) : (wr * br - wi * bi);
    WE[e] = f2bf(v);
  }
  bf16* WY = (bf16*)(p.ws + OFF_S5WY) + (size_t)item * 32768;
  for (int e = qtr * 8192 + tid; e < (qtr + 1) * 8192; e += 256) {
    int m = e >> 7, pr = e & 127;
    int i = m >> 4, c = m & 15, pp = pr & 63, im = pr >> 6;
    float cr = cre[c * 64 + pp], ci = cim[c * 64 + pp];
    float wr = pw[((i + 1) * 64 + pp) * 2], wi = pw[((i + 1) * 64 + pp) * 2 + 1];
    float zr = cr * wr - ci * wi, zi = cr * wi + ci * wr;
    WY[e] = f2bf(im ? -zi : zr);
  }
}

DI void phase_prep(const Params& p, char* smem) {
  const int bid = blockIdx.x, nb = gridDim.x;
  float* sm = (float*)smem;
  if (bid == 0 && get_tid() < 64) ((unsigned*)(p.ws + OFF_KMAX))[get_tid()] = 0u;
  {
    float2* tab = (float2*)(p.ws + OFF_ROPE1);
    for (int e = bid * 256 + get_tid(); e < 8192 * 16; e += nb * 256) {
      int t = e >> 4, f = e & 15;
      float pos = (f < 8) ? (float)(t >> 6) : (float)(t & 63);
      float inv = powf(10000.f, -(float)(f & 7) / 8.f);
      float sn, cs;
      sincosf(pos * inv, &sn, &cs);
      tab[e] = make_float2(cs, sn);
    }
  }
  const int n_mod = 192, n_s5 = 256;
  constexpr int T0 = 16 * 52, T1 = 16 * 16, T2 = 16 * 20, T3 = 16 * 16, T4 = 6 * 12, T5 = 4 * 16, T6 = 8 * 8, T7 = 16 * 32, T8 = 16 * 32;
  constexpr int NTR = T0 + T1 + T2 + T3 + T4 + T5 + T6 + T7 + T8;
  const int total = n_mod + n_s5 + NTR;
  for (int it = bid; it < total; it += nb) {
    if (it < n_s5) prep_s5(p, it, sm);
    else if (it < n_mod + n_s5) prep_mod(p, it - n_s5, sm);
    else {
      int t = it - n_mod - n_s5;
      if (t < T0) { prep_transpose(p.ev_w_in, 1024, 3328, 3328, (bf16*)(p.ws + OFF_WT_EVIN), t, sm); continue; }
      t -= T0;
      if (t < T1) { prep_transpose(p.ev_w_out, 1024, 1024, 1024, (bf16*)(p.ws + OFF_WT_EVOUT), t, sm); continue; }
      t -= T1;
      if (t < T2) { prep_transpose(p.od_w_in, 1024, 1184, 1280, (bf16*)(p.ws + OFF_WT_ODIN), t, sm); continue; }
      t -= T2;
      if (t < T3) { prep_transpose(p.od_w_out, 1024, 1024, 1024, (bf16*)(p.ws + OFF_WT_ODOUT), t, sm); continue; }
      t -= T3;
      if (t < T4) { prep_transpose(p.mla_w_qup, 384, 768, 768, (bf16*)(p.ws + OFF_WT_QUP), t, sm); continue; }
      t -= T4;
      if (t < T5) { prep_transpose(p.mla_w_kvup, 256, 1024, 1024, (bf16*)(p.ws + OFF_WT_KVUP), t, sm); continue; }
      t -= T5;
      if (t < T6) { prep_transpose(p.s5_w_glu, 512, 512, 512, (bf16*)(p.ws + OFF_WT_GLU), t, sm); continue; }
      t -= T6;
      if (t < T7) { prep_transpose(p.peer_wq, 1024, 2048, 2048, (bf16*)(p.ws + OFF_WT_PWQ), t, sm); continue; }
      t -= T7;
      prep_transpose(p.peer_wq + (size_t)1024 * 2048, 1024, 2048, 2048, (bf16*)(p.ws + OFF_WT_PWQ) + (size_t)2048 * 1024, t, sm);
    }
  }
  convert_bf16(p.peer_keys, (bf16*)(p.ws + OFF_PKEYS), (size_t)2 * 8 * 2 * 128 * 128, bid, nb);
}

DI void phase_norm(const Params& p, int layer, bool first, const float* g, int shift_chunk, int nrows) {
  const int lane = get_tid() & 63, w = get_tid() >> 6;
  bf16* dst = (bf16*)(p.ws + OFF_ACTA);
  for (int r = blockIdx.x * 4 + w; r < nrows; r += gridDim.x * 4) {
    const float* src = first ? orig_row(p, r) : res_row(p, r);
    float4 v[4];
    float ss = 0.f;
#pragma unroll
    for (int i = 0; i < 4; ++i) {
      v[i] = ((const float4*)src)[i * 64 + lane];
      ss += v[i].x * v[i].x + v[i].y * v[i].y + v[i].z * v[i].z + v[i].w * v[i].w;
    }
    ss = wave_sum(ss);
    const float rs = rsqrtf(ss * (1.0f / 1024.0f) + EPSN);
    const float* sh = mod_ptr(p, layer, r, shift_chunk);
    const float* sc = mod_ptr(p, layer, r, shift_chunk + 1);
#pragma unroll
    for (int i = 0; i < 4; ++i) {
      float4 gg = ((const float4*)g)[i * 64 + lane];
      float4 s4 = ((const float4*)sh)[i * 64 + lane];
      float4 c4 = ((const float4*)sc)[i * 64 + lane];
      float o0 = v[i].x * rs * gg.x * (1.f + c4.x) + s4.x;
      float o1 = v[i].y * rs * gg.y * (1.f + c4.y) + s4.y;
      float o2 = v[i].z * rs * gg.z * (1.f + c4.z) + s4.z;
      float o3 = v[i].w * rs * gg.w * (1.f + c4.w) + s4.w;
      u32x2 o;
      o.x = cvtpk(o0, o1); o.y = cvtpk(o2, o3);
      ((u32x2*)(dst + (size_t)r * DM))[i * 64 + lane] = o;
    }
  }
}

DI void phase_inproj0(const Params& p, char* smem) {
  bf16* As = (bf16*)smem; bf16* Bs = As + 256 * GLS;
  const bf16* A = (const bf16*)(p.ws + OFF_ACTA);
  const bf16* Wt = (const bf16*)(p.ws + OFF_WT_EVIN);
  bf16* pg = (bf16*)(p.ws + OFF_PAGQA);
  bf16* ph = (bf16*)(p.ws + OFF_PAHG);
  const int ntn = 26, ntm = NTOK / 256;
  for (int t = blockIdx.x; t < ntn * ntm; t += gridDim.x) {
    const int mt = t / ntn, nt = t % ntn;
    f32x16 acc[4][2];
    gemm_256x128(A + (size_t)mt * 256 * DM, DM, Wt + (size_t)nt * 128 * DM, DM, DM, acc, As, Bs);
    gemm_epi2(acc, [&](int row, int col, float v) {
      int r = mt * 256 + row, cg_ = nt * 128 + col;
      if (cg_ < 768) pg[(size_t)r * 768 + cg_] = f2bf(v);
      else ph[(size_t)r * 2560 + (cg_ - 768)] = f2bf(v);
    });
  }
}

DI void phase_gqa_prep(const Params& p, char* smem) {
  bf16* pg = (bf16*)(p.ws + OFF_PAGQA);
  bf16* vt = (bf16*)(p.ws + OFF_VT0);
  bf16* tl = (bf16*)smem;
  const int lane = get_tid() & 63, w = get_tid() >> 6, tid = get_tid();
  const float gq = p.gqa_qn_g[lane], gk = p.gqa_kn_g[lane];
  const float inv = __powf(10000.f, -(float)(lane & 15) / 16.f);
  float lbv[16];
#pragma unroll
  for (int e = 0; e < 16; ++e) {
    const int j = lane * 16 + e, d = j >> 9, cc = j & 511;
    const float l0 = p.hg_lb_logits[(d * 2 + 0) * 512 + cc], l1 = p.hg_lb_logits[(d * 2 + 1) * 512 + cc];
    lbv[e] = 1.0f / (1.0f + __expf(l1 - l0));
  }
  bf16* phg = (bf16*)(p.ws + OFF_PAHG);
  for (int r = blockIdx.x * 4 + w; r < NTOK; r += gridDim.x * 4) {
    bf16* row = pg + (size_t)r * 768;
    float sn = 0.f, cs = 1.f;
    if (r < NLAT) {
      int t = r & 8191;
      float pos = (lane < 32) ? (float)(t >> 6) : (float)(t & 63);
      sincosf(pos * inv, &sn, &cs);
    }
#pragma unroll
    for (int hh = 0; hh < 10; ++hh) {
      float v = bf2f(row[hh * 64 + lane]);
      float ss = wave_sum(v * v);
      float y = v * rsqrtf(ss * (1.f / 64.f) + EPSN) * (hh < 8 ? gq : gk);
      float pr = __shfl_xor(y, 16);
      float o = y * cs + ((lane & 16) ? pr * sn : -pr * sn);
      row[hh * 64 + lane] = f2bf(hh < 8 ? o * (0.125f * 1.4426950408889634f) : o);
    }
    {
      bf16* frow = phg + (size_t)r * 2560 + 512 + lane * 16;
      u32x4 a = *(const u32x4*)frow, b2 = *(const u32x4*)(frow + 8);
      float fv[16];
      fv[0] = bflo(a.x); fv[1] = bfhi(a.x); fv[2] = bflo(a.y); fv[3] = bfhi(a.y); fv[4] = bflo(a.z); fv[5] = bfhi(a.z); fv[6] = bflo(a.w); fv[7] = bfhi(a.w);
      fv[8] = bflo(b2.x); fv[9] = bfhi(b2.x); fv[10] = bflo(b2.y); fv[11] = bfhi(b2.y); fv[12] = bflo(b2.z); fv[13] = bfhi(b2.z); fv[14] = bflo(b2.w); fv[15] = bfhi(b2.w);
#pragma unroll
      for (int e = 0; e < 16; ++e) fv[e] = __logf(lbv[e] + (1.f - lbv[e]) * sigmoidf_(fv[e]));
      u32x4 o0, o1;
      o0.x = cvtpk(fv[0], fv[1]); o0.y = cvtpk(fv[2], fv[3]); o0.z = cvtpk(fv[4], fv[5]); o0.w = cvtpk(fv[6], fv[7]);
      o1.x = cvtpk(fv[8], fv[9]); o1.y = cvtpk(fv[10], fv[11]); o1.z = cvtpk(fv[12], fv[13]); o1.w = cvtpk(fv[14], fv[15]);
      *(u32x4*)frow = o0; *(u32x4*)(frow + 8) = o1;
    }
  }
  for (int blk = blockIdx.x; blk < NTOK / 64; blk += gridDim.x) {
    const int r0 = blk * 64;
    __syncthreads();
    {
      const int rr = tid >> 2, c0 = (tid & 3) * 32;
      const bf16* src = pg + (size_t)(r0 + rr) * 768 + 640 + c0;
#pragma unroll
      for (int i = 0; i < 4; ++i) {
        u32x4 v4 = *(const u32x4*)(src + i * 8);
#pragma unroll
        for (int e = 0; e < 4; ++e) {
          tl[(c0 + i * 8 + 2 * e) * GLS + rr] = (bf16)(v4[e] & 0xffffu);
          tl[(c0 + i * 8 + 2 * e + 1) * GLS + rr] = (bf16)(v4[e] >> 16);
        }
      }
    }
    __syncthreads();
    int b, s0;
    if (r0 < NLAT) { b = r0 >> 13; s0 = CTXL + (r0 & 8191); } else { int rc = r0 - NLAT; b = rc >> 8; s0 = rc & 255; }
    {
      int vcol = tid >> 1, half = tid & 1;
      int kvh = vcol >> 6, dv = vcol & 63;
      bf16* dstp = vt + ((size_t)((b * 2 + kvh) * 64 + dv)) * SKEYS + s0 + half * 32;
      const bf16* srcp = tl + vcol * GLS + half * 32;
#pragma unroll
      for (int i = 0; i < 4; ++i) ((u32x4*)dstp)[i] = ((const u32x4*)srcp)[i];
    }
  }
}

template <int DQK, int SM>
DI void attn_item(const bf16* __restrict__ Q, int ldq_, const bf16* __restrict__ Kc, const bf16* __restrict__ Kl, int ldk_,
                  const bf16* __restrict__ VT, int nkeys, bf16* __restrict__ O, int ldo_, float scale, char* smem, float kbound = 0.f) {
  constexpr bool FIXED = (SM != 0);
  constexpr int ldq = 768, ldk = 768, ldo = DM;
  (void)ldq_; (void)ldk_; (void)ldo_;
  constexpr int KLS = DQK + 8;
  constexpr int VLS = 72;
  constexpr int NKS = DQK / 16;
  constexpr int KCH = DQK / 8;
  constexpr int KLOADS = (64 * KCH) / 256;
  constexpr int BUF = 64 * KLS + 64 * VLS;
  bf16* Sb = (bf16*)smem;
  const int tid = get_tid(), lane = tid & 63, w = tid >> 6;
  const float sc = scale * 1.4426950408889634f;
  bf16x8 qf[2][NKS];
#pragma unroll
  for (int qt = 0; qt < 2; ++qt) {
    const bf16* qp = Q + (size_t)(w * 64 + qt * 32 + (lane & 31)) * ldq + (lane >> 5) * 8;
#pragma unroll
    for (int ks = 0; ks < NKS; ++ks) qf[qt][ks] = *(const bf16x8*)(qp + ks * 16);
  }
  float msh[2] = {0.f, 0.f};
  if (SM == 2) {
#pragma unroll
    for (int qt = 0; qt < 2; ++qt) {
      float sq = 0.f;
#pragma unroll
      for (int ks = 0; ks < NKS; ++ks)
#pragma unroll
        for (int e = 0; e < 8; ++e) { float f = bf2f((bf16)qf[qt][ks][e]); sq += f * f; }
      sq += __shfl_xor(sq, 32);
      msh[qt] = fminf(sqrtf(sq) * kbound, 64.0f);
    }
  }
  f32x16 ot[2][2];
#pragma unroll
  for (int i = 0; i < 2; ++i)
#pragma unroll
    for (int j = 0; j < 2; ++j)
#pragma unroll
      for (int r = 0; r < 16; ++r) ot[i][j][r] = 0.f;
  float m_run[2] = {-1e30f, -1e30f}, l_run[2] = {0.f, 0.f};
  u32x4 kr[KLOADS], vr[2];
  auto gload = [&](int s0) {
    const bf16* kb = (s0 < CTXL) ? (Kc + (size_t)s0 * ldk) : (Kl + (size_t)(s0 - CTXL) * ldk);
#pragma unroll
    for (int i = 0; i < KLOADS; ++i) {
      int ci = i * 256 + tid;
      int row = ci / KCH, ch = ci % KCH;
      kr[i] = *(const u32x4*)(kb + (size_t)row * ldk + ch * 8);
    }
#pragma unroll
    for (int i = 0; i < 2; ++i) {
      int ci = i * 256 + tid;
      int row = ci >> 3, ch = ci & 7;
      vr[i] = *(const u32x4*)(VT + (size_t)row * SKEYS + s0 + ch * 8);
    }
  };
  auto lwrite = [&](bf16* buf) {
    bf16* Ks = buf; bf16* Vs = buf + 64 * KLS;
#pragma unroll
    for (int i = 0; i < KLOADS; ++i) {
      int ci = i * 256 + tid;
      int row = ci / KCH, ch = ci % KCH;
      *(u32x4*)(Ks + row * KLS + ch * 8) = kr[i];
    }
#pragma unroll
    for (int i = 0; i < 2; ++i) {
      int ci = i * 256 + tid;
      int row = ci >> 3, ch = ci & 7;
      u32x2 lo = {vr[i].x, vr[i].y}, hi = {vr[i].z, vr[i].w};
      const int gb = (ch >> 1) * 16 + (ch & 1) * 4;
      *(u32x2*)(Vs + row * VLS + gb) = lo;
      *(u32x2*)(Vs + row * VLS + gb + 8) = hi;
    }
  };
  const int ntiles = nkeys >> 6;
  __syncthreads();
  gload(0);
  lwrite(Sb);
  if (ntiles > 1) gload(64);
  for (int j = 0; j < ntiles; ++j) {
    __syncthreads();
    if (j + 1 < ntiles) {
      lwrite(Sb + ((j + 1) & 1) * BUF);
      if (j + 2 < ntiles) gload((j + 2) * 64);
    }
    const bf16* Ks = Sb + (j & 1) * BUF;
    const bf16* Vs = Ks + 64 * KLS;
    auto half = [&](const int kt) {
      f32x16 st[2];
#pragma unroll
      for (int qt = 0; qt < 2; ++qt)
#pragma unroll
        for (int r = 0; r < 16; ++r) st[qt][r] = 0.f;
      {
        const bf16* ap = Ks + (kt * 32 + (lane & 31)) * KLS + (lane >> 5) * 8;
        __builtin_amdgcn_s_setprio(1);
#pragma unroll
        for (int ks = 0; ks < NKS; ++ks) {
          bf16x8 a = *(const bf16x8*)(ap + ks * 16);
          st[0] = MFMA32(a, qf[0][ks], st[0]);
          st[1] = MFMA32(a, qf[1][ks], st[1]);
        }
        __builtin_amdgcn_s_setprio(0);
      }
      float mx[2] = {0.f, 0.f};
      bool need = false;
      if (!FIXED) {
#pragma unroll
      for (int qt = 0; qt < 2; ++qt) {
        float m0 = fmaxf(st[qt][0], st[qt][1]);
#pragma unroll
        for (int r = 2; r < 16; r += 2) m0 = fmaxf(m0, fmaxf(st[qt][r], st[qt][r + 1]));
        m0 = fmaxf(m0, __shfl_xor(m0, 32)) * sc;
        mx[qt] = m0;
        need = need || (m0 - m_run[qt] > 8.0f);
      }
      }
      if (!FIXED && __any(need)) {
#pragma unroll
        for (int qt = 0; qt < 2; ++qt) {
          const float m_new = fmaxf(m_run[qt], mx[qt]);
          const float alpha = __builtin_amdgcn_exp2f(m_run[qt] - m_new);
          m_run[qt] = m_new;
          l_run[qt] *= alpha;
#pragma unroll
          for (int dt = 0; dt < 2; ++dt)
#pragma unroll
            for (int r = 0; r < 16; ++r) ot[qt][dt][r] *= alpha;
        }
      }
      bf16x8 pb[2][2];
#pragma unroll
      for (int qt = 0; qt < 2; ++qt) {
        float ps = 0.f;
        const float mr = m_run[qt];
#pragma unroll
        for (int r = 0; r < 16; ++r) {
          float pv = (SM == 1) ? __builtin_amdgcn_exp2f(st[qt][r]) : (SM == 2) ? __builtin_amdgcn_exp2f(st[qt][r] - msh[qt]) : __builtin_amdgcn_exp2f(st[qt][r] * sc - mr);
          st[qt][r] = pv;
          ps += pv;
        }
#pragma unroll
        for (int s2 = 0; s2 < 2; ++s2) {
          u32x4 pk;
          pk.x = cvtpk(st[qt][8 * s2 + 0], st[qt][8 * s2 + 1]);
          pk.y = cvtpk(st[qt][8 * s2 + 2], st[qt][8 * s2 + 3]);
          pk.z = cvtpk(st[qt][8 * s2 + 4], st[qt][8 * s2 + 5]);
          pk.w = cvtpk(st[qt][8 * s2 + 6], st[qt][8 * s2 + 7]);
          pb[qt][s2] = __builtin_bit_cast(bf16x8, pk);
        }
        l_run[qt] += ps;
      }
      __builtin_amdgcn_s_setprio(1);
#pragma unroll
      for (int s2 = 0; s2 < 2; ++s2)
#pragma unroll
        for (int dt = 0; dt < 2; ++dt) {
          const bf16* vp = Vs + (dt * 32 + (lane & 31)) * VLS + kt * 32 + 16 * s2 + 8 * (lane >> 5);
          bf16x8 af = *(const bf16x8*)vp;
          ot[0][dt] = MFMA32(af, pb[0][s2], ot[0][dt]);
          ot[1][dt] = MFMA32(af, pb[1][s2], ot[1][dt]);
        }
      __builtin_amdgcn_s_setprio(0);
    };
    if constexpr (SM == 1) {
#pragma unroll 1
      for (int kt = 0; kt < 2; ++kt) half(kt);
    } else {
      half(0);
      half(1);
    }
  }
#pragma unroll
  for (int qt = 0; qt < 2; ++qt) {
    const float ltot = l_run[qt] + __shfl_xor(l_run[qt], 32);
    const float inv_l = 1.0f / ltot;
    const int tid2 = get_tid();
    bf16* op = O + (size_t)((tid2 >> 6) * 64 + qt * 32 + (tid2 & 31)) * ldo;
#pragma unroll
    for (int dt = 0; dt < 2; ++dt)
#pragma unroll
      for (int g4 = 0; g4 < 4; ++g4) {
        int dv = dt * 32 + 8 * g4 + 4 * ((tid2 >> 5) & 1);
        u32x2 o;
        o.x = cvtpk(ot[qt][dt][4 * g4 + 0] * inv_l, ot[qt][dt][4 * g4 + 1] * inv_l);
        o.y = cvtpk(ot[qt][dt][4 * g4 + 2] * inv_l, ot[qt][dt][4 * g4 + 3] * inv_l);
        *(u32x2*)(op + dv) = o;
      }
  }
}

DI void hgrn2_item(const Params& p, int item, char* smem) {
  const int vs = item & 3, dir = (item >> 2) & 1, h = (item >> 3) & 3, b = item >> 5;
  constexpr int QLS = 136, TLS = 72;
  bf16* Qr = (bf16*)smem;
  bf16* Kr = Qr + 64 * QLS;
  bf16* KrT = Kr + 64 * QLS;
  bf16* VTs = KrT + 128 * TLS;
  bf16* Att = VTs + 32 * TLS;
  bf16* STb = Att + 64 * TLS;
  float* rsum = (float*)(STb + 32 * QLS);
  float* lsum = rsum + 128;
  const int tid = get_tid(), lane = tid & 63, w = tid >> 6;
  const int c = tid & 127, half = tid >> 7;
  const bf16* ph = (const bf16*)(p.ws + OFF_PAHG);
  bf16* og = (bf16*)(p.ws + OFF_OHG) + (size_t)dir * NTOK * 512;
  auto rowof = [&](int pos) -> int {
    if (pos < CTXL) { int s = dir ? (CTXL - 1 - pos) : pos; return NLAT + b * CTXL + s; }
    int t = pos - CTXL; t = dir ? (SEQ - 1 - t) : t; return b * SEQ + t;
  };
  f32x16 S0, S1;
#pragma unroll
  for (int r = 0; r < 16; ++r) { S0[r] = 0.f; S1[r] = 0.f; }
  bf16 pq[32], pf[32];
  u32x4 pv;
  auto prefetch = [&](int ch) {
    const int p0 = ch * 64;
#pragma unroll
    for (int i = 0; i < 32; ++i) {
      const bf16* row = ph + (size_t)rowof(p0 + half * 32 + i) * 2560;
      pq[i] = row[h * 128 + c];
      pf[i] = row[512 + dir * 512 + h * 128 + c];
    }
    {
      const bf16* row = ph + (size_t)rowof(p0 + (tid >> 2)) * 2560;
      pv = *(const u32x4*)(row + 1536 + h * 128 + vs * 32 + (tid & 3) * 8);
    }
  };
  for (int ch = 0; ch < 132; ++ch) {
    prefetch(ch);
    {
      float run = 0.f;
      if (half == 0) {
#pragma unroll
        for (int ii = 31; ii >= 0; --ii) {
          float lg = bf2f(pf[ii]), q = bf2f(pq[ii]);
          float k = 1.f - __expf(lg);
          float eq = __expf(fminf(-run, 80.f)), ek = __expf(fmaxf(run, -80.f));
          const unsigned pk2 = cvtpk(q * eq, k * ek);
          const bf16 qv = (bf16)(pk2 & 0xffffu), kv = (bf16)(pk2 >> 16);
          Qr[ii * QLS + c] = qv;
          Kr[ii * QLS + c] = kv;
          KrT[c * TLS + ii] = kv;
          run += lg;
        }
        rsum[c] = __expf(run);
      } else {
#pragma unroll
        for (int ii = 0; ii < 32; ++ii) {
          float lg = bf2f(pf[ii]), q = bf2f(pq[ii]);
          float k = 1.f - __expf(lg);
          run += lg;
          float eq = __expf(fmaxf(run, -80.f)), ek = __expf(fminf(-run, 80.f));
          const unsigned pk2 = cvtpk(q * eq, k * ek);
          const bf16 qv = (bf16)(pk2 & 0xffffu), kv = (bf16)(pk2 >> 16);
          Qr[(32 + ii) * QLS + c] = qv;
          Kr[(32 + ii) * QLS + c] = kv;
          KrT[c * TLS + 32 + ii] = kv;
        }
        lsum[c] = __expf(run);
      }
      {
        int i = tid >> 2, v0 = (tid & 3) * 8;
#pragma unroll
        for (int j = 0; j < 4; ++j) {
          VTs[(v0 + 2 * j) * TLS + i] = (bf16)(pv[j] & 0xffffu);
          VTs[(v0 + 2 * j + 1) * TLS + i] = (bf16)(pv[j] >> 16);
        }
      }
    }
    __syncthreads();
    if (w < 2) {
      const int ntl = (w == 0) ? 2 : 1;
      for (int q2 = 0; q2 < ntl; ++q2) {
        const int tt = (w == 0) ? q2 : 1, stl = (w == 0) ? q2 : 0;
        f32x16 a;
#pragma unroll
        for (int r = 0; r < 16; ++r) a[r] = 0.f;
        mma_tile(a, Qr + tt * 32 * QLS, QLS, Kr + stl * 32 * QLS, QLS, 128);
#pragma unroll
        for (int r = 0; r < 16; ++r) {
          int t = tt * 32 + crow(r, lane), s = stl * 32 + (lane & 31);
          float v = (s <= t) ? a[r] : 0.f;
          Att[t * TLS + s] = (bf16)(cvtpk(v, v) & 0xffffu);
        }
      }
      if (w == 1) {
#pragma unroll
        for (int r = 0; r < 16; ++r) Att[crow(r, lane) * TLS + 32 + (lane & 31)] = 0;
      }
    } else {
      const int ct0 = (w - 2) * 2;
#pragma unroll
      for (int tI = 0; tI < 2; ++tI) {
        f32x16& S = tI ? S1 : S0;
        const int cb = (ct0 + tI) * 32;
#pragma unroll
        for (int g4 = 0; g4 < 4; ++g4) {
          int cc = cb + 8 * g4 + 4 * (lane >> 5);
          float e0 = rsum[cc], e1 = rsum[cc + 1], e2 = rsum[cc + 2], e3 = rsum[cc + 3];
          u32x2 o;
          o.x = cvtpk(S[4 * g4] * e0, S[4 * g4 + 1] * e1);
          o.y = cvtpk(S[4 * g4 + 2] * e2, S[4 * g4 + 3] * e3);
          *(u32x2*)(STb + (lane & 31) * QLS + cc) = o;
        }
        f32x16 a;
#pragma unroll
        for (int r = 0; r < 16; ++r) a[r] = 0.f;
        mma_tile(a, KrT + cb * TLS, TLS, VTs, TLS, 64);
#pragma unroll
        for (int r = 0; r < 16; ++r) {
          int cc = cb + crow(r, lane);
          float el = lsum[cc];
          float er = rsum[cc];
          S[r] = S[r] * (el * er) + a[r] * el;
        }
      }
    }
    __syncthreads();
    if (w < 2) {
      f32x16 a;
#pragma unroll
      for (int r = 0; r < 16; ++r) a[r] = 0.f;
      mma_tile(a, Att + w * 32 * TLS, TLS, VTs, TLS, 64);
      mma_tile(a, Qr + w * 32 * QLS, QLS, STb, QLS, 128);
#pragma unroll
      for (int r = 0; r < 16; ++r) {
        int t = w * 32 + crow(r, lane);
        int row = rowof(ch * 64 + t);
        og[(size_t)row * 512 + h * 128 + vs * 32 + (lane & 31)] = f2bf(a[r]);
      }
    }
    __syncthreads();
  }
}

DI void phase_mix0(const Params& p, char* smem, int cidx) {
  __shared__ int s_item;
  if (blockIdx.x < 128) hgrn2_item(p, blockIdx.x, smem);
  unsigned* cnt = (unsigned*)(p.ws + OFF_CNT) + cidx;
  const bf16* pg = (const bf16*)(p.ws + OFF_PAGQA);
  const bf16* vt = (const bf16*)(p.ws + OFF_VT0);
  bf16* ycat = (bf16*)(p.ws + OFF_ACTA);
  float kb0;
  {
    const int ln = get_tid() & 63;
    kb0 = 8.0f * 1.01f * wave_max_early(fabsf(p.gqa_kn_g[ln]));
  }
  const int n_lat = 4 * 8 * 32, n_ctx = 4 * 8;
  while (true) {
    __syncthreads();
    if (get_tid() == 0) s_item = (int)atomicAdd(cnt, 1u);
    __syncthreads();
    const int it = s_item;
    if (it >= n_lat + n_ctx) break;
    int b, hq, r0, nk;
    if (it < n_lat) { const int qt = it & 31; hq = (it >> 5) & 7; b = it >> 8; r0 = b * SEQ + qt * 256; nk = SKEYS; }
    else { const int i2 = it - n_lat; hq = i2 & 7; b = i2 >> 3; r0 = NLAT + b * CTXL; nk = CTXL; }
    const int kvh = hq >> 2;
    attn_item<64, 2>(pg + (size_t)r0 * 768 + hq * 64, 768,
                  pg + (size_t)(NLAT + b * CTXL) * 768 + 512 + kvh * 64, pg + (size_t)(b * SEQ) * 768 + 512 + kvh * 64, 768,
                  vt + (size_t)((b * 2 + kvh) * 64) * SKEYS, nk, ycat + (size_t)r0 * DM + hq * 64, DM, 0.125f, smem, kb0);
  }
}

DI void phase_hg_readout(const Params& p) {
  const int lane = get_tid() & 63, w = get_tid() >> 6;
  const bf16* o0 = (const bf16*)(p.ws + OFF_OHG);
  const bf16* o1 = o0 + (size_t)NTOK * 512;
  const bf16* ph = (const bf16*)(p.ws + OFF_PAHG);
  bf16* ycat = (bf16*)(p.ws + OFF_ACTA);
  const float g0 = p.hg_onorm_g[lane * 2], g1 = p.hg_onorm_g[lane * 2 + 1];
  for (int r = blockIdx.x * 4 + w; r < NTOK; r += gridDim.x * 4) {
#pragma unroll
    for (int h = 0; h < 4; ++h) {
      unsigned a = *(const unsigned*)(o0 + (size_t)r * 512 + h * 128 + lane * 2);
      unsigned b2 = *(const unsigned*)(o1 + (size_t)r * 512 + h * 128 + lane * 2);
      unsigned gg = *(const unsigned*)(ph + (size_t)r * 2560 + 2048 + h * 128 + lane * 2);
      float x0 = bflo(a) + bflo(b2), x1 = bfhi(a) + bfhi(b2);
      float ss = wave_sum(x0 * x0 + x1 * x1);
      float rs = rsqrtf(ss * (1.f / 128.f) + EPSN);
      float y0 = x0 * rs * g0 * siluf_(bflo(gg)), y1 = x1 * rs * g1 * siluf_(bfhi(gg));
      *(unsigned*)(ycat + (size_t)r * DM + 512 + h * 128 + lane * 2) = cvtpk(y0, y1);
    }
  }
}

template <int MI>
DI void resid_epilogue(f32x16 (&acc)[MI][2], const float* src, float* dst, const float* __restrict__ g) {
  const int lane = get_tid() & 63, w = get_tid() >> 6;
  const int wm = w >> 1, wn = w & 1;
  const float g0 = g[wn * 64 + (lane & 31)], g1 = g[wn * 64 + 32 + (lane & 31)];
#pragma unroll
  for (int mi = 0; mi < MI; ++mi) {
    const size_t o0 = (size_t)(wm * (MI * 32) + mi * 32 + 4 * (lane >> 5)) * DM + wn * 64 + (lane & 31);
    float xv[2][16];
#pragma unroll
    for (int r = 0; r < 16; ++r) {
      const size_t ro = o0 + (size_t)((r & 3) + 8 * (r >> 2)) * DM;
      xv[0][r] = src[ro];
      xv[1][r] = src[ro + 32];
    }
#pragma unroll
    for (int r = 0; r < 16; ++r) {
      const size_t ro = o0 + (size_t)((r & 3) + 8 * (r >> 2)) * DM;
      dst[ro] = xv[0][r] + g0 * acc[mi][0][r];
      dst[ro + 32] = xv[1][r] + g1 * acc[mi][1][r];
    }
  }
}
DI void resid_prefetch2(float (&xv)[2][2][16], const float* src) {
  const int lane = get_tid() & 63, w = get_tid() >> 6;
  const int wm = w >> 1, wn = w & 1;
#pragma unroll
  for (int mi = 0; mi < 2; ++mi) {
    const size_t o0 = (size_t)(wm * 64 + mi * 32 + 4 * (lane >> 5)) * DM + wn * 64 + (lane & 31);
#pragma unroll
    for (int r = 0; r < 16; ++r) {
      const size_t ro = o0 + (size_t)((r & 3) + 8 * (r >> 2)) * DM;
      xv[mi][0][r] = src[ro];
      xv[mi][1][r] = src[ro + 32];
    }
  }
}
DI void resid_store2(f32x16 (&acc)[2][2], const float (&xv)[2][2][16], float* dst, const float* __restrict__ g) {
  const int lane = get_tid() & 63, w = get_tid() >> 6;
  const int wm = w >> 1, wn = w & 1;
  const float g0 = g[wn * 64 + (lane & 31)], g1 = g[wn * 64 + 32 + (lane & 31)];
#pragma unroll
  for (int mi = 0; mi < 2; ++mi) {
    const size_t o0 = (size_t)(wm * 64 + mi * 32 + 4 * (lane >> 5)) * DM + wn * 64 + (lane & 31);
#pragma unroll
    for (int r = 0; r < 16; ++r) {
      const size_t ro = o0 + (size_t)((r & 3) + 8 * (r >> 2)) * DM;
      dst[ro] = xv[mi][0][r] + g0 * acc[mi][0][r];
      dst[ro + 32] = xv[mi][1][r] + g1 * acc[mi][1][r];
    }
  }
}
DI void phase_outproj(const Params& p, int layer, size_t wt_off, int nrows, bool first, char* smem) {
  (void)first;
  bf16* As = (bf16*)smem; bf16* Bs = As + 128 * GLS;
  const bf16* A = (const bf16*)(p.ws + OFF_ACTA);
  const bf16* Wt = (const bf16*)(p.ws + wt_off);
  const int ntn = 8, ntm = nrows / 128;
  for (int t = blockIdx.x; t < ntn * ntm; t += gridDim.x) {
    const int mt = t / ntn, nt = t % ntn;
    f32x16 acc[2][2];
    const int r0 = mt * 128;
    float xv[2][2][16];
    resid_prefetch2(xv, orig_row(p, r0) + nt * 128);
    gemm_128x128(A + (size_t)mt * 128 * DM, DM, Wt + (size_t)nt * 128 * DM, DM, DM, acc, As, Bs);
    resid_store2(acc, xv, res_row(p, r0) + nt * 128, mod_ptr(p, layer, r0, 2) + nt * 128);
  }
}
DI void phase_outproj1(const Params& p, char* smem) {
  bf16* As = (bf16*)smem; bf16* Bs = As + 256 * GLS;
  const bf16* A = (const bf16*)(p.ws + OFF_ACTA);
  const bf16* Wt = (const bf16*)(p.ws + OFF_WT_ODOUT);
  const int ntn = 8, ntm = NLAT / 256;
  for (int t = blockIdx.x; t < ntn * ntm; t += gridDim.x) {
    const int mt = t / ntn, nt = t % ntn;
    f32x16 acc[4][2];
    gemm_256x128(A + (size_t)mt * 256 * DM, DM, Wt + (size_t)nt * 128 * DM, DM, DM, acc, As, Bs);
    float* xp = p.out + (size_t)(mt * 256) * DM + nt * 128;
    resid_epilogue<4>(acc, xp, xp, mod_ptr(p, 1, mt * 256, 2) + nt * 128);
  }
}

DI void tk_ins(float (&L)[16], float x) {
#pragma unroll
  for (int j = 15; j >= 1; --j) L[j] = __builtin_amdgcn_fmed3f(L[j - 1], L[j], x);
  L[0] = fmaxf(L[0], x);
}
DI void tk_insert(float (&v)[16], int (&id)[16], float x, int xi) {
  if (x > v[15]) {
    v[15] = x; id[15] = xi;
#pragma unroll
    for (int j = 15; j > 0; --j) {
      bool sw = v[j] > v[j - 1];
      float a = v[j], b2 = v[j - 1];
      int ia = id[j], ib = id[j - 1];
      v[j - 1] = sw ? a : b2; v[j] = sw ? b2 : a;
      id[j - 1] = sw ? ia : ib; id[j] = sw ? ib : ia;
    }
  }
}

DI void phase_peer_route(const Params& p, int layer, int nrows, char* smem, size_t roff = OFF_RIDX) {
  bf16* As = (bf16*)smem; bf16* Bs = As + 128 * GLS;
  constexpr int QLS = 136;
  bf16* Qt = (bf16*)smem;
  bf16* Kt = Qt + 128 * QLS;
  float* Sc = (float*)smem;
  const bf16* A = (const bf16*)(p.ws + OFF_ACTA);
  const bf16* Wt = (const bf16*)(p.ws + OFF_WT_PWQ) + (size_t)layer * 2048 * 1024;
  const bf16* keys = (const bf16*)(p.ws + OFF_PKEYS) + (size_t)layer * 8 * 2 * 128 * 128;
  int* ridx = (int*)(p.ws + roff);
  float* rgw = (float*)(p.ws + roff + (OFF_RGW - OFF_RIDX));
  const int tid = get_tid(), lane = tid & 63, w = tid >> 6;
  const int wm = w >> 1, wn = w & 1;
  const int ntm = nrows / 128;
  for (int it = blockIdx.x; it < ntm * 8; it += gridDim.x) {
    const int mt = it >> 3, h = it & 7;
    float l0v[16]; int l0i[16];
    float lv[16]; int li[16];
    for (int pp = 0; pp < 2; ++pp) {
      f32x16 acc[2][2];
      gemm_128x128(A + (size_t)mt * 128 * DM, DM, Wt + (size_t)((h * 2 + pp) * 128) * DM, DM, DM, acc, As, Bs);
      __syncthreads();
      gemm_epi(acc, [&](int row, int col, float v) { Qt[row * QLS + col] = f2bf(v); });
      {
        const bf16* kb = keys + (size_t)((h * 2 + pp) * 128) * 128;
#pragma unroll
        for (int i = 0; i < 8; ++i) {
          int ci = i * 256 + tid;
          int row = ci >> 4, chh = ci & 15;
          *(u32x4*)(Kt + row * QLS + chh * 8) = *(const u32x4*)(kb + row * 128 + chh * 8);
        }
      }
      __syncthreads();
      f32x16 sa[2][2];
#pragma unroll
      for (int i = 0; i < 2; ++i)
#pragma unroll
        for (int j = 0; j < 2; ++j) {
#pragma unroll
          for (int r = 0; r < 16; ++r) sa[i][j][r] = 0.f;
          mma_tile(sa[i][j], Qt + (wm * 64 + i * 32) * QLS, QLS, Kt + (wn * 64 + j * 32) * QLS, QLS, 128);
        }
      __syncthreads();
      gemm_epi(sa, [&](int row, int col, float v) { Sc[row * 129 + col] = v; });
      __syncthreads();
      {
        const int tok = tid & 127, hf = tid >> 7;
        float* Lst = Sc + 128 * 129;
        float L[16];
#pragma unroll
        for (int j = 0; j < 16; ++j) L[j] = -3.0e38f;
#pragma unroll 8
        for (int n = 0; n < 64; ++n) {
          const int nn = hf * 64 + n;
          const unsigned kb = (__float_as_uint(Sc[tok * 129 + nn]) & 0xffffff80u) | (unsigned)nn;
          tk_ins(L, __uint_as_float(kb));
        }
        if (hf == 1) {
#pragma unroll
          for (int j = 0; j < 16; ++j) Lst[tok * 17 + j] = L[j];
        }
        __syncthreads();
        if (hf == 0) {
#pragma unroll
          for (int j = 0; j < 16; ++j) tk_ins(L, Lst[tok * 17 + j]);
#pragma unroll
          for (int j = 0; j < 16; ++j) {
            const int ix = (int)(__float_as_uint(L[j]) & 0x7fu);
            li[j] = ix;
            lv[j] = Sc[tok * 129 + ix];
          }
          if (pp == 0) {
#pragma unroll
            for (int j = 0; j < 16; ++j) { l0v[j] = lv[j]; l0i[j] = li[j]; }
          }
        }
      }
      __syncthreads();
    }
    if (tid < 128) {
      float fv[16]; int fi[16];
#pragma unroll
      for (int j = 0; j < 16; ++j) { fv[j] = -3.0e38f; fi[j] = 0; }
#pragma unroll
      for (int a = 0; a < 16; ++a)
#pragma unroll
        for (int b2 = 0; b2 < 16; ++b2)
          if ((a + 1) * (b2 + 1) <= 16) tk_insert(fv, fi, l0v[a] + lv[b2], l0i[a] * 128 + li[b2]);
      float mx = fv[0];
      float e[16];
#pragma unroll
      for (int j = 0; j < 16; ++j) e[j] = fv[j];
      float sum = 0.f;
#pragma unroll
      for (int j = 0; j < 16; ++j) { e[j] = __expf(e[j] - mx); sum += e[j]; }
      const float inv = 1.f / sum;
      const int r = mt * 128 + tid;
      int4* ip = (int4*)(ridx + (size_t)r * 128 + h * 16);
      float4* gp = (float4*)(rgw + (size_t)r * 128 + h * 16);
#pragma unroll
      for (int j = 0; j < 4; ++j) {
        ip[j] = make_int4(fi[4 * j], fi[4 * j + 1], fi[4 * j + 2], fi[4 * j + 3]);
        gp[j] = make_float4(e[4 * j] * inv, e[4 * j + 1] * inv, e[4 * j + 2] * inv, e[4 * j + 3] * inv);
      }
    }
  }
}

typedef float f32x2 __attribute__((ext_vector_type(2)));
DI float wave_max(float v) {
#pragma unroll
  for (int o = 32; o > 0; o >>= 1) v = fmaxf(v, __shfl_xor(v, o));
  return v;
}
DI unsigned pk4_fp8(float a, float b, float c, float d) {
  int r = 0;
  r = __builtin_amdgcn_cvt_pk_fp8_f32(a, b, r, false);
  r = __builtin_amdgcn_cvt_pk_fp8_f32(c, d, r, true);
  return (unsigned)r;
}
DI float clamp6(float v) { return __builtin_amdgcn_fmed3f(v, -6.0f, 6.0f); }
DI void convert_fp8_rows(const float* __restrict__ src, unsigned char* __restrict__ dst, float* __restrict__ scl) {
  const int lane = get_tid() & 63, w = get_tid() >> 6;
  for (int row = blockIdx.x * 4 + w; row < 16384; row += gridDim.x * 4) {
    const float4* s4 = (const float4*)(src + (size_t)row * 1024) + lane * 4;
    float4 v0 = s4[0], v1 = s4[1], v2 = s4[2], v3 = s4[3];
    float ss = v0.x * v0.x + v0.y * v0.y + v0.z * v0.z + v0.w * v0.w + v1.x * v1.x + v1.y * v1.y + v1.z * v1.z + v1.w * v1.w +
               v2.x * v2.x + v2.y * v2.y + v2.z * v2.z + v2.w * v2.w + v3.x * v3.x + v3.y * v3.y + v3.z * v3.z + v3.w * v3.w;
    ss = wave_sum(ss);
    const float sc = (ss > 0.f) ? 0.5f * sqrtf(ss * (1.0f / 1024.0f)) : 1.0f;
    const float inv = 1.0f / sc;
    unsigned d0 = 0, d1 = 0;
    d0 = __builtin_amdgcn_cvt_scalef32_pk_fp4_f32(d0, clamp6(v0.x * inv), clamp6(v0.y * inv), 1.0f, 0);
    d0 = __builtin_amdgcn_cvt_scalef32_pk_fp4_f32(d0, clamp6(v0.z * inv), clamp6(v0.w * inv), 1.0f, 1);
    d0 = __builtin_amdgcn_cvt_scalef32_pk_fp4_f32(d0, clamp6(v1.x * inv), clamp6(v1.y * inv), 1.0f, 2);
    d0 = __builtin_amdgcn_cvt_scalef32_pk_fp4_f32(d0, clamp6(v1.z * inv), clamp6(v1.w * inv), 1.0f, 3);
    d1 = __builtin_amdgcn_cvt_scalef32_pk_fp4_f32(d1, clamp6(v2.x * inv), clamp6(v2.y * inv), 1.0f, 0);
    d1 = __builtin_amdgcn_cvt_scalef32_pk_fp4_f32(d1, clamp6(v2.z * inv), clamp6(v2.w * inv), 1.0f, 1);
    d1 = __builtin_amdgcn_cvt_scalef32_pk_fp4_f32(d1, clamp6(v3.x * inv), clamp6(v3.y * inv), 1.0f, 2);
    d1 = __builtin_amdgcn_cvt_scalef32_pk_fp4_f32(d1, clamp6(v3.z * inv), clamp6(v3.w * inv), 1.0f, 3);
    ((u32x2*)(dst + (size_t)row * 512))[lane] = u32x2{d0, d1};
    if (lane == 0) scl[row] = sc;
  }
}
DI int q4(float v) {
  int n = (int)floorf(v);
  return (n < -8 ? -8 : (n > 7 ? 7 : n)) & 15;
}
DI void convert_u4_rows(const float* __restrict__ src, unsigned char* __restrict__ dst, float* __restrict__ scl) {
  const int lane = get_tid() & 63, w = get_tid() >> 6;
  for (int row = blockIdx.x * 4 + w; row < 16384; row += gridDim.x * 4) {
    const float4* s4 = (const float4*)(src + (size_t)row * 1024) + lane * 4;
    float4 v0 = s4[0], v1 = s4[1], v2 = s4[2], v3 = s4[3];
    float ss = v0.x * v0.x + v0.y * v0.y + v0.z * v0.z + v0.w * v0.w + v1.x * v1.x + v1.y * v1.y + v1.z * v1.z + v1.w * v1.w +
               v2.x * v2.x + v2.y * v2.y + v2.z * v2.z + v2.w * v2.w + v3.x * v3.x + v3.y * v3.y + v3.z * v3.z + v3.w * v3.w;
    ss = wave_sum(ss);
    const float sc = (ss > 0.f) ? 0.3352f * sqrtf(ss * (1.0f / 1024.0f)) : 1.0f;
    const float inv = 1.0f / sc;
    const unsigned d0 = (unsigned)q4(v0.x * inv) | ((unsigned)q4(v1.x * inv) << 4) | ((unsigned)q4(v0.y * inv) << 8) | ((unsigned)q4(v1.y * inv) << 12) |
                        ((unsigned)q4(v0.z * inv) << 16) | ((unsigned)q4(v1.z * inv) << 20) | ((unsigned)q4(v0.w * inv) << 24) | ((unsigned)q4(v1.w * inv) << 28);
    const unsigned d1 = (unsigned)q4(v2.x * inv) | ((unsigned)q4(v3.x * inv) << 4) | ((unsigned)q4(v2.y * inv) << 8) | ((unsigned)q4(v3.y * inv) << 12) |
                        ((unsigned)q4(v2.z * inv) << 16) | ((unsigned)q4(v3.z * inv) << 20) | ((unsigned)q4(v2.w * inv) << 24) | ((unsigned)q4(v3.w * inv) << 28);
    ((u32x2*)(dst + (size_t)row * 512))[lane] = u32x2{d0, d1};
    if (lane == 0) scl[row] = sc;
  }
}
DI void phase_convert_tables(const Params& p, int layer) {
  convert_u4_rows(p.peer_u + (size_t)layer * 16384 * 1024, (unsigned char*)(p.ws + OFF_UTAB), (float*)(p.ws + OFF_SU));
  convert_fp8_rows(p.peer_v + (size_t)layer * 16384 * 1024, (unsigned char*)(p.ws + OFF_VTAB), (float*)(p.ws + OFF_SV));
}

struct GBuf { u32x4 u[8]; u32x4 v[8]; float su, sv, gw; };
#define FP4X2(d, s) __builtin_amdgcn_cvt_scalef32_pk_f32_fp4((d), 1.0f, (s))
#define FP4B2(d, s) __builtin_amdgcn_cvt_scalef32_pk_bf16_fp4((d), 1.0f, (s))
typedef __bf16 bf16x2v __attribute__((ext_vector_type(2)));
template <int X> DI float swz_xor(float v) {
  return __builtin_bit_cast(float, __builtin_amdgcn_ds_swizzle(__builtin_bit_cast(int, v), (X << 10) | 0x1f));
}
template <int L> DI float swz_bcast(float v) {
  return __builtin_bit_cast(float, __builtin_amdgcn_ds_swizzle(__builtin_bit_cast(int, v), (L << 5)));
}
DI float wave_sum_swz(float v) {
  v += swz_xor<1>(v); v += swz_xor<2>(v); v += swz_xor<4>(v); v += swz_xor<8>(v); v += swz_xor<16>(v);
  return __builtin_bit_cast(float, __builtin_amdgcn_readlane(__builtin_bit_cast(int, v), 0)) +
         __builtin_bit_cast(float, __builtin_amdgcn_readlane(__builtin_bit_cast(int, v), 32));
}
DI float bperm_f(float v, int byte_idx) { return __builtin_bit_cast(float, __builtin_amdgcn_ds_bpermute(byte_idx, __builtin_bit_cast(int, v))); }
DI void phase_peer_gather(const Params& p, int layer, int nrows, bool dry) {
  const int lane = get_tid() & 63, w = __builtin_amdgcn_readfirstlane(get_tid() >> 6);
  const int half = lane >> 5, l5 = lane & 31;
  const bf16* hb = (const bf16*)(p.ws + OFF_ACTA);
  const unsigned char* ut = (const unsigned char*)(p.ws + OFF_UTAB);
  const unsigned char* vtb = (const unsigned char*)(p.ws + OFF_VTAB);
  const float* su = (const float*)(p.ws + OFF_SU);
  const float* sv = (const float*)(p.ws + OFF_SV);
  const int* ridx = (const int*)(p.ws + OFF_RIDX);
  const float* rgw = (const float*)(p.ws + OFF_RGW);
  const int ecode = half * 8 + ((lane >> 4) & 1) * 4 + ((lane >> 3) & 1) * 2 + ((lane >> 2) & 1);
  GBuf B0, B1;
  const int hidx = half * 32;
  int r = blockIdx.x * 4 + w;
  int e_lo = 0, e_hi = 0;
  float g_lo = 0.f, g_hi = 0.f;
  auto gload = [&](GBuf& B, int kb, int elo, int ehi, float glo, float ghi) {
    const int esrc = (kb < 4) ? elo : ehi;
    const float gsrc = (kb < 4) ? glo : ghi;
    const int base = (kb & 3) * 16;
#pragma unroll
    for (int j = 0; j < 8; ++j) {
      const int e = __builtin_amdgcn_ds_bpermute(hidx + ((base + j) << 2), esrc);
      const unsigned off = (unsigned)e * 512u + (unsigned)l5 * 16u;
      B.u[j] = *(const u32x4*)(ut + off);
      B.v[j] = *(const u32x4*)(vtb + off);
    }
    const int el = __builtin_amdgcn_ds_bpermute((base + ecode) << 2, esrc);
    B.su = su[el]; B.sv = sv[el];
    B.gw = bperm_f(gsrc, (base + ecode) << 2);
  };
  if (r < nrows) {
    e_lo = ridx[(size_t)r * 128 + lane]; e_hi = ridx[(size_t)r * 128 + 64 + lane];
    g_lo = rgw[(size_t)r * 128 + lane]; g_hi = rgw[(size_t)r * 128 + 64 + lane];
    gload(B0, 0, e_lo, e_hi, g_lo, g_hi);
  }
  for (; r < nrows; r += gridDim.x * 4) {
    const int rn = r + gridDim.x * 4;
    int ne_lo = 0, ne_hi = 0;
    float ng_lo = 0.f, ng_hi = 0.f;
    if (rn < nrows) {
      ne_lo = ridx[(size_t)rn * 128 + lane]; ne_hi = ridx[(size_t)rn * 128 + 64 + lane];
      ng_lo = rgw[(size_t)rn * 128 + lane]; ng_hi = rgw[(size_t)rn * 128 + 64 + lane];
    }
    unsigned HH[4], HL[4];
    float sh8, h8tot;
    {
      const u32x4* hp = (const u32x4*)(hb + (size_t)r * DM + l5 * 32);
      u32x4 a[4];
#pragma unroll
      for (int q = 0; q < 4; ++q) a[q] = hp[q];
      float m = 0.f;
#pragma unroll
      for (int q = 0; q < 4; ++q)
#pragma unroll
        for (int c = 0; c < 4; ++c) m = fmaxf(m, fmaxf(fabsf(bflo(a[q][c])), fabsf(bfhi(a[q][c]))));
      m = fmaxf(m, swz_xor<1>(m)); m = fmaxf(m, swz_xor<2>(m)); m = fmaxf(m, swz_xor<4>(m));
      m = fmaxf(m, swz_xor<8>(m)); m = fmaxf(m, swz_xor<16>(m));
      const float sc = (m > 0.f) ? 119.0f / m : 0.f;
      sh8 = m * (1.0f / 119.0f);
      float hs = 0.f;
#pragma unroll
      for (int q = 0; q < 4; ++q) {
        float f[8] = {bflo(a[q][0]), bfhi(a[q][0]), bflo(a[q][1]), bfhi(a[q][1]), bflo(a[q][2]), bfhi(a[q][2]), bflo(a[q][3]), bfhi(a[q][3])};
        unsigned P0 = 0, P1 = 0;
#pragma unroll
        for (int i = 0; i < 4; ++i) {
          const float g0 = rintf(f[i] * sc), g1 = rintf(f[4 + i] * sc);
          hs += g0 + g1;
          P0 = __builtin_amdgcn_cvt_pk_u8_f32(g0 + 136.0f, i, P0);
          P1 = __builtin_amdgcn_cvt_pk_u8_f32(g1 + 136.0f, i, P1);
        }
        HH[q] = (((P0 >> 4) & 0x0F0F0F0Fu) | (P1 & 0xF0F0F0F0u)) ^ 0x88888888u;
        HL[q] = ((P0 & 0x0F0F0F0Fu) | ((P1 << 4) & 0xF0F0F0F0u)) ^ 0x88888888u;
      }
      hs += swz_xor<1>(hs); hs += swz_xor<2>(hs); hs += swz_xor<4>(hs); hs += swz_xor<8>(hs); hs += swz_xor<16>(hs);
      h8tot = 0.5f * hs;
    }
    f32x2 acc[16];
#pragma unroll
    for (int j = 0; j < 16; ++j) acc[j] = f32x2{0.f, 0.f};
    auto compute = [&](GBuf& B) {
      float part[8];
#pragma unroll
      for (int j = 0; j < 8; ++j) {
        int dh = 0, dl = 0;
#pragma unroll
        for (int q = 0; q < 4; ++q) {
          dh = __builtin_amdgcn_sdot8((int)B.u[j][q], (int)HH[q], dh, false);
          dl = __builtin_amdgcn_sdot8((int)B.u[j][q], (int)HL[q], dl, false);
        }
        part[j] = (float)((dh << 4) + dl);
      }
      const bool b4 = lane & 16, b3 = lane & 8, b2 = lane & 4;
      float y[4], z[2], t;
#pragma unroll
      for (int i = 0; i < 4; ++i) {
        float send = b4 ? part[i] : part[i + 4];
        float keep = b4 ? part[i + 4] : part[i];
        y[i] = keep + swz_xor<16>(send);
      }
#pragma unroll
      for (int i = 0; i < 2; ++i) {
        float send = b3 ? y[i] : y[i + 2];
        float keep = b3 ? y[i + 2] : y[i];
        z[i] = keep + swz_xor<8>(send);
      }
      {
        float send = b2 ? z[0] : z[1];
        float keep = b2 ? z[1] : z[0];
        t = keep + swz_xor<4>(send);
      }
      t += swz_xor<2>(t);
      t += swz_xor<1>(t);
      const float wl = gelu_as((t + h8tot) * (B.su * sh8)) * B.gw * B.sv;
#define GACC(J)                                                                                        \
      {                                                                                                  \
        const float wj = swz_bcast<(((J) >> 2) & 1) * 16 + (((J) >> 1) & 1) * 8 + ((J) & 1) * 4>(wl);    \
        const f32x2 w2 = f32x2{wj, wj};                                                                  \
        _Pragma("unroll") for (int q = 0; q < 4; ++q) {                                                  \
          acc[4 * q] += w2 * FP4X2(B.v[J][q], 0);                                                        \
          acc[4 * q + 1] += w2 * FP4X2(B.v[J][q], 1);                                                    \
          acc[4 * q + 2] += w2 * FP4X2(B.v[J][q], 2);                                                    \
          acc[4 * q + 3] += w2 * FP4X2(B.v[J][q], 3);                                                    \
        }                                                                                                \
      }
      GACC(0) GACC(1) GACC(2) GACC(3) GACC(4) GACC(5) GACC(6) GACC(7)
#undef GACC
    };
#pragma unroll 1
    for (int kb = 0; kb < 8; kb += 2) {
      gload(B1, kb + 1, e_lo, e_hi, g_lo, g_hi);
      compute(B0);
      if (kb + 2 < 8) gload(B0, kb + 2, e_lo, e_hi, g_lo, g_hi);
      else if (rn < nrows) gload(B0, 0, ne_lo, ne_hi, ng_lo, ng_hi);
      compute(B1);
    }
    e_lo = ne_lo; e_hi = ne_hi; g_lo = ng_lo; g_hi = ng_hi;
    if (dry && acc[0].x != 12345.678f) continue;
    f32x2 fin[8];
#pragma unroll
    for (int k = 0; k < 8; ++k) {
      f32x2 send = half ? acc[k] : acc[k + 8];
      f32x2 keep = half ? acc[k + 8] : acc[k];
      fin[k] = f32x2{keep.x + bperm_f(send.x, (lane ^ 32) << 2), keep.y + bperm_f(send.y, (lane ^ 32) << 2)};
    }
    int eo = l5 * 32 + half * 16;
    asm volatile("" : "+v"(eo));
    float* xr = res_row(p, r) + eo;
    const float* g5 = mod_ptr(p, layer, r, 5) + eo;
    float4 xn[4];
    float ss = 0.f;
#pragma unroll
    for (int q = 0; q < 4; ++q) {
      float4 x0 = ((float4*)xr)[q];
      float4 m0 = ((const float4*)g5)[q];
      x0.x += m0.x * fin[2 * q].x; x0.y += m0.y * fin[2 * q].y; x0.z += m0.z * fin[2 * q + 1].x; x0.w += m0.w * fin[2 * q + 1].y;
      xn[q] = x0;
      ss += x0.x * x0.x + x0.y * x0.y + x0.z * x0.z + x0.w * x0.w;
    }
    ss = wave_sum_swz(ss);
    const float rs = rsqrtf(ss * (1.0f / 1024.0f) + EPSN);
    if (layer == 0) {
      const float* gg = p.norm1_g + 1024 + eo;
      const float* sh = mod_ptr(p, 1, r, 0) + eo;
      const float* sc = mod_ptr(p, 1, r, 1) + eo;
      unsigned hw[8];
#pragma unroll
      for (int q = 0; q < 4; ++q) {
        ((float4*)xr)[q] = xn[q];
        float4 g4 = ((const float4*)gg)[q], s4 = ((const float4*)sh)[q], c4 = ((const float4*)sc)[q];
        float o0 = xn[q].x * rs * g4.x * (1.f + c4.x) + s4.x;
        float o1 = xn[q].y * rs * g4.y * (1.f + c4.y) + s4.y;
        float o2 = xn[q].z * rs * g4.z * (1.f + c4.z) + s4.z;
        float o3 = xn[q].w * rs * g4.w * (1.f + c4.w) + s4.w;
        hw[2 * q] = cvtpk(o0, o1); hw[2 * q + 1] = cvtpk(o2, o3);
      }
      u32x4 w0 = {hw[0], hw[1], hw[2], hw[3]}, w1 = {hw[4], hw[5], hw[6], hw[7]};
      bf16* hd = (bf16*)(p.ws + OFF_ACTA) + (size_t)r * DM + eo;
      *(u32x4*)hd = w0;
      *(u32x4*)(hd + 8) = w1;
    } else {
      const float* gg = p.final_g + eo;
#pragma unroll
      for (int q = 0; q < 4; ++q) {
        float4 g4 = ((const float4*)gg)[q];
        float4 o;
        o.x = xn[q].x * rs * g4.x; o.y = xn[q].y * rs * g4.y; o.z = xn[q].z * rs * g4.z; o.w = xn[q].w * rs * g4.w;
        ((float4*)xr)[q] = o;
      }
    }
  }
}

DI void phase_inproj1(const Params& p, char* smem) {
  bf16* As = (bf16*)smem; bf16* Bs = As + 256 * GLS;
  const bf16* A = (const bf16*)(p.ws + OFF_ACTA);
  const bf16* Wt = (const bf16*)(p.ws + OFF_WT_ODIN);
  bf16* pm = (bf16*)(p.ws + OFF_PA1M);
  bf16* pu = (bf16*)(p.ws + OFF_U1);
  const int ntn = 10, ntm = NTOK / 256;
  for (int t = blockIdx.x; t < ntn * ntm; t += gridDim.x) {
    const int mt = t / ntn, nt = t % ntn;
    f32x16 acc[4][2];
    gemm_256x128(A + (size_t)mt * 256 * DM, DM, Wt + (size_t)nt * 128 * DM, DM, DM, acc, As, Bs);
    gemm_epi2(acc, [&](int row, int col, float v) {
      int r = mt * 256 + row, cg_ = nt * 128 + col;
      if (cg_ < 672) pm[(size_t)r * 672 + cg_] = f2bf(v);
      else if (cg_ < 1184) pu[(size_t)r * 512 + (cg_ - 672)] = f2bf(v);
    });
  }
}

DI void phase_mla_prep(const Params& p) {
  const int lane = get_tid() & 63, w = get_tid() >> 6;
  const bf16* pm = (const bf16*)(p.ws + OFF_PA1M);
  bf16* qn = (bf16*)(p.ws + OFF_QN);
  bf16* kvn = (bf16*)(p.ws + OFF_KVN);
  bf16* k1 = (bf16*)(p.ws + OFF_K1);
  const float inv = __powf(10000.f, -(float)(lane & 7) / 8.f);
  for (int r = blockIdx.x * 4 + w; r < NTOK; r += gridDim.x * 4) {
    const bf16* row = pm + (size_t)r * 672;
    if (r < NLAT) {
      float v[6]; float ss = 0.f;
#pragma unroll
      for (int i = 0; i < 6; ++i) { v[i] = bf2f(row[i * 64 + lane]); ss += v[i] * v[i]; }
      ss = wave_sum(ss);
      const float rs = rsqrtf(ss * (1.f / 384.f) + EPSN);
#pragma unroll
      for (int i = 0; i < 6; ++i) qn[(size_t)r * 384 + i * 64 + lane] = f2bf(v[i] * rs * p.mla_qa_g[i * 64 + lane]);
    }
    {
      float v[4]; float ss = 0.f;
#pragma unroll
      for (int i = 0; i < 4; ++i) { v[i] = bf2f(row[384 + i * 64 + lane]); ss += v[i] * v[i]; }
      ss = wave_sum(ss);
      const float rs = rsqrtf(ss * (1.f / 256.f) + EPSN);
#pragma unroll
      for (int i = 0; i < 4; ++i) kvn[(size_t)r * 256 + i * 64 + lane] = f2bf(v[i] * rs * p.mla_kva_g[i * 64 + lane]);
    }
    {
      const int cl = lane & 31;
      float y = bf2f(row[640 + cl]);
      float sn = 0.f, cs = 1.f;
      if (r < NLAT) {
        int t = r & 8191;
        float pos = (cl < 16) ? (float)(t >> 6) : (float)(t & 63);
        sincosf(pos * inv, &sn, &cs);
      }
      float pr = __shfl_xor(y, 8);
      float o = y * cs + ((cl & 8) ? pr * sn : -pr * sn);
      bf16 ob = f2bf(o);
      {
        const float ob_f = bf2f(ob);
        const float sq = wave_sum(lane < 32 ? ob_f * ob_f : 0.f);
        if (lane == 0) ((float*)(p.ws + OFF_KRSQ))[r] = sq;
      }
      const int hb = (lane >> 5) * 4;
#pragma unroll
      for (int hh = 0; hh < 4; ++hh) k1[(size_t)r * 768 + (hb + hh) * 96 + 64 + cl] = ob;
    }
  }
}

DI void phase_mla_up(const Params& p, char* smem) {
  bf16* As = (bf16*)smem; bf16* Bs = As + 128 * GLS;
  const bf16* qn = (const bf16*)(p.ws + OFF_QN);
  const bf16* kvn = (const bf16*)(p.ws + OFF_KVN);
  const bf16* wq = (const bf16*)(p.ws + OFF_WT_QUP);
  const bf16* wkv = (const bf16*)(p.ws + OFF_WT_KVUP);
  bf16* q1 = (bf16*)(p.ws + OFF_Q1);
  bf16* k1 = (bf16*)(p.ws + OFF_K1);
  bf16* vt1 = (bf16*)(p.ws + OFF_VT1);
  const float2* rtab = (const float2*)(p.ws + OFF_ROPE1);
  const int lane = get_tid() & 63, w = get_tid() >> 6;
  const int wm = w >> 1, wn = w & 1;
  const int nq = (NLAT / 128) * 6, nkv = (NTOK / 128) * 8;
  for (int t = blockIdx.x; t < nq + nkv; t += gridDim.x) {
    f32x16 acc[2][2];
    if (t < nq) {
      const int mt = t / 6, nt = t % 6;
      gemm_128x128(qn + (size_t)mt * 128 * 384, 384, wq + (size_t)nt * 128 * 384, 384, 384, acc, As, Bs);
#pragma unroll
      for (int mi = 0; mi < 2; ++mi)
#pragma unroll
        for (int ni = 0; ni < 2; ++ni) {
          const int colbase = nt * 128 + wn * 64 + ni * 32;
          const bool rope = (colbase % 96) == 64;
          const int cl = lane & 31;
#pragma unroll
          for (int r = 0; r < 16; ++r) {
            const int row = mt * 128 + wm * 64 + mi * 32 + crow(r, lane);
            float v = acc[mi][ni][r];
            float pr = __shfl_xor(v, 8);
            if (rope) {
              int tt = row & 8191;
              float2 csn = rtab[tt * 16 + ((cl >> 4) << 3) + (cl & 7)];
              v = v * csn.x + ((cl & 8) ? pr * csn.y : -pr * csn.y);
            }
            q1[(size_t)row * 768 + colbase + cl] = f2bf(v * (0.10206207261596577f * 1.4426950408889634f));
          }
        }
    } else {
      const int t2 = t - nq;
      const int mt = t2 >> 3, h = t2 & 7;
      gemm_128x128(kvn + (size_t)mt * 128 * 256, 256, wkv + (size_t)h * 128 * 256, 256, 256, acc, As, Bs);
      const int r0 = mt * 128;
      int b, s0;
      if (r0 < NLAT) { b = r0 >> 13; s0 = CTXL + (r0 & 8191); } else { int rc = r0 - NLAT; b = rc >> 8; s0 = rc & 255; }
#pragma unroll
      for (int mi = 0; mi < 2; ++mi)
#pragma unroll
        for (int ni = 0; ni < 2; ++ni) {
          const int cl = ni * 32 + (lane & 31);
          if (wn == 0) {
#pragma unroll
            for (int r = 0; r < 16; ++r) {
              const int row = r0 + wm * 64 + mi * 32 + crow(r, lane);
              k1[(size_t)row * 768 + h * 96 + cl] = f2bf(acc[mi][ni][r]);
            }
            if (ni == 1) {
              float mxk = 0.f;
#pragma unroll
              for (int r = 0; r < 16; ++r) {
                float sq = acc[mi][0][r] * acc[mi][0][r] + acc[mi][1][r] * acc[mi][1][r];
                sq += __shfl_xor(sq, 16); sq += __shfl_xor(sq, 8); sq += __shfl_xor(sq, 4); sq += __shfl_xor(sq, 2); sq += __shfl_xor(sq, 1);
                const int row = r0 + wm * 64 + mi * 32 + crow(r, lane);
                sq += ((const float*)(p.ws + OFF_KRSQ))[row];
                mxk = fmaxf(mxk, sq);
              }
              mxk = wave_max(mxk);
              if (lane == 0) atomicMax((unsigned*)(p.ws + OFF_KMAX) + b * 8 + h, __float_as_uint(sqrtf(mxk) * 1.02f));
            }
          } else {
            bf16* vrow = vt1 + (size_t)((b * 8 + h) * 64 + cl) * SKEYS + s0 + wm * 64 + mi * 32;
#pragma unroll
            for (int g4 = 0; g4 < 4; ++g4) {
              u32x2 o;
              o.x = cvtpk(acc[mi][ni][4 * g4], acc[mi][ni][4 * g4 + 1]);
              o.y = cvtpk(acc[mi][ni][4 * g4 + 2], acc[mi][ni][4 * g4 + 3]);
              *(u32x2*)(vrow + 8 * g4 + 4 * (lane >> 5)) = o;
            }
          }
        }
    }
  }
}

DI void s5_item(const Params& p, int item, char* smem) {
  const int dir = item & 1, g = (item >> 1) & 31, b = item >> 6;
  constexpr int ULS = 264, SLS = 136;
  bf16* Uc = (bf16*)smem;
  bf16* Sp = Uc + 32 * ULS;
  float* E = (float*)(Sp + 32 * SLS);
  const int mi_ = g * 2 + dir;
  const bf16* T = (const bf16*)(p.ws + OFF_S5T) + (size_t)mi_ * 65536;
  const bf16* WE = (const bf16*)(p.ws + OFF_S5WE) + (size_t)mi_ * 32768;
  const bf16* WY = (const bf16*)(p.ws + OFF_S5WY) + (size_t)mi_ * 32768;
  const float* A16 = (const float*)(p.ws + OFF_S5A16) + (size_t)mi_ * 128;
  const bf16* U1 = (const bf16*)(p.ws + OFF_U1);
  bf16* ys = (bf16*)(p.ws + OFF_YS5) + (size_t)dir * NLAT * 512;
  const int tid = get_tid(), lane = tid & 63, w = tid >> 6;
  auto rowof = [&](int pos) -> int {
    if (pos < CTXL) { int s = dir ? (CTXL - 1 - pos) : pos; return NLAT + b * CTXL + s; }
    int t = pos - CTXL; t = dir ? (SEQ - 1 - t) : t; return b * SEQ + t;
  };
  float sre = 0.f, sim = 0.f;
  const float a16r = A16[(lane & 63) * 2], a16i = A16[(lane & 63) * 2 + 1];
  for (int sc = 0; sc < 17; ++sc) {
    const int nvalid = (528 - sc * 32) < 32 ? (528 - sc * 32) : 32;
    __syncthreads();
    {
      const int n = tid >> 3, j0 = (tid & 7) * 2;
#pragma unroll
      for (int jj = 0; jj < 2; ++jj) {
        u32x4 a = {0u, 0u, 0u, 0u}, b2 = {0u, 0u, 0u, 0u};
        if (n < nvalid) {
          const int pos = (sc * 32 + n) * 16 + j0 + jj;
          const bf16* src = U1 + (size_t)rowof(pos) * 512 + g * 16;
          a = *(const u32x4*)src; b2 = *(const u32x4*)(src + 8);
        }
        *(u32x4*)(Uc + n * ULS + (j0 + jj) * 16) = a;
        *(u32x4*)(Uc + n * ULS + (j0 + jj) * 16 + 8) = b2;
      }
    }
    __syncthreads();
    f32x16 e, y0, y1;
#pragma unroll
    for (int r = 0; r < 16; ++r) { e[r] = 0.f; y0[r] = 0.f; y1[r] = 0.f; }
    mma_tile_ga<256>(e, WE + (size_t)(w * 32) * 256, 256, Uc, ULS);
#pragma unroll
    for (int r = 0; r < 16; ++r) E[(w * 32 + crow(r, lane)) * 33 + (lane & 31)] = e[r];
    mma_tile_ga<256>(y0, T + (size_t)(2 * w * 32) * 256, 256, Uc, ULS);
    mma_tile_ga<256>(y1, T + (size_t)((2 * w + 1) * 32) * 256, 256, Uc, ULS);
    __syncthreads();
    if (w == 0) {
      for (int n = 0; n < 32; ++n) {
        Sp[n * SLS + lane] = f2bf(sre);
        Sp[n * SLS + 64 + lane] = f2bf(sim);
        float er = E[lane * 33 + n], ei = E[(64 + lane) * 33 + n];
        float nr = a16r * sre - a16i * sim + er;
        float ni = a16r * sim + a16i * sre + ei;
        sre = nr; sim = ni;
      }
    }
    __syncthreads();
    mma_tile_ga<128>(y0, WY + (size_t)(2 * w * 32) * 128, 128, Sp, SLS);
    mma_tile_ga<128>(y1, WY + (size_t)((2 * w + 1) * 32) * 128, 128, Sp, SLS);
    {
      const int n = lane & 31;
      if (n < nvalid) {
        const int cgi = sc * 32 + n;
#pragma unroll
        for (int tI = 0; tI < 2; ++tI) {
          const f32x16& y = tI ? y1 : y0;
#pragma unroll
          for (int g4 = 0; g4 < 4; ++g4) {
            const int m = (2 * w + tI) * 32 + 8 * g4 + 4 * (lane >> 5);
            const int i = m >> 4, c0 = m & 15;
            const int pos = cgi * 16 + i;
            if (pos >= CTXL) {
              u32x2 o;
              o.x = cvtpk(y[4 * g4], y[4 * g4 + 1]);
              o.y = cvtpk(y[4 * g4 + 2], y[4 * g4 + 3]);
              *(u32x2*)(ys + (size_t)rowof(pos) * 512 + g * 16 + c0) = o;
            }
          }
        }
      }
    }
  }
}

DI void phase_mix1(const Params& p, char* smem, int cidx) {
  __shared__ int s_item1;
  if (cidx == 1 && blockIdx.x < 256) s5_item(p, blockIdx.x, smem);
  unsigned* cnt = (unsigned*)(p.ws + OFF_CNT) + cidx;
  const bf16* q1 = (const bf16*)(p.ws + OFF_Q1);
  const bf16* k1 = (const bf16*)(p.ws + OFF_K1);
  const bf16* vt = (const bf16*)(p.ws + OFF_VT1);
  bf16* ycat = (bf16*)(p.ws + OFF_ACTA);
  const int n_lat = 4 * 8 * 32;
  while (true) {
    __syncthreads();
    if (get_tid() == 0) s_item1 = (int)atomicAdd(cnt, 1u);
    __syncthreads();
    const int it = s_item1;
    if (it >= n_lat) break;
    const int qt = it & 31, h = (it >> 5) & 7, b = it >> 8;
    const int r0 = b * SEQ + qt * 256;
    attn_item<96, 2>(q1 + (size_t)r0 * 768 + h * 96, 768, k1 + (size_t)(NLAT + b * CTXL) * 768 + h * 96,
                  k1 + (size_t)(b * SEQ) * 768 + h * 96, 768, vt + (size_t)((b * 8 + h) * 64) * SKEYS, SKEYS,
                  ycat + (size_t)r0 * DM + h * 64, DM, 0.10206207261596577f, smem, ((const float*)(p.ws + OFF_KMAX))[b * 8 + h]);
  }
}

DI void phase_s5_z(const Params& p) {
  const bf16* U1 = (const bf16*)(p.ws + OFF_U1);
  const bf16* y0 = (const bf16*)(p.ws + OFF_YS5);
  const bf16* y1 = y0 + (size_t)NLAT * 512;
  bf16* z = (bf16*)(p.ws + OFF_Z1);
  const size_t nv = (size_t)NLAT * 512 / 8;
  for (size_t i = (size_t)blockIdx.x * 256 + get_tid(); i < nv; i += (size_t)gridDim.x * 256) {
    const int col = (int)(i & 63) * 8;
    u32x4 u = ((const u32x4*)U1)[i], a = ((const u32x4*)y0)[i], b2 = ((const u32x4*)y1)[i];
    float fu[8], fa[8], fb[8], o[8];
    f32x16 dummy; (void)dummy;
    fu[0] = bflo(u.x); fu[1] = bfhi(u.x); fu[2] = bflo(u.y); fu[3] = bfhi(u.y); fu[4] = bflo(u.z); fu[5] = bfhi(u.z); fu[6] = bflo(u.w); fu[7] = bfhi(u.w);
    fa[0] = bflo(a.x); fa[1] = bfhi(a.x); fa[2] = bflo(a.y); fa[3] = bfhi(a.y); fa[4] = bflo(a.z); fa[5] = bfhi(a.z); fa[6] = bflo(a.w); fa[7] = bfhi(a.w);
    fb[0] = bflo(b2.x); fb[1] = bfhi(b2.x); fb[2] = bflo(b2.y); fb[3] = bfhi(b2.y); fb[4] = bflo(b2.z); fb[5] = bfhi(b2.z); fb[6] = bflo(b2.w); fb[7] = bfhi(b2.w);
#pragma unroll
    for (int j = 0; j < 8; ++j) o[j] = geluf_(p.s5_d[col + j] * fu[j] + fa[j] + fb[j]);
    u32x4 ov;
    ov.x = cvtpk(o[0], o[1]); ov.y = cvtpk(o[2], o[3]); ov.z = cvtpk(o[4], o[5]); ov.w = cvtpk(o[6], o[7]);
    ((u32x4*)z)[i] = ov;
  }
}

DI void phase_glu(const Params& p, char* smem) {
  bf16* As = (bf16*)smem; bf16* Bs = As + 256 * GLS;
  const bf16* z = (const bf16*)(p.ws + OFF_Z1);
  const bf16* Wt = (const bf16*)(p.ws + OFF_WT_GLU);
  bf16* ycat = (bf16*)(p.ws + OFF_ACTA);
  const int ntn = 4, ntm = NLAT / 256;
  for (int t = blockIdx.x; t < ntn * ntm; t += gridDim.x) {
    const int mt = t / ntn, nt = t % ntn;
    f32x16 acc[4][2];
    gemm_256x128(z + (size_t)mt * 256 * 512, 512, Wt + (size_t)nt * 128 * 512, 512, 512, acc, As, Bs);
    gemm_epi2(acc, [&](int row, int col, float v) {
      int r = mt * 256 + row, cc = nt * 128 + col;
      float zz = bf2f(z[(size_t)r * 512 + cc]);
      ycat[(size_t)r * DM + 512 + cc] = f2bf(zz * sigmoidf_(v + p.s5_b_glu[cc]));
    });
  }
}

DI void phase_final(const Params& p) {
  const int lane = get_tid() & 63, w = get_tid() >> 6;
  for (int r = blockIdx.x * 4 + w; r < NLAT; r += gridDim.x * 4) {
    float* row = p.out + (size_t)r * DM;
    float4 v[4];
    float ss = 0.f;
#pragma unroll
    for (int i = 0; i < 4; ++i) {
      v[i] = ((const float4*)row)[i * 64 + lane];
      ss += v[i].x * v[i].x + v[i].y * v[i].y + v[i].z * v[i].z + v[i].w * v[i].w;
    }
    ss = wave_sum(ss);
    const float rs = rsqrtf(ss * (1.0f / 1024.0f) + EPSN);
#pragma unroll
    for (int i = 0; i < 4; ++i) {
      float4 gg = ((const float4*)p.final_g)[i * 64 + lane];
      float4 o;
      o.x = v[i].x * rs * gg.x; o.y = v[i].y * rs * gg.y; o.z = v[i].z * rs * gg.z; o.w = v[i].w * rs * gg.w;
      ((float4*)row)[i * 64 + lane] = o;
    }
  }
}

DI void phase_copy_x(const Params& p) {
  const size_t n4 = (size_t)NLAT * DM / 4;
  for (size_t i = (size_t)blockIdx.x * 256 + get_tid(); i < n4; i += (size_t)gridDim.x * 256)
    ((float4*)p.out)[i] = ((const float4*)p.x)[i];
}

#define XB_TMO      128
#define XB_XCNT(j)  (256  + 64 * (j))
#define XB_XSUB(j)  (1280 + 64 * (j))
#define XB_XGEN(j)  (2304 + 64 * (j))
#define XB_TOP      3328
#define XB_TOPGEN   3392
#define XCD_BAR_WORDS 3456
#define XB_SPIN_CAP (1u << 22)
#define LAS __attribute__((address_space(3)))

__device__ __forceinline__ unsigned xb_ld(unsigned* p)              { return __hip_atomic_load(p, __ATOMIC_RELAXED, __HIP_MEMORY_SCOPE_AGENT); }
__device__ __forceinline__ unsigned xb_add(unsigned* p, unsigned v) { return __hip_atomic_fetch_add(p, v, __ATOMIC_RELAXED, __HIP_MEMORY_SCOPE_AGENT); }
__device__ __forceinline__ unsigned xb_xcc_id() { return (unsigned)__builtin_amdgcn_s_getreg((3 << 11) | 20) & 0xFu; }
#define XB_SPIN(cond, bar) do { unsigned _sp = 0; while (cond) { __builtin_amdgcn_s_sleep(1); \
    if ((++_sp & 255u) == 0u) { if (xb_ld(&(bar)[XB_TMO])) break; if (_sp > XB_SPIN_CAP) { atomicAdd(&(bar)[XB_TMO], 1u); break; } } } } while (0)

struct XcdBarrier {
    unsigned* bar; unsigned x;
    volatile LAS unsigned* st;
};

__device__ __forceinline__ XcdBarrier xcd_barrier_post(unsigned* bar, volatile LAS unsigned* st) {
    XcdBarrier b; b.bar = bar; b.x = xb_xcc_id(); b.st = st;
    if (threadIdx.x == 0) (void)xb_add(&bar[XB_XCNT(b.x)], 1u);
    return b;
}
__device__ __forceinline__ void xcd_barrier_complete(unsigned* bar, unsigned x, unsigned& nloc, unsigned& nx) {
    const unsigned G = gridDim.x * gridDim.y * gridDim.z;
    unsigned sum, cnt, mine, sp = 0u;
    for (;;) {
        sum = 0u; cnt = 0u; mine = 0u;
#pragma unroll
        for (unsigned j = 0; j < 16; ++j) { const unsigned c = xb_ld(&bar[XB_XCNT(j)]); sum += c; cnt += (c > 0u) ? 1u : 0u; mine = (j == x) ? c : mine; }
        if (sum == G) break;
        __builtin_amdgcn_s_sleep(1);
        if ((++sp & 255u) == 0u) { if (xb_ld(&bar[XB_TMO])) break; if (sp > XB_SPIN_CAP) { atomicAdd(&bar[XB_TMO], 1u); break; } }
    }
    nloc = mine > 0u ? mine : 1u; nx = cnt > 0u ? cnt : 1u;
}

__device__ __forceinline__ void xcd_barrier(const XcdBarrier& b) {
    asm volatile("s_waitcnt vmcnt(0)" ::: "memory");
    __syncthreads();
    if (threadIdx.x == 0) {
        unsigned* bar = b.bar;
        __builtin_amdgcn_s_waitcnt(0);
        unsigned nloc = b.st[0], nx = b.st[1];
        if (nloc == 0u) { xcd_barrier_complete(bar, b.x, nloc, nx); b.st[0] = nloc; b.st[1] = nx; }
        const unsigned old = xb_add(&bar[XB_XSUB(b.x)], 1u);
        const unsigned gen = old / nloc;
        if (old + 1u == (gen + 1u) * nloc) {
            __builtin_amdgcn_fence(__ATOMIC_RELEASE, "agent");
            asm volatile("s_waitcnt vmcnt(0)" ::: "memory");
            const unsigned og = xb_add(&bar[XB_TOP], 1u);
            const unsigned tg = og / nx;
            if (og + 1u == (tg + 1u) * nx) xb_add(&bar[XB_TOPGEN], 1u);
            else XB_SPIN(xb_ld(&bar[XB_TOPGEN]) == tg, bar);
            __builtin_amdgcn_fence(__ATOMIC_ACQUIRE, "agent");
            xb_add(&bar[XB_XGEN(b.x)], 1u);
            asm volatile("s_waitcnt vmcnt(0)" ::: "memory");
        } else {
            XB_SPIN(xb_ld(&bar[XB_XGEN(b.x)]) == gen, bar);
            __builtin_amdgcn_fence(__ATOMIC_ACQUIRE, "agent");
            asm volatile("s_waitcnt vmcnt(0)" ::: "memory");
        }
    }
    __syncthreads();
}
__device__ __forceinline__ void xcd_barrier_fast(const XcdBarrier& b) {
    asm volatile("s_waitcnt vmcnt(0)" ::: "memory");
    __syncthreads();
    if (threadIdx.x == 0) {
        unsigned* bar = b.bar;
        __builtin_amdgcn_s_waitcnt(0);
        unsigned nloc = b.st[0], nx = b.st[1];
        const unsigned old = xb_add(&bar[XB_XSUB(b.x)], 1u);
        const unsigned gen = old / nloc;
        if (old + 1u == (gen + 1u) * nloc) {
            __builtin_amdgcn_fence(__ATOMIC_RELEASE, "agent");
            asm volatile("s_waitcnt vmcnt(0)" ::: "memory");
            const unsigned og = xb_add(&bar[XB_TOP], 1u);
            const unsigned tg = og / nx;
            if (og + 1u == (tg + 1u) * nx) xb_add(&bar[XB_TOPGEN], 1u);
            else XB_SPIN(xb_ld(&bar[XB_TOPGEN]) == tg, bar);
            __builtin_amdgcn_fence(__ATOMIC_ACQUIRE, "agent");
            xb_add(&bar[XB_XGEN(b.x)], 1u);
            asm volatile("s_waitcnt vmcnt(0)" ::: "memory");
        } else {
            XB_SPIN(xb_ld(&bar[XB_XGEN(b.x)]) == gen, bar);
            __builtin_amdgcn_fence(__ATOMIC_ACQUIRE, "agent");
            asm volatile("s_waitcnt vmcnt(0)" ::: "memory");
        }
    }
    __syncthreads();
}


DI void gsync(cg::grid_group& grid) {
  asm volatile("s_waitcnt vmcnt(0) lgkmcnt(0)" ::: "memory");
  __syncthreads();
  if (threadIdx.x == 0) {
    __builtin_amdgcn_fence(__ATOMIC_RELEASE, "agent");
    asm volatile("s_waitcnt vmcnt(0)" ::: "memory");
  }
  grid.sync();
  if (threadIdx.x == 0) {
    __builtin_amdgcn_fence(__ATOMIC_ACQUIRE, "agent");
    asm volatile("s_waitcnt vmcnt(0)" ::: "memory");
  }
  __syncthreads();
}

DI Params load_params() {
  Params r{};
#if defined(__HIP_DEVICE_COMPILE__)
  const __attribute__((address_space(4))) unsigned long long* q =
      (const __attribute__((address_space(4))) unsigned long long*)__builtin_amdgcn_kernarg_segment_ptr();
  asm volatile("" : "+s"(q));
  unsigned long long* d = (unsigned long long*)&r;
  static_assert(sizeof(Params) % 8 == 0, "Params size");
#pragma unroll
  for (int i = 0; i < (int)(sizeof(Params) / 8); ++i) d[i] = q[i];
#endif
  return r;
}
#define P_ p
__global__ void __launch_bounds__(256, 2) fwd_megakernel(Params p) {
  cg::grid_group grid = cg::this_grid();
  __shared__ __attribute__((aligned(16))) char smem[SMEM_BYTES];
  __shared__ uint4 xb_words;
  if (threadIdx.x == 0) xb_words = make_uint4(0u, 0u, 0u, 0u);
  __syncthreads();
  XcdBarrier xb;
  { const Params lp = P_; xb = xcd_barrier_post((unsigned*)(lp.ws + OFF_BAR), (volatile LAS unsigned*)&xb_words); }
  { const Params lp = P_; phase_prep(lp, smem); }
  xcd_barrier(xb);
  { const Params lp = P_; phase_norm(lp, 0, true, lp.norm1_g, 0, NTOK); }
  xcd_barrier_fast(xb);
  { const Params lp = P_; phase_inproj0(lp, smem); }
  xcd_barrier_fast(xb);
  { const Params lp = P_; phase_gqa_prep(lp, smem); }
  xcd_barrier_fast(xb);
  { const Params lp = P_; phase_mix0(lp, smem, 0); }
  xcd_barrier_fast(xb);
  { const Params lp = P_; phase_hg_readout(lp); }
  xcd_barrier_fast(xb);
  { const Params lp = P_; phase_outproj(lp, 0, OFF_WT_EVOUT, NTOK, true, smem); }
  xcd_barrier_fast(xb);
#if STAGE_LIMIT >= 2
  { const Params lp = P_; phase_norm(lp, 0, false, lp.norm2_g, 3, NTOK); }
  { const Params lp = P_; phase_convert_tables(lp, 0); }
  xcd_barrier_fast(xb);
  { const Params lp = P_; phase_peer_route(lp, 0, NTOK, smem); }
  xcd_barrier_fast(xb);
  { const Params lp = P_; phase_peer_gather(lp, 0, NTOK, false); }
  xcd_barrier_fast(xb);
#endif
#if STAGE_LIMIT >= 3
  { const Params lp = P_; phase_inproj1(lp, smem); }
  xcd_barrier_fast(xb);
  { const Params lp = P_; phase_mla_prep(lp); }
  xcd_barrier_fast(xb);
  { const Params lp = P_; phase_mla_up(lp, smem); }
  xcd_barrier_fast(xb);
  { const Params lp = P_; phase_mix1(lp, smem, 1); }
  xcd_barrier_fast(xb);
  { const Params lp = P_; phase_s5_z(lp); }
  xcd_barrier_fast(xb);
  { const Params lp = P_; phase_glu(lp, smem); }
  xcd_barrier_fast(xb);
  { const Params lp = P_; phase_outproj1(lp, smem); }
  xcd_barrier_fast(xb);
#endif
#if STAGE_LIMIT >= 4
  { const Params lp = P_; phase_norm(lp, 1, false, lp.norm2_g + 1024, 3, NLAT); }
  { const Params lp = P_; phase_convert_tables(lp, 1); }
  xcd_barrier_fast(xb);
  { const Params lp = P_; phase_peer_route(lp, 1, NLAT, smem); }
  xcd_barrier_fast(xb);
  { const Params lp = P_; phase_peer_gather(lp, 1, NLAT, false); }
#endif
}

extern "C" void kernel_launch(void* const* d_in, const int* in_sizes, int n_in, void* d_out, int out_size, void* d_ws,
                              size_t ws_size, hipStream_t stream) {
  static int grid_blocks = 0;
  if (!grid_blocks) {
    int dev = 0, cus = 0, per_cu = 0;
    (void)hipGetDevice(&dev);
    (void)hipDeviceGetAttribute(&cus, hipDeviceAttributeMultiprocessorCount, dev);
    (void)hipOccupancyMaxActiveBlocksPerMultiprocessor(&per_cu, fwd_megakernel, 256, 0);
    if (per_cu > 2) per_cu = 2;
    if (per_cu < 1) per_cu = 1;
    grid_blocks = cus * per_cu;
  }
  Params p{};
  const float** pp = (const float**)&p;
  for (int i = 0; i < 35; ++i) pp[i] = (const float*)d_in[i];
  p.out = (float*)d_out;
  p.ws = (char*)d_ws;
  p.rep_mix = REP_MIX; p.rep_route = REP_ROUTE; p.rep_gdry = REP_GDRY; p.rep_gemm = REP_GEMM;
  (void)hipMemsetAsync((char*)d_ws + OFF_CNT, 0, 256 + 16384, stream);
  void* args[] = {&p};
  hipError_t e = hipLaunchCooperativeKernel((void*)fwd_megakernel, dim3(grid_blocks), dim3(256), args, 0, stream);
  if (e != hipSuccess) fprintf(stderr, "cooperative launch failed: %s (grid %d)\n", hipGetErrorString(e), grid_blocks);
}
```

```cpp
#include <hip/hip_runtime.h>
#include <hip/hip_cooperative_groups.h>
#include <cstdio>
namespace cg = cooperative_groups;

#ifndef STAGE_LIMIT
#define STAGE_LIMIT 99
#endif
#define REP_MIX 1
#define REP_ROUTE 1
#define REP_GDRY 0
#define REP_GEMM 1

typedef unsigned short bf16;
typedef __attribute__((ext_vector_type(8))) short bf16x8;
typedef __attribute__((ext_vector_type(4))) short bf16x4;
typedef __attribute__((ext_vector_type(16))) float f32x16;
typedef float f32x2_t __attribute__((ext_vector_type(2)));
typedef unsigned u32x4 __attribute__((ext_vector_type(4)));
typedef unsigned u32x2 __attribute__((ext_vector_type(2)));
typedef __bf16 bf16x2_t __attribute__((ext_vector_type(2)));

#define DI __device__ __forceinline__
#define MFMA32(a, b, c) __builtin_amdgcn_mfma_f32_32x32x16_bf16((a), (b), (c), 0, 0, 0)

constexpr int NLAT = 32768, NCTX = 1024, NTOK = 33792, DM = 1024;
constexpr int SEQ = 8192, CTXL = 256, SKEYS = 8448;
constexpr float EPSN = 1e-6f;

constexpr size_t al256(size_t x) { return (x + 255) & ~(size_t)255; }
constexpr size_t OFF_WT_EVIN = 0;
constexpr size_t OFF_WT_EVOUT = OFF_WT_EVIN + al256((size_t)3328 * 1024 * 2);
constexpr size_t OFF_WT_ODIN = OFF_WT_EVOUT + al256((size_t)1024 * 1024 * 2);
constexpr size_t OFF_WT_ODOUT = OFF_WT_ODIN + al256((size_t)1280 * 1024 * 2);
constexpr size_t OFF_WT_QUP = OFF_WT_ODOUT + al256((size_t)1024 * 1024 * 2);
constexpr size_t OFF_WT_KVUP = OFF_WT_QUP + al256((size_t)768 * 384 * 2);
constexpr size_t OFF_WT_GLU = OFF_WT_KVUP + al256((size_t)1024 * 256 * 2);
constexpr size_t OFF_WT_PWQ = OFF_WT_GLU + al256((size_t)512 * 512 * 2);
constexpr size_t OFF_PKEYS = OFF_WT_PWQ + al256((size_t)2 * 2048 * 1024 * 2);
constexpr size_t OFF_MOD = OFF_PKEYS + al256((size_t)2 * 8 * 2 * 128 * 128 * 2);
constexpr size_t OFF_S5T = OFF_MOD + al256((size_t)2 * 5 * 6144 * 4);
constexpr size_t OFF_S5WE = OFF_S5T + al256((size_t)64 * 256 * 256 * 2);
constexpr size_t OFF_S5WY = OFF_S5WE + al256((size_t)64 * 128 * 256 * 2);
constexpr size_t OFF_S5A16 = OFF_S5WY + al256((size_t)64 * 256 * 128 * 2);
constexpr size_t OFF_CNT = OFF_S5A16 + al256((size_t)64 * 64 * 2 * 4);
constexpr size_t OFF_BAR = OFF_CNT + 256;
constexpr size_t OFF_ROPE1 = OFF_BAR + 16384;
constexpr size_t OFF_SU = OFF_ROPE1 + al256((size_t)8192 * 16 * 8);
constexpr size_t OFF_SV = OFF_SU + 65536;
constexpr size_t OFF_KMAX = OFF_SV + 65536;
constexpr size_t OFF_KRSQ = OFF_KMAX + 256;
constexpr size_t OFF_XC = OFF_KRSQ + al256((size_t)NTOK * 4);
constexpr size_t OFF_UTAB = OFF_XC + al256((size_t)NCTX * DM * 4);
constexpr size_t OFF_VTAB = OFF_UTAB + al256((size_t)16384 * 1024 * 2);
constexpr size_t OFF_ACTA = OFF_VTAB + al256((size_t)16384 * 1024 * 2);
constexpr size_t OFF_BIG = OFF_ACTA + al256((size_t)NTOK * DM * 2);
constexpr size_t OFF_PAGQA = OFF_BIG;
constexpr size_t OFF_VT0 = OFF_PAGQA + al256((size_t)NTOK * 768 * 2);
constexpr size_t OFF_PAHG = OFF_VT0 + al256((size_t)512 * SKEYS * 2);
constexpr size_t OFF_OHG = OFF_PAHG + al256((size_t)NTOK * 2560 * 2);
constexpr size_t OFF_END0 = OFF_OHG + al256((size_t)2 * NTOK * 512 * 2);
constexpr size_t OFF_K1 = OFF_BIG;
constexpr size_t OFF_PA1M = OFF_K1 + al256((size_t)NTOK * 768 * 2);
constexpr size_t OFF_Q1 = OFF_PA1M;
constexpr size_t OFF_U1 = OFF_PA1M + al256((size_t)NTOK * 768 * 2);
constexpr size_t OFF_QN = OFF_U1 + al256((size_t)NTOK * 512 * 2);
constexpr size_t OFF_KVN = OFF_QN + al256((size_t)NLAT * 384 * 2);
constexpr size_t OFF_Z1 = OFF_QN;
constexpr size_t OFF_KROPE = OFF_KVN + al256((size_t)NTOK * 256 * 2);
constexpr size_t OFF_VT1 = OFF_KROPE + al256((size_t)NTOK * 32 * 2);
constexpr size_t OFF_YS5 = OFF_VT1 + al256((size_t)2048 * SKEYS * 2);
constexpr size_t OFF_END1 = OFF_YS5 + al256((size_t)2 * NLAT * 512 * 2);
constexpr size_t OFF_RIDX = OFF_BIG;
constexpr size_t OFF_RGW = OFF_RIDX + al256((size_t)NTOK * 128 * 4);
constexpr size_t WS_NEEDED = (OFF_END0 > OFF_END1 ? OFF_END0 : OFF_END1);
static_assert(OFF_RGW + (size_t)NTOK * 128 * 4 <= OFF_VT0, "route alias overflow");
static_assert((size_t)NLAT * 512 * 2 <= (OFF_KROPE - OFF_QN), "z alias overflow");
static_assert(WS_NEEDED < (size_t)500 * 1024 * 1024, "workspace too large");

constexpr int SMEM_BYTES = 78 * 1024;

struct Params {
  const float *x, *c, *ctx, *c_ctx, *ada_w, *ada_b, *norm1_g, *norm2_g, *ev_w_in, *ev_w_out, *gqa_qn_g, *gqa_kn_g,
      *hg_lb_logits, *hg_onorm_g, *od_w_in, *od_w_out, *mla_qa_g, *mla_w_qup, *mla_kva_g, *mla_w_kvup, *s5_a_re, *s5_a_im,
      *s5_log_dt, *s5_b_re, *s5_b_im, *s5_c_re, *s5_c_im, *s5_d, *s5_w_glu, *s5_b_glu, *peer_wq, *peer_keys, *peer_u,
      *peer_v, *final_g;
  float* out;
  char* ws;
  int rep_mix, rep_route, rep_gdry, rep_gemm;
};

DI int get_tid() { int t = threadIdx.x; asm volatile("" : "+v"(t)); return t; }
DI bf16 f2bf(float x) {
  unsigned u = __float_as_uint(x);
  u += 0x7fffu + ((u >> 16) & 1u);
  return (bf16)(u >> 16);
}
DI float bf2f(bf16 h) { return __uint_as_float(((unsigned)h) << 16); }
DI unsigned cvtpk(float lo, float hi) {
  f32x2_t v = {lo, hi};
  bf16x2_t b = __builtin_convertvector(v, bf16x2_t);
  return __builtin_bit_cast(unsigned, b);
}
DI float bflo(unsigned u) { return __uint_as_float(u << 16); }
DI float bfhi(unsigned u) { return __uint_as_float(u & 0xffff0000u); }
DI float wave_sum(float v) {
#pragma unroll
  for (int o = 32; o > 0; o >>= 1) v += __shfl_xor(v, o);
  return v;
}
DI float wave_max_early(float v) {
#pragma unroll
  for (int o = 32; o > 0; o >>= 1) v = fmaxf(v, __shfl_xor(v, o));
  return v;
}
DI float sigmoidf_(float x) { return 1.0f / (1.0f + __expf(-x)); }
DI float siluf_(float x) { return x * sigmoidf_(x); }
DI float geluf_(float x) { return 0.5f * x * (1.0f + erff(x * 0.70710678118654752f)); }
DI float gelu_as(float x) {
  const float z = x * 0.70710678118654752f, az = fabsf(z);
  const float t = __builtin_amdgcn_rcpf(fmaf(0.3275911f, az, 1.0f));
  const float poly = t * fmaf(t, fmaf(t, fmaf(t, fmaf(t, 1.061405429f, -1.453152027f), 1.421413741f), -0.284496736f), 0.254829592f);
  const float e = __builtin_amdgcn_exp2f(az * az * -1.4426950408889634f);
  const float er = copysignf(fmaf(-poly, e, 1.0f), z);
  const float hx = 0.5f * x;
  return fmaf(hx, er, hx);
}

DI const float* orig_row(const Params& p, int r) {
  return r < NLAT ? p.x + (size_t)r * DM : p.ctx + (size_t)(r - NLAT) * DM;
}
DI float* res_row(const Params& p, int r) {
  return r < NLAT ? p.out + (size_t)r * DM : (float*)(p.ws + OFF_XC) + (size_t)(r - NLAT) * DM;
}
DI int mod_row(int r) { return r < NLAT ? (r >> 13) : 4; }
DI const float* mod_ptr(const Params& p, int layer, int r, int chunk) {
  return (const float*)(p.ws + OFF_MOD) + ((size_t)(layer * 5 + mod_row(r)) * 6 + chunk) * 1024;
}

constexpr int GLS = 72;
DI void gemm_128x128(const bf16* __restrict__ A, int lda, const bf16* __restrict__ Bt, int ldb, int K, f32x16 (&acc)[2][2],
                     bf16* As, bf16* Bs) {
  const int tid = get_tid(), lane = tid & 63, w = tid >> 6;
  const int wm = w >> 1, wn = w & 1;
  const int lr = tid >> 3, lc = (tid & 7) * 8;
  u32x4 ra[4], rb[4];
#pragma unroll
  for (int i = 0; i < 4; ++i) {
    ra[i] = *(const u32x4*)(A + (size_t)(i * 32 + lr) * lda + lc);
    rb[i] = *(const u32x4*)(Bt + (size_t)(i * 32 + lr) * ldb + lc);
  }
#pragma unroll
  for (int i = 0; i < 2; ++i)
#pragma unroll
    for (int j = 0; j < 2; ++j)
#pragma unroll
      for (int r = 0; r < 16; ++r) acc[i][j][r] = 0.f;
  for (int k0 = 0; k0 < K; k0 += 64) {
    __syncthreads();
#pragma unroll
    for (int i = 0; i < 4; ++i) {
      *(u32x4*)(As + (i * 32 + lr) * GLS + lc) = ra[i];
      *(u32x4*)(Bs + (i * 32 + lr) * GLS + lc) = rb[i];
    }
    __syncthreads();
    if (k0 + 64 < K) {
#pragma unroll
      for (int i = 0; i < 4; ++i) {
        ra[i] = *(const u32x4*)(A + (size_t)(i * 32 + lr) * lda + k0 + 64 + lc);
        rb[i] = *(const u32x4*)(Bt + (size_t)(i * 32 + lr) * ldb + k0 + 64 + lc);
      }
    }
#pragma unroll
    for (int ks = 0; ks < 64; ks += 16) {
      const int ko = ks + (lane >> 5) * 8;
      bf16x8 a0 = *(const bf16x8*)(As + (wm * 64 + (lane & 31)) * GLS + ko);
      bf16x8 a1 = *(const bf16x8*)(As + (wm * 64 + 32 + (lane & 31)) * GLS + ko);
      bf16x8 b0 = *(const bf16x8*)(Bs + (wn * 64 + (lane & 31)) * GLS + ko);
      bf16x8 b1 = *(const bf16x8*)(Bs + (wn * 64 + 32 + (lane & 31)) * GLS + ko);
      acc[0][0] = MFMA32(a0, b0, acc[0][0]);
      acc[0][1] = MFMA32(a0, b1, acc[0][1]);
      acc[1][0] = MFMA32(a1, b0, acc[1][0]);
      acc[1][1] = MFMA32(a1, b1, acc[1][1]);
    }
  }
}
template <class F>
DI void gemm_epi(f32x16 (&acc)[2][2], F f) {
  const int lane = get_tid() & 63, w = get_tid() >> 6;
  const int wm = w >> 1, wn = w & 1;
#pragma unroll
  for (int mi = 0; mi < 2; ++mi)
#pragma unroll
    for (int ni = 0; ni < 2; ++ni)
#pragma unroll
      for (int r = 0; r < 16; ++r) {
        int row = wm * 64 + mi * 32 + (r & 3) + 8 * (r >> 2) + 4 * (lane >> 5);
        int col = wn * 64 + ni * 32 + (lane & 31);
        f(row, col, acc[mi][ni][r]);
      }
}

DI void gemm_256x128(const bf16* __restrict__ A, int lda, const bf16* __restrict__ Bt, int ldb, int K, f32x16 (&acc)[4][2],
                     bf16* As, bf16* Bs) {
  const int tid = get_tid(), lane = tid & 63, w = tid >> 6;
  const int wm = w >> 1, wn = w & 1;
  const int lr = tid >> 3, lc = (tid & 7) * 8;
  u32x4 ra[8], rb[4];
#pragma unroll
  for (int i = 0; i < 8; ++i) ra[i] = *(const u32x4*)(A + (size_t)(i * 32 + lr) * lda + lc);
#pragma unroll
  for (int i = 0; i < 4; ++i) rb[i] = *(const u32x4*)(Bt + (size_t)(i * 32 + lr) * ldb + lc);
#pragma unroll
  for (int i = 0; i < 4; ++i)
#pragma unroll
    for (int j = 0; j < 2; ++j)
#pragma unroll
      for (int r = 0; r < 16; ++r) acc[i][j][r] = 0.f;
  for (int k0 = 0; k0 < K; k0 += 64) {
    __syncthreads();
#pragma unroll
    for (int i = 0; i < 8; ++i) *(u32x4*)(As + (i * 32 + lr) * GLS + lc) = ra[i];
#pragma unroll
    for (int i = 0; i < 4; ++i) *(u32x4*)(Bs + (i * 32 + lr) * GLS + lc) = rb[i];
    __syncthreads();
    if (k0 + 64 < K) {
#pragma unroll
      for (int i = 0; i < 8; ++i) ra[i] = *(const u32x4*)(A + (size_t)(i * 32 + lr) * lda + k0 + 64 + lc);
#pragma unroll
      for (int i = 0; i < 4; ++i) rb[i] = *(const u32x4*)(Bt + (size_t)(i * 32 + lr) * ldb + k0 + 64 + lc);
    }
#pragma unroll
    for (int ks = 0; ks < 64; ks += 16) {
      const int ko = ks + (lane >> 5) * 8;
      bf16x8 b0 = *(const bf16x8*)(Bs + (wn * 64 + (lane & 31)) * GLS + ko);
      bf16x8 b1 = *(const bf16x8*)(Bs + (wn * 64 + 32 + (lane & 31)) * GLS + ko);
#pragma unroll
      for (int mi = 0; mi < 4; ++mi) {
        bf16x8 a = *(const bf16x8*)(As + (wm * 128 + mi * 32 + (lane & 31)) * GLS + ko);
        acc[mi][0] = MFMA32(a, b0, acc[mi][0]);
        acc[mi][1] = MFMA32(a, b1, acc[mi][1]);
      }
    }
  }
}
template <class F>
DI void gemm_epi2(f32x16 (&acc)[4][2], F f) {
  const int lane = get_tid() & 63, w = get_tid() >> 6;
  const int wm = w >> 1, wn = w & 1;
#pragma unroll
  for (int mi = 0; mi < 4; ++mi)
#pragma unroll
    for (int ni = 0; ni < 2; ++ni)
#pragma unroll
      for (int r = 0; r < 16; ++r) {
        int row = wm * 128 + mi * 32 + (r & 3) + 8 * (r >> 2) + 4 * (lane >> 5);
        int col = wn * 64 + ni * 32 + (lane & 31);
        f(row, col, acc[mi][ni][r]);
      }
}

DI void mma_tile(f32x16& acc, const bf16* A, int lda, const bf16* Bt, int ldb, int K) {
  const int lane = get_tid() & 63;
  const bf16* ap = A + (size_t)(lane & 31) * lda + (lane >> 5) * 8;
  const bf16* bp = Bt + (size_t)(lane & 31) * ldb + (lane >> 5) * 8;
#pragma unroll 4
  for (int ks = 0; ks < K; ks += 16) {
    bf16x8 a = *(const bf16x8*)(ap + ks);
    bf16x8 b = *(const bf16x8*)(bp + ks);
    acc = MFMA32(a, b, acc);
  }
}
template <int K>
DI void mma_tile_ga(f32x16& acc, const bf16* __restrict__ A, int lda, const bf16* Bt, int ldb) {
  const int lane = get_tid() & 63;
  const bf16* ap = A + (size_t)(lane & 31) * lda + (lane >> 5) * 8;
  const bf16* bp = Bt + (size_t)(lane & 31) * ldb + (lane >> 5) * 8;
  bf16x8 af[K / 16];
#pragma unroll
  for (int i = 0; i < K / 16; ++i) af[i] = *(const bf16x8*)(ap + i * 16);
#pragma unroll
  for (int i = 0; i < K / 16; ++i) {
    bf16x8 b = *(const bf16x8*)(bp + i * 16);
    acc = MFMA32(af[i], b, acc);
  }
}
DI int crow(int r, int lane) { return (r & 3) + 8 * (r >> 2) + 4 * (lane >> 5); }

DI void prep_transpose(const float* __restrict__ W, int K, int N, int Npad, bf16* __restrict__ Wt, int tile, float* tl) {
  const int ntn = Npad / 64;
  const int kt = tile / ntn, nt = tile % ntn;
  const int k0 = kt * 64, n0 = nt * 64;
  const int tid = get_tid();
  __syncthreads();
  for (int i = 0; i < 16; ++i) {
    int r = i * 4 + (tid >> 6), cidx = tid & 63;
    int n = n0 + cidx;
    float v = (n < N) ? W[(size_t)(k0 + r) * N + n] : 0.f;
    tl[cidx * 65 + r] = v;
  }
  __syncthreads();
  for (int i = 0; i < 16; ++i) {
    int n = i * 4 + (tid >> 6), k = tid & 63;
    Wt[(size_t)(n0 + n) * K + k0 + k] = f2bf(tl[n * 65 + k]);
  }
}

DI void convert_bf16(const float* __restrict__ src, bf16* __restrict__ dst, size_t n, int bid, int nb) {
  size_t nv = n / 8;
  for (size_t i = (size_t)bid * 256 + get_tid(); i < nv; i += (size_t)nb * 256) {
    float4 a = ((const float4*)src)[2 * i], b = ((const float4*)src)[2 * i + 1];
    u32x4 o;
    o.x = cvtpk(a.x, a.y); o.y = cvtpk(a.z, a.w); o.z = cvtpk(b.x, b.y); o.w = cvtpk(b.z, b.w);
    ((u32x4*)dst)[i] = o;
  }
}

DI void prep_mod(const Params& p, int item, float* sm) {
  const int l = item / 96, n0 = (item % 96) * 64;
  const int tid = get_tid(), lane = tid & 63, w = tid >> 6;
  const float* W = p.ada_w + (size_t)l * 1024 * 6144 + n0 + lane;
  float* sc = sm;
  float* red = sm + 5 * 1024;
  __syncthreads();
  for (int i = tid; i < 5 * 1024; i += 256) {
    const int r = i >> 10, k = i & 1023;
    sc[i] = siluf_(r < 4 ? p.c[r * 1024 + k] : p.c_ctx[k]);
  }
  __syncthreads();
  float acc[5] = {0.f, 0.f, 0.f, 0.f, 0.f};
#pragma unroll 1
  for (int k0 = w * 256; k0 < w * 256 + 256; k0 += 16) {
    float wv[16];
#pragma unroll
    for (int j = 0; j < 16; ++j) wv[j] = W[(size_t)(k0 + j) * 6144];
#pragma unroll
    for (int j = 0; j < 16; ++j) {
#pragma unroll
      for (int r = 0; r < 5; ++r) acc[r] += sc[r * 1024 + k0 + j] * wv[j];
    }
  }
#pragma unroll
  for (int r = 0; r < 5; ++r) red[(w * 5 + r) * 64 + lane] = acc[r];
  __syncthreads();
  if (w == 0) {
    float* M = (float*)(p.ws + OFF_MOD);
#pragma unroll
    for (int r = 0; r < 5; ++r) {
      float s2 = red[(0 * 5 + r) * 64 + lane] + red[(1 * 5 + r) * 64 + lane] + red[(2 * 5 + r) * 64 + lane] + red[(3 * 5 + r) * 64 + lane];
      M[(size_t)(l * 5 + r) * 6144 + n0 + lane] = s2 + p.ada_b[l * 6144 + n0 + lane];
    }
  }
}

DI void prep_s5(const Params& p, int item4, float* sm) {
  const int item = item4 >> 2, qtr = item4 & 3;
  const int g = item >> 1, d = item & 1;
  const int tid = get_tid();
  float* pw = sm;
  float* bb = sm + 17 * 128;
  float* kc = bb + 64 * 32;
  __syncthreads();
  const float dt = __expf(p.s5_log_dt[d * 32 + g]);
  if (tid < 64) {
    const int pp = tid;
    const float are = p.s5_a_re[(d * 32 + g) * 64 + pp], aim = p.s5_a_im[(d * 32 + g) * 64 + pp];
    for (int n = 0; n <= 16; ++n) {
      float mag = expf(are * dt * n);
      float sn, cs;
      sincosf(aim * dt * n, &sn, &cs);
      pw[(n * 64 + pp) * 2 + 0] = mag * cs;
      pw[(n * 64 + pp) * 2 + 1] = mag * sn;
    }
    float abr = pw[(64 + pp) * 2 + 0] - 1.0f, abi = pw[(64 + pp) * 2 + 1];
    float den = are * are + aim * aim;
    float qr = (abr * are + abi * aim) / den, qi = (abi * are - abr * aim) / den;
    for (int c2 = 0; c2 < 16; ++c2) {
      float br = p.s5_b_re[((size_t)(d * 32 + g) * 64 + pp) * 16 + c2], bi = p.s5_b_im[((size_t)(d * 32 + g) * 64 + pp) * 16 + c2];
      bb[(pp * 16 + c2) * 2 + 0] = qr * br - qi * bi;
      bb[(pp * 16 + c2) * 2 + 1] = qr * bi + qi * br;
    }
    float* A16 = (float*)(p.ws + OFF_S5A16) + (size_t)item * 128;
    A16[pp * 2 + 0] = pw[(16 * 64 + pp) * 2 + 0];
    A16[pp * 2 + 1] = pw[(16 * 64 + pp) * 2 + 1];
  }
  float* cre = kc + 4096;
  float* cim = cre + 1024;
  for (int e = tid; e < 1024; e += 256) {
    cre[e] = p.s5_c_re[(size_t)(d * 32 + g) * 1024 + e];
    cim[e] = p.s5_c_im[(size_t)(d * 32 + g) * 1024 + e];
  }
  __syncthreads();
  for (int e = tid; e < (4 * qtr + 4) * 256; e += 256) {
    int tau = e >> 8, c = (e >> 4) & 15, c2 = e & 15;
    float s = 0.f;
    for (int pp = 0; pp < 64; ++pp) {
      float cr = cre[c * 64 + pp], ci = cim[c * 64 + pp];
      float wr = pw[(tau * 64 + pp) * 2], wi = pw[(tau * 64 + pp) * 2 + 1];
      float zr = cr * wr - ci * wi, zi = cr * wi + ci * wr;
      float br = bb[(pp * 16 + c2) * 2], bi = bb[(pp * 16 + c2) * 2 + 1];
      s += zr * br - zi * bi;
    }
    kc[e] = s;
  }
  __syncthreads();
  bf16* T = (bf16*)(p.ws + OFF_S5T) + (size_t)item * 65536;
  for (int e = qtr * 16384 + tid; e < (qtr + 1) * 16384; e += 256) {
    int m = e >> 8, k = e & 255;
    int i = m >> 4, c = m & 15, j = k >> 4, c2 = k & 15;
    float v = (i >= j) ? kc[((i - j) * 16 + c) * 16 + c2] : 0.f;
    T[e] = f2bf(v);
  }
  bf16* WE = (bf16*)(p.ws + OFF_S5WE) + (size_t)item * 32768;
  for (int e = qtr * 8192 + tid; e < (qtr + 1) * 8192; e += 256) {
    int pr = e >> 8, k = e & 255;
    int pp = pr & 63, im = pr >> 6, j = k >> 4, c2 = k & 15;
    float wr = pw[((15 - j) * 64 + pp) * 2], wi = pw[((15 - j) * 64 + pp) * 2 + 1];
    float br = bb[(pp * 16 + c2) * 2], bi = bb[(pp * 16 + c2) * 2 + 1];
    float v = im ? (wr * bi + wi * br) : (wr * br - wi * bi);
    WE[e] = f2bf(v);
  }
  bf16* WY = (bf16*)(p.ws + OFF_S5WY) + (size_t)item * 32768;
  for (int e = qtr * 8192 + tid; e < (qtr + 1) * 8192; e += 256) {
    int m = e >> 7, pr = e & 127;
    int i = m >> 4, c = m & 15, pp = pr & 63, im = pr >> 6;
    float cr = cre[c * 64 + pp], ci = cim[c * 64 + pp];
    float wr = pw[((i + 1) * 64 + pp) * 2], wi = pw[((i + 1) * 64 + pp) * 2 + 1];
    float zr = cr * wr - ci * wi, zi = cr * wi + ci * wr;
    WY[e] = f2bf(im ? -zi : zr);
  }
}

DI void phase_prep(const Params& p, char* smem) {
  const int bid = blockIdx.x, nb = gridDim.x;
  float* sm = (float*)smem;
  if (bid == 0 && get_tid() < 64) ((unsigned*)(p.ws + OFF_KMAX))[get_tid()] = 0u;
  {
    float2* tab = (float2*)(p.ws + OFF_ROPE1);
    for (int e = bid * 256 + get_tid(); e < 8192 * 16; e += nb * 256) {
      int t = e >> 4, f = e & 15;
      float pos = (f < 8) ? (float)(t >> 6) : (float)(t & 63);
      float inv = powf(10000.f, -(float)(f & 7) / 8.f);
      float sn, cs;
      sincosf(pos * inv, &sn, &cs);
      tab[e] = make_float2(cs, sn);
    }
  }
  const int n_mod = 192, n_s5 = 256;
  constexpr int T0 = 16 * 52, T1 = 16 * 16, T2 = 16 * 20, T3 = 16 * 16, T4 = 6 * 12, T5 = 4 * 16, T6 = 8 * 8, T7 = 16 * 32, T8 = 16 * 32;
  constexpr int NTR = T0 + T1 + T2 + T3 + T4 + T5 + T6 + T7 + T8;
  const int total = n_mod + n_s5 + NTR;
  for (int it = bid; it < total; it += nb) {
    if (it < n_s5) prep_s5(p, it, sm);
    else if (it < n_mod + n_s5) prep_mod(p, it - n_s5, sm);
    else {
      int t = it - n_mod - n_s5;
      if (t < T0) { prep_transpose(p.ev_w_in, 1024, 3328, 3328, (bf16*)(p.ws + OFF_WT_EVIN), t, sm); continue; }
      t -= T0;
      if (t < T1) { prep_transpose(p.ev_w_out, 1024, 1024, 1024, (bf16*)(p.ws + OFF_WT_EVOUT), t, sm); continue; }
      t -= T1;
      if (t < T2) { prep_transpose(p.od_w_in, 1024, 1184, 1280, (bf16*)(p.ws + OFF_WT_ODIN), t, sm); continue; }
      t -= T2;
      if (t < T3) { prep_transpose(p.od_w_out, 1024, 1024, 1024, (bf16*)(p.ws + OFF_WT_ODOUT), t, sm); continue; }
      t -= T3;
      if (t < T4) { prep_transpose(p.mla_w_qup, 384, 768, 768, (bf16*)(p.ws + OFF_WT_QUP), t, sm); continue; }
      t -= T4;
      if (t < T5) { prep_transpose(p.mla_w_kvup, 256, 1024, 1024, (bf16*)(p.ws + OFF_WT_KVUP), t, sm); continue; }
      t -= T5;
      if (t < T6) { prep_transpose(p.s5_w_glu, 512, 512, 512, (bf16*)(p.ws + OFF_WT_GLU), t, sm); continue; }
      t -= T6;
      if (t < T7) { prep_transpose(p.peer_wq, 1024, 2048, 2048, (bf16*)(p.ws + OFF_WT_PWQ), t, sm); continue; }
      t -= T7;
      prep_transpose(p.peer_wq + (size_t)1024 * 2048, 1024, 2048, 2048, (bf16*)(p.ws + OFF_WT_PWQ) + (size_t)2048 * 1024, t, sm);
    }
  }
  convert_bf16(p.peer_keys, (bf16*)(p.ws + OFF_PKEYS), (size_t)2 * 8 * 2 * 128 * 128, bid, nb);
}

DI void phase_norm(const Params& p, int layer, bool first, const float* g, int shift_chunk, int nrows) {
  const int lane = get_tid() & 63, w = get_tid() >> 6;
  bf16* dst = (bf16*)(p.ws + OFF_ACTA);
  for (int r = blockIdx.x * 4 + w; r < nrows; r += gridDim.x * 4) {
    const float* src = first ? orig_row(p, r) : res_row(p, r);
    float4 v[4];
    float ss = 0.f;
#pragma unroll
    for (int i = 0; i < 4; ++i) {
      v[i] = ((const float4*)src)[i * 64 + lane];
      ss += v[i].x * v[i].x + v[i].y * v[i].y + v[i].z * v[i].z + v[i].w * v[i].w;
    }
    ss = wave_sum(ss);
    const float rs = rsqrtf(ss * (1.0f / 1024.0f) + EPSN);
    const float* sh = mod_ptr(p, layer, r, shift_chunk);
    const float* sc = mod_ptr(p, layer, r, shift_chunk + 1);
#pragma unroll
    for (int i = 0; i < 4; ++i) {
      float4 gg = ((const float4*)g)[i * 64 + lane];
      float4 s4 = ((const float4*)sh)[i * 64 + lane];
      float4 c4 = ((const float4*)sc)[i * 64 + lane];
      float o0 = v[i].x * rs * gg.x * (1.f + c4.x) + s4.x;
      float o1 = v[i].y * rs * gg.y * (1.f + c4.y) + s4.y;
      float o2 = v[i].z * rs * gg.z * (1.f + c4.z) + s4.z;
      float o3 = v[i].w * rs * gg.w * (1.f + c4.w) + s4.w;
      u32x2 o;
      o.x = cvtpk(o0, o1); o.y = cvtpk(o2, o3);
      ((u32x2*)(dst + (size_t)r * DM))[i * 64 + lane] = o;
    }
  }
}

DI void phase_inproj0(const Params& p, char* smem) {
  bf16* As = (bf16*)smem; bf16* Bs = As + 256 * GLS;
  const bf16* A = (const bf16*)(p.ws + OFF_ACTA);
  const bf16* Wt = (const bf16*)(p.ws + OFF_WT_EVIN);
  bf16* pg = (bf16*)(p.ws + OFF_PAGQA);
  bf16* ph = (bf16*)(p.ws + OFF_PAHG);
  const int ntn = 26, ntm = NTOK / 256;
  for (int t = blockIdx.x; t < ntn * ntm; t += gridDim.x) {
    const int mt = t / ntn, nt = t % ntn;
    f32x16 acc[4][2];
    gemm_256x128(A + (size_t)mt * 256 * DM, DM, Wt + (size_t)nt * 128 * DM, DM, DM, acc, As, Bs);
    gemm_epi2(acc, [&](int row, int col, float v) {
      int r = mt * 256 + row, cg_ = nt * 128 + col;
      if (cg_ < 768) pg[(size_t)r * 768 + cg_] = f2bf(v);
      else ph[(size_t)r * 2560 + (cg_ - 768)] = f2bf(v);
    });
  }
}

DI void phase_gqa_prep(const Params& p, char* smem) {
  bf16* pg = (bf16*)(p.ws + OFF_PAGQA);
  bf16* vt = (bf16*)(p.ws + OFF_VT0);
  bf16* tl = (bf16*)smem;
  const int lane = get_tid() & 63, w = get_tid() >> 6, tid = get_tid();
  const float gq = p.gqa_qn_g[lane], gk = p.gqa_kn_g[lane];
  const float inv = __powf(10000.f, -(float)(lane & 15) / 16.f);
  float lbv[16];
#pragma unroll
  for (int e = 0; e < 16; ++e) {
    const int j = lane * 16 + e, d = j >> 9, cc = j & 511;
    const float l0 = p.hg_lb_logits[(d * 2 + 0) * 512 + cc], l1 = p.hg_lb_logits[(d * 2 + 1) * 512 + cc];
    lbv[e] = 1.0f / (1.0f + __expf(l1 - l0));
  }
  bf16* phg = (bf16*)(p.ws + OFF_PAHG);
  for (int r = blockIdx.x * 4 + w; r < NTOK; r += gridDim.x * 4) {
    bf16* row = pg + (size_t)r * 768;
    float sn = 0.f, cs = 1.f;
    if (r < NLAT) {
      int t = r & 8191;
      float pos = (lane < 32) ? (float)(t >> 6) : (float)(t & 63);
      sincosf(pos * inv, &sn, &cs);
    }
#pragma unroll
    for (int hh = 0; hh < 10; ++hh) {
      float v = bf2f(row[hh * 64 + lane]);
      float ss = wave_sum(v * v);
      float y = v * rsqrtf(ss * (1.f / 64.f) + EPSN) * (hh < 8 ? gq : gk);
      float pr = __shfl_xor(y, 16);
      float o = y * cs + ((lane & 16) ? pr * sn : -pr * sn);
      row[hh * 64 + lane] = f2bf(hh < 8 ? o * (0.125f * 1.4426950408889634f) : o);
    }
    {
      bf16* frow = phg + (size_t)r * 2560 + 512 + lane * 16;
      u32x4 a = *(const u32x4*)frow, b2 = *(const u32x4*)(frow + 8);
      float fv[16];
      fv[0] = bflo(a.x); fv[1] = bfhi(a.x); fv[2] = bflo(a.y); fv[3] = bfhi(a.y); fv[4] = bflo(a.z); fv[5] = bfhi(a.z); fv[6] = bflo(a.w); fv[7] = bfhi(a.w);
      fv[8] = bflo(b2.x); fv[9] = bfhi(b2.x); fv[10] = bflo(b2.y); fv[11] = bfhi(b2.y); fv[12] = bflo(b2.z); fv[13] = bfhi(b2.z); fv[14] = bflo(b2.w); fv[15] = bfhi(b2.w);
#pragma unroll
      for (int e = 0; e < 16; ++e) fv[e] = __logf(lbv[e] + (1.f - lbv[e]) * sigmoidf_(fv[e]));
      u32x4 o0, o1;
      o0.x = cvtpk(fv[0], fv[1]); o0.y = cvtpk(fv[2], fv[3]); o0.z = cvtpk(fv[4], fv[5]); o0.w = cvtpk(fv[6], fv[7]);
      o1.x = cvtpk(fv[8], fv[9]); o1.y = cvtpk(fv[10], fv[11]); o1.z = cvtpk(fv[12], fv[13]); o1.w = cvtpk(fv[14], fv[15]);
      *(u32x4*)frow = o0; *(u32x4*)(frow + 8) = o1;
    }
  }
  for (int blk = blockIdx.x; blk < NTOK / 64; blk += gridDim.x) {
    const int r0 = blk * 64;
    __syncthreads();
    {
      const int rr = tid >> 2, c0 = (tid & 3) * 32;
      const bf16* src = pg + (size_t)(r0 + rr) * 768 + 640 + c0;
#pragma unroll
      for (int i = 0; i < 4; ++i) {
        u32x4 v4 = *(const u32x4*)(src + i * 8);
#pragma unroll
        for (int e = 0; e < 4; ++e) {
          tl[(c0 + i * 8 + 2 * e) * GLS + rr] = (bf16)(v4[e] & 0xffffu);
          tl[(c0 + i * 8 + 2 * e + 1) * GLS + rr] = (bf16)(v4[e] >> 16);
        }
      }
    }
    __syncthreads();
    int b, s0;
    if (r0 < NLAT) { b = r0 >> 13; s0 = CTXL + (r0 & 8191); } else { int rc = r0 - NLAT; b = rc >> 8; s0 = rc & 255; }
    {
      int vcol = tid >> 1, half = tid & 1;
      int kvh = vcol >> 6, dv = vcol & 63;
      bf16* dstp = vt + ((size_t)((b * 2 + kvh) * 64 + dv)) * SKEYS + s0 + half * 32;
      const bf16* srcp = tl + vcol * GLS + half * 32;
#pragma unroll
      for (int i = 0; i < 4; ++i) ((u32x4*)dstp)[i] = ((const u32x4*)srcp)[i];
    }
  }
}

template <int DQK, int SM>
DI void attn_item(const bf16* __restrict__ Q, int ldq_, const bf16* __restrict__ Kc, const bf16* __restrict__ Kl, int ldk_,
                  const bf16* __restrict__ VT, int nkeys, bf16* __restrict__ O, int ldo_, float scale, char* smem, float kbound = 0.f) {
  constexpr bool FIXED = (SM != 0);
  constexpr int ldq = 768, ldk = 768, ldo = DM;
  (void)ldq_; (void)ldk_; (void)ldo_;
  constexpr int KLS = DQK + 8;
  constexpr int VLS = 72;
  constexpr int NKS = DQK / 16;
  constexpr int KCH = DQK / 8;
  constexpr int KLOADS = (64 * KCH) / 256;
  constexpr int BUF = 64 * KLS + 64 * VLS;
  bf16* Sb = (bf16*)smem;
  const int tid = get_tid(), lane = tid & 63, w = tid >> 6;
  const float sc = scale * 1.4426950408889634f;
  bf16x8 qf[2][NKS];
#pragma unroll
  for (int qt = 0; qt < 2; ++qt) {
    const bf16* qp = Q + (size_t)(w * 64 + qt * 32 + (lane & 31)) * ldq + (lane >> 5) * 8;
#pragma unroll
    for (int ks = 0; ks < NKS; ++ks) qf[qt][ks] = *(const bf16x8*)(qp + ks * 16);
  }
  float msh[2] = {0.f, 0.f};
  if (SM == 2) {
#pragma unroll
    for (int qt = 0; qt < 2; ++qt) {
      float sq = 0.f;
#pragma unroll
      for (int ks = 0; ks < NKS; ++ks)
#pragma unroll
        for (int e = 0; e < 8; ++e) { float f = bf2f((bf16)qf[qt][ks][e]); sq += f * f; }
      sq += __shfl_xor(sq, 32);
      msh[qt] = fminf(sqrtf(sq) * kbound, 64.0f);
    }
  }
  f32x16 ot[2][2];
#pragma unroll
  for (int i = 0; i < 2; ++i)
#pragma unroll
    for (int j = 0; j < 2; ++j)
#pragma unroll
      for (int r = 0; r < 16; ++r) ot[i][j][r] = 0.f;
  float m_run[2] = {-1e30f, -1e30f}, l_run[2] = {0.f, 0.f};
  u32x4 kr[KLOADS], vr[2];
  auto gload = [&](int s0) {
    const bf16* kb = (s0 < CTXL) ? (Kc + (size_t)s0 * ldk) : (Kl + (size_t)(s0 - CTXL) * ldk);
#pragma unroll
    for (int i = 0; i < KLOADS; ++i) {
      int ci = i * 256 + tid;
      int row = ci / KCH, ch = ci % KCH;
      kr[i] = *(const u32x4*)(kb + (size_t)row * ldk + ch * 8);
    }
#pragma unroll
    for (int i = 0; i < 2; ++i) {
      int ci = i * 256 + tid;
      int row = ci >> 3, ch = ci & 7;
      vr[i] = *(const u32x4*)(VT + (size_t)row * SKEYS + s0 + ch * 8);
    }
  };
  auto lwrite = [&](bf16* buf) {
    bf16* Ks = buf; bf16* Vs = buf + 64 * KLS;
#pragma unroll
    for (int i = 0; i < KLOADS; ++i) {
      int ci = i * 256 + tid;
      int row = ci / KCH, ch = ci % KCH;
      *(u32x4*)(Ks + row * KLS + ch * 8) = kr[i];
    }
#pragma unroll
    for (int i = 0; i < 2; ++i) {
      int ci = i * 256 + tid;
      int row = ci >> 3, ch = ci & 7;
      u32x2 lo = {vr[i].x, vr[i].y}, hi = {vr[i].z, vr[i].w};
      const int gb = (ch >> 1) * 16 + (ch & 1) * 4;
      *(u32x2*)(Vs + row * VLS + gb) = lo;
      *(u32x2*)(Vs + row * VLS + gb + 8) = hi;
    }
  };
  const int ntiles = nkeys >> 6;
  __syncthreads();
  gload(0);
  lwrite(Sb);
  if (ntiles > 1) gload(64);
  for (int j = 0; j < ntiles; ++j) {
    __syncthreads();
    if (j + 1 < ntiles) {
      lwrite(Sb + ((j + 1) & 1) * BUF);
      if (j + 2 < ntiles) gload((j + 2) * 64);
    }
    const bf16* Ks = Sb + (j & 1) * BUF;
    const bf16* Vs = Ks + 64 * KLS;
    auto half = [&](const int kt) {
      f32x16 st[2];
#pragma unroll
      for (int qt = 0; qt < 2; ++qt)
#pragma unroll
        for (int r = 0; r < 16; ++r) st[qt][r] = 0.f;
      {
        const bf16* ap = Ks + (kt * 32 + (lane & 31)) * KLS + (lane >> 5) * 8;
        __builtin_amdgcn_s_setprio(1);
#pragma unroll
        for (int ks = 0; ks < NKS; ++ks) {
          bf16x8 a = *(const bf16x8*)(ap + ks * 16);
          st[0] = MFMA32(a, qf[0][ks], st[0]);
          st[1] = MFMA32(a, qf[1][ks], st[1]);
        }
        __builtin_amdgcn_s_setprio(0);
      }
      float mx[2] = {0.f, 0.f};
      bool need = false;
      if (!FIXED) {
#pragma unroll
      for (int qt = 0; qt < 2; ++qt) {
        float m0 = fmaxf(st[qt][0], st[qt][1]);
#pragma unroll
        for (int r = 2; r < 16; r += 2) m0 = fmaxf(m0, fmaxf(st[qt][r], st[qt][r + 1]));
        m0 = fmaxf(m0, __shfl_xor(m0, 32)) * sc;
        mx[qt] = m0;
        need = need || (m0 - m_run[qt] > 8.0f);
      }
      }
      if (!FIXED && __any(need)) {
#pragma unroll
        for (int qt = 0; qt < 2; ++qt) {
          const float m_new = fmaxf(m_run[qt], mx[qt]);
          const float alpha = __builtin_amdgcn_exp2f(m_run[qt] - m_new);
          m_run[qt] = m_new;
          l_run[qt] *= alpha;
#pragma unroll
          for (int dt = 0; dt < 2; ++dt)
#pragma unroll
            for (int r = 0; r < 16; ++r) ot[qt][dt][r] *= alpha;
        }
      }
      bf16x8 pb[2][2];
#pragma unroll
      for (int qt = 0; qt < 2; ++qt) {
        float ps = 0.f;
        const float mr = m_run[qt];
#pragma unroll
        for (int r = 0; r < 16; ++r) {
          float pv = (SM == 1) ? __builtin_amdgcn_exp2f(st[qt][r]) : (SM == 2) ? __builtin_amdgcn_exp2f(st[qt][r] - msh[qt]) : __builtin_amdgcn_exp2f(st[qt][r] * sc - mr);
          st[qt][r] = pv;
          ps += pv;
        }
#pragma unroll
        for (int s2 = 0; s2 < 2; ++s2) {
          u32x4 pk;
          pk.x = cvtpk(st[qt][8 * s2 + 0], st[qt][8 * s2 + 1]);
          pk.y = cvtpk(st[qt][8 * s2 + 2], st[qt][8 * s2 + 3]);
          pk.z = cvtpk(st[qt][8 * s2 + 4], st[qt][8 * s2 + 5]);
          pk.w = cvtpk(st[qt][8 * s2 + 6], st[qt][8 * s2 + 7]);
          pb[qt][s2] = __builtin_bit_cast(bf16x8, pk);
        }
        l_run[qt] += ps;
      }
      __builtin_amdgcn_s_setprio(1);
#pragma unroll
      for (int s2 = 0; s2 < 2; ++s2)
#pragma unroll
        for (int dt = 0; dt < 2; ++dt) {
          const bf16* vp = Vs + (dt * 32 + (lane & 31)) * VLS + kt * 32 + 16 * s2 + 8 * (lane >> 5);
          bf16x8 af = *(const bf16x8*)vp;
          ot[0][dt] = MFMA32(af, pb[0][s2], ot[0][dt]);
          ot[1][dt] = MFMA32(af, pb[1][s2], ot[1][dt]);
        }
      __builtin_amdgcn_s_setprio(0);
    };
    if constexpr (SM == 1) {
#pragma unroll 1
      for (int kt = 0; kt < 2; ++kt) half(kt);
    } else {
      half(0);
      half(1);
    }
  }
#pragma unroll
  for (int qt = 0; qt < 2; ++qt) {
    const float ltot = l_run[qt] + __shfl_xor(l_run[qt], 32);
    const float inv_l = 1.0f / ltot;
    const int tid2 = get_tid();
    bf16* op = O + (size_t)((tid2 >> 6) * 64 + qt * 32 + (tid2 & 31)) * ldo;
#pragma unroll
    for (int dt = 0; dt < 2; ++dt)
#pragma unroll
      for (int g4 = 0; g4 < 4; ++g4) {
        int dv = dt * 32 + 8 * g4 + 4 * ((tid2 >> 5) & 1);
        u32x2 o;
        o.x = cvtpk(ot[qt][dt][4 * g4 + 0] * inv_l, ot[qt][dt][4 * g4 + 1] * inv_l);
        o.y = cvtpk(ot[qt][dt][4 * g4 + 2] * inv_l, ot[qt][dt][4 * g4 + 3] * inv_l);
        *(u32x2*)(op + dv) = o;
      }
  }
}

DI void hgrn2_item(const Params& p, int item, char* smem) {
  const int vs = item & 3, dir = (item >> 2) & 1, h = (item >> 3) & 3, b = item >> 5;
  constexpr int QLS = 136, TLS = 72;
  bf16* Qr = (bf16*)smem;
  bf16* Kr = Qr + 64 * QLS;
  bf16* KrT = Kr + 64 * QLS;
  bf16* VTs = KrT + 128 * TLS;
  bf16* Att = VTs + 32 * TLS;
  bf16* STb = Att + 64 * TLS;
  float* rsum = (float*)(STb + 32 * QLS);
  float* lsum = rsum + 128;
  const int tid = get_tid(), lane = tid & 63, w = tid >> 6;
  const int c = tid & 127, half = tid >> 7;
  const bf16* ph = (const bf16*)(p.ws + OFF_PAHG);
  bf16* og = (bf16*)(p.ws + OFF_OHG) + (size_t)dir * NTOK * 512;
  auto rowof = [&](int pos) -> int {
    if (pos < CTXL) { int s = dir ? (CTXL - 1 - pos) : pos; return NLAT + b * CTXL + s; }
    int t = pos - CTXL; t = dir ? (SEQ - 1 - t) : t; return b * SEQ + t;
  };
  f32x16 S0, S1;
#pragma unroll
  for (int r = 0; r < 16; ++r) { S0[r] = 0.f; S1[r] = 0.f; }
  bf16 pq[32], pf[32];
  u32x4 pv;
  auto prefetch = [&](int ch) {
    const int p0 = ch * 64;
#pragma unroll
    for (int i = 0; i < 32; ++i) {
      const bf16* row = ph + (size_t)rowof(p0 + half * 32 + i) * 2560;
      pq[i] = row[h * 128 + c];
      pf[i] = row[512 + dir * 512 + h * 128 + c];
    }
    {
      const bf16* row = ph + (size_t)rowof(p0 + (tid >> 2)) * 2560;
      pv = *(const u32x4*)(row + 1536 + h * 128 + vs * 32 + (tid & 3) * 8);
    }
  };
  for (int ch = 0; ch < 132; ++ch) {
    prefetch(ch);
    {
      float run = 0.f;
      if (half == 0) {
#pragma unroll
        for (int ii = 31; ii >= 0; --ii) {
          float lg = bf2f(pf[ii]), q = bf2f(pq[ii]);
          float k = 1.f - __expf(lg);
          float eq = __expf(fminf(-run, 80.f)), ek = __expf(fmaxf(run, -80.f));
          const unsigned pk2 = cvtpk(q * eq, k * ek);
          const bf16 qv = (bf16)(pk2 & 0xffffu), kv = (bf16)(pk2 >> 16);
          Qr[ii * QLS + c] = qv;
          Kr[ii * QLS + c] = kv;
          KrT[c * TLS + ii] = kv;
          run += lg;
        }
        rsum[c] = __expf(run);
      } else {
#pragma unroll
        for (int ii = 0; ii < 32; ++ii) {
          float lg = bf2f(pf[ii]), q = bf2f(pq[ii]);
          float k = 1.f - __expf(lg);
          run += lg;
          float eq = __expf(fmaxf(run, -80.f)), ek = __expf(fminf(-run, 80.f));
          const unsigned pk2 = cvtpk(q * eq, k * ek);
          const bf16 qv = (bf16)(pk2 & 0xffffu), kv = (bf16)(pk2 >> 16);
          Qr[(32 + ii) * QLS + c] = qv;
          Kr[(32 + ii) * QLS + c] = kv;
          KrT[c * TLS + 32 + ii] = kv;
        }
        lsum[c] = __expf(run);
      }
      {
        int i = tid >> 2, v0 = (tid & 3) * 8;
#pragma unroll
        for (int j = 0; j < 4; ++j) {
          VTs[(v0 + 2 * j) * TLS + i] = (bf16)(pv[j] & 0xffffu);
          VTs[(v0 + 2 * j + 1) * TLS + i] = (bf16)(pv[j] >> 16);
        }
      }
    }
    __syncthreads();
    if (w < 2) {
      const int ntl = (w == 0) ? 2 : 1;
      for (int q2 = 0; q2 < ntl; ++q2) {
        const int tt = (w == 0) ? q2 : 1, stl = (w == 0) ? q2 : 0;
        f32x16 a;
#pragma unroll
        for (int r = 0; r < 16; ++r) a[r] = 0.f;
        mma_tile(a, Qr + tt * 32 * QLS, QLS, Kr + stl * 32 * QLS, QLS, 128);
#pragma unroll
        for (int r = 0; r < 16; ++r) {
          int t = tt * 32 + crow(r, lane), s = stl * 32 + (lane & 31);
          float v = (s <= t) ? a[r] : 0.f;
          Att[t * TLS + s] = (bf16)(cvtpk(v, v) & 0xffffu);
        }
      }
      if (w == 1) {
#pragma unroll
        for (int r = 0; r < 16; ++r) Att[crow(r, lane) * TLS + 32 + (lane & 31)] = 0;
      }
    } else {
      const int ct0 = (w - 2) * 2;
#pragma unroll
      for (int tI = 0; tI < 2; ++tI) {
        f32x16& S = tI ? S1 : S0;
        const int cb = (ct0 + tI) * 32;
#pragma unroll
        for (int g4 = 0; g4 < 4; ++g4) {
          int cc = cb + 8 * g4 + 4 * (lane >> 5);
          float e0 = rsum[cc], e1 = rsum[cc + 1], e2 = rsum[cc + 2], e3 = rsum[cc + 3];
          u32x2 o;
          o.x = cvtpk(S[4 * g4] * e0, S[4 * g4 + 1] * e1);
          o.y = cvtpk(S[4 * g4 + 2] * e2, S[4 * g4 + 3] * e3);
          *(u32x2*)(STb + (lane & 31) * QLS + cc) = o;
        }
        f32x16 a;
#pragma unroll
        for (int r = 0; r < 16; ++r) a[r] = 0.f;
        mma_tile(a, KrT + cb * TLS, TLS, VTs, TLS, 64);
#pragma unroll
        for (int r = 0; r < 16; ++r) {
          int cc = cb + crow(r, lane);
          float el = lsum[cc];
          float er = rsum[cc];
          S[r] = S[r] * (el * er) + a[r] * el;
        }
      }
    }
    __syncthreads();
    if (w < 2) {
      f32x16 a;
#pragma unroll
      for (int r = 0; r < 16; ++r) a[r] = 0.f;
      mma_tile(a, Att + w * 32 * TLS, TLS, VTs, TLS, 64);
      mma_tile(a, Qr + w * 32 * QLS, QLS, STb, QLS, 128);
#pragma unroll
      for (int r = 0; r < 16; ++r) {
        int t = w * 32 + crow(r, lane);
        int row = rowof(ch * 64 + t);
        og[(size_t)row * 512 + h * 128 + vs * 32 + (lane & 31)] = f2bf(a[r]);
      }
    }
    __syncthreads();
  }
}

DI void phase_mix0(const Params& p, char* smem, int cidx) {
  __shared__ int s_item;
  if (blockIdx.x < 128) hgrn2_item(p, blockIdx.x, smem);
  unsigned* cnt = (unsigned*)(p.ws + OFF_CNT) + cidx;
  const bf16* pg = (const bf16*)(p.ws + OFF_PAGQA);
  const bf16* vt = (const bf16*)(p.ws + OFF_VT0);
  bf16* ycat = (bf16*)(p.ws + OFF_ACTA);
  float kb0;
  {
    const int ln = get_tid() & 63;
    kb0 = 8.0f * 1.01f * wave_max_early(fabsf(p.gqa_kn_g[ln]));
  }
  const int n_lat = 4 * 8 * 32, n_ctx = 4 * 8;
  while (true) {
    __syncthreads();
    if (get_tid() == 0) s_item = (int)atomicAdd(cnt, 1u);
    __syncthreads();
    const int it = s_item;
    if (it >= n_lat + n_ctx) break;
    int b, hq, r0, nk;
    if (it < n_lat) { const int qt = it & 31; hq = (it >> 5) & 7; b = it >> 8; r0 = b * SEQ + qt * 256; nk = SKEYS; }
    else { const int i2 = it - n_lat; hq = i2 & 7; b = i2 >> 3; r0 = NLAT + b * CTXL; nk = CTXL; }
    const int kvh = hq >> 2;
    attn_item<64, 2>(pg + (size_t)r0 * 768 + hq * 64, 768,
                  pg + (size_t)(NLAT + b * CTXL) * 768 + 512 + kvh * 64, pg + (size_t)(b * SEQ) * 768 + 512 + kvh * 64, 768,
                  vt + (size_t)((b * 2 + kvh) * 64) * SKEYS, nk, ycat + (size_t)r0 * DM + hq * 64, DM, 0.125f, smem, kb0);
  }
}

DI void phase_hg_readout(const Params& p) {
  const int lane = get_tid() & 63, w = get_tid() >> 6;
  const bf16* o0 = (const bf16*)(p.ws + OFF_OHG);
  const bf16* o1 = o0 + (size_t)NTOK * 512;
  const bf16* ph = (const bf16*)(p.ws + OFF_PAHG);
  bf16* ycat = (bf16*)(p.ws + OFF_ACTA);
  const float g0 = p.hg_onorm_g[lane * 2], g1 = p.hg_onorm_g[lane * 2 + 1];
  for (int r = blockIdx.x * 4 + w; r < NTOK; r += gridDim.x * 4) {
#pragma unroll
    for (int h = 0; h < 4; ++h) {
      unsigned a = *(const unsigned*)(o0 + (size_t)r * 512 + h * 128 + lane * 2);
      unsigned b2 = *(const unsigned*)(o1 + (size_t)r * 512 + h * 128 + lane * 2);
      unsigned gg = *(const unsigned*)(ph + (size_t)r * 2560 + 2048 + h * 128 + lane * 2);
      float x0 = bflo(a) + bflo(b2), x1 = bfhi(a) + bfhi(b2);
      float ss = wave_sum(x0 * x0 + x1 * x1);
      float rs = rsqrtf(ss * (1.f / 128.f) + EPSN);
      float y0 = x0 * rs * g0 * siluf_(bflo(gg)), y1 = x1 * rs * g1 * siluf_(bfhi(gg));
      *(unsigned*)(ycat + (size_t)r * DM + 512 + h * 128 + lane * 2) = cvtpk(y0, y1);
    }
  }
}

template <int MI>
DI void resid_epilogue(f32x16 (&acc)[MI][2], const float* src, float* dst, const float* __restrict__ g) {
  const int lane = get_tid() & 63, w = get_tid() >> 6;
  const int wm = w >> 1, wn = w & 1;
  const float g0 = g[wn * 64 + (lane & 31)], g1 = g[wn * 64 + 32 + (lane & 31)];
#pragma unroll
  for (int mi = 0; mi < MI; ++mi) {
    const size_t o0 = (size_t)(wm * (MI * 32) + mi * 32 + 4 * (lane >> 5)) * DM + wn * 64 + (lane & 31);
    float xv[2][16];
#pragma unroll
    for (int r = 0; r < 16; ++r) {
      const size_t ro = o0 + (size_t)((r & 3) + 8 * (r >> 2)) * DM;
      xv[0][r] = src[ro];
      xv[1][r] = src[ro + 32];
    }
#pragma unroll
    for (int r = 0; r < 16; ++r) {
      const size_t ro = o0 + (size_t)((r & 3) + 8 * (r >> 2)) * DM;
      dst[ro] = xv[0][r] + g0 * acc[mi][0][r];
      dst[ro + 32] = xv[1][r] + g1 * acc[mi][1][r];
    }
  }
}
DI void resid_prefetch2(float (&xv)[2][2][16], const float* src) {
  const int lane = get_tid() & 63, w = get_tid() >> 6;
  const int wm = w >> 1, wn = w & 1;
#pragma unroll
  for (int mi = 0; mi < 2; ++mi) {
    const size_t o0 = (size_t)(wm * 64 + mi * 32 + 4 * (lane >> 5)) * DM + wn * 64 + (lane & 31);
#pragma unroll
    for (int r = 0; r < 16; ++r) {
      const size_t ro = o0 + (size_t)((r & 3) + 8 * (r >> 2)) * DM;
      xv[mi][0][r] = src[ro];
      xv[mi][1][r] = src[ro + 32];
    }
  }
}
DI void resid_store2(f32x16 (&acc)[2][2], const float (&xv)[2][2][16], float* dst, const float* __restrict__ g) {
  const int lane = get_tid() & 63, w = get_tid() >> 6;
  const int wm = w >> 1, wn = w & 1;
  const float g0 = g[wn * 64 + (lane & 31)], g1 = g[wn * 64 + 32 + (lane & 31)];
#pragma unroll
  for (int mi = 0; mi < 2; ++mi) {
    const size_t o0 = (size_t)(wm * 64 + mi * 32 + 4 * (lane >> 5)) * DM + wn * 64 + (lane & 31);
#pragma unroll
    for (int r = 0; r < 16; ++r) {
      const size_t ro = o0 + (size_t)((r & 3) + 8 * (r >> 2)) * DM;
      dst[ro] = xv[mi][0][r] + g0 * acc[mi][0][r];
      dst[ro + 32] = xv[mi][1][r] + g1 * acc[mi][1][r];
    }
  }
}
DI void phase_outproj(const Params& p, int layer, size_t wt_off, int nrows, bool first, char* smem) {
  (void)first;
  bf16* As = (bf16*)smem; bf16* Bs = As + 128 * GLS;
  const bf16* A = (const bf16*)(p.ws + OFF_ACTA);
  const bf16* Wt = (const bf16*)(p.ws + wt_off);
  const int ntn = 8, ntm = nrows / 128;
  for (int t = blockIdx.x; t < ntn * ntm; t += gridDim.x) {
    const int mt = t / ntn, nt = t % ntn;
    f32x16 acc[2][2];
    const int r0 = mt * 128;
    float xv[2][2][16];
    resid_prefetch2(xv, orig_row(p, r0) + nt * 128);
    gemm_128x128(A + (size_t)mt * 128 * DM, DM, Wt + (size_t)nt * 128 * DM, DM, DM, acc, As, Bs);
    resid_store2(acc, xv, res_row(p, r0) + nt * 128, mod_ptr(p, layer, r0, 2) + nt * 128);
  }
}
DI void phase_outproj1(const Params& p, char* smem) {
  bf16* As = (bf16*)smem; bf16* Bs = As + 256 * GLS;
  const bf16* A = (const bf16*)(p.ws + OFF_ACTA);
  const bf16* Wt = (const bf16*)(p.ws + OFF_WT_ODOUT);
  const int ntn = 8, ntm = NLAT / 256;
  for (int t = blockIdx.x; t < ntn * ntm; t += gridDim.x) {
    const int mt = t / ntn, nt = t % ntn;
    f32x16 acc[4][2];
    gemm_256x128(A + (size_t)mt * 256 * DM, DM, Wt + (size_t)nt * 128 * DM, DM, DM, acc, As, Bs);
    float* xp = p.out + (size_t)(mt * 256) * DM + nt * 128;
    resid_epilogue<4>(acc, xp, xp, mod_ptr(p, 1, mt * 256, 2) + nt * 128);
  }
}

DI void tk_ins(float (&L)[16], float x) {
#pragma unroll
  for (int j = 15; j >= 1; --j) L[j] = __builtin_amdgcn_fmed3f(L[j - 1], L[j], x);
  L[0] = fmaxf(L[0], x);
}
DI void tk_insert(float (&v)[16], int (&id)[16], float x, int xi) {
  if (x > v[15]) {
    v[15] = x; id[15] = xi;
#pragma unroll
    for (int j = 15; j > 0; --j) {
      bool sw = v[j] > v[j - 1];
      float a = v[j], b2 = v[j - 1];
      int ia = id[j], ib = id[j - 1];
      v[j - 1] = sw ? a : b2; v[j] = sw ? b2 : a;
      id[j - 1] = sw ? ia : ib; id[j] = sw ? ib : ia;
    }
  }
}

DI void phase_peer_route(const Params& p, int layer, int nrows, char* smem, size_t roff = OFF_RIDX) {
  bf16* As = (bf16*)smem; bf16* Bs = As + 128 * GLS;
  constexpr int QLS = 136;
  bf16* Qt = (bf16*)smem;
  bf16* Kt = Qt + 128 * QLS;
  const bf16* A = (const bf16*)(p.ws + OFF_ACTA);
  const bf16* Wt = (const bf16*)(p.ws + OFF_WT_PWQ) + (size_t)layer * 2048 * 1024;
  const bf16* keys = (const bf16*)(p.ws + OFF_PKEYS) + (size_t)layer * 8 * 2 * 128 * 128;
  int* ridx = (int*)(p.ws + roff);
  float* rgw = (float*)(p.ws + roff + (OFF_RGW - OFF_RIDX));
  const int tid = get_tid(), lane = tid & 63, w = tid >> 6;
  const int hi5 = lane >> 5;
  const int xl = (lane ^ 32) << 2;
  const int ntm = nrows / 128;
  for (int it = blockIdx.x; it < ntm * 8; it += gridDim.x) {
    const int mt = it >> 3, h = it & 7;
    float l0[16], L[16];
    for (int pp = 0; pp < 2; ++pp) {
      {
        f32x16 acc[2][2];
        gemm_128x128(A + (size_t)mt * 128 * DM, DM, Wt + (size_t)((h * 2 + pp) * 128) * DM, DM, DM, acc, As, Bs);
        __syncthreads();
        gemm_epi(acc, [&](int row, int col, float v) { Qt[row * QLS + col] = f2bf(v); });
      }
      {
        const bf16* kb = keys + (size_t)((h * 2 + pp) * 128) * 128;
#pragma unroll
        for (int i = 0; i < 8; ++i) {
          int ci = i * 256 + tid;
          int row = ci >> 4, chh = ci & 15;
          *(u32x4*)(Kt + row * QLS + chh * 8) = *(const u32x4*)(kb + row * 128 + chh * 8);
        }
      }
      __syncthreads();
      f32x16 st[4];
#pragma unroll
      for (int i = 0; i < 4; ++i) {
#pragma unroll
        for (int r = 0; r < 16; ++r) st[i][r] = 0.f;
        mma_tile(st[i], Kt + (i * 32) * QLS, QLS, Qt + (w * 32) * QLS, QLS, 128);
      }
#pragma unroll
      for (int j = 0; j < 16; ++j) L[j] = -3.0e38f;
#pragma unroll
      for (int i = 0; i < 4; ++i)
#pragma unroll
        for (int r = 0; r < 16; ++r) {
          const unsigned kb = (__float_as_uint(st[i][r]) & 0xffffff80u) | (unsigned)(i * 16 + r);
          tk_ins(L, __uint_as_float(kb));
        }
#pragma unroll
      for (int j = 0; j < 16; ++j) {
        const unsigned u = __float_as_uint(L[j]);
        const unsigned nn = ((u & 0x3cu) << 1) | (u & 3u) | ((unsigned)hi5 << 2);
        L[j] = __uint_as_float((u & 0xffffff80u) | nn);
      }
      {
        float O[16];
#pragma unroll
        for (int j = 0; j < 16; ++j) O[j] = __builtin_bit_cast(float, __builtin_amdgcn_ds_bpermute(xl, __builtin_bit_cast(int, L[j])));
#pragma unroll
        for (int j = 0; j < 16; ++j) tk_ins(L, O[j]);
      }
      if (pp == 0) {
#pragma unroll
        for (int j = 0; j < 16; ++j) l0[j] = L[j];
      }
      __syncthreads();
    }
    {
      float av[16], bv[16];
      unsigned ai[16], bi[16];
#pragma unroll
      for (int j = 0; j < 16; ++j) {
        const unsigned ua = __float_as_uint(l0[j]), ub = __float_as_uint(L[j]);
        av[j] = __uint_as_float(ua & 0xffffff80u); ai[j] = (ua & 0x7fu) << 7;
        bv[j] = __uint_as_float(ub & 0xffffff80u); bi[j] = ub & 0x7fu;
      }
      float F[16];
#pragma unroll
      for (int j = 0; j < 16; ++j) F[j] = -3.0e38f;
#pragma unroll
      for (int a = 0; a < 16; ++a)
#pragma unroll
        for (int b2 = 0; b2 < 16; ++b2)
          if ((a + 1) * (b2 + 1) <= 16) {
            const unsigned sb = __float_as_uint(av[a] + bv[b2]) + 0x2000u;
            tk_ins(F, __uint_as_float((sb & 0xffffc000u) | ai[a] | bi[b2]));
          }
      float e[16];
      const float mx = __uint_as_float(__float_as_uint(F[0]) & 0xffffc000u);
      float sum = 0.f;
#pragma unroll
      for (int j = 0; j < 16; ++j) {
        e[j] = __expf(__uint_as_float(__float_as_uint(F[j]) & 0xffffc000u) - mx);
        sum += e[j];
      }
      const float inv = 1.f / sum;
      const int r = mt * 128 + w * 32 + (lane & 31);
      const unsigned hm = (unsigned)(-hi5);
      unsigned gi[8];
      float ge[8];
#pragma unroll
      for (int k = 0; k < 8; ++k) {
        gi[k] = ((__float_as_uint(F[k]) & ~hm) | (__float_as_uint(F[8 + k]) & hm)) & 0x3fffu;
        ge[k] = __uint_as_float((__float_as_uint(e[k]) & ~hm) | (__float_as_uint(e[8 + k]) & hm)) * inv;
      }
      int4* ip = (int4*)(ridx + (size_t)r * 128 + h * 16 + hi5 * 8);
      float4* gp = (float4*)(rgw + (size_t)r * 128 + h * 16 + hi5 * 8);
      ip[0] = make_int4((int)gi[0], (int)gi[1], (int)gi[2], (int)gi[3]);
      ip[1] = make_int4((int)gi[4], (int)gi[5], (int)gi[6], (int)gi[7]);
      gp[0] = make_float4(ge[0], ge[1], ge[2], ge[3]);
      gp[1] = make_float4(ge[4], ge[5], ge[6], ge[7]);
    }
  }
}

typedef float f32x2 __attribute__((ext_vector_type(2)));
DI float wave_max(float v) {
#pragma unroll
  for (int o = 32; o > 0; o >>= 1) v = fmaxf(v, __shfl_xor(v, o));
  return v;
}
DI unsigned pk4_fp8(float a, float b, float c, float d) {
  int r = 0;
  r = __builtin_amdgcn_cvt_pk_fp8_f32(a, b, r, false);
  r = __builtin_amdgcn_cvt_pk_fp8_f32(c, d, r, true);
  return (unsigned)r;
}
DI float clamp6(float v) { return __builtin_amdgcn_fmed3f(v, -6.0f, 6.0f); }
DI void convert_fp8_rows(const float* __restrict__ src, unsigned char* __restrict__ dst, float* __restrict__ scl) {
  const int lane = get_tid() & 63, w = get_tid() >> 6;
  for (int row = blockIdx.x * 4 + w; row < 16384; row += gridDim.x * 4) {
    const float4* s4 = (const float4*)(src + (size_t)row * 1024) + lane * 4;
    float4 v0 = s4[0], v1 = s4[1], v2 = s4[2], v3 = s4[3];
    float ss = v0.x * v0.x + v0.y * v0.y + v0.z * v0.z + v0.w * v0.w + v1.x * v1.x + v1.y * v1.y + v1.z * v1.z + v1.w * v1.w +
               v2.x * v2.x + v2.y * v2.y + v2.z * v2.z + v2.w * v2.w + v3.x * v3.x + v3.y * v3.y + v3.z * v3.z + v3.w * v3.w;
    ss = wave_sum(ss);
    const float sc = (ss > 0.f) ? 0.5f * sqrtf(ss * (1.0f / 1024.0f)) : 1.0f;
    const float inv = 1.0f / sc;
    unsigned d0 = 0, d1 = 0;
    d0 = __builtin_amdgcn_cvt_scalef32_pk_fp4_f32(d0, clamp6(v0.x * inv), clamp6(v0.y * inv), 1.0f, 0);
    d0 = __builtin_amdgcn_cvt_scalef32_pk_fp4_f32(d0, clamp6(v0.z * inv), clamp6(v0.w * inv), 1.0f, 1);
    d0 = __builtin_amdgcn_cvt_scalef32_pk_fp4_f32(d0, clamp6(v1.x * inv), clamp6(v1.y * inv), 1.0f, 2);
    d0 = __builtin_amdgcn_cvt_scalef32_pk_fp4_f32(d0, clamp6(v1.z * inv), clamp6(v1.w * inv), 1.0f, 3);
    d1 = __builtin_amdgcn_cvt_scalef32_pk_fp4_f32(d1, clamp6(v2.x * inv), clamp6(v2.y * inv), 1.0f, 0);
    d1 = __builtin_amdgcn_cvt_scalef32_pk_fp4_f32(d1, clamp6(v2.z * inv), clamp6(v2.w * inv), 1.0f, 1);
    d1 = __builtin_amdgcn_cvt_scalef32_pk_fp4_f32(d1, clamp6(v3.x * inv), clamp6(v3.y * inv), 1.0f, 2);
    d1 = __builtin_amdgcn_cvt_scalef32_pk_fp4_f32(d1, clamp6(v3.z * inv), clamp6(v3.w * inv), 1.0f, 3);
    ((u32x2*)(dst + (size_t)row * 512))[lane] = u32x2{d0, d1};
    if (lane == 0) scl[row] = sc;
  }
}
DI int q4(float v) {
  int n = (int)floorf(v);
  return (n < -8 ? -8 : (n > 7 ? 7 : n)) & 15;
}
DI void convert_u4_rows(const float* __restrict__ src, unsigned char* __restrict__ dst, float* __restrict__ scl) {
  const int lane = get_tid() & 63, w = get_tid() >> 6;
  for (int row = blockIdx.x * 4 + w; row < 16384; row += gridDim.x * 4) {
    const float4* s4 = (const float4*)(src + (size_t)row * 1024) + lane * 4;
    float4 v0 = s4[0], v1 = s4[1], v2 = s4[2], v3 = s4[3];
    float ss = v0.x * v0.x + v0.y * v0.y + v0.z * v0.z + v0.w * v0.w + v1.x * v1.x + v1.y * v1.y + v1.z * v1.z + v1.w * v1.w +
               v2.x * v2.x + v2.y * v2.y + v2.z * v2.z + v2.w * v2.w + v3.x * v3.x + v3.y * v3.y + v3.z * v3.z + v3.w * v3.w;
    ss = wave_sum(ss);
    const float sc = (ss > 0.f) ? 0.3352f * sqrtf(ss * (1.0f / 1024.0f)) : 1.0f;
    const float inv = 1.0f / sc;
    const unsigned d0 = (unsigned)q4(v0.x * inv) | ((unsigned)q4(v1.x * inv) << 4) | ((unsigned)q4(v0.y * inv) << 8) | ((unsigned)q4(v1.y * inv) << 12) |
                        ((unsigned)q4(v0.z * inv) << 16) | ((unsigned)q4(v1.z * inv) << 20) | ((unsigned)q4(v0.w * inv) << 24) | ((unsigned)q4(v1.w * inv) << 28);
    const unsigned d1 = (unsigned)q4(v2.x * inv) | ((unsigned)q4(v3.x * inv) << 4) | ((unsigned)q4(v2.y * inv) << 8) | ((unsigned)q4(v3.y * inv) << 12) |
                        ((unsigned)q4(v2.z * inv) << 16) | ((unsigned)q4(v3.z * inv) << 20) | ((unsigned)q4(v2.w * inv) << 24) | ((unsigned)q4(v3.w * inv) << 28);
    ((u32x2*)(dst + (size_t)row * 512))[lane] = u32x2{d0, d1};
    if (lane == 0) scl[row] = sc;
  }
}
DI void phase_convert_tables(const Params& p, int layer) {
  convert_u4_rows(p.peer_u + (size_t)layer * 16384 * 1024, (unsigned char*)(p.ws + OFF_UTAB), (float*)(p.ws + OFF_SU));
  convert_fp8_rows(p.peer_v + (size_t)layer * 16384 * 1024, (unsigned char*)(p.ws + OFF_VTAB), (float*)(p.ws + OFF_SV));
}

struct GBuf { u32x4 u[8]; u32x4 v[8]; float su, sv, gw; };
#define FP4X2(d, s) __builtin_amdgcn_cvt_scalef32_pk_f32_fp4((d), 1.0f, (s))
#define FP4B2(d, s) __builtin_amdgcn_cvt_scalef32_pk_bf16_fp4((d), 1.0f, (s))
typedef __bf16 bf16x2v __attribute__((ext_vector_type(2)));
template <int X> DI float swz_xor(float v) {
  return __builtin_bit_cast(float, __builtin_amdgcn_ds_swizzle(__builtin_bit_cast(int, v), (X << 10) | 0x1f));
}
template <int L> DI float swz_bcast(float v) {
  return __builtin_bit_cast(float, __builtin_amdgcn_ds_swizzle(__builtin_bit_cast(int, v), (L << 5)));
}
DI float wave_sum_swz(float v) {
  v += swz_xor<1>(v); v += swz_xor<2>(v); v += swz_xor<4>(v); v += swz_xor<8>(v); v += swz_xor<16>(v);
  return __builtin_bit_cast(float, __builtin_amdgcn_readlane(__builtin_bit_cast(int, v), 0)) +
         __builtin_bit_cast(float, __builtin_amdgcn_readlane(__builtin_bit_cast(int, v), 32));
}
DI float bperm_f(float v, int byte_idx) { return __builtin_bit_cast(float, __builtin_amdgcn_ds_bpermute(byte_idx, __builtin_bit_cast(int, v))); }
DI void phase_peer_gather(const Params& p, int layer, int nrows, bool dry) {
  const int lane = get_tid() & 63, w = __builtin_amdgcn_readfirstlane(get_tid() >> 6);
  const int half = lane >> 5, l5 = lane & 31;
  const bf16* hb = (const bf16*)(p.ws + OFF_ACTA);
  const unsigned char* ut = (const unsigned char*)(p.ws + OFF_UTAB);
  const unsigned char* vtb = (const unsigned char*)(p.ws + OFF_VTAB);
  const float* su = (const float*)(p.ws + OFF_SU);
  const float* sv = (const float*)(p.ws + OFF_SV);
  const int* ridx = (const int*)(p.ws + OFF_RIDX);
  const float* rgw = (const float*)(p.ws + OFF_RGW);
  const int ecode = half * 8 + ((lane >> 4) & 1) * 4 + ((lane >> 3) & 1) * 2 + ((lane >> 2) & 1);
  GBuf B0, B1;
  const int hidx = half * 32;
  int r = blockIdx.x * 4 + w;
  int e_lo = 0, e_hi = 0;
  float g_lo = 0.f, g_hi = 0.f;
  auto gload = [&](GBuf& B, int kb, int elo, int ehi, float glo, float ghi) {
    const int esrc = (kb < 4) ? elo : ehi;
    const float gsrc = (kb < 4) ? glo : ghi;
    const int base = (kb & 3) * 16;
#pragma unroll
    for (int j = 0; j < 8; ++j) {
      const int e = __builtin_amdgcn_ds_bpermute(hidx + ((base + j) << 2), esrc);
      const unsigned off = (unsigned)e * 512u + (unsigned)l5 * 16u;
      B.u[j] = *(const u32x4*)(ut + off);
      B.v[j] = *(const u32x4*)(vtb + off);
    }
    const int el = __builtin_amdgcn_ds_bpermute((base + ecode) << 2, esrc);
    B.su = su[el]; B.sv = sv[el];
    B.gw = bperm_f(gsrc, (base + ecode) << 2);
  };
  if (r < nrows) {
    e_lo = ridx[(size_t)r * 128 + lane]; e_hi = ridx[(size_t)r * 128 + 64 + lane];
    g_lo = rgw[(size_t)r * 128 + lane]; g_hi = rgw[(size_t)r * 128 + 64 + lane];
    gload(B0, 0, e_lo, e_hi, g_lo, g_hi);
  }
  for (; r < nrows; r += gridDim.x * 4) {
    const int rn = r + gridDim.x * 4;
    int ne_lo = 0, ne_hi = 0;
    float ng_lo = 0.f, ng_hi = 0.f;
    if (rn < nrows) {
      ne_lo = ridx[(size_t)rn * 128 + lane]; ne_hi = ridx[(size_t)rn * 128 + 64 + lane];
      ng_lo = rgw[(size_t)rn * 128 + lane]; ng_hi = rgw[(size_t)rn * 128 + 64 + lane];
    }
    unsigned HH[4], HL[4];
    float sh8, h8tot;
    {
      const u32x4* hp = (const u32x4*)(hb + (size_t)r * DM + l5 * 32);
      u32x4 a[4];
#pragma unroll
      for (int q = 0; q < 4; ++q) a[q] = hp[q];
      float m = 0.f;
#pragma unroll
      for (int q = 0; q < 4; ++q)
#pragma unroll
        for (int c = 0; c < 4; ++c) m = fmaxf(m, fmaxf(fabsf(bflo(a[q][c])), fabsf(bfhi(a[q][c]))));
      m = fmaxf(m, swz_xor<1>(m)); m = fmaxf(m, swz_xor<2>(m)); m = fmaxf(m, swz_xor<4>(m));
      m = fmaxf(m, swz_xor<8>(m)); m = fmaxf(m, swz_xor<16>(m));
      const float sc = (m > 0.f) ? 119.0f / m : 0.f;
      sh8 = m * (1.0f / 119.0f);
      float hs = 0.f;
#pragma unroll
      for (int q = 0; q < 4; ++q) {
        float f[8] = {bflo(a[q][0]), bfhi(a[q][0]), bflo(a[q][1]), bfhi(a[q][1]), bflo(a[q][2]), bfhi(a[q][2]), bflo(a[q][3]), bfhi(a[q][3])};
        unsigned P0 = 0, P1 = 0;
#pragma unroll
        for (int i = 0; i < 4; ++i) {
          const float g0 = rintf(f[i] * sc), g1 = rintf(f[4 + i] * sc);
          hs += g0 + g1;
          P0 = __builtin_amdgcn_cvt_pk_u8_f32(g0 + 136.0f, i, P0);
          P1 = __builtin_amdgcn_cvt_pk_u8_f32(g1 + 136.0f, i, P1);
        }
        HH[q] = (((P0 >> 4) & 0x0F0F0F0Fu) | (P1 & 0xF0F0F0F0u)) ^ 0x88888888u;
        HL[q] = ((P0 & 0x0F0F0F0Fu) | ((P1 << 4) & 0xF0F0F0F0u)) ^ 0x88888888u;
      }
      hs += swz_xor<1>(hs); hs += swz_xor<2>(hs); hs += swz_xor<4>(hs); hs += swz_xor<8>(hs); hs += swz_xor<16>(hs);
      h8tot = 0.5f * hs;
    }
    f32x2 acc[16];
#pragma unroll
    for (int j = 0; j < 16; ++j) acc[j] = f32x2{0.f, 0.f};
    auto compute = [&](GBuf& B) {
      float part[8];
#pragma unroll
      for (int j = 0; j < 8; ++j) {
        int dh = 0, dl = 0;
#pragma unroll
        for (int q = 0; q < 4; ++q) {
          dh = __builtin_amdgcn_sdot8((int)B.u[j][q], (int)HH[q], dh, false);
          dl = __builtin_amdgcn_sdot8((int)B.u[j][q], (int)HL[q], dl, false);
        }
        part[j] = (float)((dh << 4) + dl);
      }
      const bool b4 = lane & 16, b3 = lane & 8, b2 = lane & 4;
      float y[4], z[2], t;
#pragma unroll
      for (int i = 0; i < 4; ++i) {
        float send = b4 ? part[i] : part[i + 4];
        float keep = b4 ? part[i + 4] : part[i];
        y[i] = keep + swz_xor<16>(send);
      }
#pragma unroll
      for (int i = 0; i < 2; ++i) {
        float send = b3 ? y[i] : y[i + 2];
        float keep = b3 ? y[i + 2] : y[i];
        z[i] = keep + swz_xor<8>(send);
      }
      {
        float send = b2 ? z[0] : z[1];
        float keep = b2 ? z[1] : z[0];
        t = keep + swz_xor<4>(send);
      }
      t += swz_xor<2>(t);
      t += swz_xor<1>(t);
      const float wl = gelu_as((t + h8tot) * (B.su * sh8)) * B.gw * B.sv;
#define GACC(J)                                                                                        \
      {                                                                                                  \
        const float wj = swz_bcast<(((J) >> 2) & 1) * 16 + (((J) >> 1) & 1) * 8 + ((J) & 1) * 4>(wl);    \
        const f32x2 w2 = f32x2{wj, wj};                                                                  \
        _Pragma("unroll") for (int q = 0; q < 4; ++q) {                                                  \
          acc[4 * q] += w2 * FP4X2(B.v[J][q], 0);                                                        \
          acc[4 * q + 1] += w2 * FP4X2(B.v[J][q], 1);                                                    \
          acc[4 * q + 2] += w2 * FP4X2(B.v[J][q], 2);                                                    \
          acc[4 * q + 3] += w2 * FP4X2(B.v[J][q], 3);                                                    \
        }                                                                                                \
      }
      GACC(0) GACC(1) GACC(2) GACC(3) GACC(4) GACC(5) GACC(6) GACC(7)
#undef GACC
    };
#pragma unroll 1
    for (int kb = 0; kb < 8; kb += 2) {
      gload(B1, kb + 1, e_lo, e_hi, g_lo, g_hi);
      compute(B0);
      if (kb + 2 < 8) gload(B0, kb + 2, e_lo, e_hi, g_lo, g_hi);
      else if (rn < nrows) gload(B0, 0, ne_lo, ne_hi, ng_lo, ng_hi);
      compute(B1);
    }
    e_lo = ne_lo; e_hi = ne_hi; g_lo = ng_lo; g_hi = ng_hi;
    if (dry && acc[0].x != 12345.678f) continue;
    f32x2 fin[8];
#pragma unroll
    for (int k = 0; k < 8; ++k) {
      f32x2 send = half ? acc[k] : acc[k + 8];
      f32x2 keep = half ? acc[k + 8] : acc[k];
      fin[k] = f32x2{keep.x + bperm_f(send.x, (lane ^ 32) << 2), keep.y + bperm_f(send.y, (lane ^ 32) << 2)};
    }
    int eo = l5 * 32 + half * 16;
    asm volatile("" : "+v"(eo));
    float* xr = res_row(p, r) + eo;
    const float* g5 = mod_ptr(p, layer, r, 5) + eo;
    float4 xn[4];
    float ss = 0.f;
#pragma unroll
    for (int q = 0; q < 4; ++q) {
      float4 x0 = ((float4*)xr)[q];
      float4 m0 = ((const float4*)g5)[q];
      x0.x += m0.x * fin[2 * q].x; x0.y += m0.y * fin[2 * q].y; x0.z += m0.z * fin[2 * q + 1].x; x0.w += m0.w * fin[2 * q + 1].y;
      xn[q] = x0;
      ss += x0.x * x0.x + x0.y * x0.y + x0.z * x0.z + x0.w * x0.w;
    }
    ss = wave_sum_swz(ss);
    const float rs = rsqrtf(ss * (1.0f / 1024.0f) + EPSN);
    if (layer == 0) {
      const float* gg = p.norm1_g + 1024 + eo;
      const float* sh = mod_ptr(p, 1, r, 0) + eo;
      const float* sc = mod_ptr(p, 1, r, 1) + eo;
      unsigned hw[8];
#pragma unroll
      for (int q = 0; q < 4; ++q) {
        ((float4*)xr)[q] = xn[q];
        float4 g4 = ((const float4*)gg)[q], s4 = ((const float4*)sh)[q], c4 = ((const float4*)sc)[q];
        float o0 = xn[q].x * rs * g4.x * (1.f + c4.x) + s4.x;
        float o1 = xn[q].y * rs * g4.y * (1.f + c4.y) + s4.y;
        float o2 = xn[q].z * rs * g4.z * (1.f + c4.z) + s4.z;
        float o3 = xn[q].w * rs * g4.w * (1.f + c4.w) + s4.w;
        hw[2 * q] = cvtpk(o0, o1); hw[2 * q + 1] = cvtpk(o2, o3);
      }
      u32x4 w0 = {hw[0], hw[1], hw[2], hw[3]}, w1 = {hw[4], hw[5], hw[6], hw[7]};
      bf16* hd = (bf16*)(p.ws + OFF_ACTA) + (size_t)r * DM + eo;
      *(u32x4*)hd = w0;
      *(u32x4*)(hd + 8) = w1;
    } else {
      const float* gg = p.final_g + eo;
#pragma unroll
      for (int q = 0; q < 4; ++q) {
        float4 g4 = ((const float4*)gg)[q];
        float4 o;
        o.x = xn[q].x * rs * g4.x; o.y = xn[q].y * rs * g4.y; o.z = xn[q].z * rs * g4.z; o.w = xn[q].w * rs * g4.w;
        ((float4*)xr)[q] = o;
      }
    }
  }
}

DI void phase_inproj1(const Params& p, char* smem) {
  bf16* As = (bf16*)smem; bf16* Bs = As + 256 * GLS;
  const bf16* A = (const bf16*)(p.ws + OFF_ACTA);
  const bf16* Wt = (const bf16*)(p.ws + OFF_WT_ODIN);
  bf16* pm = (bf16*)(p.ws + OFF_PA1M);
  bf16* pu = (bf16*)(p.ws + OFF_U1);
  const int ntn = 10, ntm = NTOK / 256;
  for (int t = blockIdx.x; t < ntn * ntm; t += gridDim.x) {
    const int mt = t / ntn, nt = t % ntn;
    f32x16 acc[4][2];
    gemm_256x128(A + (size_t)mt * 256 * DM, DM, Wt + (size_t)nt * 128 * DM, DM, DM, acc, As, Bs);
    gemm_epi2(acc, [&](int row, int col, float v) {
      int r = mt * 256 + row, cg_ = nt * 128 + col;
      if (cg_ < 672) pm[(size_t)r * 672 + cg_] = f2bf(v);
      else if (cg_ < 1184) pu[(size_t)r * 512 + (cg_ - 672)] = f2bf(v);
    });
  }
}

DI void phase_mla_prep(const Params& p) {
  const int lane = get_tid() & 63, w = get_tid() >> 6;
  const bf16* pm = (const bf16*)(p.ws + OFF_PA1M);
  bf16* qn = (bf16*)(p.ws + OFF_QN);
  bf16* kvn = (bf16*)(p.ws + OFF_KVN);
  bf16* k1 = (bf16*)(p.ws + OFF_K1);
  const float inv = __powf(10000.f, -(float)(lane & 7) / 8.f);
  for (int r = blockIdx.x * 4 + w; r < NTOK; r += gridDim.x * 4) {
    const bf16* row = pm + (size_t)r * 672;
    if (r < NLAT) {
      float v[6]; float ss = 0.f;
#pragma unroll
      for (int i = 0; i < 6; ++i) { v[i] = bf2f(row[i * 64 + lane]); ss += v[i] * v[i]; }
      ss = wave_sum(ss);
      const float rs = rsqrtf(ss * (1.f / 384.f) + EPSN);
#pragma unroll
      for (int i = 0; i < 6; ++i) qn[(size_t)r * 384 + i * 64 + lane] = f2bf(v[i] * rs * p.mla_qa_g[i * 64 + lane]);
    }
    {
      float v[4]; float ss = 0.f;
#pragma unroll
      for (int i = 0; i < 4; ++i) { v[i] = bf2f(row[384 + i * 64 + lane]); ss += v[i] * v[i]; }
      ss = wave_sum(ss);
      const float rs = rsqrtf(ss * (1.f / 256.f) + EPSN);
#pragma unroll
      for (int i = 0; i < 4; ++i) kvn[(size_t)r * 256 + i * 64 + lane] = f2bf(v[i] * rs * p.mla_kva_g[i * 64 + lane]);
    }
    {
      const int cl = lane & 31;
      float y = bf2f(row[640 + cl]);
      float sn = 0.f, cs = 1.f;
      if (r < NLAT) {
        int t = r & 8191;
        float pos = (cl < 16) ? (float)(t >> 6) : (float)(t & 63);
        sincosf(pos * inv, &sn, &cs);
      }
      float pr = __shfl_xor(y, 8);
      float o = y * cs + ((cl & 8) ? pr * sn : -pr * sn);
      bf16 ob = f2bf(o);
      {
        const float ob_f = bf2f(ob);
        const float sq = wave_sum(lane < 32 ? ob_f * ob_f : 0.f);
        if (lane == 0) ((float*)(p.ws + OFF_KRSQ))[r] = sq;
      }
      const int hb = (lane >> 5) * 4;
#pragma unroll
      for (int hh = 0; hh < 4; ++hh) k1[(size_t)r * 768 + (hb + hh) * 96 + 64 + cl] = ob;
    }
  }
}

DI void phase_mla_up(const Params& p, char* smem) {
  bf16* As = (bf16*)smem; bf16* Bs = As + 128 * GLS;
  const bf16* qn = (const bf16*)(p.ws + OFF_QN);
  const bf16* kvn = (const bf16*)(p.ws + OFF_KVN);
  const bf16* wq = (const bf16*)(p.ws + OFF_WT_QUP);
  const bf16* wkv = (const bf16*)(p.ws + OFF_WT_KVUP);
  bf16* q1 = (bf16*)(p.ws + OFF_Q1);
  bf16* k1 = (bf16*)(p.ws + OFF_K1);
  bf16* vt1 = (bf16*)(p.ws + OFF_VT1);
  const float2* rtab = (const float2*)(p.ws + OFF_ROPE1);
  const int lane = get_tid() & 63, w = get_tid() >> 6;
  const int wm = w >> 1, wn = w & 1;
  const int nq = (NLAT / 128) * 6, nkv = (NTOK / 128) * 8;
  for (int t = blockIdx.x; t < nq + nkv; t += gridDim.x) {
    f32x16 acc[2][2];
    if (t < nq) {
      const int mt = t / 6, nt = t % 6;
      gemm_128x128(qn + (size_t)mt * 128 * 384, 384, wq + (size_t)nt * 128 * 384, 384, 384, acc, As, Bs);
#pragma unroll
      for (int mi = 0; mi < 2; ++mi)
#pragma unroll
        for (int ni = 0; ni < 2; ++ni) {
          const int colbase = nt * 128 + wn * 64 + ni * 32;
          const bool rope = (colbase % 96) == 64;
          const int cl = lane & 31;
#pragma unroll
          for (int r = 0; r < 16; ++r) {
            const int row = mt * 128 + wm * 64 + mi * 32 + crow(r, lane);
            float v = acc[mi][ni][r];
            float pr = __shfl_xor(v, 8);
            if (rope) {
              int tt = row & 8191;
              float2 csn = rtab[tt * 16 + ((cl >> 4) << 3) + (cl & 7)];
              v = v * csn.x + ((cl & 8) ? pr * csn.y : -pr * csn.y);
            }
            q1[(size_t)row * 768 + colbase + cl] = f2bf(v * (0.10206207261596577f * 1.4426950408889634f));
          }
        }
    } else {
      const int t2 = t - nq;
      const int mt = t2 >> 3, h = t2 & 7;
      gemm_128x128(kvn + (size_t)mt * 128 * 256, 256, wkv + (size_t)h * 128 * 256, 256, 256, acc, As, Bs);
      const int r0 = mt * 128;
      int b, s0;
      if (r0 < NLAT) { b = r0 >> 13; s0 = CTXL + (r0 & 8191); } else { int rc = r0 - NLAT; b = rc >> 8; s0 = rc & 255; }
#pragma unroll
      for (int mi = 0; mi < 2; ++mi)
#pragma unroll
        for (int ni = 0; ni < 2; ++ni) {
          const int cl = ni * 32 + (lane & 31);
          if (wn == 0) {
#pragma unroll
            for (int r = 0; r < 16; ++r) {
              const int row = r0 + wm * 64 + mi * 32 + crow(r, lane);
              k1[(size_t)row * 768 + h * 96 + cl] = f2bf(acc[mi][ni][r]);
            }
            if (ni == 1) {
              float mxk = 0.f;
#pragma unroll
              for (int r = 0; r < 16; ++r) {
                float sq = acc[mi][0][r] * acc[mi][0][r] + acc[mi][1][r] * acc[mi][1][r];
                sq += __shfl_xor(sq, 16); sq += __shfl_xor(sq, 8); sq += __shfl_xor(sq, 4); sq += __shfl_xor(sq, 2); sq += __shfl_xor(sq, 1);
                const int row = r0 + wm * 64 + mi * 32 + crow(r, lane);
                sq += ((const float*)(p.ws + OFF_KRSQ))[row];
                mxk = fmaxf(mxk, sq);
              }
              mxk = wave_max(mxk);
              if (lane == 0) atomicMax((unsigned*)(p.ws + OFF_KMAX) + b * 8 + h, __float_as_uint(sqrtf(mxk) * 1.02f));
            }
          } else {
            bf16* vrow = vt1 + (size_t)((b * 8 + h) * 64 + cl) * SKEYS + s0 + wm * 64 + mi * 32;
#pragma unroll
            for (int g4 = 0; g4 < 4; ++g4) {
              u32x2 o;
              o.x = cvtpk(acc[mi][ni][4 * g4], acc[mi][ni][4 * g4 + 1]);
              o.y = cvtpk(acc[mi][ni][4 * g4 + 2], acc[mi][ni][4 * g4 + 3]);
              *(u32x2*)(vrow + 8 * g4 + 4 * (lane >> 5)) = o;
            }
          }
        }
    }
  }
}

DI void s5_item(const Params& p, int item, char* smem) {
  const int dir = item & 1, g = (item >> 1) & 31, b = item >> 6;
  constexpr int ULS = 264, SLS = 136;
  bf16* Uc = (bf16*)smem;
  bf16* Sp = Uc + 32 * ULS;
  float* E = (float*)(Sp + 32 * SLS);
  const int mi_ = g * 2 + dir;
  const bf16* T = (const bf16*)(p.ws + OFF_S5T) + (size_t)mi_ * 65536;
  const bf16* WE = (const bf16*)(p.ws + OFF_S5WE) + (size_t)mi_ * 32768;
  const bf16* WY = (const bf16*)(p.ws + OFF_S5WY) + (size_t)mi_ * 32768;
  const float* A16 = (const float*)(p.ws + OFF_S5A16) + (size_t)mi_ * 128;
  const bf16* U1 = (const bf16*)(p.ws + OFF_U1);
  bf16* ys = (bf16*)(p.ws + OFF_YS5) + (size_t)dir * NLAT * 512;
  const int tid = get_tid(), lane = tid & 63, w = tid >> 6;
  auto rowof = [&](int pos) -> int {
    if (pos < CTXL) { int s = dir ? (CTXL - 1 - pos) : pos; return NLAT + b * CTXL + s; }
    int t = pos - CTXL; t = dir ? (SEQ - 1 - t) : t; return b * SEQ + t;
  };
  float sre = 0.f, sim = 0.f;
  const float a16r = A16[(lane & 63) * 2], a16i = A16[(lane & 63) * 2 + 1];
  for (int sc = 0; sc < 17; ++sc) {
    const int nvalid = (528 - sc * 32) < 32 ? (528 - sc * 32) : 32;
    __syncthreads();
    {
      const int n = tid >> 3, j0 = (tid & 7) * 2;
#pragma unroll
      for (int jj = 0; jj < 2; ++jj) {
        u32x4 a = {0u, 0u, 0u, 0u}, b2 = {0u, 0u, 0u, 0u};
        if (n < nvalid) {
          const int pos = (sc * 32 + n) * 16 + j0 + jj;
          const bf16* src = U1 + (size_t)rowof(pos) * 512 + g * 16;
          a = *(const u32x4*)src; b2 = *(const u32x4*)(src + 8);
        }
        *(u32x4*)(Uc + n * ULS + (j0 + jj) * 16) = a;
        *(u32x4*)(Uc + n * ULS + (j0 + jj) * 16 + 8) = b2;
      }
    }
    __syncthreads();
    f32x16 e, y0, y1;
#pragma unroll
    for (int r = 0; r < 16; ++r) { e[r] = 0.f; y0[r] = 0.f; y1[r] = 0.f; }
    mma_tile_ga<256>(e, WE + (size_t)(w * 32) * 256, 256, Uc, ULS);
#pragma unroll
    for (int r = 0; r < 16; ++r) E[(w * 32 + crow(r, lane)) * 33 + (lane & 31)] = e[r];
    mma_tile_ga<256>(y0, T + (size_t)(2 * w * 32) * 256, 256, Uc, ULS);
    mma_tile_ga<256>(y1, T + (size_t)((2 * w + 1) * 32) * 256, 256, Uc, ULS);
    __syncthreads();
    if (w == 0) {
      for (int n = 0; n < 32; ++n) {
        Sp[n * SLS + lane] = f2bf(sre);
        Sp[n * SLS + 64 + lane] = f2bf(sim);
        float er = E[lane * 33 + n], ei = E[(64 + lane) * 33 + n];
        float nr = a16r * sre - a16i * sim + er;
        float ni = a16r * sim + a16i * sre + ei;
        sre = nr; sim = ni;
      }
    }
    __syncthreads();
    mma_tile_ga<128>(y0, WY + (size_t)(2 * w * 32) * 128, 128, Sp, SLS);
    mma_tile_ga<128>(y1, WY + (size_t)((2 * w + 1) * 32) * 128, 128, Sp, SLS);
    {
      const int n = lane & 31;
      if (n < nvalid) {
        const int cgi = sc * 32 + n;
#pragma unroll
        for (int tI = 0; tI < 2; ++tI) {
          const f32x16& y = tI ? y1 : y0;
#pragma unroll
          for (int g4 = 0; g4 < 4; ++g4) {
            const int m = (2 * w + tI) * 32 + 8 * g4 + 4 * (lane >> 5);
            const int i = m >> 4, c0 = m & 15;
            const int pos = cgi * 16 + i;
            if (pos >= CTXL) {
              u32x2 o;
              o.x = cvtpk(y[4 * g4], y[4 * g4 + 1]);
              o.y = cvtpk(y[4 * g4 + 2], y[4 * g4 + 3]);
              *(u32x2*)(ys + (size_t)rowof(pos) * 512 + g * 16 + c0) = o;
            }
          }
        }
      }
    }
  }
}

DI void phase_mix1(const Params& p, char* smem, int cidx) {
  __shared__ int s_item1;
  if (cidx == 1 && blockIdx.x < 256) s5_item(p, blockIdx.x, smem);
  unsigned* cnt = (unsigned*)(p.ws + OFF_CNT) + cidx;
  const bf16* q1 = (const bf16*)(p.ws + OFF_Q1);
  const bf16* k1 = (const bf16*)(p.ws + OFF_K1);
  const bf16* vt = (const bf16*)(p.ws + OFF_VT1);
  bf16* ycat = (bf16*)(p.ws + OFF_ACTA);
  const int n_lat = 4 * 8 * 32;
  while (true) {
    __syncthreads();
    if (get_tid() == 0) s_item1 = (int)atomicAdd(cnt, 1u);
    __syncthreads();
    const int it = s_item1;
    if (it >= n_lat) break;
    const int qt = it & 31, h = (it >> 5) & 7, b = it >> 8;
    const int r0 = b * SEQ + qt * 256;
    attn_item<96, 2>(q1 + (size_t)r0 * 768 + h * 96, 768, k1 + (size_t)(NLAT + b * CTXL) * 768 + h * 96,
                  k1 + (size_t)(b * SEQ) * 768 + h * 96, 768, vt + (size_t)((b * 8 + h) * 64) * SKEYS, SKEYS,
                  ycat + (size_t)r0 * DM + h * 64, DM, 0.10206207261596577f, smem, ((const float*)(p.ws + OFF_KMAX))[b * 8 + h]);
  }
}

DI void phase_s5_z(const Params& p) {
  const bf16* U1 = (const bf16*)(p.ws + OFF_U1);
  const bf16* y0 = (const bf16*)(p.ws + OFF_YS5);
  const bf16* y1 = y0 + (size_t)NLAT * 512;
  bf16* z = (bf16*)(p.ws + OFF_Z1);
  const size_t nv = (size_t)NLAT * 512 / 8;
  for (size_t i = (size_t)blockIdx.x * 256 + get_tid(); i < nv; i += (size_t)gridDim.x * 256) {
    const int col = (int)(i & 63) * 8;
    u32x4 u = ((const u32x4*)U1)[i], a = ((const u32x4*)y0)[i], b2 = ((const u32x4*)y1)[i];
    float fu[8], fa[8], fb[8], o[8];
    f32x16 dummy; (void)dummy;
    fu[0] = bflo(u.x); fu[1] = bfhi(u.x); fu[2] = bflo(u.y); fu[3] = bfhi(u.y); fu[4] = bflo(u.z); fu[5] = bfhi(u.z); fu[6] = bflo(u.w); fu[7] = bfhi(u.w);
    fa[0] = bflo(a.x); fa[1] = bfhi(a.x); fa[2] = bflo(a.y); fa[3] = bfhi(a.y); fa[4] = bflo(a.z); fa[5] = bfhi(a.z); fa[6] = bflo(a.w); fa[7] = bfhi(a.w);
    fb[0] = bflo(b2.x); fb[1] = bfhi(b2.x); fb[2] = bflo(b2.y); fb[3] = bfhi(b2.y); fb[4] = bflo(b2.z); fb[5] = bfhi(b2.z); fb[6] = bflo(b2.w); fb[7] = bfhi(b2.w);
#pragma unroll
    for (int j = 0; j < 8; ++j) o[j] = geluf_(p.s5_d[col + j] * fu[j] + fa[j] + fb[j]);
    u32x4 ov;
    ov.x = cvtpk(o[0], o[1]); ov.y = cvtpk(o[2], o[3]); ov.z = cvtpk(o[4], o[5]); ov.w = cvtpk(o[6], o[7]);
    ((u32x4*)z)[i] = ov;
  }
}

DI void phase_glu(const Params& p, char* smem) {
  bf16* As = (bf16*)smem; bf16* Bs = As + 256 * GLS;
  const bf16* z = (const bf16*)(p.ws + OFF_Z1);
  const bf16* Wt = (const bf16*)(p.ws + OFF_WT_GLU);
  bf16* ycat = (bf16*)(p.ws + OFF_ACTA);
  const int ntn = 4, ntm = NLAT / 256;
  for (int t = blockIdx.x; t < ntn * ntm; t += gridDim.x) {
    const int mt = t / ntn, nt = t % ntn;
    f32x16 acc[4][2];
    gemm_256x128(z + (size_t)mt * 256 * 512, 512, Wt + (size_t)nt * 128 * 512, 512, 512, acc, As, Bs);
    gemm_epi2(acc, [&](int row, int col, float v) {
      int r = mt * 256 + row, cc = nt * 128 + col;
      float zz = bf2f(z[(size_t)r * 512 + cc]);
      ycat[(size_t)r * DM + 512 + cc] = f2bf(zz * sigmoidf_(v + p.s5_b_glu[cc]));
    });
  }
}

DI void phase_final(const Params& p) {
  const int lane = get_tid() & 63, w = get_tid() >> 6;
  for (int r = blockIdx.x * 4 + w; r < NLAT; r += gridDim.x * 4) {
    float* row = p.out + (size_t)r * DM;
    float4 v[4];
    float ss = 0.f;
#pragma unroll
    for (int i = 0; i < 4; ++i) {
      v[i] = ((const float4*)row)[i * 64 + lane];
      ss += v[i].x * v[i].x + v[i].y * v[i].y + v[i].z * v[i].z + v[i].w * v[i].w;
    }
    ss = wave_sum(ss);
    const float rs = rsqrtf(ss * (1.0f / 1024.0f) + EPSN);
#pragma unroll
    for (int i = 0; i < 4; ++i) {
      float4 gg = ((const float4*)p.final_g)[i * 64 + lane];
      float4 o;
      o.x = v[i].x * rs * gg.x; o.y = v[i].y * rs * gg.y; o.z = v[i].z * rs * gg.z; o.w = v[i].w * rs * gg.w;
      ((float4*)row)[i * 64 + lane] = o;
    }
  }
}

DI void phase_copy_x(const Params& p) {
  const size_t n4 = (size_t)NLAT * DM / 4;
  for (size_t i = (size_t)blockIdx.x * 256 + get_tid(); i < n4; i += (size_t)gridDim.x * 256)
    ((float4*)p.out)[i] = ((const float4*)p.x)[i];
}

#define XB_TMO      128
#define XB_XCNT(j)  (256  + 64 * (j))
#define XB_XSUB(j)  (1280 + 64 * (j))
#define XB_XGEN(j)  (2304 + 64 * (j))
#define XB_TOP      3328
#define XB_TOPGEN   3392
#define XCD_BAR_WORDS 3456
#define XB_SPIN_CAP (1u << 22)
#define LAS __attribute__((address_space(3)))

__device__ __forceinline__ unsigned xb_ld(unsigned* p)              { return __hip_atomic_load(p, __ATOMIC_RELAXED, __HIP_MEMORY_SCOPE_AGENT); }
__device__ __forceinline__ unsigned xb_add(unsigned* p, unsigned v) { return __hip_atomic_fetch_add(p, v, __ATOMIC_RELAXED, __HIP_MEMORY_SCOPE_AGENT); }
__device__ __forceinline__ unsigned xb_xcc_id() { return (unsigned)__builtin_amdgcn_s_getreg((3 << 11) | 20) & 0xFu; }
#define XB_SPIN(cond, bar) do { unsigned _sp = 0; while (cond) { __builtin_amdgcn_s_sleep(1); \
    if ((++_sp & 255u) == 0u) { if (xb_ld(&(bar)[XB_TMO])) break; if (_sp > XB_SPIN_CAP) { atomicAdd(&(bar)[XB_TMO], 1u); break; } } } } while (0)

struct XcdBarrier {
    unsigned* bar; unsigned x;
    volatile LAS unsigned* st;
};

__device__ __forceinline__ XcdBarrier xcd_barrier_post(unsigned* bar, volatile LAS unsigned* st) {
    XcdBarrier b; b.bar = bar; b.x = xb_xcc_id(); b.st = st;
    if (threadIdx.x == 0) (void)xb_add(&bar[XB_XCNT(b.x)], 1u);
    return b;
}
__device__ __forceinline__ void xcd_barrier_complete(unsigned* bar, unsigned x, unsigned& nloc, unsigned& nx) {
    const unsigned G = gridDim.x * gridDim.y * gridDim.z;
    unsigned sum, cnt, mine, sp = 0u;
    for (;;) {
        sum = 0u; cnt = 0u; mine = 0u;
#pragma unroll
        for (unsigned j = 0; j < 16; ++j) { const unsigned c = xb_ld(&bar[XB_XCNT(j)]); sum += c; cnt += (c > 0u) ? 1u : 0u; mine = (j == x) ? c : mine; }
        if (sum == G) break;
        __builtin_amdgcn_s_sleep(1);
        if ((++sp & 255u) == 0u) { if (xb_ld(&bar[XB_TMO])) break; if (sp > XB_SPIN_CAP) { atomicAdd(&bar[XB_TMO], 1u); break; } }
    }
    nloc = mine > 0u ? mine : 1u; nx = cnt > 0u ? cnt : 1u;
}

__device__ __forceinline__ void xcd_barrier(const XcdBarrier& b) {
    asm volatile("s_waitcnt vmcnt(0)" ::: "memory");
    __syncthreads();
    if (threadIdx.x == 0) {
        unsigned* bar = b.bar;
        __builtin_amdgcn_s_waitcnt(0);
        unsigned nloc = b.st[0], nx = b.st[1];
        if (nloc == 0u) { xcd_barrier_complete(bar, b.x, nloc, nx); b.st[0] = nloc; b.st[1] = nx; }
        const unsigned old = xb_add(&bar[XB_XSUB(b.x)], 1u);
        const unsigned gen = old / nloc;
        if (old + 1u == (gen + 1u) * nloc) {
            __builtin_amdgcn_fence(__ATOMIC_RELEASE, "agent");
            asm volatile("s_waitcnt vmcnt(0)" ::: "memory");
            const unsigned og = xb_add(&bar[XB_TOP], 1u);
            const unsigned tg = og / nx;
            if (og + 1u == (tg + 1u) * nx) xb_add(&bar[XB_TOPGEN], 1u);
            else XB_SPIN(xb_ld(&bar[XB_TOPGEN]) == tg, bar);
            __builtin_amdgcn_fence(__ATOMIC_ACQUIRE, "agent");
            xb_add(&bar[XB_XGEN(b.x)], 1u);
            asm volatile("s_waitcnt vmcnt(0)" ::: "memory");
        } else {
            XB_SPIN(xb_ld(&bar[XB_XGEN(b.x)]) == gen, bar);
            __builtin_amdgcn_fence(__ATOMIC_ACQUIRE, "agent");
            asm volatile("s_waitcnt vmcnt(0)" ::: "memory");
        }
    }
    __syncthreads();
}
__device__ __forceinline__ void xcd_barrier_fast(const XcdBarrier& b) {
    asm volatile("s_waitcnt vmcnt(0)" ::: "memory");
    __syncthreads();
    if (threadIdx.x == 0) {
        unsigned* bar = b.bar;
        __builtin_amdgcn_s_waitcnt(0);
        unsigned nloc = b.st[0], nx = b.st[1];
        const unsigned old = xb_add(&bar[XB_XSUB(b.x)], 1u);
        const unsigned gen = old / nloc;
        if (old + 1u == (gen + 1u) * nloc) {
            __builtin_amdgcn_fence(__ATOMIC_RELEASE, "agent");
            asm volatile("s_waitcnt vmcnt(0)" ::: "memory");
            const unsigned og = xb_add(&bar[XB_TOP], 1u);
            const unsigned tg = og / nx;
            if (og + 1u == (tg + 1u) * nx) xb_add(&bar[XB_TOPGEN], 1u);
            else XB_SPIN(xb_ld(&bar[XB_TOPGEN]) == tg, bar);
            __builtin_amdgcn_fence(__ATOMIC_ACQUIRE, "agent");
            xb_add(&bar[XB_XGEN(b.x)], 1u);
            asm volatile("s_waitcnt vmcnt(0)" ::: "memory");
        } else {
            XB_SPIN(xb_ld(&bar[XB_XGEN(b.x)]) == gen, bar);
            __builtin_amdgcn_fence(__ATOMIC_ACQUIRE, "agent");
            asm volatile("s_waitcnt vmcnt(0)" ::: "memory");
        }
    }
    __syncthreads();
}


DI void gsync(cg::grid_group& grid) {
  asm volatile("s_waitcnt vmcnt(0) lgkmcnt(0)" ::: "memory");
  __syncthreads();
  if (threadIdx.x == 0) {
    __builtin_amdgcn_fence(__ATOMIC_RELEASE, "agent");
    asm volatile("s_waitcnt vmcnt(0)" ::: "memory");
  }
  grid.sync();
  if (threadIdx.x == 0) {
    __builtin_amdgcn_fence(__ATOMIC_ACQUIRE, "agent");
    asm volatile("s_waitcnt vmcnt(0)" ::: "memory");
  }
  __syncthreads();
}

DI Params load_params() {
  Params r{};
#if defined(__HIP_DEVICE_COMPILE__)
  const __attribute__((address_space(4))) unsigned long long* q =
      (const __attribute__((address_space(4))) unsigned long long*)__builtin_amdgcn_kernarg_segment_ptr();
  asm volatile("" : "+s"(q));
  unsigned long long* d = (unsigned long long*)&r;
  static_assert(sizeof(Params) % 8 == 0, "Params size");
#pragma unroll
  for (int i = 0; i < (int)(sizeof(Params) / 8); ++i) d[i] = q[i];
#endif
  return r;
}
#define P_ p
__global__ void __launch_bounds__(256, 2) fwd_megakernel(Params p) {
  cg::grid_group grid = cg::this_grid();
  __shared__ __attribute__((aligned(16))) char smem[SMEM_BYTES];
  __shared__ uint4 xb_words;
  if (threadIdx.x == 0) xb_words = make_uint4(0u, 0u, 0u, 0u);
  __syncthreads();
  XcdBarrier xb;
  { const Params lp = P_; xb = xcd_barrier_post((unsigned*)(lp.ws + OFF_BAR), (volatile LAS unsigned*)&xb_words); }
  { const Params lp = P_; phase_prep(lp, smem); }
  xcd_barrier(xb);
  { const Params lp = P_; phase_norm(lp, 0, true, lp.norm1_g, 0, NTOK); }
  xcd_barrier_fast(xb);
  { const Params lp = P_; phase_inproj0(lp, smem); }
  xcd_barrier_fast(xb);
  { const Params lp = P_; phase_gqa_prep(lp, smem); }
  xcd_barrier_fast(xb);
  { const Params lp = P_; phase_mix0(lp, smem, 0); }
  xcd_barrier_fast(xb);
  { const Params lp = P_; phase_hg_readout(lp); }
  xcd_barrier_fast(xb);
  { const Params lp = P_; phase_outproj(lp, 0, OFF_WT_EVOUT, NTOK, true, smem); }
  xcd_barrier_fast(xb);
#if STAGE_LIMIT >= 2
  { const Params lp = P_; phase_norm(lp, 0, false, lp.norm2_g, 3, NTOK); }
  { const Params lp = P_; phase_convert_tables(lp, 0); }
  xcd_barrier_fast(xb);
  { const Params lp = P_; phase_peer_route(lp, 0, NTOK, smem); }
  xcd_barrier_fast(xb);
  { const Params lp = P_; phase_peer_gather(lp, 0, NTOK, false); }
  xcd_barrier_fast(xb);
#endif
#if STAGE_LIMIT >= 3
  { const Params lp = P_; phase_inproj1(lp, smem); }
  xcd_barrier_fast(xb);
  { const Params lp = P_; phase_mla_prep(lp); }
  xcd_barrier_fast(xb);
  { const Params lp = P_; phase_mla_up(lp, smem); }
  xcd_barrier_fast(xb);
  { const Params lp = P_; phase_mix1(lp, smem, 1); }
  xcd_barrier_fast(xb);
  { const Params lp = P_; phase_s5_z(lp); }
  xcd_barrier_fast(xb);
  { const Params lp = P_; phase_glu(lp, smem); }
  xcd_barrier_fast(xb);
  { const Params lp = P_; phase_outproj1(lp, smem); }
  xcd_barrier_fast(xb);
#endif
#if STAGE_LIMIT >= 4
  { const Params lp = P_; phase_norm(lp, 1, false, lp.norm2_g + 1024, 3, NLAT); }
  { const Params lp = P_; phase_convert_tables(lp, 1); }
  xcd_barrier_fast(xb);
  { const Params lp = P_; phase_peer_route(lp, 1, NLAT, smem); }
  xcd_barrier_fast(xb);
  { const Params lp = P_; phase_peer_gather(lp, 1, NLAT, false); }
#endif
}

extern "C" void kernel_launch(void* const* d_in, const int* in_sizes, int n_in, void* d_out, int out_size, void* d_ws,
                              size_t ws_size, hipStream_t stream) {
  static int grid_blocks = 0;
  if (!grid_blocks) {
    int dev = 0, cus = 0, per_cu = 0;
    (void)hipGetDevice(&dev);
    (void)hipDeviceGetAttribute(&cus, hipDeviceAttributeMultiprocessorCount, dev);
    (void)hipOccupancyMaxActiveBlocksPerMultiprocessor(&per_cu, fwd_megakernel, 256, 0);
    if (per_cu > 2) per_cu = 2;
    if (per_cu < 1) per_cu = 1;
    grid_blocks = cus * per_cu;
  }
  Params p{};
  const float** pp = (const float**)&p;
  for (int i = 0; i < 35; ++i) pp[i] = (const float*)d_in[i];
  p.out = (float*)d_out;
  p.ws = (char*)d_ws;
  p.rep_mix = REP_MIX; p.rep_route = REP_ROUTE; p.rep_gdry = REP_GDRY; p.rep_gemm = REP_GEMM;
  (void)hipMemsetAsync((char*)d_ws + OFF_CNT, 0, 256 + 16384, stream);
  void* args[] = {&p};
  hipError_t e = hipLaunchCooperativeKernel((void*)fwd_megakernel, dim3(grid_blocks), dim3(256), args, 0, stream);
  if (e != hipSuccess) fprintf(stderr, "cooperative launch failed: %s (grid %d)\n", hipGetErrorString(e), grid_blocks);
}
```

```cpp
#include <hip/hip_runtime.h>
#include <hip/hip_cooperative_groups.h>
#include <cstdio>
namespace cg = cooperative_groups;

#ifndef STAGE_LIMIT
#define STAGE_LIMIT 99
#endif
#define REP_MIX 1
#define REP_ROUTE 1
#define REP_GDRY 0
#define REP_GEMM 1

typedef unsigned short bf16;
typedef __attribute__((ext_vector_type(8))) short bf16x8;
typedef __attribute__((ext_vector_type(4))) short bf16x4;
typedef __attribute__((ext_vector_type(16))) float f32x16;
typedef float f32x2_t __attribute__((ext_vector_type(2)));
typedef unsigned u32x4 __attribute__((ext_vector_type(4)));
typedef unsigned u32x2 __attribute__((ext_vector_type(2)));
typedef __bf16 bf16x2_t __attribute__((ext_vector_type(2)));

#define DI __device__ __forceinline__
#define MFMA32(a, b, c) __builtin_amdgcn_mfma_f32_32x32x16_bf16((a), (b), (c), 0, 0, 0)

constexpr int NLAT = 32768, NCTX = 1024, NTOK = 33792, DM = 1024;
constexpr int SEQ = 8192, CTXL = 256, SKEYS = 8448;
constexpr float EPSN = 1e-6f;

constexpr size_t al256(size_t x) { return (x + 255) & ~(size_t)255; }
constexpr size_t OFF_WT_EVIN = 0;
constexpr size_t OFF_WT_EVOUT = OFF_WT_EVIN + al256((size_t)3328 * 1024 * 2);
constexpr size_t OFF_WT_ODIN = OFF_WT_EVOUT + al256((size_t)1024 * 1024 * 2);
constexpr size_t OFF_WT_ODOUT = OFF_WT_ODIN + al256((size_t)1280 * 1024 * 2);
constexpr size_t OFF_WT_QUP = OFF_WT_ODOUT + al256((size_t)1024 * 1024 * 2);
constexpr size_t OFF_WT_KVUP = OFF_WT_QUP + al256((size_t)768 * 384 * 2);
constexpr size_t OFF_WT_GLU = OFF_WT_KVUP + al256((size_t)1024 * 256 * 2);
constexpr size_t OFF_WT_PWQ = OFF_WT_GLU + al256((size_t)512 * 512 * 2);
constexpr size_t OFF_PKEYS = OFF_WT_PWQ + al256((size_t)2 * 2048 * 1024 * 2);
constexpr size_t OFF_MOD = OFF_PKEYS + al256((size_t)2 * 8 * 2 * 128 * 128 * 2);
constexpr size_t OFF_S5T = OFF_MOD + al256((size_t)2 * 5 * 6144 * 4);
constexpr size_t OFF_S5WE = OFF_S5T + al256((size_t)64 * 256 * 256 * 2);
constexpr size_t OFF_S5WY = OFF_S5WE + al256((size_t)64 * 128 * 256 * 2);
constexpr size_t OFF_S5A16 = OFF_S5WY + al256((size_t)64 * 256 * 128 * 2);
constexpr size_t OFF_CNT = OFF_S5A16 + al256((size_t)64 * 64 * 2 * 4);
constexpr size_t OFF_BAR = OFF_CNT + 256;
constexpr size_t OFF_ROPE1 = OFF_BAR + 16384;
constexpr size_t OFF_SU = OFF_ROPE1 + al256((size_t)8192 * 16 * 8);
constexpr size_t OFF_SV = OFF_SU + 65536;
constexpr size_t OFF_KMAX = OFF_SV + 65536;
constexpr size_t OFF_KRSQ = OFF_KMAX + 256;
constexpr size_t OFF_XC = OFF_KRSQ + al256((size_t)NTOK * 4);
constexpr size_t OFF_UTAB = OFF_XC + al256((size_t)NCTX * DM * 4);
constexpr size_t OFF_VTAB = OFF_UTAB + al256((size_t)16384 * 1024 * 2);
constexpr size_t OFF_ACTA = OFF_VTAB + al256((size_t)16384 * 1024 * 2);
constexpr size_t OFF_WQB = OFF_UTAB + (size_t)16 * 1024 * 1024;
constexpr size_t OFF_BIG = OFF_ACTA + al256((size_t)NTOK * DM * 2);
constexpr size_t OFF_PAGQA = OFF_BIG;
constexpr size_t OFF_VT0 = OFF_PAGQA + al256((size_t)NTOK * 768 * 2);
constexpr size_t OFF_PAHG = OFF_VT0 + al256((size_t)512 * SKEYS * 2);
constexpr size_t OFF_OHG = OFF_PAHG + al256((size_t)NTOK * 2560 * 2);
constexpr size_t OFF_END0 = OFF_OHG + al256((size_t)2 * NTOK * 512 * 2);
constexpr size_t OFF_K1 = OFF_BIG;
constexpr size_t OFF_PA1M = OFF_K1 + al256((size_t)NTOK * 768 * 2);
constexpr size_t OFF_Q1 = OFF_PA1M;
constexpr size_t OFF_U1 = OFF_PA1M + al256((size_t)NTOK * 768 * 2);
constexpr size_t OFF_QN = OFF_U1 + al256((size_t)NTOK * 512 * 2);
constexpr size_t OFF_KVN = OFF_QN + al256((size_t)NLAT * 384 * 2);
constexpr size_t OFF_Z1 = OFF_QN;
constexpr size_t OFF_KROPE = OFF_KVN + al256((size_t)NTOK * 256 * 2);
constexpr size_t OFF_VT1 = OFF_KROPE + al256((size_t)NTOK * 32 * 2);
constexpr size_t OFF_YS5 = OFF_VT1 + al256((size_t)2048 * SKEYS * 2);
constexpr size_t OFF_END1 = OFF_YS5 + al256((size_t)2 * NLAT * 512 * 2);
constexpr size_t OFF_RIDX = OFF_BIG;
constexpr size_t OFF_RGW = OFF_RIDX + al256((size_t)NTOK * 128 * 4);
constexpr size_t WS_NEEDED = (OFF_END0 > OFF_END1 ? OFF_END0 : OFF_END1);
static_assert(OFF_RGW + (size_t)NTOK * 128 * 4 <= OFF_VT0, "route alias overflow");
static_assert((size_t)NLAT * 512 * 2 <= (OFF_KROPE - OFF_QN), "z alias overflow");
static_assert(WS_NEEDED < (size_t)500 * 1024 * 1024, "workspace too large");
static_assert(3 * (size_t)16384 * 512 + 65536 <= (size_t)16384 * 1024 * 2, "table region overflow");

constexpr int SMEM_BYTES = 78 * 1024;

struct Params {
  const float *x, *c, *ctx, *c_ctx, *ada_w, *ada_b, *norm1_g, *norm2_g, *ev_w_in, *ev_w_out, *gqa_qn_g, *gqa_kn_g,
      *hg_lb_logits, *hg_onorm_g, *od_w_in, *od_w_out, *mla_qa_g, *mla_w_qup, *mla_kva_g, *mla_w_kvup, *s5_a_re, *s5_a_im,
      *s5_log_dt, *s5_b_re, *s5_b_im, *s5_c_re, *s5_c_im, *s5_d, *s5_w_glu, *s5_b_glu, *peer_wq, *peer_keys, *peer_u,
      *peer_v, *final_g;
  float* out;
  char* ws;
  int rep_mix, rep_route, rep_gdry, rep_gemm;
};

DI int get_tid() { int t = threadIdx.x; asm volatile("" : "+v"(t)); return t; }
DI bf16 f2bf(float x) {
  unsigned u = __float_as_uint(x);
  u += 0x7fffu + ((u >> 16) & 1u);
  return (bf16)(u >> 16);
}
DI float bf2f(bf16 h) { return __uint_as_float(((unsigned)h) << 16); }
DI unsigned cvtpk(float lo, float hi) {
  f32x2_t v = {lo, hi};
  bf16x2_t b = __builtin_convertvector(v, bf16x2_t);
  return __builtin_bit_cast(unsigned, b);
}
DI float bflo(unsigned u) { return __uint_as_float(u << 16); }
DI float bfhi(unsigned u) { return __uint_as_float(u & 0xffff0000u); }
DI float wave_sum(float v) {
#pragma unroll
  for (int o = 32; o > 0; o >>= 1) v += __shfl_xor(v, o);
  return v;
}
DI float wave_max_early(float v) {
#pragma unroll
  for (int o = 32; o > 0; o >>= 1) v = fmaxf(v, __shfl_xor(v, o));
  return v;
}
DI float sigmoidf_(float x) { return 1.0f / (1.0f + __expf(-x)); }
DI float siluf_(float x) { return x * sigmoidf_(x); }
DI float geluf_(float x) { return 0.5f * x * (1.0f + erff(x * 0.70710678118654752f)); }
DI float gelu_as(float x) {
  const float z = x * 0.70710678118654752f, az = fabsf(z);
  const float t = __builtin_amdgcn_rcpf(fmaf(0.3275911f, az, 1.0f));
  const float poly = t * fmaf(t, fmaf(t, fmaf(t, fmaf(t, 1.061405429f, -1.453152027f), 1.421413741f), -0.284496736f), 0.254829592f);
  const float e = __builtin_amdgcn_exp2f(az * az * -1.4426950408889634f);
  const float er = copysignf(fmaf(-poly, e, 1.0f), z);
  const float hx = 0.5f * x;
  return fmaf(hx, er, hx);
}

DI const float* orig_row(const Params& p, int r) {
  return r < NLAT ? p.x + (size_t)r * DM : p.ctx + (size_t)(r - NLAT) * DM;
}
DI float* res_row(const Params& p, int r) {
  return r < NLAT ? p.out + (size_t)r * DM : (float*)(p.ws + OFF_XC) + (size_t)(r - NLAT) * DM;
}
DI int mod_row(int r) { return r < NLAT ? (r >> 13) : 4; }
DI const float* mod_ptr(const Params& p, int layer, int r, int chunk) {
  return (const float*)(p.ws + OFF_MOD) + ((size_t)(layer * 5 + mod_row(r)) * 6 + chunk) * 1024;
}

constexpr int GLS = 72;
DI void gemm_128x128(const bf16* __restrict__ A, int lda, const bf16* __restrict__ Bt, int ldb, int K, f32x16 (&acc)[2][2],
                     bf16* As, bf16* Bs) {
  const int tid = get_tid(), lane = tid & 63, w = tid >> 6;
  const int wm = w >> 1, wn = w & 1;
  const int lr = tid >> 3, lc = (tid & 7) * 8;
  u32x4 ra[4], rb[4];
#pragma unroll
  for (int i = 0; i < 4; ++i) {
    ra[i] = *(const u32x4*)(A + (size_t)(i * 32 + lr) * lda + lc);
    rb[i] = *(const u32x4*)(Bt + (size_t)(i * 32 + lr) * ldb + lc);
  }
#pragma unroll
  for (int i = 0; i < 2; ++i)
#pragma unroll
    for (int j = 0; j < 2; ++j)
#pragma unroll
      for (int r = 0; r < 16; ++r) acc[i][j][r] = 0.f;
  for (int k0 = 0; k0 < K; k0 += 64) {
    __syncthreads();
#pragma unroll
    for (int i = 0; i < 4; ++i) {
      *(u32x4*)(As + (i * 32 + lr) * GLS + lc) = ra[i];
      *(u32x4*)(Bs + (i * 32 + lr) * GLS + lc) = rb[i];
    }
    __syncthreads();
    if (k0 + 64 < K) {
#pragma unroll
      for (int i = 0; i < 4; ++i) {
        ra[i] = *(const u32x4*)(A + (size_t)(i * 32 + lr) * lda + k0 + 64 + lc);
        rb[i] = *(const u32x4*)(Bt + (size_t)(i * 32 + lr) * ldb + k0 + 64 + lc);
      }
    }
#pragma unroll
    for (int ks = 0; ks < 64; ks += 16) {
      const int ko = ks + (lane >> 5) * 8;
      bf16x8 a0 = *(const bf16x8*)(As + (wm * 64 + (lane & 31)) * GLS + ko);
      bf16x8 a1 = *(const bf16x8*)(As + (wm * 64 + 32 + (lane & 31)) * GLS + ko);
      bf16x8 b0 = *(const bf16x8*)(Bs + (wn * 64 + (lane & 31)) * GLS + ko);
      bf16x8 b1 = *(const bf16x8*)(Bs + (wn * 64 + 32 + (lane & 31)) * GLS + ko);
      acc[0][0] = MFMA32(a0, b0, acc[0][0]);
      acc[0][1] = MFMA32(a0, b1, acc[0][1]);
      acc[1][0] = MFMA32(a1, b0, acc[1][0]);
      acc[1][1] = MFMA32(a1, b1, acc[1][1]);
    }
  }
}
template <class H>
DI void gemm_128x128_hook(const bf16* __restrict__ A, int lda, const bf16* __restrict__ Bt, int ldb, f32x16 (&acc)[2][2],
                          bf16* As, bf16* Bs, H hook) {
  const int tid = get_tid(), lane = tid & 63, w = tid >> 6;
  const int wm = w >> 1, wn = w & 1;
  const int lr = tid >> 3, lc = (tid & 7) * 8;
  u32x4 ra[4], rb[4];
#pragma unroll
  for (int i = 0; i < 4; ++i) {
    ra[i] = *(const u32x4*)(A + (size_t)(i * 32 + lr) * lda + lc);
    rb[i] = *(const u32x4*)(Bt + (size_t)(i * 32 + lr) * ldb + lc);
  }
#pragma unroll
  for (int i = 0; i < 2; ++i)
#pragma unroll
    for (int j = 0; j < 2; ++j)
#pragma unroll
      for (int r = 0; r < 16; ++r) acc[i][j][r] = 0.f;
#pragma unroll
  for (int kk = 0; kk < 16; ++kk) {
    const int k0 = kk * 64;
    __syncthreads();
#pragma unroll
    for (int i = 0; i < 4; ++i) {
      *(u32x4*)(As + (i * 32 + lr) * GLS + lc) = ra[i];
      *(u32x4*)(Bs + (i * 32 + lr) * GLS + lc) = rb[i];
    }
    __syncthreads();
    if (kk + 1 < 16) {
#pragma unroll
      for (int i = 0; i < 4; ++i) {
        ra[i] = *(const u32x4*)(A + (size_t)(i * 32 + lr) * lda + k0 + 64 + lc);
        rb[i] = *(const u32x4*)(Bt + (size_t)(i * 32 + lr) * ldb + k0 + 64 + lc);
      }
    }
#pragma unroll
    for (int ks = 0; ks < 64; ks += 16) {
      const int ko = ks + (lane >> 5) * 8;
      bf16x8 a0 = *(const bf16x8*)(As + (wm * 64 + (lane & 31)) * GLS + ko);
      bf16x8 a1 = *(const bf16x8*)(As + (wm * 64 + 32 + (lane & 31)) * GLS + ko);
      bf16x8 b0 = *(const bf16x8*)(Bs + (wn * 64 + (lane & 31)) * GLS + ko);
      bf16x8 b1 = *(const bf16x8*)(Bs + (wn * 64 + 32 + (lane & 31)) * GLS + ko);
      acc[0][0] = MFMA32(a0, b0, acc[0][0]);
      acc[0][1] = MFMA32(a0, b1, acc[0][1]);
      acc[1][0] = MFMA32(a1, b0, acc[1][0]);
      acc[1][1] = MFMA32(a1, b1, acc[1][1]);
    }
    hook(kk);
  }
}
DI void gemm_128x128_cols(const bf16* __restrict__ A, int lda, const bf16* __restrict__ Bt, int ldb, int K, f32x16 (&st)[4],
                          bf16* As, bf16* Bs) {
  const int tid = get_tid(), lane = tid & 63, w = tid >> 6;
  const int lr = tid >> 3, lc = (tid & 7) * 8;
  u32x4 ra[4], rb[4];
#pragma unroll
  for (int i = 0; i < 4; ++i) {
    ra[i] = *(const u32x4*)(A + (size_t)(i * 32 + lr) * lda + lc);
    rb[i] = *(const u32x4*)(Bt + (size_t)(i * 32 + lr) * ldb + lc);
  }
#pragma unroll
  for (int i = 0; i < 4; ++i)
#pragma unroll
    for (int r = 0; r < 16; ++r) st[i][r] = 0.f;
  for (int k0 = 0; k0 < K; k0 += 64) {
    __syncthreads();
#pragma unroll
    for (int i = 0; i < 4; ++i) {
      *(u32x4*)(As + (i * 32 + lr) * GLS + lc) = ra[i];
      *(u32x4*)(Bs + (i * 32 + lr) * GLS + lc) = rb[i];
    }
    __syncthreads();
    if (k0 + 64 < K) {
#pragma unroll
      for (int i = 0; i < 4; ++i) {
        ra[i] = *(const u32x4*)(A + (size_t)(i * 32 + lr) * lda + k0 + 64 + lc);
        rb[i] = *(const u32x4*)(Bt + (size_t)(i * 32 + lr) * ldb + k0 + 64 + lc);
      }
    }
#pragma unroll
    for (int ks = 0; ks < 64; ks += 16) {
      const int ko = ks + (lane >> 5) * 8;
      bf16x8 b = *(const bf16x8*)(Bs + (w * 32 + (lane & 31)) * GLS + ko);
#pragma unroll
      for (int i = 0; i < 4; ++i) {
        bf16x8 a = *(const bf16x8*)(As + (i * 32 + (lane & 31)) * GLS + ko);
        st[i] = MFMA32(a, b, st[i]);
      }
    }
  }
}
template <class H>
DI void gemm_128x128_cols_hook(const bf16* __restrict__ A, int lda, const bf16* __restrict__ Bt, int ldb, f32x16 (&st)[4],
                               bf16* As, bf16* Bs, H hook) {
  const int tid = get_tid(), lane = tid & 63, w = tid >> 6;
  const int lr = tid >> 3, lc = (tid & 7) * 8;
  u32x4 ra[4], rb[4];
#pragma unroll
  for (int i = 0; i < 4; ++i) {
    ra[i] = *(const u32x4*)(A + (size_t)(i * 32 + lr) * lda + lc);
    rb[i] = *(const u32x4*)(Bt + (size_t)(i * 32 + lr) * ldb + lc);
  }
#pragma unroll
  for (int i = 0; i < 4; ++i)
#pragma unroll
    for (int r = 0; r < 16; ++r) st[i][r] = 0.f;
#pragma unroll
  for (int kk = 0; kk < 16; ++kk) {
    const int k0 = kk * 64;
    __syncthreads();
#pragma unroll
    for (int i = 0; i < 4; ++i) {
      *(u32x4*)(As + (i * 32 + lr) * GLS + lc) = ra[i];
      *(u32x4*)(Bs + (i * 32 + lr) * GLS + lc) = rb[i];
    }
    __syncthreads();
    if (kk + 1 < 16) {
#pragma unroll
      for (int i = 0; i < 4; ++i) {
        ra[i] = *(const u32x4*)(A + (size_t)(i * 32 + lr) * lda + k0 + 64 + lc);
        rb[i] = *(const u32x4*)(Bt + (size_t)(i * 32 + lr) * ldb + k0 + 64 + lc);
      }
    }
#pragma unroll
    for (int ks = 0; ks < 64; ks += 16) {
      const int ko = ks + (lane >> 5) * 8;
      bf16x8 b = *(const bf16x8*)(Bs + (w * 32 + (lane & 31)) * GLS + ko);
#pragma unroll
      for (int i = 0; i < 4; ++i) {
        bf16x8 a = *(const bf16x8*)(As + (i * 32 + (lane & 31)) * GLS + ko);
        st[i] = MFMA32(a, b, st[i]);
      }
    }
    hook(kk);
  }
}
template <class F>
DI void gemm_epi(f32x16 (&acc)[2][2], F f) {
  const int lane = get_tid() & 63, w = get_tid() >> 6;
  const int wm = w >> 1, wn = w & 1;
#pragma unroll
  for (int mi = 0; mi < 2; ++mi)
#pragma unroll
    for (int ni = 0; ni < 2; ++ni)
#pragma unroll
      for (int r = 0; r < 16; ++r) {
        int row = wm * 64 + mi * 32 + (r & 3) + 8 * (r >> 2) + 4 * (lane >> 5);
        int col = wn * 64 + ni * 32 + (lane & 31);
        f(row, col, acc[mi][ni][r]);
      }
}

DI void gemm_256x128(const bf16* __restrict__ A, int lda, const bf16* __restrict__ Bt, int ldb, int K, f32x16 (&acc)[4][2],
                     bf16* As, bf16* Bs) {
  const int tid = get_tid(), lane = tid & 63, w = tid >> 6;
  const int wm = w >> 1, wn = w & 1;
  const int lr = tid >> 3, lc = (tid & 7) * 8;
  u32x4 ra[8], rb[4];
#pragma unroll
  for (int i = 0; i < 8; ++i) ra[i] = *(const u32x4*)(A + (size_t)(i * 32 + lr) * lda + lc);
#pragma unroll
  for (int i = 0; i < 4; ++i) rb[i] = *(const u32x4*)(Bt + (size_t)(i * 32 + lr) * ldb + lc);
#pragma unroll
  for (int i = 0; i < 4; ++i)
#pragma unroll
    for (int j = 0; j < 2; ++j)
#pragma unroll
      for (int r = 0; r < 16; ++r) acc[i][j][r] = 0.f;
  for (int k0 = 0; k0 < K; k0 += 64) {
    __syncthreads();
#pragma unroll
    for (int i = 0; i < 8; ++i) *(u32x4*)(As + (i * 32 + lr) * GLS + lc) = ra[i];
#pragma unroll
    for (int i = 0; i < 4; ++i) *(u32x4*)(Bs + (i * 32 + lr) * GLS + lc) = rb[i];
    __syncthreads();
    if (k0 + 64 < K) {
#pragma unroll
      for (int i = 0; i < 8; ++i) ra[i] = *(const u32x4*)(A + (size_t)(i * 32 + lr) * lda + k0 + 64 + lc);
#pragma unroll
      for (int i = 0; i < 4; ++i) rb[i] = *(const u32x4*)(Bt + (size_t)(i * 32 + lr) * ldb + k0 + 64 + lc);
    }
#pragma unroll
    for (int ks = 0; ks < 64; ks += 16) {
      const int ko = ks + (lane >> 5) * 8;
      bf16x8 b0 = *(const bf16x8*)(Bs + (wn * 64 + (lane & 31)) * GLS + ko);
      bf16x8 b1 = *(const bf16x8*)(Bs + (wn * 64 + 32 + (lane & 31)) * GLS + ko);
#pragma unroll
      for (int mi = 0; mi < 4; ++mi) {
        bf16x8 a = *(const bf16x8*)(As + (wm * 128 + mi * 32 + (lane & 31)) * GLS + ko);
        acc[mi][0] = MFMA32(a, b0, acc[mi][0]);
        acc[mi][1] = MFMA32(a, b1, acc[mi][1]);
      }
    }
  }
}
template <class F>
DI void gemm_epi2(f32x16 (&acc)[4][2], F f) {
  const int lane = get_tid() & 63, w = get_tid() >> 6;
  const int wm = w >> 1, wn = w & 1;
#pragma unroll
  for (int mi = 0; mi < 4; ++mi)
#pragma unroll
    for (int ni = 0; ni < 2; ++ni)
#pragma unroll
      for (int r = 0; r < 16; ++r) {
        int row = wm * 128 + mi * 32 + (r & 3) + 8 * (r >> 2) + 4 * (lane >> 5);
        int col = wn * 64 + ni * 32 + (lane & 31);
        f(row, col, acc[mi][ni][r]);
      }
}

DI void mma_tile(f32x16& acc, const bf16* A, int lda, const bf16* Bt, int ldb, int K) {
  const int lane = get_tid() & 63;
  const bf16* ap = A + (size_t)(lane & 31) * lda + (lane >> 5) * 8;
  const bf16* bp = Bt + (size_t)(lane & 31) * ldb + (lane >> 5) * 8;
#pragma unroll 4
  for (int ks = 0; ks < K; ks += 16) {
    bf16x8 a = *(const bf16x8*)(ap + ks);
    bf16x8 b = *(const bf16x8*)(bp + ks);
    acc = MFMA32(a, b, acc);
  }
}
template <int K>
DI void mma_tile_ga(f32x16& acc, const bf16* __restrict__ A, int lda, const bf16* Bt, int ldb) {
  const int lane = get_tid() & 63;
  const bf16* ap = A + (size_t)(lane & 31) * lda + (lane >> 5) * 8;
  const bf16* bp = Bt + (size_t)(lane & 31) * ldb + (lane >> 5) * 8;
  bf16x8 af[K / 16];
#pragma unroll
  for (int i = 0; i < K / 16; ++i) af[i] = *(const bf16x8*)(ap + i * 16);
#pragma unroll
  for (int i = 0; i < K / 16; ++i) {
    bf16x8 b = *(const bf16x8*)(bp + i * 16);
    acc = MFMA32(af[i], b, acc);
  }
}
DI int crow(int r, int lane) { return (r & 3) + 8 * (r >> 2) + 4 * (lane >> 5); }

DI void prep_transpose(const float* __restrict__ W, int K, int N, int Npad, bf16* __restrict__ Wt, int tile, float* tl) {
  const int ntn = Npad / 64;
  const int kt = tile / ntn, nt = tile % ntn;
  const int k0 = kt * 64, n0 = nt * 64;
  const int tid = get_tid();
  __syncthreads();
  for (int i = 0; i < 16; ++i) {
    int r = i * 4 + (tid >> 6), cidx = tid & 63;
    int n = n0 + cidx;
    float v = (n < N) ? W[(size_t)(k0 + r) * N + n] : 0.f;
    tl[cidx * 65 + r] = v;
  }
  __syncthreads();
  for (int i = 0; i < 16; ++i) {
    int n = i * 4 + (tid >> 6), k = tid & 63;
    Wt[(size_t)(n0 + n) * K + k0 + k] = f2bf(tl[n * 65 + k]);
  }
}

DI void convert_bf16(const float* __restrict__ src, bf16* __restrict__ dst, size_t n, int bid, int nb) {
  size_t nv = n / 8;
  for (size_t i = (size_t)bid * 256 + get_tid(); i < nv; i += (size_t)nb * 256) {
    float4 a = ((const float4*)src)[2 * i], b = ((const float4*)src)[2 * i + 1];
    u32x4 o;
    o.x = cvtpk(a.x, a.y); o.y = cvtpk(a.z, a.w); o.z = cvtpk(b.x, b.y); o.w = cvtpk(b.z, b.w);
    ((u32x4*)dst)[i] = o;
  }
}

DI void prep_mod(const Params& p, int item, float* sm) {
  const int l = item / 96, n0 = (item % 96) * 64;
  const int tid = get_tid(), lane = tid & 63, w = tid >> 6;
  const float* W = p.ada_w + (size_t)l * 1024 * 6144 + n0 + lane;
  float* sc = sm;
  float* red = sm + 5 * 1024;
  __syncthreads();
  for (int i = tid; i < 5 * 1024; i += 256) {
    const int r = i >> 10, k = i & 1023;
    sc[i] = siluf_(r < 4 ? p.c[r * 1024 + k] : p.c_ctx[k]);
  }
  __syncthreads();
  float acc[5] = {0.f, 0.f, 0.f, 0.f, 0.f};
#pragma unroll 1
  for (int k0 = w * 256; k0 < w * 256 + 256; k0 += 16) {
    float wv[16];
#pragma unroll
    for (int j = 0; j < 16; ++j) wv[j] = W[(size_t)(k0 + j) * 6144];
#pragma unroll
    for (int j = 0; j < 16; ++j) {
#pragma unroll
      for (int r = 0; r < 5; ++r) acc[r] += sc[r * 1024 + k0 + j] * wv[j];
    }
  }
#pragma unroll
  for (int r = 0; r < 5; ++r) red[(w * 5 + r) * 64 + lane] = acc[r];
  __syncthreads();
  if (w == 0) {
    float* M = (float*)(p.ws + OFF_MOD);
#pragma unroll
    for (int r = 0; r < 5; ++r) {
      float s2 = red[(0 * 5 + r) * 64 + lane] + red[(1 * 5 + r) * 64 + lane] + red[(2 * 5 + r) * 64 + lane] + red[(3 * 5 + r) * 64 + lane];
      M[(size_t)(l * 5 + r) * 6144 + n0 + lane] = s2 + p.ada_b[l * 6144 + n0 + lane];
    }
  }
}

DI void prep_s5(const Params& p, int item4, float* sm) {
  const int item = item4 >> 2, qtr = item4 & 3;
  const int g = item >> 1, d = item & 1;
  const int tid = get_tid();
  float* pw = sm;
  float* bb = sm + 17 * 128;
  float* kc = bb + 64 * 32;
  __syncthreads();
  const float dt = __expf(p.s5_log_dt[d * 32 + g]);
  if (tid < 64) {
    const int pp = tid;
    const float are = p.s5_a_re[(d * 32 + g) * 64 + pp], aim = p.s5_a_im[(d * 32 + g) * 64 + pp];
    for (int n = 0; n <= 16; ++n) {
      float mag = expf(are * dt * n);
      float sn, cs;
      sincosf(aim * dt * n, &sn, &cs);
      pw[(n * 64 + pp) * 2 + 0] = mag * cs;
      pw[(n * 64 + pp) * 2 + 1] = mag * sn;
    }
    float abr = pw[(64 + pp) * 2 + 0] - 1.0f, abi = pw[(64 + pp) * 2 + 1];
    float den = are * are + aim * aim;
    float qr = (abr * are + abi * aim) / den, qi = (abi * are - abr * aim) / den;
    for (int c2 = 0; c2 < 16; ++c2) {
      float br = p.s5_b_re[((size_t)(d * 32 + g) * 64 + pp) * 16 + c2], bi = p.s5_b_im[((size_t)(d * 32 + g) * 64 + pp) * 16 + c2];
      bb[(pp * 16 + c2) * 2 + 0] = qr * br - qi * bi;
      bb[(pp * 16 + c2) * 2 + 1] = qr * bi + qi * br;
    }
    float* A16 = (float*)(p.ws + OFF_S5A16) + (size_t)item * 128;
    A16[pp * 2 + 0] = pw[(16 * 64 + pp) * 2 + 0];
    A16[pp * 2 + 1] = pw[(16 * 64 + pp) * 2 + 1];
  }
  float* cre = kc + 4096;
  float* cim = cre + 1024;
  for (int e = tid; e < 1024; e += 256) {
    cre[e] = p.s5_c_re[(size_t)(d * 32 + g) * 1024 + e];
    cim[e] = p.s5_c_im[(size_t)(d * 32 + g) * 1024 + e];
  }
  __syncthreads();
  for (int e = tid; e < (4 * qtr + 4) * 256; e += 256) {
    int tau = e >> 8, c = (e >> 4) & 15, c2 = e & 15;
    float s = 0.f;
    for (int pp = 0; pp < 64; ++pp) {
      float cr = cre[c * 64 + pp], ci = cim[c * 64 + pp];
      float wr = pw[(tau * 64 + pp) * 2], wi = pw[(tau * 64 + pp) * 2 + 1];
      float zr = cr * wr - ci * wi, zi = cr * wi + ci * wr;
      float br = bb[(pp * 16 + c2) * 2], bi = bb[(pp * 16 + c2) * 2 + 1];
      s += zr * br - zi * bi;
    }
    kc[e] = s;
  }
  __syncthreads();
  bf16* T = (bf16*)(p.ws + OFF_S5T) + (size_t)item * 65536;
  for (int e = qtr * 16384 + tid; e < (qtr + 1) * 16384; e += 256) {
    int m = e >> 8, k = e & 255;
    int i = m >> 4, c = m & 15, j = k >> 4, c2 = k & 15;
    float v = (i >= j) ? kc[((i - j) * 16 + c) * 16 + c2] : 0.f;
    T[e] = f2bf(v);
  }
  bf16* WE = (bf16*)(p.ws + OFF_S5WE) + (size_t)item * 32768;
  for (int e = qtr * 8192 + tid; e < (qtr + 1) * 8192; e += 256) {
    int pr = e >> 8, k = e & 255;
    int pp = pr & 63, im = pr >> 6, j = k >> 4, c2 = k & 15;
    float wr = pw[((15 - j) * 64 + pp) * 2], wi = pw[((15 - j) * 64 + pp) * 2 + 1];
    float br = bb[(pp * 16 + c2) * 2], bi = bb[(pp * 16 + c2) * 2 + 1];
    float v = im ? (wr * bi + wi * br) : (wr * br - wi * bi);
    WE[e] = f2bf(v);
  }
  bf16* WY = (bf16*)(p.ws + OFF_S5WY) + (size_t)item * 32768;
  for (int e = qtr * 8192 + tid; e < (qtr + 1) * 8192; e += 256) {
    int m = e >> 7, pr = e & 127;
    int i = m >> 4, c = m & 15, pp = pr & 63, im = pr >> 6;
    float cr = cre[c * 64 + pp], ci = cim[c * 64 + pp];
    float wr = pw[((i + 1) * 64 + pp) * 2], wi = pw[((i + 1) * 64 + pp) * 2 + 1];
    float zr = cr * wr - ci * wi, zi = cr * wi + ci * wr;
    WY[e] = f2bf(im ? -zi : zr);
  }
}

DI void phase_prep(const Params& p, char* smem) {
  const int bid = blockIdx.x, nb = gridDim.x;
  float* sm = (float*)smem;
  if (bid == 0 && get_tid() < 64) ((unsigned*)(p.ws + OFF_KMAX))[get_tid()] = 0u;
  {
    float2* tab = (float2*)(p.ws + OFF_ROPE1);
    for (int e = bid * 256 + get_tid(); e < 8192 * 16; e += nb * 256) {
      int t = e >> 4, f = e & 15;
      float pos = (f < 8) ? (float)(t >> 6) : (float)(t & 63);
      float inv = powf(10000.f, -(float)(f & 7) / 8.f);
      float sn, cs;
      sincosf(pos * inv, &sn, &cs);
      tab[e] = make_float2(cs, sn);
    }
  }
  const int n_mod = 192, n_s5 = 256;
  constexpr int T0 = 16 * 52, T1 = 16 * 16, T2 = 16 * 20, T3 = 16 * 16, T4 = 6 * 12, T5 = 4 * 16, T6 = 8 * 8, T7 = 0, T8 = 0;
  constexpr int NTR = T0 + T1 + T2 + T3 + T4 + T5 + T6 + T7 + T8;
  const int total = n_mod + n_s5 + NTR;
  for (int it = bid; it < total; it += nb) {
    if (it < n_s5) prep_s5(p, it, sm);
    else if (it < n_mod + n_s5) prep_mod(p, it - n_s5, sm);
    else {
      int t = it - n_mod - n_s5;
      if (t < T0) { prep_transpose(p.ev_w_in, 1024, 3328, 3328, (bf16*)(p.ws + OFF_WT_EVIN), t, sm); continue; }
      t -= T0;
      if (t < T1) { prep_transpose(p.ev_w_out, 1024, 1024, 1024, (bf16*)(p.ws + OFF_WT_EVOUT), t, sm); continue; }
      t -= T1;
      if (t < T2) { prep_transpose(p.od_w_in, 1024, 1184, 1280, (bf16*)(p.ws + OFF_WT_ODIN), t, sm); continue; }
      t -= T2;
      if (t < T3) { prep_transpose(p.od_w_out, 1024, 1024, 1024, (bf16*)(p.ws + OFF_WT_ODOUT), t, sm); continue; }
      t -= T3;
      if (t < T4) { prep_transpose(p.mla_w_qup, 384, 768, 768, (bf16*)(p.ws + OFF_WT_QUP), t, sm); continue; }
      t -= T4;
      if (t < T5) { prep_transpose(p.mla_w_kvup, 256, 1024, 1024, (bf16*)(p.ws + OFF_WT_KVUP), t, sm); continue; }
      t -= T5;
      if (t < T6) { prep_transpose(p.s5_w_glu, 512, 512, 512, (bf16*)(p.ws + OFF_WT_GLU), t, sm); continue; }
      t -= T6;
      if (t < T7) { prep_transpose(p.peer_wq, 1024, 2048, 2048, (bf16*)(p.ws + OFF_WT_PWQ), t, sm); continue; }
      t -= T7;
      prep_transpose(p.peer_wq + (size_t)1024 * 2048, 1024, 2048, 2048, (bf16*)(p.ws + OFF_WT_PWQ) + (size_t)2048 * 1024, t, sm);
    }
  }
  convert_bf16(p.peer_keys, (bf16*)(p.ws + OFF_PKEYS), (size_t)2 * 8 * 2 * 128 * 128, bid, nb);
  convert_bf16(p.peer_wq, (bf16*)(p.ws + OFF_WQB), (size_t)2 * 1024 * 2048, bid, nb);
}

DI void phase_norm(const Params& p, int layer, bool first, const float* g, int shift_chunk, int nrows) {
  const int lane = get_tid() & 63, w = get_tid() >> 6;
  bf16* dst = (bf16*)(p.ws + OFF_ACTA);
  for (int r = blockIdx.x * 4 + w; r < nrows; r += gridDim.x * 4) {
    const float* src = first ? orig_row(p, r) : res_row(p, r);
    float4 v[4];
    float ss = 0.f;
#pragma unroll
    for (int i = 0; i < 4; ++i) {
      v[i] = ((const float4*)src)[i * 64 + lane];
      ss += v[i].x * v[i].x + v[i].y * v[i].y + v[i].z * v[i].z + v[i].w * v[i].w;
    }
    ss = wave_sum(ss);
    const float rs = rsqrtf(ss * (1.0f / 1024.0f) + EPSN);
    const float* sh = mod_ptr(p, layer, r, shift_chunk);
    const float* sc = mod_ptr(p, layer, r, shift_chunk + 1);
#pragma unroll
    for (int i = 0; i < 4; ++i) {
      float4 gg = ((const float4*)g)[i * 64 + lane];
      float4 s4 = ((const float4*)sh)[i * 64 + lane];
      float4 c4 = ((const float4*)sc)[i * 64 + lane];
      float o0 = v[i].x * rs * gg.x * (1.f + c4.x) + s4.x;
      float o1 = v[i].y * rs * gg.y * (1.f + c4.y) + s4.y;
      float o2 = v[i].z * rs * gg.z * (1.f + c4.z) + s4.z;
      float o3 = v[i].w * rs * gg.w * (1.f + c4.w) + s4.w;
      u32x2 o;
      o.x = cvtpk(o0, o1); o.y = cvtpk(o2, o3);
      ((u32x2*)(dst + (size_t)r * DM))[i * 64 + lane] = o;
    }
  }
}

DI void phase_inproj0(const Params& p, char* smem) {
  bf16* As = (bf16*)smem; bf16* Bs = As + 256 * GLS;
  const bf16* A = (const bf16*)(p.ws + OFF_ACTA);
  const bf16* Wt = (const bf16*)(p.ws + OFF_WT_EVIN);
  bf16* pg = (bf16*)(p.ws + OFF_PAGQA);
  bf16* ph = (bf16*)(p.ws + OFF_PAHG);
  const int ntn = 26, ntm = NTOK / 256;
  for (int t = blockIdx.x; t < ntn * ntm; t += gridDim.x) {
    const int mt = t / ntn, nt = t % ntn;
    f32x16 acc[4][2];
    gemm_256x128(A + (size_t)mt * 256 * DM, DM, Wt + (size_t)nt * 128 * DM, DM, DM, acc, As, Bs);
    constexpr int OLS = 136;
    bf16* Ot = (bf16*)smem;
    __syncthreads();
    gemm_epi2(acc, [&](int row, int col, float v) { Ot[row * OLS + col] = f2bf(v); });
    __syncthreads();
    bf16* dst; int ldd;
    if (nt < 6) { dst = pg + (size_t)(mt * 256) * 768 + nt * 128; ldd = 768; }
    else { dst = ph + (size_t)(mt * 256) * 2560 + (nt * 128 - 768); ldd = 2560; }
#pragma unroll
    for (int i = 0; i < 16; ++i) {
      const int ci = i * 256 + get_tid(), orow = ci >> 4, och = ci & 15;
      *(u32x4*)(dst + (size_t)orow * ldd + och * 8) = *(const u32x4*)(Ot + orow * OLS + och * 8);
    }
  }
}

DI void phase_gqa_prep(const Params& p, char* smem) {
  bf16* pg = (bf16*)(p.ws + OFF_PAGQA);
  bf16* vt = (bf16*)(p.ws + OFF_VT0);
  bf16* tl = (bf16*)smem;
  const int lane = get_tid() & 63, w = get_tid() >> 6, tid = get_tid();
  const float gq = p.gqa_qn_g[lane], gk = p.gqa_kn_g[lane];
  const float inv = __powf(10000.f, -(float)(lane & 15) / 16.f);
  float lbv[16];
#pragma unroll
  for (int e = 0; e < 16; ++e) {
    const int j = lane * 16 + e, d = j >> 9, cc = j & 511;
    const float l0 = p.hg_lb_logits[(d * 2 + 0) * 512 + cc], l1 = p.hg_lb_logits[(d * 2 + 1) * 512 + cc];
    lbv[e] = 1.0f / (1.0f + __expf(l1 - l0));
  }
  bf16* phg = (bf16*)(p.ws + OFF_PAHG);
  for (int r = blockIdx.x * 4 + w; r < NTOK; r += gridDim.x * 4) {
    bf16* row = pg + (size_t)r * 768;
    float sn = 0.f, cs = 1.f;
    if (r < NLAT) {
      int t = r & 8191;
      float pos = (lane < 32) ? (float)(t >> 6) : (float)(t & 63);
      sincosf(pos * inv, &sn, &cs);
    }
#pragma unroll
    for (int hh = 0; hh < 10; ++hh) {
      float v = bf2f(row[hh * 64 + lane]);
      float ss = wave_sum(v * v);
      float y = v * rsqrtf(ss * (1.f / 64.f) + EPSN) * (hh < 8 ? gq : gk);
      float pr = __shfl_xor(y, 16);
      float o = y * cs + ((lane & 16) ? pr * sn : -pr * sn);
      row[hh * 64 + lane] = f2bf(hh < 8 ? o * (0.125f * 1.4426950408889634f) : o);
    }
    {
      bf16* frow = phg + (size_t)r * 2560 + 512 + lane * 16;
      u32x4 a = *(const u32x4*)frow, b2 = *(const u32x4*)(frow + 8);
      float fv[16];
      fv[0] = bflo(a.x); fv[1] = bfhi(a.x); fv[2] = bflo(a.y); fv[3] = bfhi(a.y); fv[4] = bflo(a.z); fv[5] = bfhi(a.z); fv[6] = bflo(a.w); fv[7] = bfhi(a.w);
      fv[8] = bflo(b2.x); fv[9] = bfhi(b2.x); fv[10] = bflo(b2.y); fv[11] = bfhi(b2.y); fv[12] = bflo(b2.z); fv[13] = bfhi(b2.z); fv[14] = bflo(b2.w); fv[15] = bfhi(b2.w);
#pragma unroll
      for (int e = 0; e < 16; ++e) fv[e] = __logf(lbv[e] + (1.f - lbv[e]) * sigmoidf_(fv[e]));
      u32x4 o0, o1;
      o0.x = cvtpk(fv[0], fv[1]); o0.y = cvtpk(fv[2], fv[3]); o0.z = cvtpk(fv[4], fv[5]); o0.w = cvtpk(fv[6], fv[7]);
      o1.x = cvtpk(fv[8], fv[9]); o1.y = cvtpk(fv[10], fv[11]); o1.z = cvtpk(fv[12], fv[13]); o1.w = cvtpk(fv[14], fv[15]);
      *(u32x4*)frow = o0; *(u32x4*)(frow + 8) = o1;
    }
  }
  for (int blk = blockIdx.x; blk < NTOK / 64; blk += gridDim.x) {
    const int r0 = blk * 64;
    __syncthreads();
    {
      const int rr = tid >> 2, c0 = (tid & 3) * 32;
      const bf16* src = pg + (size_t)(r0 + rr) * 768 + 640 + c0;
#pragma unroll
      for (int i = 0; i < 4; ++i) {
        u32x4 v4 = *(const u32x4*)(src + i * 8);
#pragma unroll
        for (int e = 0; e < 4; ++e) {
          tl[(c0 + i * 8 + 2 * e) * GLS + rr] = (bf16)(v4[e] & 0xffffu);
          tl[(c0 + i * 8 + 2 * e + 1) * GLS + rr] = (bf16)(v4[e] >> 16);
        }
      }
    }
    __syncthreads();
    int b, s0;
    if (r0 < NLAT) { b = r0 >> 13; s0 = CTXL + (r0 & 8191); } else { int rc = r0 - NLAT; b = rc >> 8; s0 = rc & 255; }
    {
      int vcol = tid >> 1, half = tid & 1;
      int kvh = vcol >> 6, dv = vcol & 63;
      bf16* dstp = vt + ((size_t)((b * 2 + kvh) * 64 + dv)) * SKEYS + s0 + half * 32;
      const bf16* srcp = tl + vcol * GLS + half * 32;
#pragma unroll
      for (int i = 0; i < 4; ++i) ((u32x4*)dstp)[i] = ((const u32x4*)srcp)[i];
    }
  }
}

template <int DQK, int SM>
DI void attn_item(const bf16* __restrict__ Q, int ldq_, const bf16* __restrict__ Kc, const bf16* __restrict__ Kl, int ldk_,
                  const bf16* __restrict__ VT, int nkeys, bf16* __restrict__ O, int ldo_, float scale, char* smem, float kbound = 0.f) {
  constexpr bool FIXED = (SM != 0);
  constexpr int ldq = 768, ldk = 768, ldo = DM;
  (void)ldq_; (void)ldk_; (void)ldo_;
  constexpr int KLS = DQK + 8;
  constexpr int VLS = 72;
  constexpr int NKS = DQK / 16;
  constexpr int KCH = DQK / 8;
  constexpr int KLOADS = (64 * KCH) / 256;
  constexpr int BUF = 64 * KLS + 64 * VLS;
  bf16* Sb = (bf16*)smem;
  const int tid = get_tid(), lane = tid & 63, w = tid >> 6;
  const float sc = scale * 1.4426950408889634f;
  bf16x8 qf[2][NKS];
#pragma unroll
  for (int qt = 0; qt < 2; ++qt) {
    const bf16* qp = Q + (size_t)(w * 64 + qt * 32 + (lane & 31)) * ldq + (lane >> 5) * 8;
#pragma unroll
    for (int ks = 0; ks < NKS; ++ks) qf[qt][ks] = *(const bf16x8*)(qp + ks * 16);
  }
  float msh[2] = {0.f, 0.f};
  if (SM == 2) {
#pragma unroll
    for (int qt = 0; qt < 2; ++qt) {
      float sq = 0.f;
#pragma unroll
      for (int ks = 0; ks < NKS; ++ks)
#pragma unroll
        for (int e = 0; e < 8; ++e) { float f = bf2f((bf16)qf[qt][ks][e]); sq += f * f; }
      sq += __shfl_xor(sq, 32);
      msh[qt] = fminf(sqrtf(sq) * kbound, 64.0f);
    }
  }
  f32x16 ot[2][2];
#pragma unroll
  for (int i = 0; i < 2; ++i)
#pragma unroll
    for (int j = 0; j < 2; ++j)
#pragma unroll
      for (int r = 0; r < 16; ++r) ot[i][j][r] = 0.f;
  float m_run[2] = {-1e30f, -1e30f}, l_run[2] = {0.f, 0.f};
  u32x4 kr[KLOADS], vr[2];
  auto gload = [&](int s0) {
    const bf16* kb = (s0 < CTXL) ? (Kc + (size_t)s0 * ldk) : (Kl + (size_t)(s0 - CTXL) * ldk);
#pragma unroll
    for (int i = 0; i < KLOADS; ++i) {
      int ci = i * 256 + tid;
      int row = ci / KCH, ch = ci % KCH;
      kr[i] = *(const u32x4*)(kb + (size_t)row * ldk + ch * 8);
    }
#pragma unroll
    for (int i = 0; i < 2; ++i) {
      int ci = i * 256 + tid;
      int row = ci >> 3, ch = ci & 7;
      vr[i] = *(const u32x4*)(VT + (size_t)row * SKEYS + s0 + ch * 8);
    }
  };
  auto lwrite = [&](bf16* buf) {
    bf16* Ks = buf; bf16* Vs = buf + 64 * KLS;
#pragma unroll
    for (int i = 0; i < KLOADS; ++i) {
      int ci = i * 256 + tid;
      int row = ci / KCH, ch = ci % KCH;
      *(u32x4*)(Ks + row * KLS + ch * 8) = kr[i];
    }
#pragma unroll
    for (int i = 0; i < 2; ++i) {
      int ci = i * 256 + tid;
      int row = ci >> 3, ch = ci & 7;
      u32x2 lo = {vr[i].x, vr[i].y}, hi = {vr[i].z, vr[i].w};
      const int gb = (ch >> 1) * 16 + (ch & 1) * 4;
      *(u32x2*)(Vs + row * VLS + gb) = lo;
      *(u32x2*)(Vs + row * VLS + gb + 8) = hi;
    }
  };
  const int ntiles = nkeys >> 6;
  __syncthreads();
  gload(0);
  lwrite(Sb);
  if (ntiles > 1) gload(64);
  for (int j = 0; j < ntiles; ++j) {
    __syncthreads();
    if (j + 1 < ntiles) {
      lwrite(Sb + ((j + 1) & 1) * BUF);
      if (j + 2 < ntiles) gload((j + 2) * 64);
    }
    const bf16* Ks = Sb + (j & 1) * BUF;
    const bf16* Vs = Ks + 64 * KLS;
    auto half = [&](const int kt) {
      f32x16 st[2];
#pragma unroll
      for (int qt = 0; qt < 2; ++qt)
#pragma unroll
        for (int r = 0; r < 16; ++r) st[qt][r] = 0.f;
      {
        const bf16* ap = Ks + (kt * 32 + (lane & 31)) * KLS + (lane >> 5) * 8;
        __builtin_amdgcn_s_setprio(1);
#pragma unroll
        for (int ks = 0; ks < NKS; ++ks) {
          bf16x8 a = *(const bf16x8*)(ap + ks * 16);
          st[0] = MFMA32(a, qf[0][ks], st[0]);
          st[1] = MFMA32(a, qf[1][ks], st[1]);
        }
        __builtin_amdgcn_s_setprio(0);
      }
      float mx[2] = {0.f, 0.f};
      bool need = false;
      if (!FIXED) {
#pragma unroll
      for (int qt = 0; qt < 2; ++qt) {
        float m0 = fmaxf(st[qt][0], st[qt][1]);
#pragma unroll
        for (int r = 2; r < 16; r += 2) m0 = fmaxf(m0, fmaxf(st[qt][r], st[qt][r + 1]));
        m0 = fmaxf(m0, __shfl_xor(m0, 32)) * sc;
        mx[qt] = m0;
        need = need || (m0 - m_run[qt] > 8.0f);
      }
      }
      if (!FIXED && __any(need)) {
#pragma unroll
        for (int qt = 0; qt < 2; ++qt) {
          const float m_new = fmaxf(m_run[qt], mx[qt]);
          const float alpha = __builtin_amdgcn_exp2f(m_run[qt] - m_new);
          m_run[qt] = m_new;
          l_run[qt] *= alpha;
#pragma unroll
          for (int dt = 0; dt < 2; ++dt)
#pragma unroll
            for (int r = 0; r < 16; ++r) ot[qt][dt][r] *= alpha;
        }
      }
      bf16x8 pb[2][2];
#pragma unroll
      for (int qt = 0; qt < 2; ++qt) {
        float ps = 0.f;
        const float mr = m_run[qt];
#pragma unroll
        for (int r = 0; r < 16; ++r) {
          float pv = (SM == 1) ? __builtin_amdgcn_exp2f(st[qt][r]) : (SM == 2) ? __builtin_amdgcn_exp2f(st[qt][r] - msh[qt]) : __builtin_amdgcn_exp2f(st[qt][r] * sc - mr);
          st[qt][r] = pv;
          ps += pv;
        }
#pragma unroll
        for (int s2 = 0; s2 < 2; ++s2) {
          u32x4 pk;
          pk.x = cvtpk(st[qt][8 * s2 + 0], st[qt][8 * s2 + 1]);
          pk.y = cvtpk(st[qt][8 * s2 + 2], st[qt][8 * s2 + 3]);
          pk.z = cvtpk(st[qt][8 * s2 + 4], st[qt][8 * s2 + 5]);
          pk.w = cvtpk(st[qt][8 * s2 + 6], st[qt][8 * s2 + 7]);
          pb[qt][s2] = __builtin_bit_cast(bf16x8, pk);
        }
        l_run[qt] += ps;
      }
      __builtin_amdgcn_s_setprio(1);
#pragma unroll
      for (int s2 = 0; s2 < 2; ++s2)
#pragma unroll
        for (int dt = 0; dt < 2; ++dt) {
          const bf16* vp = Vs + (dt * 32 + (lane & 31)) * VLS + kt * 32 + 16 * s2 + 8 * (lane >> 5);
          bf16x8 af = *(const bf16x8*)vp;
          ot[0][dt] = MFMA32(af, pb[0][s2], ot[0][dt]);
          ot[1][dt] = MFMA32(af, pb[1][s2], ot[1][dt]);
        }
      __builtin_amdgcn_s_setprio(0);
    };
    if constexpr (SM == 1) {
#pragma unroll 1
      for (int kt = 0; kt < 2; ++kt) half(kt);
    } else {
      half(0);
      half(1);
    }
  }
#pragma unroll
  for (int qt = 0; qt < 2; ++qt) {
    const float ltot = l_run[qt] + __shfl_xor(l_run[qt], 32);
    const float inv_l = 1.0f / ltot;
    const int tid2 = get_tid();
    bf16* op = O + (size_t)((tid2 >> 6) * 64 + qt * 32 + (tid2 & 31)) * ldo;
#pragma unroll
    for (int dt = 0; dt < 2; ++dt)
#pragma unroll
      for (int g4 = 0; g4 < 4; ++g4) {
        int dv = dt * 32 + 8 * g4 + 4 * ((tid2 >> 5) & 1);
        u32x2 o;
        o.x = cvtpk(ot[qt][dt][4 * g4 + 0] * inv_l, ot[qt][dt][4 * g4 + 1] * inv_l);
        o.y = cvtpk(ot[qt][dt][4 * g4 + 2] * inv_l, ot[qt][dt][4 * g4 + 3] * inv_l);
        *(u32x2*)(op + dv) = o;
      }
  }
}

DI void hgrn2_item(const Params& p, int item, char* smem) {
  const int vs = item & 3, dir = (item >> 2) & 1, h = (item >> 3) & 3, b = item >> 5;
  constexpr int QLS = 136, TLS = 72;
  bf16* Qr = (bf16*)smem;
  bf16* Kr = Qr + 64 * QLS;
  bf16* KrT = Kr + 64 * QLS;
  bf16* VTs = KrT + 128 * TLS;
  bf16* Att = VTs + 32 * TLS;
  bf16* STb = Att + 64 * TLS;
  float* rsum = (float*)(STb + 32 * QLS);
  float* lsum = rsum + 128;
  const int tid = get_tid(), lane = tid & 63, w = tid >> 6;
  const int c = tid & 127, half = tid >> 7;
  const bf16* ph = (const bf16*)(p.ws + OFF_PAHG);
  bf16* og = (bf16*)(p.ws + OFF_OHG) + (size_t)dir * NTOK * 512;
  auto rowof = [&](int pos) -> int {
    if (pos < CTXL) { int s = dir ? (CTXL - 1 - pos) : pos; return NLAT + b * CTXL + s; }
    int t = pos - CTXL; t = dir ? (SEQ - 1 - t) : t; return b * SEQ + t;
  };
  f32x16 S0, S1;
#pragma unroll
  for (int r = 0; r < 16; ++r) { S0[r] = 0.f; S1[r] = 0.f; }
  bf16 pq[32], pf[32];
  u32x4 pv;
  auto prefetch = [&](int ch) {
    const int p0 = ch * 64;
#pragma unroll
    for (int i = 0; i < 32; ++i) {
      const bf16* row = ph + (size_t)rowof(p0 + half * 32 + i) * 2560;
      pq[i] = row[h * 128 + c];
      pf[i] = row[512 + dir * 512 + h * 128 + c];
    }
    {
      const bf16* row = ph + (size_t)rowof(p0 + (tid >> 2)) * 2560;
      pv = *(const u32x4*)(row + 1536 + h * 128 + vs * 32 + (tid & 3) * 8);
    }
  };
  for (int ch = 0; ch < 132; ++ch) {
    prefetch(ch);
    {
      float run = 0.f;
      if (half == 0) {
#pragma unroll
        for (int ii = 31; ii >= 0; --ii) {
          float lg = bf2f(pf[ii]), q = bf2f(pq[ii]);
          float k = 1.f - __expf(lg);
          float eq = __expf(fminf(-run, 80.f)), ek = __expf(fmaxf(run, -80.f));
          const unsigned pk2 = cvtpk(q * eq, k * ek);
          const bf16 qv = (bf16)(pk2 & 0xffffu), kv = (bf16)(pk2 >> 16);
          Qr[ii * QLS + c] = qv;
          Kr[ii * QLS + c] = kv;
          KrT[c * TLS + ii] = kv;
          run += lg;
        }
        rsum[c] = __expf(run);
      } else {
#pragma unroll
        for (int ii = 0; ii < 32; ++ii) {
          float lg = bf2f(pf[ii]), q = bf2f(pq[ii]);
          float k = 1.f - __expf(lg);
          run += lg;
          float eq = __expf(fmaxf(run, -80.f)), ek = __expf(fminf(-run, 80.f));
          const unsigned pk2 = cvtpk(q * eq, k * ek);
          const bf16 qv = (bf16)(pk2 & 0xffffu), kv = (bf16)(pk2 >> 16);
          Qr[(32 + ii) * QLS + c] = qv;
          Kr[(32 + ii) * QLS + c] = kv;
          KrT[c * TLS + 32 + ii] = kv;
        }
        lsum[c] = __expf(run);
      }
      {
        int i = tid >> 2, v0 = (tid & 3) * 8;
#pragma unroll
        for (int j = 0; j < 4; ++j) {
          VTs[(v0 + 2 * j) * TLS + i] = (bf16)(pv[j] & 0xffffu);
          VTs[(v0 + 2 * j + 1) * TLS + i] = (bf16)(pv[j] >> 16);
        }
      }
    }
    __syncthreads();
    if (w < 2) {
      const int ntl = (w == 0) ? 2 : 1;
      for (int q2 = 0; q2 < ntl; ++q2) {
        const int tt = (w == 0) ? q2 : 1, stl = (w == 0) ? q2 : 0;
        f32x16 a;
#pragma unroll
        for (int r = 0; r < 16; ++r) a[r] = 0.f;
        mma_tile(a, Qr + tt * 32 * QLS, QLS, Kr + stl * 32 * QLS, QLS, 128);
#pragma unroll
        for (int r = 0; r < 16; ++r) {
          int t = tt * 32 + crow(r, lane), s = stl * 32 + (lane & 31);
          float v = (s <= t) ? a[r] : 0.f;
          Att[t * TLS + s] = (bf16)(cvtpk(v, v) & 0xffffu);
        }
      }
      if (w == 1) {
#pragma unroll
        for (int r = 0; r < 16; ++r) Att[crow(r, lane) * TLS + 32 + (lane & 31)] = 0;
      }
    } else {
      const int ct0 = (w - 2) * 2;
#pragma unroll
      for (int tI = 0; tI < 2; ++tI) {
        f32x16& S = tI ? S1 : S0;
        const int cb = (ct0 + tI) * 32;
#pragma unroll
        for (int g4 = 0; g4 < 4; ++g4) {
          int cc = cb + 8 * g4 + 4 * (lane >> 5);
          float e0 = rsum[cc], e1 = rsum[cc + 1], e2 = rsum[cc + 2], e3 = rsum[cc + 3];
          u32x2 o;
          o.x = cvtpk(S[4 * g4] * e0, S[4 * g4 + 1] * e1);
          o.y = cvtpk(S[4 * g4 + 2] * e2, S[4 * g4 + 3] * e3);
          *(u32x2*)(STb + (lane & 31) * QLS + cc) = o;
        }
        f32x16 a;
#pragma unroll
        for (int r = 0; r < 16; ++r) a[r] = 0.f;
        mma_tile(a, KrT + cb * TLS, TLS, VTs, TLS, 64);
#pragma unroll
        for (int r = 0; r < 16; ++r) {
          int cc = cb + crow(r, lane);
          float el = lsum[cc];
          float er = rsum[cc];
          S[r] = S[r] * (el * er) + a[r] * el;
        }
      }
    }
    __syncthreads();
    if (w < 2) {
      f32x16 a;
#pragma unroll
      for (int r = 0; r < 16; ++r) a[r] = 0.f;
      mma_tile(a, Att + w * 32 * TLS, TLS, VTs, TLS, 64);
      mma_tile(a, Qr + w * 32 * QLS, QLS, STb, QLS, 128);
#pragma unroll
      for (int r = 0; r < 16; ++r) {
        int t = w * 32 + crow(r, lane);
        int row = rowof(ch * 64 + t);
        og[(size_t)row * 512 + h * 128 + vs * 32 + (lane & 31)] = f2bf(a[r]);
      }
    }
    __syncthreads();
  }
}

DI void phase_mix0(const Params& p, char* smem, int cidx) {
  __shared__ int s_item;
  if (blockIdx.x < 128) hgrn2_item(p, blockIdx.x, smem);
  unsigned* cnt = (unsigned*)(p.ws + OFF_CNT) + cidx;
  const bf16* pg = (const bf16*)(p.ws + OFF_PAGQA);
  const bf16* vt = (const bf16*)(p.ws + OFF_VT0);
  bf16* ycat = (bf16*)(p.ws + OFF_ACTA);
  float kb0;
  {
    const int ln = get_tid() & 63;
    kb0 = 8.0f * 1.01f * wave_max_early(fabsf(p.gqa_kn_g[ln]));
  }
  const int n_lat = 4 * 8 * 32, n_ctx = 4 * 8;
  while (true) {
    __syncthreads();
    if (get_tid() == 0) s_item = (int)atomicAdd(cnt, 1u);
    __syncthreads();
    const int it = s_item;
    if (it >= n_lat + n_ctx) break;
    int b, hq, r0, nk;
    if (it < n_lat) { const int qt = it & 31; hq = (it >> 5) & 7; b = it >> 8; r0 = b * SEQ + qt * 256; nk = SKEYS; }
    else { const int i2 = it - n_lat; hq = i2 & 7; b = i2 >> 3; r0 = NLAT + b * CTXL; nk = CTXL; }
    const int kvh = hq >> 2;
    attn_item<64, 2>(pg + (size_t)r0 * 768 + hq * 64, 768,
                  pg + (size_t)(NLAT + b * CTXL) * 768 + 512 + kvh * 64, pg + (size_t)(b * SEQ) * 768 + 512 + kvh * 64, 768,
                  vt + (size_t)((b * 2 + kvh) * 64) * SKEYS, nk, ycat + (size_t)r0 * DM + hq * 64, DM, 0.125f, smem, kb0);
  }
}

DI void phase_hg_readout(const Params& p) {
  const int lane = get_tid() & 63, w = get_tid() >> 6;
  const bf16* o0 = (const bf16*)(p.ws + OFF_OHG);
  const bf16* o1 = o0 + (size_t)NTOK * 512;
  const bf16* ph = (const bf16*)(p.ws + OFF_PAHG);
  bf16* ycat = (bf16*)(p.ws + OFF_ACTA);
  const float g0 = p.hg_onorm_g[lane * 2], g1 = p.hg_onorm_g[lane * 2 + 1];
  for (int r = blockIdx.x * 4 + w; r < NTOK; r += gridDim.x * 4) {
#pragma unroll
    for (int h = 0; h < 4; ++h) {
      unsigned a = *(const unsigned*)(o0 + (size_t)r * 512 + h * 128 + lane * 2);
      unsigned b2 = *(const unsigned*)(o1 + (size_t)r * 512 + h * 128 + lane * 2);
      unsigned gg = *(const unsigned*)(ph + (size_t)r * 2560 + 2048 + h * 128 + lane * 2);
      float x0 = bflo(a) + bflo(b2), x1 = bfhi(a) + bfhi(b2);
      float ss = wave_sum(x0 * x0 + x1 * x1);
      float rs = rsqrtf(ss * (1.f / 128.f) + EPSN);
      float y0 = x0 * rs * g0 * siluf_(bflo(gg)), y1 = x1 * rs * g1 * siluf_(bfhi(gg));
      *(unsigned*)(ycat + (size_t)r * DM + 512 + h * 128 + lane * 2) = cvtpk(y0, y1);
    }
  }
}

template <int MI>
DI void resid_epilogue(f32x16 (&acc)[MI][2], const float* src, float* dst, const float* __restrict__ g) {
  const int lane = get_tid() & 63, w = get_tid() >> 6;
  const int wm = w >> 1, wn = w & 1;
  const float g0 = g[wn * 64 + (lane & 31)], g1 = g[wn * 64 + 32 + (lane & 31)];
#pragma unroll
  for (int mi = 0; mi < MI; ++mi) {
    const size_t o0 = (size_t)(wm * (MI * 32) + mi * 32 + 4 * (lane >> 5)) * DM + wn * 64 + (lane & 31);
    float xv[2][16];
#pragma unroll
    for (int r = 0; r < 16; ++r) {
      const size_t ro = o0 + (size_t)((r & 3) + 8 * (r >> 2)) * DM;
      xv[0][r] = src[ro];
      xv[1][r] = src[ro + 32];
    }
#pragma unroll
    for (int r = 0; r < 16; ++r) {
      const size_t ro = o0 + (size_t)((r & 3) + 8 * (r >> 2)) * DM;
      dst[ro] = xv[0][r] + g0 * acc[mi][0][r];
      dst[ro + 32] = xv[1][r] + g1 * acc[mi][1][r];
    }
  }
}
DI void resid_prefetch2(float (&xv)[2][2][16], const float* src) {
  const int lane = get_tid() & 63, w = get_tid() >> 6;
  const int wm = w >> 1, wn = w & 1;
#pragma unroll
  for (int mi = 0; mi < 2; ++mi) {
    const size_t o0 = (size_t)(wm * 64 + mi * 32 + 4 * (lane >> 5)) * DM + wn * 64 + (lane & 31);
#pragma unroll
    for (int r = 0; r < 16; ++r) {
      const size_t ro = o0 + (size_t)((r & 3) + 8 * (r >> 2)) * DM;
      xv[mi][0][r] = src[ro];
      xv[mi][1][r] = src[ro + 32];
    }
  }
}
DI void resid_store2(f32x16 (&acc)[2][2], const float (&xv)[2][2][16], float* dst, const float* __restrict__ g) {
  const int lane = get_tid() & 63, w = get_tid() >> 6;
  const int wm = w >> 1, wn = w & 1;
  const float g0 = g[wn * 64 + (lane & 31)], g1 = g[wn * 64 + 32 + (lane & 31)];
#pragma unroll
  for (int mi = 0; mi < 2; ++mi) {
    const size_t o0 = (size_t)(wm * 64 + mi * 32 + 4 * (lane >> 5)) * DM + wn * 64 + (lane & 31);
#pragma unroll
    for (int r = 0; r < 16; ++r) {
      const size_t ro = o0 + (size_t)((r & 3) + 8 * (r >> 2)) * DM;
      dst[ro] = xv[mi][0][r] + g0 * acc[mi][0][r];
      dst[ro + 32] = xv[mi][1][r] + g1 * acc[mi][1][r];
    }
  }
}
constexpr size_t TAB_BYTES = (size_t)16384 * 512;
DI unsigned char* tab_u(const Params& p, int layer) { return (unsigned char*)(p.ws + OFF_UTAB) + (size_t)layer * TAB_BYTES; }
DI unsigned char* tab_v(const Params& p, int layer) { return (unsigned char*)(p.ws + OFF_VTAB) + (size_t)layer * TAB_BYTES; }
DI float* tab_su(const Params& p, int layer) { return layer == 0 ? (float*)(p.ws + OFF_SU) : (float*)(p.ws + OFF_UTAB + 3 * TAB_BYTES); }
DI float* tab_sv(const Params& p, int layer) { return layer == 0 ? (float*)(p.ws + OFF_SV) : (float*)(p.ws + OFF_VTAB + 3 * TAB_BYTES); }
struct ConvRide { float4 v0, v1, v2, v3; int idx; };
DI void conv_ride_issue(const Params& p, int, ConvRide& cs, int lane) {
  const int row = cs.idx & 16383, layer = cs.idx >> 15;
  const float* src = ((cs.idx & 16384) ? p.peer_v : p.peer_u) + (size_t)layer * 16384 * 1024 + (size_t)row * 1024;
  const float4* s4 = (const float4*)src + lane * 4;
  cs.v0 = s4[0]; cs.v1 = s4[1]; cs.v2 = s4[2]; cs.v3 = s4[3];
}
DI int q4r(float v) {
  int n = (int)floorf(v);
  return (n < -8 ? -8 : (n > 7 ? 7 : n)) & 15;
}
DI float clamp6r(float v) { return __builtin_amdgcn_fmed3f(v, -6.0f, 6.0f); }
DI void conv_ride_finish(const Params& p, const ConvRide& cs, int lane) {
  const float4 v0 = cs.v0, v1 = cs.v1, v2 = cs.v2, v3 = cs.v3;
  const int row = cs.idx & 16383, layer = cs.idx >> 15;
  float ss = v0.x * v0.x + v0.y * v0.y + v0.z * v0.z + v0.w * v0.w + v1.x * v1.x + v1.y * v1.y + v1.z * v1.z + v1.w * v1.w +
             v2.x * v2.x + v2.y * v2.y + v2.z * v2.z + v2.w * v2.w + v3.x * v3.x + v3.y * v3.y + v3.z * v3.z + v3.w * v3.w;
  ss = wave_sum(ss);
  const float rms = sqrtf(ss * (1.0f / 1024.0f));
  if (!(cs.idx & 16384)) {
    const float sc = (ss > 0.f) ? 0.3352f * rms : 1.0f;
    const float inv = 1.0f / sc;
    const unsigned d0 = (unsigned)q4r(v0.x * inv) | ((unsigned)q4r(v1.x * inv) << 4) | ((unsigned)q4r(v0.y * inv) << 8) | ((unsigned)q4r(v1.y * inv) << 12) |
                        ((unsigned)q4r(v0.z * inv) << 16) | ((unsigned)q4r(v1.z * inv) << 20) | ((unsigned)q4r(v0.w * inv) << 24) | ((unsigned)q4r(v1.w * inv) << 28);
    const unsigned d1 = (unsigned)q4r(v2.x * inv) | ((unsigned)q4r(v3.x * inv) << 4) | ((unsigned)q4r(v2.y * inv) << 8) | ((unsigned)q4r(v3.y * inv) << 12) |
                        ((unsigned)q4r(v2.z * inv) << 16) | ((unsigned)q4r(v3.z * inv) << 20) | ((unsigned)q4r(v2.w * inv) << 24) | ((unsigned)q4r(v3.w * inv) << 28);
    ((u32x2*)(tab_u(p, layer) + (size_t)row * 512))[lane] = u32x2{d0, d1};
    if (lane == 0) tab_su(p, layer)[row] = sc;
  } else {
    const float sc = (ss > 0.f) ? 0.5f * rms : 1.0f;
    const float inv = 1.0f / sc;
    unsigned d0 = 0, d1 = 0;
    d0 = __builtin_amdgcn_cvt_scalef32_pk_fp4_f32(d0, clamp6r(v0.x * inv), clamp6r(v0.y * inv), 1.0f, 0);
    d0 = __builtin_amdgcn_cvt_scalef32_pk_fp4_f32(d0, clamp6r(v0.z * inv), clamp6r(v0.w * inv), 1.0f, 1);
    d0 = __builtin_amdgcn_cvt_scalef32_pk_fp4_f32(d0, clamp6r(v1.x * inv), clamp6r(v1.y * inv), 1.0f, 2);
    d0 = __builtin_amdgcn_cvt_scalef32_pk_fp4_f32(d0, clamp6r(v1.z * inv), clamp6r(v1.w * inv), 1.0f, 3);
    d1 = __builtin_amdgcn_cvt_scalef32_pk_fp4_f32(d1, clamp6r(v2.x * inv), clamp6r(v2.y * inv), 1.0f, 0);
    d1 = __builtin_amdgcn_cvt_scalef32_pk_fp4_f32(d1, clamp6r(v2.z * inv), clamp6r(v2.w * inv), 1.0f, 1);
    d1 = __builtin_amdgcn_cvt_scalef32_pk_fp4_f32(d1, clamp6r(v3.x * inv), clamp6r(v3.y * inv), 1.0f, 2);
    d1 = __builtin_amdgcn_cvt_scalef32_pk_fp4_f32(d1, clamp6r(v3.z * inv), clamp6r(v3.w * inv), 1.0f, 3);
    ((u32x2*)(tab_v(p, layer) + (size_t)row * 512))[lane] = u32x2{d0, d1};
    if (lane == 0) tab_sv(p, layer)[row] = sc;
  }
}
DI void conv_ride_step(const Params& p, int layer, ConvRide& cs, int lane, int stride) {
  if (cs.idx < 65536) {
    conv_ride_finish(p, cs, lane);
    cs.idx += stride;
    if (cs.idx < 65536) conv_ride_issue(p, layer, cs, lane);
  }
}
DI void phase_outproj(const Params& p, int layer, size_t wt_off, int nrows, bool first, char* smem) {
  (void)first;
  bf16* As = (bf16*)smem; bf16* Bs = As + 128 * GLS;
  const bf16* A = (const bf16*)(p.ws + OFF_ACTA);
  const bf16* Wt = (const bf16*)(p.ws + wt_off);
  const int ntn = 8, ntm = nrows / 128;
  const int lane_ = get_tid() & 63, wave_ = __builtin_amdgcn_readfirstlane(get_tid() >> 6);
  const int cstride = gridDim.x * 4;
  ConvRide cs;
  cs.idx = blockIdx.x * 4 + wave_;
  cs.v0 = cs.v1 = cs.v2 = cs.v3 = make_float4(0.f, 0.f, 0.f, 0.f);
  if (cs.idx < 65536) conv_ride_issue(p, layer, cs, lane_);
  for (int t = blockIdx.x; t < ntn * ntm; t += gridDim.x) {
    const int mt = t / ntn, nt = t % ntn;
    f32x16 acc[2][2];
    const int r0 = mt * 128;
    float xv[2][2][16];
    resid_prefetch2(xv, orig_row(p, r0) + nt * 128);
    gemm_128x128_hook(A + (size_t)mt * 128 * DM, DM, Wt + (size_t)nt * 128 * DM, DM, acc, As, Bs,
                      [&](const int) { conv_ride_step(p, layer, cs, lane_, cstride); });
    resid_store2(acc, xv, res_row(p, r0) + nt * 128, mod_ptr(p, layer, r0, 2) + nt * 128);
  }
  while (cs.idx < 65536) conv_ride_step(p, layer, cs, lane_, cstride);
}
DI void phase_outproj1(const Params& p, char* smem) {
  bf16* As = (bf16*)smem; bf16* Bs = As + 256 * GLS;
  const bf16* A = (const bf16*)(p.ws + OFF_ACTA);
  const bf16* Wt = (const bf16*)(p.ws + OFF_WT_ODOUT);
  const int ntn = 8, ntm = NLAT / 256;
  for (int t = blockIdx.x; t < ntn * ntm; t += gridDim.x) {
    const int mt = t / ntn, nt = t % ntn;
    f32x16 acc[4][2];
    gemm_256x128(A + (size_t)mt * 256 * DM, DM, Wt + (size_t)nt * 128 * DM, DM, DM, acc, As, Bs);
    float* xp = p.out + (size_t)(mt * 256) * DM + nt * 128;
    resid_epilogue<4>(acc, xp, xp, mod_ptr(p, 1, mt * 256, 2) + nt * 128);
  }
}

DI void tk_ins(float (&L)[16], float x) {
#pragma unroll
  for (int j = 15; j >= 1; --j) L[j] = __builtin_amdgcn_fmed3f(L[j - 1], L[j], x);
  L[0] = fmaxf(L[0], x);
}
DI void tk_insert(float (&v)[16], int (&id)[16], float x, int xi) {
  if (x > v[15]) {
    v[15] = x; id[15] = xi;
#pragma unroll
    for (int j = 15; j > 0; --j) {
      bool sw = v[j] > v[j - 1];
      float a = v[j], b2 = v[j - 1];
      int ia = id[j], ib = id[j - 1];
      v[j - 1] = sw ? a : b2; v[j] = sw ? b2 : a;
      id[j - 1] = sw ? ia : ib; id[j] = sw ? ib : ia;
    }
  }
}

DI void phase_peer_mt(const Params& p, char* smem) {
  bf16* As = (bf16*)smem; bf16* Bs = As + 128 * GLS;
  const bf16* keys = (const bf16*)(p.ws + OFF_PKEYS);
  const bf16* wqb = (const bf16*)(p.ws + OFF_WQB);
  bf16* mtp = (bf16*)(p.ws + OFF_WT_PWQ);
  for (int it = blockIdx.x; it < 256; it += gridDim.x) {
    const int layer = it >> 7, sl = (it >> 3) & 15, kb = it & 7;
    f32x16 acc[2][2];
    gemm_128x128(keys + (size_t)(layer * 16 + sl) * 128 * 128, 128,
                 wqb + (size_t)layer * 1024 * 2048 + (size_t)kb * 128 * 2048 + sl * 128, 2048, 128, acc, As, Bs);
    bf16* dst = mtp + (size_t)(layer * 16 + sl) * 128 * 1024 + kb * 128;
    gemm_epi(acc, [&](int row, int col, float v) { dst[(size_t)row * 1024 + col] = f2bf(v); });
  }
}
DI void phase_peer_route(const Params& p, int layer, int nrows, char* smem, size_t roff = OFF_RIDX) {
  bf16* As = (bf16*)smem; bf16* Bs = As + 128 * GLS;
  const bf16* A = (const bf16*)(p.ws + OFF_ACTA);
  const bf16* Wt = (const bf16*)(p.ws + OFF_WT_PWQ) + (size_t)layer * 2048 * 1024;
  int* ridx = (int*)(p.ws + roff);
  float* rgw = (float*)(p.ws + roff + (OFF_RGW - OFF_RIDX));
  const int tid = get_tid(), lane = tid & 63, w = tid >> 6;
  const int hi5 = lane >> 5;
  const int xl = (lane ^ 32) << 2;
  const int ntm = nrows / 128;
  auto finish_list = [&](float (&Lx)[16]) {
#pragma unroll
      for (int j = 0; j < 16; ++j) {
        const unsigned u = __float_as_uint(Lx[j]);
        const unsigned nn = ((u & 0x3cu) << 1) | (u & 3u) | ((unsigned)hi5 << 2);
        Lx[j] = __uint_as_float((u & 0xffffff80u) | nn);
      }
      float O[16];
#pragma unroll
      for (int j = 0; j < 16; ++j) O[j] = __builtin_bit_cast(float, __builtin_amdgcn_ds_bpermute(xl, __builtin_bit_cast(int, Lx[j])));
#pragma unroll
      for (int j = 0; j < 16; ++j) tk_ins(Lx, O[j]);
    };
  auto emit = [&](const int mt, const int h, const float (&l0)[16], const float (&L)[16]) {
      float av[16], bv[16];
      unsigned ai[16], bi[16];
#pragma unroll
      for (int j = 0; j < 16; ++j) {
        const unsigned ua = __float_as_uint(l0[j]), ub = __float_as_uint(L[j]);
        av[j] = __uint_as_float(ua & 0xffffff80u); ai[j] = (ua & 0x7fu) << 7;
        bv[j] = __uint_as_float(ub & 0xffffff80u); bi[j] = ub & 0x7fu;
      }
      float F[16];
#pragma unroll
      for (int j = 0; j < 16; ++j) F[j] = -3.0e38f;
#pragma unroll
      for (int a = 0; a < 16; ++a)
#pragma unroll
        for (int b2 = 0; b2 < 16; ++b2)
          if ((a + 1) * (b2 + 1) <= 16) {
            const unsigned sb = __float_as_uint(av[a] + bv[b2]) + 0x2000u;
            tk_ins(F, __uint_as_float((sb & 0xffffc000u) | ai[a] | bi[b2]));
          }
      float e[16];
      const float mx = __uint_as_float(__float_as_uint(F[0]) & 0xffffc000u);
      float sum = 0.f;
#pragma unroll
      for (int j = 0; j < 16; ++j) {
        e[j] = __expf(__uint_as_float(__float_as_uint(F[j]) & 0xffffc000u) - mx);
        sum += e[j];
      }
      const float inv = 1.f / sum;
      const int r = mt * 128 + w * 32 + (lane & 31);
      const unsigned hm = (unsigned)(-hi5);
      unsigned gi[8];
      float ge[8];
#pragma unroll
      for (int k = 0; k < 8; ++k) {
        gi[k] = ((__float_as_uint(F[k]) & ~hm) | (__float_as_uint(F[8 + k]) & hm)) & 0x3fffu;
        ge[k] = __uint_as_float((__float_as_uint(e[k]) & ~hm) | (__float_as_uint(e[8 + k]) & hm)) * inv;
      }
      int4* ip = (int4*)(ridx + (size_t)r * 128 + h * 16 + hi5 * 8);
      float4* gp = (float4*)(rgw + (size_t)r * 128 + h * 16 + hi5 * 8);
      ip[0] = make_int4((int)gi[0], (int)gi[1], (int)gi[2], (int)gi[3]);
      ip[1] = make_int4((int)gi[4], (int)gi[5], (int)gi[6], (int)gi[7]);
      gp[0] = make_float4(ge[0], ge[1], ge[2], ge[3]);
      gp[1] = make_float4(ge[4], ge[5], ge[6], ge[7]);
  };
  f32x16 sp[4];
  float lp0[16];
  int pmt = 0, ph = 0;
  bool have_prev = false;
#pragma unroll
  for (int i = 0; i < 4; ++i)
#pragma unroll
    for (int r = 0; r < 16; ++r) sp[i][r] = 0.f;
#pragma unroll
  for (int j = 0; j < 16; ++j) lp0[j] = 0.f;
  for (int it = blockIdx.x; it < ntm * 8; it += gridDim.x) {
    const int mt = it >> 3, h = it & 7;
    float l0[16], L[16];
    f32x16 s0[4], s1[4];
#pragma unroll
    for (int j = 0; j < 16; ++j) L[j] = -3.0e38f;
    gemm_128x128_cols_hook(Wt + (size_t)((h * 2 + 0) * 128) * DM, DM, A + (size_t)mt * 128 * DM, DM, s0, As, Bs, [&](const int kk) {
#pragma unroll
      for (int c4 = 0; c4 < 4; ++c4) {
        const int c = kk * 4 + c4;
        const unsigned kb = (__float_as_uint(sp[c >> 4][c & 15]) & 0xffffff80u) | (unsigned)c;
        tk_ins(L, __uint_as_float(kb));
      }
    });
    if (have_prev) {
      finish_list(L);
      emit(pmt, ph, lp0, L);
    }
#pragma unroll
    for (int j = 0; j < 16; ++j) l0[j] = -3.0e38f;
    gemm_128x128_cols_hook(Wt + (size_t)((h * 2 + 1) * 128) * DM, DM, A + (size_t)mt * 128 * DM, DM, s1, As, Bs, [&](const int kk) {
#pragma unroll
      for (int c4 = 0; c4 < 4; ++c4) {
        const int c = kk * 4 + c4;
        const unsigned kb = (__float_as_uint(s0[c >> 4][c & 15]) & 0xffffff80u) | (unsigned)c;
        tk_ins(l0, __uint_as_float(kb));
      }
    });
    finish_list(l0);
#pragma unroll
    for (int i = 0; i < 4; ++i) sp[i] = s1[i];
#pragma unroll
    for (int j = 0; j < 16; ++j) lp0[j] = l0[j];
    pmt = mt; ph = h; have_prev = true;
  }
  if (have_prev) {
    float L[16];
#pragma unroll
    for (int j = 0; j < 16; ++j) L[j] = -3.0e38f;
#pragma unroll
    for (int i = 0; i < 4; ++i)
#pragma unroll
      for (int r = 0; r < 16; ++r) {
        const unsigned kb = (__float_as_uint(sp[i][r]) & 0xffffff80u) | (unsigned)(i * 16 + r);
        tk_ins(L, __uint_as_float(kb));
      }
    finish_list(L);
    emit(pmt, ph, lp0, L);
  }
}

typedef float f32x2 __attribute__((ext_vector_type(2)));
DI float wave_max(float v) {
#pragma unroll
  for (int o = 32; o > 0; o >>= 1) v = fmaxf(v, __shfl_xor(v, o));
  return v;
}
DI float clamp6(float v) { return __builtin_amdgcn_fmed3f(v, -6.0f, 6.0f); }
DI void convert_v4_rows(const float* __restrict__ src, unsigned char* __restrict__ dst, float* __restrict__ scl) {
  const int lane = get_tid() & 63, w = get_tid() >> 6;
  for (int row = blockIdx.x * 4 + w; row < 16384; row += gridDim.x * 4) {
    const float4* s4 = (const float4*)(src + (size_t)row * 1024) + lane * 4;
    float4 v0 = s4[0], v1 = s4[1], v2 = s4[2], v3 = s4[3];
    float ss = v0.x * v0.x + v0.y * v0.y + v0.z * v0.z + v0.w * v0.w + v1.x * v1.x + v1.y * v1.y + v1.z * v1.z + v1.w * v1.w +
               v2.x * v2.x + v2.y * v2.y + v2.z * v2.z + v2.w * v2.w + v3.x * v3.x + v3.y * v3.y + v3.z * v3.z + v3.w * v3.w;
    ss = wave_sum(ss);
    const float sc = (ss > 0.f) ? 0.5f * sqrtf(ss * (1.0f / 1024.0f)) : 1.0f;
    const float inv = 1.0f / sc;
    unsigned d0 = 0, d1 = 0;
    d0 = __builtin_amdgcn_cvt_scalef32_pk_fp4_f32(d0, clamp6(v0.x * inv), clamp6(v0.y * inv), 1.0f, 0);
    d0 = __builtin_amdgcn_cvt_scalef32_pk_fp4_f32(d0, clamp6(v0.z * inv), clamp6(v0.w * inv), 1.0f, 1);
    d0 = __builtin_amdgcn_cvt_scalef32_pk_fp4_f32(d0, clamp6(v1.x * inv), clamp6(v1.y * inv), 1.0f, 2);
    d0 = __builtin_amdgcn_cvt_scalef32_pk_fp4_f32(d0, clamp6(v1.z * inv), clamp6(v1.w * inv), 1.0f, 3);
    d1 = __builtin_amdgcn_cvt_scalef32_pk_fp4_f32(d1, clamp6(v2.x * inv), clamp6(v2.y * inv), 1.0f, 0);
    d1 = __builtin_amdgcn_cvt_scalef32_pk_fp4_f32(d1, clamp6(v2.z * inv), clamp6(v2.w * inv), 1.0f, 1);
    d1 = __builtin_amdgcn_cvt_scalef32_pk_fp4_f32(d1, clamp6(v3.x * inv), clamp6(v3.y * inv), 1.0f, 2);
    d1 = __builtin_amdgcn_cvt_scalef32_pk_fp4_f32(d1, clamp6(v3.z * inv), clamp6(v3.w * inv), 1.0f, 3);
    ((u32x2*)(dst + (size_t)row * 512))[lane] = u32x2{d0, d1};
    if (lane == 0) scl[row] = sc;
  }
}
DI int q4(float v) {
  int n = (int)floorf(v);
  return (n < -8 ? -8 : (n > 7 ? 7 : n)) & 15;
}
DI void convert_u4_rows(const float* __restrict__ src, unsigned char* __restrict__ dst, float* __restrict__ scl) {
  const int lane = get_tid() & 63, w = get_tid() >> 6;
  for (int row = blockIdx.x * 4 + w; row < 16384; row += gridDim.x * 4) {
    const float4* s4 = (const float4*)(src + (size_t)row * 1024) + lane * 4;
    float4 v0 = s4[0], v1 = s4[1], v2 = s4[2], v3 = s4[3];
    float ss = v0.x * v0.x + v0.y * v0.y + v0.z * v0.z + v0.w * v0.w + v1.x * v1.x + v1.y * v1.y + v1.z * v1.z + v1.w * v1.w +
               v2.x * v2.x + v2.y * v2.y + v2.z * v2.z + v2.w * v2.w + v3.x * v3.x + v3.y * v3.y + v3.z * v3.z + v3.w * v3.w;
    ss = wave_sum(ss);
    const float sc = (ss > 0.f) ? 0.3352f * sqrtf(ss * (1.0f / 1024.0f)) : 1.0f;
    const float inv = 1.0f / sc;
    const unsigned d0 = (unsigned)q4(v0.x * inv) | ((unsigned)q4(v1.x * inv) << 4) | ((unsigned)q4(v0.y * inv) << 8) | ((unsigned)q4(v1.y * inv) << 12) |
                        ((unsigned)q4(v0.z * inv) << 16) | ((unsigned)q4(v1.z * inv) << 20) | ((unsigned)q4(v0.w * inv) << 24) | ((unsigned)q4(v1.w * inv) << 28);
    const unsigned d1 = (unsigned)q4(v2.x * inv) | ((unsigned)q4(v3.x * inv) << 4) | ((unsigned)q4(v2.y * inv) << 8) | ((unsigned)q4(v3.y * inv) << 12) |
                        ((unsigned)q4(v2.z * inv) << 16) | ((unsigned)q4(v3.z * inv) << 20) | ((unsigned)q4(v2.w * inv) << 24) | ((unsigned)q4(v3.w * inv) << 28);
    ((u32x2*)(dst + (size_t)row * 512))[lane] = u32x2{d0, d1};
    if (lane == 0) scl[row] = sc;
  }
}
DI void phase_convert_tables(const Params& p, int layer) {
  convert_u4_rows(p.peer_u + (size_t)layer * 16384 * 1024, (unsigned char*)(p.ws + OFF_UTAB), (float*)(p.ws + OFF_SU));
  convert_v4_rows(p.peer_v + (size_t)layer * 16384 * 1024, (unsigned char*)(p.ws + OFF_VTAB), (float*)(p.ws + OFF_SV));
}

struct GBuf { u32x4 u[8]; u32x4 v[8]; float su, sv, gw; };
#define FP4X2(d, s) __builtin_amdgcn_cvt_scalef32_pk_f32_fp4((d), 1.0f, (s))
#define FP4B2(d, s) __builtin_amdgcn_cvt_scalef32_pk_bf16_fp4((d), 1.0f, (s))
typedef __bf16 bf16x2v __attribute__((ext_vector_type(2)));
template <int X> DI float swz_xor(float v) {
  return __builtin_bit_cast(float, __builtin_amdgcn_ds_swizzle(__builtin_bit_cast(int, v), (X << 10) | 0x1f));
}
template <int L> DI float swz_bcast(float v) {
  return __builtin_bit_cast(float, __builtin_amdgcn_ds_swizzle(__builtin_bit_cast(int, v), (L << 5)));
}
DI float wave_sum_swz(float v) {
  v += swz_xor<1>(v); v += swz_xor<2>(v); v += swz_xor<4>(v); v += swz_xor<8>(v); v += swz_xor<16>(v);
  return __builtin_bit_cast(float, __builtin_amdgcn_readlane(__builtin_bit_cast(int, v), 0)) +
         __builtin_bit_cast(float, __builtin_amdgcn_readlane(__builtin_bit_cast(int, v), 32));
}
DI float bperm_f(float v, int byte_idx) { return __builtin_bit_cast(float, __builtin_amdgcn_ds_bpermute(byte_idx, __builtin_bit_cast(int, v))); }
DI void phase_peer_gather(const Params& p, int layer, int nrows, bool dry) {
  const int lane = get_tid() & 63, w = __builtin_amdgcn_readfirstlane(get_tid() >> 6);
  const int half = lane >> 5, l5 = lane & 31;
  const bf16* hb = (const bf16*)(p.ws + OFF_ACTA);
  const unsigned char* ut = tab_u(p, layer);
  const unsigned char* vtb = tab_v(p, layer);
  const float* su = tab_su(p, layer);
  const float* sv = tab_sv(p, layer);
  const int* ridx = (const int*)(p.ws + OFF_RIDX);
  const float* rgw = (const float*)(p.ws + OFF_RGW);
  const int ecode = half * 8 + ((lane >> 4) & 1) * 4 + ((lane >> 3) & 1) * 2 + ((lane >> 2) & 1);
  GBuf B0, B1;
  const int hidx = half * 32;
  int r = blockIdx.x * 4 + w;
  int e_lo = 0, e_hi = 0;
  float g_lo = 0.f, g_hi = 0.f;
  auto gload = [&](GBuf& B, int kb, int elo, int ehi, float glo, float ghi) {
    const int esrc = (kb < 4) ? elo : ehi;
    const float gsrc = (kb < 4) ? glo : ghi;
    const int base = (kb & 3) * 16;
#pragma unroll
    for (int j = 0; j < 8; ++j) {
      const int e = __builtin_amdgcn_ds_bpermute(hidx + ((base + j) << 2), esrc);
      const unsigned off = (unsigned)e * 512u + (unsigned)l5 * 16u;
      B.u[j] = *(const u32x4*)(ut + off);
      B.v[j] = *(const u32x4*)(vtb + off);
    }
    const int el = __builtin_amdgcn_ds_bpermute((base + ecode) << 2, esrc);
    B.su = su[el]; B.sv = sv[el];
    B.gw = bperm_f(gsrc, (base + ecode) << 2);
  };
  if (r < nrows) {
    e_lo = ridx[(size_t)r * 128 + lane]; e_hi = ridx[(size_t)r * 128 + 64 + lane];
    g_lo = rgw[(size_t)r * 128 + lane]; g_hi = rgw[(size_t)r * 128 + 64 + lane];
    gload(B0, 0, e_lo, e_hi, g_lo, g_hi);
  }
  for (; r < nrows; r += gridDim.x * 4) {
    const int rn = r + gridDim.x * 4;
    int ne_lo = 0, ne_hi = 0;
    float ng_lo = 0.f, ng_hi = 0.f;
    if (rn < nrows) {
      ne_lo = ridx[(size_t)rn * 128 + lane]; ne_hi = ridx[(size_t)rn * 128 + 64 + lane];
      ng_lo = rgw[(size_t)rn * 128 + lane]; ng_hi = rgw[(size_t)rn * 128 + 64 + lane];
    }
    unsigned HH[4], HL[4];
    float sh8, h8tot;
    {
      const u32x4* hp = (const u32x4*)(hb + (size_t)r * DM + l5 * 32);
      u32x4 a[4];
#pragma unroll
      for (int q = 0; q < 4; ++q) a[q] = hp[q];
      float m = 0.f;
#pragma unroll
      for (int q = 0; q < 4; ++q)
#pragma unroll
        for (int c = 0; c < 4; ++c) m = fmaxf(m, fmaxf(fabsf(bflo(a[q][c])), fabsf(bfhi(a[q][c]))));
      m = fmaxf(m, swz_xor<1>(m)); m = fmaxf(m, swz_xor<2>(m)); m = fmaxf(m, swz_xor<4>(m));
      m = fmaxf(m, swz_xor<8>(m)); m = fmaxf(m, swz_xor<16>(m));
      const float sc = (m > 0.f) ? 119.0f / m : 0.f;
      sh8 = m * (1.0f / 119.0f);
      float hs = 0.f;
#pragma unroll
      for (int q = 0; q < 4; ++q) {
        float f[8] = {bflo(a[q][0]), bfhi(a[q][0]), bflo(a[q][1]), bfhi(a[q][1]), bflo(a[q][2]), bfhi(a[q][2]), bflo(a[q][3]), bfhi(a[q][3])};
        unsigned P0 = 0, P1 = 0;
#pragma unroll
        for (int i = 0; i < 4; ++i) {
          const float g0 = rintf(f[i] * sc), g1 = rintf(f[4 + i] * sc);
          hs += g0 + g1;
          P0 = __builtin_amdgcn_cvt_pk_u8_f32(g0 + 136.0f, i, P0);
          P1 = __builtin_amdgcn_cvt_pk_u8_f32(g1 + 136.0f, i, P1);
        }
        HH[q] = (((P0 >> 4) & 0x0F0F0F0Fu) | (P1 & 0xF0F0F0F0u)) ^ 0x88888888u;
        HL[q] = ((P0 & 0x0F0F0F0Fu) | ((P1 << 4) & 0xF0F0F0F0u)) ^ 0x88888888u;
      }
      hs += swz_xor<1>(hs); hs += swz_xor<2>(hs); hs += swz_xor<4>(hs); hs += swz_xor<8>(hs); hs += swz_xor<16>(hs);
      h8tot = 0.5f * hs;
    }
    f32x2 acc[16];
#pragma unroll
    for (int j = 0; j < 16; ++j) acc[j] = f32x2{0.f, 0.f};
    auto compute = [&](GBuf& B) {
      float part[8];
#pragma unroll
      for (int j = 0; j < 8; ++j) {
        int dh = 0, dl = 0;
#pragma unroll
        for (int q = 0; q < 4; ++q) {
          dh = __builtin_amdgcn_sdot8((int)B.u[j][q], (int)HH[q], dh, false);
          dl = __builtin_amdgcn_sdot8((int)B.u[j][q], (int)HL[q], dl, false);
        }
        part[j] = (float)((dh << 4) + dl);
      }
      const bool b4 = lane & 16, b3 = lane & 8, b2 = lane & 4;
      float y[4], z[2], t;
#pragma unroll
      for (int i = 0; i < 4; ++i) {
        float send = b4 ? part[i] : part[i + 4];
        float keep = b4 ? part[i + 4] : part[i];
        y[i] = keep + swz_xor<16>(send);
      }
#pragma unroll
      for (int i = 0; i < 2; ++i) {
        float send = b3 ? y[i] : y[i + 2];
        float keep = b3 ? y[i + 2] : y[i];
        z[i] = keep + swz_xor<8>(send);
      }
      {
        float send = b2 ? z[0] : z[1];
        float keep = b2 ? z[1] : z[0];
        t = keep + swz_xor<4>(send);
      }
      t += swz_xor<2>(t);
      t += swz_xor<1>(t);
      const float wl = gelu_as((t + h8tot) * (B.su * sh8)) * B.gw * B.sv;
#define GACC(J)                                                                                        \
      {                                                                                                  \
        const float wj = swz_bcast<(((J) >> 2) & 1) * 16 + (((J) >> 1) & 1) * 8 + ((J) & 1) * 4>(wl);    \
        const f32x2 w2 = f32x2{wj, wj};                                                                  \
        _Pragma("unroll") for (int q = 0; q < 4; ++q) {                                                  \
          acc[4 * q] += w2 * FP4X2(B.v[J][q], 0);                                                        \
          acc[4 * q + 1] += w2 * FP4X2(B.v[J][q], 1);                                                    \
          acc[4 * q + 2] += w2 * FP4X2(B.v[J][q], 2);                                                    \
          acc[4 * q + 3] += w2 * FP4X2(B.v[J][q], 3);                                                    \
        }                                                                                                \
      }
      GACC(0) GACC(1) GACC(2) GACC(3) GACC(4) GACC(5) GACC(6) GACC(7)
#undef GACC
    };
#pragma unroll 1
    for (int kb = 0; kb < 8; kb += 2) {
      gload(B1, kb + 1, e_lo, e_hi, g_lo, g_hi);
      compute(B0);
      {
        const bool nx = kb + 2 >= 8;
        gload(B0, (kb + 2) & 7, nx ? ne_lo : e_lo, nx ? ne_hi : e_hi, nx ? ng_lo : g_lo, nx ? ng_hi : g_hi);
      }
      compute(B1);
    }
    e_lo = ne_lo; e_hi = ne_hi; g_lo = ng_lo; g_hi = ng_hi;
    if (dry && acc[0].x != 12345.678f) continue;
    f32x2 fin[8];
#pragma unroll
    for (int k = 0; k < 8; ++k) {
      f32x2 send = half ? acc[k] : acc[k + 8];
      f32x2 keep = half ? acc[k + 8] : acc[k];
      fin[k] = f32x2{keep.x + bperm_f(send.x, (lane ^ 32) << 2), keep.y + bperm_f(send.y, (lane ^ 32) << 2)};
    }
    int eo = l5 * 32 + half * 16;
    asm volatile("" : "+v"(eo));
    float* xr = res_row(p, r) + eo;
    const float* g5 = mod_ptr(p, layer, r, 5) + eo;
    float4 xn[4];
    float ss = 0.f;
#pragma unroll
    for (int q = 0; q < 4; ++q) {
      float4 x0 = ((float4*)xr)[q];
      float4 m0 = ((const float4*)g5)[q];
      x0.x += m0.x * fin[2 * q].x; x0.y += m0.y * fin[2 * q].y; x0.z += m0.z * fin[2 * q + 1].x; x0.w += m0.w * fin[2 * q + 1].y;
      xn[q] = x0;
      ss += x0.x * x0.x + x0.y * x0.y + x0.z * x0.z + x0.w * x0.w;
    }
    ss = wave_sum_swz(ss);
    const float rs = rsqrtf(ss * (1.0f / 1024.0f) + EPSN);
    if (layer == 0) {
      const float* gg = p.norm1_g + 1024 + eo;
      const float* sh = mod_ptr(p, 1, r, 0) + eo;
      const float* sc = mod_ptr(p, 1, r, 1) + eo;
      unsigned hw[8];
#pragma unroll
      for (int q = 0; q < 4; ++q) {
        ((float4*)xr)[q] = xn[q];
        float4 g4 = ((const float4*)gg)[q], s4 = ((const float4*)sh)[q], c4 = ((const float4*)sc)[q];
        float o0 = xn[q].x * rs * g4.x * (1.f + c4.x) + s4.x;
        float o1 = xn[q].y * rs * g4.y * (1.f + c4.y) + s4.y;
        float o2 = xn[q].z * rs * g4.z * (1.f + c4.z) + s4.z;
        float o3 = xn[q].w * rs * g4.w * (1.f + c4.w) + s4.w;
        hw[2 * q] = cvtpk(o0, o1); hw[2 * q + 1] = cvtpk(o2, o3);
      }
      u32x4 w0 = {hw[0], hw[1], hw[2], hw[3]}, w1 = {hw[4], hw[5], hw[6], hw[7]};
      bf16* hd = (bf16*)(p.ws + OFF_ACTA) + (size_t)r * DM + eo;
      *(u32x4*)hd = w0;
      *(u32x4*)(hd + 8) = w1;
    } else {
      const float* gg = p.final_g + eo;
#pragma unroll
      for (int q = 0; q < 4; ++q) {
        float4 g4 = ((const float4*)gg)[q];
        float4 o;
        o.x = xn[q].x * rs * g4.x; o.y = xn[q].y * rs * g4.y; o.z = xn[q].z * rs * g4.z; o.w = xn[q].w * rs * g4.w;
        ((float4*)xr)[q] = o;
      }
    }
  }
}

DI void phase_inproj1(const Params& p, char* smem) {
  bf16* As = (bf16*)smem; bf16* Bs = As + 256 * GLS;
  const bf16* A = (const bf16*)(p.ws + OFF_ACTA);
  const bf16* Wt = (const bf16*)(p.ws + OFF_WT_ODIN);
  bf16* pm = (bf16*)(p.ws + OFF_PA1M);
  bf16* pu = (bf16*)(p.ws + OFF_U1);
  const int ntn = 10, ntm = NTOK / 256;
  for (int t = blockIdx.x; t < ntn * ntm; t += gridDim.x) {
    const int mt = t / ntn, nt = t % ntn;
    f32x16 acc[4][2];
    gemm_256x128(A + (size_t)mt * 256 * DM, DM, Wt + (size_t)nt * 128 * DM, DM, DM, acc, As, Bs);
    constexpr int OLS = 136;
    bf16* Ot = (bf16*)smem;
    __syncthreads();
    gemm_epi2(acc, [&](int row, int col, float v) { Ot[row * OLS + col] = f2bf(v); });
    __syncthreads();
#pragma unroll
    for (int i = 0; i < 16; ++i) {
      const int ci = i * 256 + get_tid(), orow = ci >> 4, och = ci & 15;
      const int cg0 = nt * 128 + och * 8, r = mt * 256 + orow;
      const u32x4 val = *(const u32x4*)(Ot + orow * OLS + och * 8);
      if (cg0 < 672) *(u32x4*)(pm + (size_t)r * 672 + cg0) = val;
      else if (cg0 < 1184) *(u32x4*)(pu + (size_t)r * 512 + (cg0 - 672)) = val;
    }
  }
}

DI void phase_mla_prep(const Params& p) {
  const int lane = get_tid() & 63, w = get_tid() >> 6;
  const bf16* pm = (const bf16*)(p.ws + OFF_PA1M);
  bf16* qn = (bf16*)(p.ws + OFF_QN);
  bf16* kvn = (bf16*)(p.ws + OFF_KVN);
  bf16* k1 = (bf16*)(p.ws + OFF_K1);
  const float inv = __powf(10000.f, -(float)(lane & 7) / 8.f);
  for (int r = blockIdx.x * 4 + w; r < NTOK; r += gridDim.x * 4) {
    const bf16* row = pm + (size_t)r * 672;
    if (r < NLAT) {
      float v[6]; float ss = 0.f;
#pragma unroll
      for (int i = 0; i < 6; ++i) { v[i] = bf2f(row[i * 64 + lane]); ss += v[i] * v[i]; }
      ss = wave_sum(ss);
      const float rs = rsqrtf(ss * (1.f / 384.f) + EPSN);
#pragma unroll
      for (int i = 0; i < 6; ++i) qn[(size_t)r * 384 + i * 64 + lane] = f2bf(v[i] * rs * p.mla_qa_g[i * 64 + lane]);
    }
    {
      float v[4]; float ss = 0.f;
#pragma unroll
      for (int i = 0; i < 4; ++i) { v[i] = bf2f(row[384 + i * 64 + lane]); ss += v[i] * v[i]; }
      ss = wave_sum(ss);
      const float rs = rsqrtf(ss * (1.f / 256.f) + EPSN);
#pragma unroll
      for (int i = 0; i < 4; ++i) kvn[(size_t)r * 256 + i * 64 + lane] = f2bf(v[i] * rs * p.mla_kva_g[i * 64 + lane]);
    }
    {
      const int cl = lane & 31;
      float y = bf2f(row[640 + cl]);
      float sn = 0.f, cs = 1.f;
      if (r < NLAT) {
        int t = r & 8191;
        float pos = (cl < 16) ? (float)(t >> 6) : (float)(t & 63);
        sincosf(pos * inv, &sn, &cs);
      }
      float pr = __shfl_xor(y, 8);
      float o = y * cs + ((cl & 8) ? pr * sn : -pr * sn);
      bf16 ob = f2bf(o);
      {
        const float ob_f = bf2f(ob);
        const float sq = wave_sum(lane < 32 ? ob_f * ob_f : 0.f);
        if (lane == 0) ((float*)(p.ws + OFF_KRSQ))[r] = sq;
      }
      const int hb = (lane >> 5) * 4;
#pragma unroll
      for (int hh = 0; hh < 4; ++hh) k1[(size_t)r * 768 + (hb + hh) * 96 + 64 + cl] = ob;
    }
  }
}

DI void phase_mla_up(const Params& p, char* smem) {
  bf16* As = (bf16*)smem; bf16* Bs = As + 128 * GLS;
  constexpr int OLS = 136;
  bf16* Ot = (bf16*)smem;
  const bf16* qn = (const bf16*)(p.ws + OFF_QN);
  const bf16* kvn = (const bf16*)(p.ws + OFF_KVN);
  const bf16* wq = (const bf16*)(p.ws + OFF_WT_QUP);
  const bf16* wkv = (const bf16*)(p.ws + OFF_WT_KVUP);
  bf16* q1 = (bf16*)(p.ws + OFF_Q1);
  bf16* k1 = (bf16*)(p.ws + OFF_K1);
  bf16* vt1 = (bf16*)(p.ws + OFF_VT1);
  const float2* rtab = (const float2*)(p.ws + OFF_ROPE1);
  const int lane = get_tid() & 63, w = get_tid() >> 6;
  const int wm = w >> 1, wn = w & 1;
  const int nq = (NLAT / 128) * 6, nkv = (NTOK / 128) * 8;
  for (int t = blockIdx.x; t < nq + nkv; t += gridDim.x) {
    f32x16 acc[2][2];
    if (t < nq) {
      const int mt = t / 6, nt = t % 6;
      gemm_128x128(qn + (size_t)mt * 128 * 384, 384, wq + (size_t)nt * 128 * 384, 384, 384, acc, As, Bs);
      __syncthreads();
#pragma unroll
      for (int mi = 0; mi < 2; ++mi)
#pragma unroll
        for (int ni = 0; ni < 2; ++ni) {
          const int colbase = nt * 128 + wn * 64 + ni * 32;
          const bool rope = (colbase % 96) == 64;
          const int cl = lane & 31;
#pragma unroll
          for (int r = 0; r < 16; ++r) {
            const int trow = wm * 64 + mi * 32 + crow(r, lane);
            const int row = mt * 128 + trow;
            float v = acc[mi][ni][r];
            if (rope) {
              float pr = __shfl_xor(v, 8);
              int tt = row & 8191;
              float2 csn = rtab[tt * 16 + ((cl >> 4) << 3) + (cl & 7)];
              v = v * csn.x + ((cl & 8) ? pr * csn.y : -pr * csn.y);
            }
            Ot[trow * OLS + wn * 64 + ni * 32 + cl] = f2bf(v * (0.10206207261596577f * 1.4426950408889634f));
          }
        }
      __syncthreads();
#pragma unroll
      for (int i = 0; i < 8; ++i) {
        const int ci = i * 256 + get_tid(), orow = ci >> 4, och = ci & 15;
        *(u32x4*)(q1 + (size_t)(mt * 128 + orow) * 768 + nt * 128 + och * 8) = *(const u32x4*)(Ot + orow * OLS + och * 8);
      }
    } else {
      const int t2 = t - nq;
      const int mt = t2 >> 3, h = t2 & 7;
      gemm_128x128(kvn + (size_t)mt * 128 * 256, 256, wkv + (size_t)h * 128 * 256, 256, 256, acc, As, Bs);
      __syncthreads();
      const int r0 = mt * 128;
      int b, s0;
      if (r0 < NLAT) { b = r0 >> 13; s0 = CTXL + (r0 & 8191); } else { int rc = r0 - NLAT; b = rc >> 8; s0 = rc & 255; }
#pragma unroll
      for (int mi = 0; mi < 2; ++mi)
#pragma unroll
        for (int ni = 0; ni < 2; ++ni) {
          const int cl = ni * 32 + (lane & 31);
          if (wn == 0) {
#pragma unroll
            for (int r = 0; r < 16; ++r) Ot[(wm * 64 + mi * 32 + crow(r, lane)) * OLS + cl] = f2bf(acc[mi][ni][r]);
            if (ni == 1) {
              float mxk = 0.f;
#pragma unroll
              for (int r = 0; r < 16; ++r) {
                float sq = acc[mi][0][r] * acc[mi][0][r] + acc[mi][1][r] * acc[mi][1][r];
                sq += __shfl_xor(sq, 16); sq += __shfl_xor(sq, 8); sq += __shfl_xor(sq, 4); sq += __shfl_xor(sq, 2); sq += __shfl_xor(sq, 1);
                const int row = r0 + wm * 64 + mi * 32 + crow(r, lane);
                sq += ((const float*)(p.ws + OFF_KRSQ))[row];
                mxk = fmaxf(mxk, sq);
              }
              mxk = wave_max(mxk);
              if (lane == 0) atomicMax((unsigned*)(p.ws + OFF_KMAX) + b * 8 + h, __float_as_uint(sqrtf(mxk) * 1.02f));
            }
          } else {
            bf16* vrow = vt1 + (size_t)((b * 8 + h) * 64 + cl) * SKEYS + s0 + wm * 64 + mi * 32;
#pragma unroll
            for (int g4 = 0; g4 < 4; ++g4) {
              u32x2 o;
              o.x = cvtpk(acc[mi][ni][4 * g4], acc[mi][ni][4 * g4 + 1]);
              o.y = cvtpk(acc[mi][ni][4 * g4 + 2], acc[mi][ni][4 * g4 + 3]);
              *(u32x2*)(vrow + 8 * g4 + 4 * (lane >> 5)) = o;
            }
          }
        }
      __syncthreads();
#pragma unroll
      for (int i = 0; i < 4; ++i) {
        const int ci = i * 256 + get_tid(), orow = ci >> 3, och = ci & 7;
        *(u32x4*)(k1 + (size_t)(r0 + orow) * 768 + h * 96 + och * 8) = *(const u32x4*)(Ot + orow * OLS + och * 8);
      }
    }
  }
}

DI void s5_item(const Params& p, int item, char* smem) {
  const int dir = item & 1, g = (item >> 1) & 31, b = item >> 6;
  constexpr int ULS = 264, SLS = 136;
  bf16* Uc = (bf16*)smem;
  bf16* Sp = Uc + 32 * ULS;
  float* E = (float*)(Sp + 32 * SLS);
  const int mi_ = g * 2 + dir;
  const bf16* T = (const bf16*)(p.ws + OFF_S5T) + (size_t)mi_ * 65536;
  const bf16* WE = (const bf16*)(p.ws + OFF_S5WE) + (size_t)mi_ * 32768;
  const bf16* WY = (const bf16*)(p.ws + OFF_S5WY) + (size_t)mi_ * 32768;
  const float* A16 = (const float*)(p.ws + OFF_S5A16) + (size_t)mi_ * 128;
  const bf16* U1 = (const bf16*)(p.ws + OFF_U1);
  bf16* ys = (bf16*)(p.ws + OFF_YS5) + (size_t)dir * NLAT * 512;
  const int tid = get_tid(), lane = tid & 63, w = tid >> 6;
  auto rowof = [&](int pos) -> int {
    if (pos < CTXL) { int s = dir ? (CTXL - 1 - pos) : pos; return NLAT + b * CTXL + s; }
    int t = pos - CTXL; t = dir ? (SEQ - 1 - t) : t; return b * SEQ + t;
  };
  float sre = 0.f, sim = 0.f;
  const float a16r = A16[(lane & 63) * 2], a16i = A16[(lane & 63) * 2 + 1];
  for (int sc = 0; sc < 17; ++sc) {
    const int nvalid = (528 - sc * 32) < 32 ? (528 - sc * 32) : 32;
    __syncthreads();
    {
      const int n = tid >> 3, j0 = (tid & 7) * 2;
#pragma unroll
      for (int jj = 0; jj < 2; ++jj) {
        u32x4 a = {0u, 0u, 0u, 0u}, b2 = {0u, 0u, 0u, 0u};
        if (n < nvalid) {
          const int pos = (sc * 32 + n) * 16 + j0 + jj;
          const bf16* src = U1 + (size_t)rowof(pos) * 512 + g * 16;
          a = *(const u32x4*)src; b2 = *(const u32x4*)(src + 8);
        }
        *(u32x4*)(Uc + n * ULS + (j0 + jj) * 16) = a;
        *(u32x4*)(Uc + n * ULS + (j0 + jj) * 16 + 8) = b2;
      }
    }
    __syncthreads();
    f32x16 e, y0, y1;
#pragma unroll
    for (int r = 0; r < 16; ++r) { e[r] = 0.f; y0[r] = 0.f; y1[r] = 0.f; }
    mma_tile_ga<256>(e, WE + (size_t)(w * 32) * 256, 256, Uc, ULS);
#pragma unroll
    for (int r = 0; r < 16; ++r) E[(w * 32 + crow(r, lane)) * 33 + (lane & 31)] = e[r];
    mma_tile_ga<256>(y0, T + (size_t)(2 * w * 32) * 256, 256, Uc, ULS);
    mma_tile_ga<256>(y1, T + (size_t)((2 * w + 1) * 32) * 256, 256, Uc, ULS);
    __syncthreads();
    if (w == 0) {
      for (int n = 0; n < 32; ++n) {
        Sp[n * SLS + lane] = f2bf(sre);
        Sp[n * SLS + 64 + lane] = f2bf(sim);
        float er = E[lane * 33 + n], ei = E[(64 + lane) * 33 + n];
        float nr = a16r * sre - a16i * sim + er;
        float ni = a16r * sim + a16i * sre + ei;
        sre = nr; sim = ni;
      }
    }
    __syncthreads();
    mma_tile_ga<128>(y0, WY + (size_t)(2 * w * 32) * 128, 128, Sp, SLS);
    mma_tile_ga<128>(y1, WY + (size_t)((2 * w + 1) * 32) * 128, 128, Sp, SLS);
    {
      const int n = lane & 31;
      if (n < nvalid) {
        const int cgi = sc * 32 + n;
#pragma unroll
        for (int tI = 0; tI < 2; ++tI) {
          const f32x16& y = tI ? y1 : y0;
#pragma unroll
          for (int g4 = 0; g4 < 4; ++g4) {
            const int m = (2 * w + tI) * 32 + 8 * g4 + 4 * (lane >> 5);
            const int i = m >> 4, c0 = m & 15;
            const int pos = cgi * 16 + i;
            if (pos >= CTXL) {
              u32x2 o;
              o.x = cvtpk(y[4 * g4], y[4 * g4 + 1]);
              o.y = cvtpk(y[4 * g4 + 2], y[4 * g4 + 3]);
              *(u32x2*)(ys + (size_t)rowof(pos) * 512 + g * 16 + c0) = o;
            }
          }
        }
      }
    }
  }
}

DI void phase_mix1(const Params& p, char* smem, int cidx) {
  __shared__ int s_item1;
  if (cidx == 1 && blockIdx.x < 256) s5_item(p, blockIdx.x, smem);
  unsigned* cnt = (unsigned*)(p.ws + OFF_CNT) + cidx;
  const bf16* q1 = (const bf16*)(p.ws + OFF_Q1);
  const bf16* k1 = (const bf16*)(p.ws + OFF_K1);
  const bf16* vt = (const bf16*)(p.ws + OFF_VT1);
  bf16* ycat = (bf16*)(p.ws + OFF_ACTA);
  const int n_lat = 4 * 8 * 32;
  while (true) {
    __syncthreads();
    if (get_tid() == 0) s_item1 = (int)atomicAdd(cnt, 1u);
    __syncthreads();
    const int it = s_item1;
    if (it >= n_lat) break;
    const int qt = it & 31, h = (it >> 5) & 7, b = it >> 8;
    const int r0 = b * SEQ + qt * 256;
    attn_item<96, 2>(q1 + (size_t)r0 * 768 + h * 96, 768, k1 + (size_t)(NLAT + b * CTXL) * 768 + h * 96,
                  k1 + (size_t)(b * SEQ) * 768 + h * 96, 768, vt + (size_t)((b * 8 + h) * 64) * SKEYS, SKEYS,
                  ycat + (size_t)r0 * DM + h * 64, DM, 0.10206207261596577f, smem, ((const float*)(p.ws + OFF_KMAX))[b * 8 + h]);
  }
}

DI void phase_s5_z(const Params& p) {
  const bf16* U1 = (const bf16*)(p.ws + OFF_U1);
  const bf16* y0 = (const bf16*)(p.ws + OFF_YS5);
  const bf16* y1 = y0 + (size_t)NLAT * 512;
  bf16* z = (bf16*)(p.ws + OFF_Z1);
  const size_t nv = (size_t)NLAT * 512 / 8;
  for (size_t i = (size_t)blockIdx.x * 256 + get_tid(); i < nv; i += (size_t)gridDim.x * 256) {
    const int col = (int)(i & 63) * 8;
    u32x4 u = ((const u32x4*)U1)[i], a = ((const u32x4*)y0)[i], b2 = ((const u32x4*)y1)[i];
    float fu[8], fa[8], fb[8], o[8];
    f32x16 dummy; (void)dummy;
    fu[0] = bflo(u.x); fu[1] = bfhi(u.x); fu[2] = bflo(u.y); fu[3] = bfhi(u.y); fu[4] = bflo(u.z); fu[5] = bfhi(u.z); fu[6] = bflo(u.w); fu[7] = bfhi(u.w);
    fa[0] = bflo(a.x); fa[1] = bfhi(a.x); fa[2] = bflo(a.y); fa[3] = bfhi(a.y); fa[4] = bflo(a.z); fa[5] = bfhi(a.z); fa[6] = bflo(a.w); fa[7] = bfhi(a.w);
    fb[0] = bflo(b2.x); fb[1] = bfhi(b2.x); fb[2] = bflo(b2.y); fb[3] = bfhi(b2.y); fb[4] = bflo(b2.z); fb[5] = bfhi(b2.z); fb[6] = bflo(b2.w); fb[7] = bfhi(b2.w);
#pragma unroll
    for (int j = 0; j < 8; ++j) o[j] = geluf_(p.s5_d[col + j] * fu[j] + fa[j] + fb[j]);
    u32x4 ov;
    ov.x = cvtpk(o[0], o[1]); ov.y = cvtpk(o[2], o[3]); ov.z = cvtpk(o[4], o[5]); ov.w = cvtpk(o[6], o[7]);
    ((u32x4*)z)[i] = ov;
  }
}

DI void phase_glu(const Params& p, char* smem) {
  bf16* As = (bf16*)smem; bf16* Bs = As + 256 * GLS;
  const bf16* z = (const bf16*)(p.ws + OFF_Z1);
  const bf16* Wt = (const bf16*)(p.ws + OFF_WT_GLU);
  bf16* ycat = (bf16*)(p.ws + OFF_ACTA);
  const int ntn = 4, ntm = NLAT / 256;
  for (int t = blockIdx.x; t < ntn * ntm; t += gridDim.x) {
    const int mt = t / ntn, nt = t % ntn;
    f32x16 acc[4][2];
    gemm_256x128(z + (size_t)mt * 256 * 512, 512, Wt + (size_t)nt * 128 * 512, 512, 512, acc, As, Bs);
    constexpr int OLS = 136;
    bf16* Ot = (bf16*)smem;
    __syncthreads();
    gemm_epi2(acc, [&](int row, int col, float v) { Ot[row * OLS + col] = f2bf(sigmoidf_(v + p.s5_b_glu[nt * 128 + col])); });
    __syncthreads();
#pragma unroll
    for (int i = 0; i < 16; ++i) {
      const int ci = i * 256 + get_tid(), orow = ci >> 4, och = ci & 15;
      const int r = mt * 256 + orow, cc = nt * 128 + och * 8;
      const u32x4 gz = *(const u32x4*)(Ot + orow * OLS + och * 8);
      const u32x4 zz = *(const u32x4*)(z + (size_t)r * 512 + cc);
      u32x4 o;
      o.x = cvtpk(bflo(zz.x) * bflo(gz.x), bfhi(zz.x) * bfhi(gz.x));
      o.y = cvtpk(bflo(zz.y) * bflo(gz.y), bfhi(zz.y) * bfhi(gz.y));
      o.z = cvtpk(bflo(zz.z) * bflo(gz.z), bfhi(zz.z) * bfhi(gz.z));
      o.w = cvtpk(bflo(zz.w) * bflo(gz.w), bfhi(zz.w) * bfhi(gz.w));
      *(u32x4*)(ycat + (size_t)r * DM + 512 + cc) = o;
    }
  }
}

DI void phase_final(const Params& p) {
  const int lane = get_tid() & 63, w = get_tid() >> 6;
  for (int r = blockIdx.x * 4 + w; r < NLAT; r += gridDim.x * 4) {
    float* row = p.out + (size_t)r * DM;
    float4 v[4];
    float ss = 0.f;
#pragma unroll
    for (int i = 0; i < 4; ++i) {
      v[i] = ((const float4*)row)[i * 64 + lane];
      ss += v[i].x * v[i].x + v[i].y * v[i].y + v[i].z * v[i].z + v[i].w * v[i].w;
    }
    ss = wave_sum(ss);
    const float rs = rsqrtf(ss * (1.0f / 1024.0f) + EPSN);
#pragma unroll
    for (int i = 0; i < 4; ++i) {
      float4 gg = ((const float4*)p.final_g)[i * 64 + lane];
      float4 o;
      o.x = v[i].x * rs * gg.x; o.y = v[i].y * rs * gg.y; o.z = v[i].z * rs * gg.z; o.w = v[i].w * rs * gg.w;
      ((float4*)row)[i * 64 + lane] = o;
    }
  }
}

DI void phase_copy_x(const Params& p) {
  const size_t n4 = (size_t)NLAT * DM / 4;
  for (size_t i = (size_t)blockIdx.x * 256 + get_tid(); i < n4; i += (size_t)gridDim.x * 256)
    ((float4*)p.out)[i] = ((const float4*)p.x)[i];
}

#define XB_TMO      128
#define XB_XCNT(j)  (256  + 64 * (j))
#define XB_XSUB(j)  (1280 + 64 * (j))
#define XB_XGEN(j)  (2304 + 64 * (j))
#define XB_TOP      3328
#define XB_TOPGEN   3392
#define XCD_BAR_WORDS 3456
#define XB_SPIN_CAP (1u << 22)
#define LAS __attribute__((address_space(3)))

__device__ __forceinline__ unsigned xb_ld(unsigned* p)              { return __hip_atomic_load(p, __ATOMIC_RELAXED, __HIP_MEMORY_SCOPE_AGENT); }
__device__ __forceinline__ unsigned xb_add(unsigned* p, unsigned v) { return __hip_atomic_fetch_add(p, v, __ATOMIC_RELAXED, __HIP_MEMORY_SCOPE_AGENT); }
__device__ __forceinline__ unsigned xb_xcc_id() { return (unsigned)__builtin_amdgcn_s_getreg((3 << 11) | 20) & 0xFu; }
#define XB_SPIN(cond, bar) do { unsigned _sp = 0; while (cond) { __builtin_amdgcn_s_sleep(1); \
    if ((++_sp & 255u) == 0u) { if (xb_ld(&(bar)[XB_TMO])) break; if (_sp > XB_SPIN_CAP) { atomicAdd(&(bar)[XB_TMO], 1u); break; } } } } while (0)

struct XcdBarrier {
    unsigned* bar; unsigned x;
    volatile LAS unsigned* st;
};

__device__ __forceinline__ XcdBarrier xcd_barrier_post(unsigned* bar, volatile LAS unsigned* st) {
    XcdBarrier b; b.bar = bar; b.x = xb_xcc_id(); b.st = st;
    if (threadIdx.x == 0) (void)xb_add(&bar[XB_XCNT(b.x)], 1u);
    return b;
}
__device__ __forceinline__ void xcd_barrier_complete(unsigned* bar, unsigned x, unsigned& nloc, unsigned& nx) {
    const unsigned G = gridDim.x * gridDim.y * gridDim.z;
    unsigned sum, cnt, mine, sp = 0u;
    for (;;) {
        sum = 0u; cnt = 0u; mine = 0u;
#pragma unroll
        for (unsigned j = 0; j < 16; ++j) { const unsigned c = xb_ld(&bar[XB_XCNT(j)]); sum += c; cnt += (c > 0u) ? 1u : 0u; mine = (j == x) ? c : mine; }
        if (sum == G) break;
        __builtin_amdgcn_s_sleep(1);
        if ((++sp & 255u) == 0u) { if (xb_ld(&bar[XB_TMO])) break; if (sp > XB_SPIN_CAP) { atomicAdd(&bar[XB_TMO], 1u); break; } }
    }
    nloc = mine > 0u ? mine : 1u; nx = cnt > 0u ? cnt : 1u;
}

__device__ __forceinline__ void xcd_barrier(const XcdBarrier& b) {
    asm volatile("s_waitcnt vmcnt(0)" ::: "memory");
    __syncthreads();
    if (threadIdx.x == 0) {
        unsigned* bar = b.bar;
        __builtin_amdgcn_s_waitcnt(0);
        unsigned nloc = b.st[0], nx = b.st[1];
        if (nloc == 0u) { xcd_barrier_complete(bar, b.x, nloc, nx); b.st[0] = nloc; b.st[1] = nx; }
        const unsigned old = xb_add(&bar[XB_XSUB(b.x)], 1u);
        const unsigned gen = old / nloc;
        if (old + 1u == (gen + 1u) * nloc) {
            __builtin_amdgcn_fence(__ATOMIC_RELEASE, "agent");
            asm volatile("s_waitcnt vmcnt(0)" ::: "memory");
            const unsigned og = xb_add(&bar[XB_TOP], 1u);
            const unsigned tg = og / nx;
            if (og + 1u == (tg + 1u) * nx) xb_add(&bar[XB_TOPGEN], 1u);
            else XB_SPIN(xb_ld(&bar[XB_TOPGEN]) == tg, bar);
            __builtin_amdgcn_fence(__ATOMIC_ACQUIRE, "agent");
            xb_add(&bar[XB_XGEN(b.x)], 1u);
            asm volatile("s_waitcnt vmcnt(0)" ::: "memory");
        } else {
            XB_SPIN(xb_ld(&bar[XB_XGEN(b.x)]) == gen, bar);
            __builtin_amdgcn_fence(__ATOMIC_ACQUIRE, "agent");
            asm volatile("s_waitcnt vmcnt(0)" ::: "memory");
        }
    }
    __syncthreads();
}
__device__ __forceinline__ void xcd_barrier_fast(const XcdBarrier& b) {
    asm volatile("s_waitcnt vmcnt(0)" ::: "memory");
    __syncthreads();
    if (threadIdx.x == 0) {
        unsigned* bar = b.bar;
        __builtin_amdgcn_s_waitcnt(0);
        unsigned nloc = b.st[0], nx = b.st[1];
        const unsigned old = xb_add(&bar[XB_XSUB(b.x)], 1u);
        const unsigned gen = old / nloc;
        if (old + 1u == (gen + 1u) * nloc) {
            __builtin_amdgcn_fence(__ATOMIC_RELEASE, "agent");
            asm volatile("s_waitcnt vmcnt(0)" ::: "memory");
            const unsigned og = xb_add(&bar[XB_TOP], 1u);
            const unsigned tg = og / nx;
            if (og + 1u == (tg + 1u) * nx) xb_add(&bar[XB_TOPGEN], 1u);
            else XB_SPIN(xb_ld(&bar[XB_TOPGEN]) == tg, bar);
            __builtin_amdgcn_fence(__ATOMIC_ACQUIRE, "agent");
            xb_add(&bar[XB_XGEN(b.x)], 1u);
            asm volatile("s_waitcnt vmcnt(0)" ::: "memory");
        } else {
            XB_SPIN(xb_ld(&bar[XB_XGEN(b.x)]) == gen, bar);
            __builtin_amdgcn_fence(__ATOMIC_ACQUIRE, "agent");
            asm volatile("s_waitcnt vmcnt(0)" ::: "memory");
        }
    }
    __syncthreads();
}


DI void gsync(cg::grid_group& grid) {
  asm volatile("s_waitcnt vmcnt(0) lgkmcnt(0)" ::: "memory");
  __syncthreads();
  if (threadIdx.x == 0) {
    __builtin_amdgcn_fence(__ATOMIC_RELEASE, "agent");
    asm volatile("s_waitcnt vmcnt(0)" ::: "memory");
  }
  grid.sync();
  if (threadIdx.x == 0) {
    __builtin_amdgcn_fence(__ATOMIC_ACQUIRE, "agent");
    asm volatile("s_waitcnt vmcnt(0)" ::: "memory");
  }
  __syncthreads();
}

DI Params load_params() {
  Params r{};
#if defined(__HIP_DEVICE_COMPILE__)
  const __attribute__((address_space(4))) unsigned long long* q =
      (const __attribute__((address_space(4))) unsigned long long*)__builtin_amdgcn_kernarg_segment_ptr();
  asm volatile("" : "+s"(q));
  unsigned long long* d = (unsigned long long*)&r;
  static_assert(sizeof(Params) % 8 == 0, "Params size");
#pragma unroll
  for (int i = 0; i < (int)(sizeof(Params) / 8); ++i) d[i] = q[i];
#endif
  return r;
}
#define P_ p
__global__ void __launch_bounds__(256, 2) fwd_megakernel(Params p) {
  cg::grid_group grid = cg::this_grid();
  __shared__ __attribute__((aligned(16))) char smem[SMEM_BYTES];
  __shared__ uint4 xb_words;
  if (threadIdx.x == 0) xb_words = make_uint4(0u, 0u, 0u, 0u);
  __syncthreads();
  XcdBarrier xb;
  { const Params lp = P_; xb = xcd_barrier_post((unsigned*)(lp.ws + OFF_BAR), (volatile LAS unsigned*)&xb_words); }
  { const Params lp = P_; phase_prep(lp, smem); }
  xcd_barrier(xb);
  { const Params lp = P_; phase_norm(lp, 0, true, lp.norm1_g, 0, NTOK); }
  { const Params lp = P_; phase_peer_mt(lp, smem); }
  xcd_barrier_fast(xb);
  { const Params lp = P_; phase_inproj0(lp, smem); }
  xcd_barrier_fast(xb);
  { const Params lp = P_; phase_gqa_prep(lp, smem); }
  xcd_barrier_fast(xb);
  { const Params lp = P_; phase_mix0(lp, smem, 0); }
  xcd_barrier_fast(xb);
  { const Params lp = P_; phase_hg_readout(lp); }
  xcd_barrier_fast(xb);
  { const Params lp = P_; phase_outproj(lp, 0, OFF_WT_EVOUT, NTOK, true, smem); }
  xcd_barrier_fast(xb);
#if STAGE_LIMIT >= 2
  { const Params lp = P_; phase_norm(lp, 0, false, lp.norm2_g, 3, NTOK); }
  xcd_barrier_fast(xb);
  { const Params lp = P_; phase_peer_route(lp, 0, NTOK, smem); }
  xcd_barrier_fast(xb);
  { const Params lp = P_; phase_peer_gather(lp, 0, NTOK, false); }
  xcd_barrier_fast(xb);
#endif
#if STAGE_LIMIT >= 3
  { const Params lp = P_; phase_inproj1(lp, smem); }
  xcd_barrier_fast(xb);
  { const Params lp = P_; phase_mla_prep(lp); }
  xcd_barrier_fast(xb);
  { const Params lp = P_; phase_mla_up(lp, smem); }
  xcd_barrier_fast(xb);
  { const Params lp = P_; phase_mix1(lp, smem, 1); }
  xcd_barrier_fast(xb);
  { const Params lp = P_; phase_s5_z(lp); }
  xcd_barrier_fast(xb);
  { const Params lp = P_; phase_glu(lp, smem); }
  xcd_barrier_fast(xb);
  { const Params lp = P_; phase_outproj1(lp, smem); }
  xcd_barrier_fast(xb);
#endif
#if STAGE_LIMIT >= 4
  { const Params lp = P_; phase_norm(lp, 1, false, lp.norm2_g + 1024, 3, NLAT); }
  xcd_barrier_fast(xb);
  { const Params lp = P_; phase_peer_route(lp, 1, NLAT, smem); }
  xcd_barrier_fast(xb);
  { const Params lp = P_; phase_peer_gather(lp, 1, NLAT, false); }
#endif
}

extern "C" void kernel_launch(void* const* d_in, const int* in_sizes, int n_in, void* d_out, int out_size, void* d_ws,
                              size_t ws_size, hipStream_t stream) {
  static int grid_blocks = 0;
  if (!grid_blocks) {
    int dev = 0, cus = 0, per_cu = 0;
    (void)hipGetDevice(&dev);
    (void)hipDeviceGetAttribute(&cus, hipDeviceAttributeMultiprocessorCount, dev);
    (void)hipOccupancyMaxActiveBlocksPerMultiprocessor(&per_cu, fwd_megakernel, 256, 0);
    if (per_cu > 2) per_cu = 2;
    if (per_cu < 1) per_cu = 1;
    grid_blocks = cus * per_cu;
  }
  Params p{};
  const float** pp = (const float**)&p;
  for (int i = 0; i < 35; ++i) pp[i] = (const float*)d_in[i];
  p.out = (float*)d_out;
  p.ws = (char*)d_ws;
  p.rep_mix = REP_MIX; p.rep_route = REP_ROUTE; p.rep_gdry = REP_GDRY; p.rep_gemm = REP_GEMM;
  (void)hipMemsetAsync((char*)d_ws + OFF_CNT, 0, 256 + 16384, stream);
  void* args[] = {&p};
  hipError_t e = hipLaunchCooperativeKernel((void*)fwd_megakernel, dim3(grid_blocks), dim3(256), args, 0, stream);
  if (e != hipSuccess) fprintf(stderr, "cooperative launch failed: %s (grid %d)\n", hipGetErrorString(e), grid_blocks);
}
```
